# Optimizing an MI355X kernel written in HIP

```python
import jax, jax.numpy as jnp
from jax import lax
import numpy as np

D_MODEL = 1024
BATCH = 2
SEQ = 8192
DEPTH = 1

CHUNK = 64
N_ATTN_HEADS = 8
HEAD_DIM = 64
D_ATTN = N_ATTN_HEADS * HEAD_DIM
LEFT_CHUNKS = 8
BAND = (LEFT_CHUNKS + 1) * CHUNK
REL_MAX = 128
REL_MIN = -(CHUNK - 1)
N_REL = REL_MAX - REL_MIN + 1
D_CONV = D_MODEL - D_ATTN
CONV_WIDTH = 31
D_MIX = D_ATTN + D_CONV
D_IN_COLS = 3 * D_ATTN + 2 * D_CONV
N_EXPERTS = 32
TOP_K = 4
D_EXPERT = D_MODEL
SWIGLU_ALPHA = 1.702
SWIGLU_LIMIT = 7.0
RMS_EPS = 1e-5
LN_EPS = 1e-5

kernel_name = "hymba_conformer_chunkattn_moe_block"


def rms_norm(x, g):
    xf = x.astype(jnp.float32)
    y = xf * lax.rsqrt(jnp.mean(xf * xf, axis=-1, keepdims=True) + RMS_EPS)
    return (y * g.astype(jnp.float32)).astype(x.dtype)


def layer_norm(x, g, b):
    xf = x.astype(jnp.float32)
    mu = jnp.mean(xf, axis=-1, keepdims=True)
    var = jnp.mean(jnp.square(xf - mu), axis=-1, keepdims=True)
    y = (xf - mu) * lax.rsqrt(var + LN_EPS)
    return (y * g.astype(jnp.float32) + b.astype(jnp.float32)).astype(x.dtype)


def chunked_rel_attention(q, k, v, rel_bias):
    b, s, h, dh = q.shape
    nc = s // CHUNK
    qc = q.reshape(b, nc, CHUNK, h, dh)
    pad = ((0, 0), (LEFT_CHUNKS * CHUNK, 0), (0, 0), (0, 0))
    kp = jnp.pad(k, pad).reshape(b, nc + LEFT_CHUNKS, CHUNK, h, dh)
    vp = jnp.pad(v, pad).reshape(b, nc + LEFT_CHUNKS, CHUNK, h, dh)
    k_band = jnp.concatenate([kp[:, j:j + nc] for j in range(LEFT_CHUNKS + 1)], axis=2)
    v_band = jnp.concatenate([vp[:, j:j + nc] for j in range(LEFT_CHUNKS + 1)], axis=2)

    iq = jnp.arange(CHUNK)[:, None]
    kk = jnp.arange(BAND)[None, :]
    dist = iq + LEFT_CHUNKS * CHUNK - kk
    idx = jnp.clip(dist, REL_MIN, REL_MAX) - REL_MIN
    bias = rel_bias[:, idx].astype(jnp.float32)

    chunk_of_key = jnp.arange(nc)[:, None] - LEFT_CHUNKS + jnp.arange(BAND)[None, :] // CHUNK
    valid = chunk_of_key >= 0

    scale = HEAD_DIM ** -0.5
    scores = jnp.einsum('bcqhd,bckhd->bchqk', qc, k_band).astype(jnp.float32) * scale
    scores = scores + bias[None, None]
    scores = jnp.where(valid[None, :, None, None, :], scores, -jnp.inf)
    probs = jax.nn.softmax(scores, axis=-1).astype(v.dtype)
    out = jnp.einsum('bchqk,bckhd->bcqhd', probs, v_band)
    return out.reshape(b, s, h * dh)


def conformer_conv(u, dw_w, dw_b, ln_g, ln_b):
    a, gate = jnp.split(u, 2, axis=-1)
    hcv = a * jax.nn.sigmoid(gate)
    hcv = lax.conv_general_dilated(
        hcv, dw_w[:, None, :].astype(hcv.dtype),
        window_strides=(1,),
        padding=((CONV_WIDTH - 1, 0),),
        dimension_numbers=('NWC', 'WIO', 'NWC'),
        feature_group_count=D_CONV) + dw_b
    hcv = layer_norm(hcv, ln_g, ln_b)
    return jax.nn.silu(hcv)


def clamped_swiglu_expert(t, wg, bg, wu, bu, wd, bd):
    gate = jnp.minimum(t @ wg + bg, SWIGLU_LIMIT)
    up = jnp.clip(t @ wu + bu, -SWIGLU_LIMIT, SWIGLU_LIMIT)
    hid = (up + 1.0) * (gate * jax.nn.sigmoid(SWIGLU_ALPHA * gate))
    return hid @ wd + bd


def moe_ffn(x, router_w, router_b, w_gate, b_gate, w_up, b_up, w_down, b_down):
    b, s, d = x.shape
    t = x.reshape(b * s, d)
    logits = (t @ router_w + router_b).astype(jnp.float32)
    top_val, top_idx = lax.top_k(logits, TOP_K)
    top_w = jax.nn.softmax(top_val, axis=-1)
    combine = jnp.sum(jax.nn.one_hot(top_idx, N_EXPERTS, dtype=jnp.float32) * top_w[..., None], axis=1)
    combine = combine.astype(x.dtype)
    y = jnp.zeros_like(t)
    for e in range(N_EXPERTS):
        y = y + combine[:, e:e + 1] * clamped_swiglu_expert(
            t, w_gate[e], b_gate[e], w_up[e], b_up[e], w_down[e], b_down[e])
    return y.reshape(b, s, d)


def setup_inputs(seed: int = 0) -> dict:
    key = jax.random.key(seed)
    ks = jax.random.split(key, 20)
    f32 = jnp.float32
    L = DEPTH

    def nrm(k, shape, scale):
        return scale * jax.random.normal(k, shape, f32)

    return {
        "x": nrm(ks[0], (BATCH, SEQ, D_MODEL), 1.0),
        "norm_mix_g": 1.0 + nrm(ks[1], (L, D_MODEL), 0.02),
        "w_in": nrm(ks[2], (L, D_MODEL, D_IN_COLS), D_MODEL ** -0.5),
        "conv_dw_w": nrm(ks[3], (L, CONV_WIDTH, D_CONV), CONV_WIDTH ** -0.5),
        "conv_dw_b": nrm(ks[4], (L, D_CONV), 0.02),
        "conv_ln_g": 1.0 + nrm(ks[5], (L, D_CONV), 0.02),
        "conv_ln_b": nrm(ks[6], (L, D_CONV), 0.02),
        "rel_bias": nrm(ks[7], (L, N_ATTN_HEADS, N_REL), 0.1),
        "w_out": nrm(ks[8], (L, D_MIX, D_MODEL), D_MIX ** -0.5),
        "norm_ffn_g": 1.0 + nrm(ks[9], (L, D_MODEL), 0.02),
        "router_w": nrm(ks[10], (L, D_MODEL, N_EXPERTS), D_MODEL ** -0.5),
        "router_b": nrm(ks[11], (L, N_EXPERTS), 0.01),
        "exp_w_gate": nrm(ks[12], (L, N_EXPERTS, D_MODEL, D_EXPERT), D_MODEL ** -0.5),
        "exp_b_gate": nrm(ks[13], (L, N_EXPERTS, D_EXPERT), 0.02),
        "exp_w_up": nrm(ks[14], (L, N_EXPERTS, D_MODEL, D_EXPERT), D_MODEL ** -0.5),
        "exp_b_up": nrm(ks[15], (L, N_EXPERTS, D_EXPERT), 0.02),
        "exp_w_down": nrm(ks[16], (L, N_EXPERTS, D_EXPERT, D_MODEL), D_EXPERT ** -0.5),
        "exp_b_down": nrm(ks[17], (L, N_EXPERTS, D_MODEL), 0.02),
        "norm_final_g": 1.0 + nrm(ks[18], (D_MODEL,), 0.02),
    }


def reference(x, norm_mix_g, w_in, conv_dw_w, conv_dw_b, conv_ln_g, conv_ln_b, rel_bias,
              w_out, norm_ffn_g, router_w, router_b, exp_w_gate, exp_b_gate, exp_w_up,
              exp_b_up, exp_w_down, exp_b_down, norm_final_g):
    b, s, _ = x.shape
    for l in range(DEPTH):
        h = rms_norm(x, norm_mix_g[l])
        proj = h @ w_in[l]
        q, k, v, conv_in = jnp.split(proj, [D_ATTN, 2 * D_ATTN, 3 * D_ATTN], axis=-1)
        q = q.reshape(b, s, N_ATTN_HEADS, HEAD_DIM)
        k = k.reshape(b, s, N_ATTN_HEADS, HEAD_DIM)
        v = v.reshape(b, s, N_ATTN_HEADS, HEAD_DIM)
        attn_out = chunked_rel_attention(q, k, v, rel_bias[l])
        conv_out = conformer_conv(conv_in, conv_dw_w[l], conv_dw_b[l],
                                  conv_ln_g[l], conv_ln_b[l])
        mixed = jnp.concatenate([attn_out, conv_out], axis=-1) @ w_out[l]
        x = x + mixed
        x = x + moe_ffn(rms_norm(x, norm_ffn_g[l]), router_w[l], router_b[l],
                        exp_w_gate[l], exp_b_gate[l], exp_w_up[l], exp_b_up[l],
                        exp_w_down[l], exp_b_down[l])
    return rms_norm(x, norm_final_g)
```

```cpp
#include <hip/hip_runtime.h>
#include <cstdio>
#include <cstdint>

#define GAS __attribute__((address_space(1)))
#define LAS __attribute__((address_space(3)))
typedef unsigned short bf16_t;
typedef short bf16x8 __attribute__((ext_vector_type(8)));
typedef short s16x4 __attribute__((ext_vector_type(4)));
typedef float f32x2 __attribute__((ext_vector_type(2)));
typedef float f32x4 __attribute__((ext_vector_type(4)));
typedef float f32x16 __attribute__((ext_vector_type(16)));
typedef unsigned u32x2 __attribute__((ext_vector_type(2)));
typedef unsigned u32x4 __attribute__((ext_vector_type(4)));
typedef GAS unsigned gu32;
#define RLX_AGENT __ATOMIC_RELAXED, __HIP_MEMORY_SCOPE_AGENT
#define LDS_WAIT() asm volatile("s_waitcnt lgkmcnt(0)" ::: "memory")
#define VM_WAIT() asm volatile("s_waitcnt vmcnt(0)" ::: "memory")

constexpr int T = 16384, SEQ = 8192, D = 1024, NIN = 2560, DA = 512, NH = 8, HD = 64, DC = 512, CW = 31;
constexpr int NE = 32, TOPK = 4, NP = T * TOPK, LCAP = 16384, NREL = 192;
constexpr float RMS_EPS = 1e-5f, LN_EPS = 1e-5f, LOG2E = 1.4426950408889634f;
constexpr float QSCALE = 0.125f * LOG2E;

constexpr size_t MiB = 1u << 20;
constexpr size_t WS_CTL = 0, CTL_ZERO_BYTES = 1 * MiB;
constexpr size_t WS_WIN = 1 * MiB, WS_WOUT = 6 * MiB, WS_WGU = 8 * MiB, WS_WD = 136 * MiB, WS_X1 = 200 * MiB, WS_XN = 264 * MiB;
constexpr size_t WS_Q = 296 * MiB, WS_K = 312 * MiB, WS_V = 328 * MiB, WS_A = 344 * MiB, WS_G = 360 * MiB, WS_MIX = 376 * MiB;
constexpr size_t WS_HID = 296 * MiB;
constexpr size_t WS_O = WS_WGU;
constexpr size_t WS_LIST = 424 * MiB, WS_TOPW = 426 * MiB, WS_RWT = 427 * MiB, WS_END = 428 * MiB;
constexpr int CW_TMO = 0, CW_BAR = 4096, CW_CNT = 8192;

constexpr int RING_BYTES = 131072, LDSCTL_OFF = RING_BYTES, XTRA_OFF = LDSCTL_OFF + 512, LDS_BYTES = 147456;
constexpr int NWAVES = 8;

__device__ __forceinline__ unsigned f2bf(float f) { unsigned u = __builtin_bit_cast(unsigned, f); return (u + 0x7fffu + ((u >> 16) & 1u)) >> 16; }
__device__ __forceinline__ unsigned pk2(float lo, float hi) { return f2bf(lo) | (f2bf(hi) << 16); }
__device__ __forceinline__ unsigned cvt_pk_bf16(float lo, float hi) { unsigned r; asm volatile("v_cvt_pk_bf16_f32 %0, %1, %2" : "=v"(r) : "v"(lo), "v"(hi)); return r; }
__device__ __forceinline__ float bf_lo(unsigned w) { return __uint_as_float(w << 16); }
__device__ __forceinline__ float bf_hi(unsigned w) { return __uint_as_float(w & 0xffff0000u); }
__device__ __forceinline__ float fsigmoid(float z) { return __builtin_amdgcn_rcpf(1.0f + __builtin_amdgcn_exp2f(-z * LOG2E)); }
__device__ __forceinline__ float wave_sum(float v) {
#pragma unroll
    for (int o = 1; o < 64; o <<= 1) v += __shfl_xor(v, o);
    return v;
}

namespace pg8 {
constexpr int BM = 256, BK = 64, HALF = 128, HTB = HALF * BK * 2, STAGE_BYTES = 8 * HTB;
__device__ __forceinline__ int lds_byte(int r, int c) { const int st = (r >> 4) * 2 + (c >> 5), rr = r & 15, cc = c & 31, ob = rr * 64 + cc * 2; return st * 1024 + (ob ^ (((ob >> 9) & 1) << 5)); }
__device__ __forceinline__ void stage_rc(int b, int& R, int& C) { const int st = b / 1024, sb = b % 1024, swz = sb ^ (((sb >> 9) & 1) << 5); R = (st >> 1) * 16 + swz / 64; C = (st & 1) * 32 + (swz % 64) / 2; }
__device__ __forceinline__ int perm32(int rho) { const int n = rho >> 4, i = rho & 15; return 8 * (i >> 2) + 4 * n + (i & 3); }

struct Unit { int pm, pn, e, nv; };

template <class Epi, class Sched, bool ALIGN_EPI>
__device__ __forceinline__ void gemm_phase(LAS unsigned char* lds, const char* Abase, const int K, const Sched& S, const Epi& E) {
    const int tid = threadIdx.x, wid = __builtin_amdgcn_readfirstlane(tid >> 6), lane = tid & 63, wr = wid >> 2, wc = wid & 3, fr = lane & 15, fq = lane >> 4;
    const int nt = K / BK;
    int Rr[2], Cc[2]; unsigned voffB[2];
#pragma unroll
    for (int i = 0; i < 2; ++i) { int R, C; stage_rc(tid * 16 + i * 8192, R, C); Rr[i] = R; Cc[i] = C; const int Rb = Epi::PERM ? ((R & ~31) + perm32(R & 31)) : R; voffB[i] = (unsigned)(Rb * K + C) * 2u; }
    const size_t kstep = (size_t)(BK * 2);
    const size_t hstep = (size_t)HALF * K * 2;
    const unsigned ldsw = (unsigned)wid * 1024u;
    const int aoff = lds_byte(wr * 64 + fr, fq * 8), boff = lds_byte(wc * 32 + fr, fq * 8);
#define PG8_SA(b, h) (((b) * 2 + (h)) * HTB)
#define PG8_SB(b, h) ((4 + (b) * 2 + (h)) * HTB)
#define PG8_STAGE(bufoff, gbase, voff) do { _Pragma("unroll") for (int _i = 0; _i < 2; ++_i) \
        __builtin_amdgcn_global_load_lds((const unsigned*)((const char*)(gbase) + (voff)[_i]), (LAS unsigned*)(lds + (bufoff) + ldsw + _i * 8192), 16, 0, 0); } while (0)
#define PG8_LDA(dst, b, h) do { _Pragma("unroll") for (int m = 0; m < 4; ++m) _Pragma("unroll") for (int k = 0; k < 2; ++k) dst[m][k] = *(const LAS bf16x8*)(lds + PG8_SA(b, h) + aoff + m * 2048 + k * 1024); } while (0)
#define PG8_LDB(dst, b, h) do { _Pragma("unroll") for (int n = 0; n < 2; ++n) _Pragma("unroll") for (int k = 0; k < 2; ++k) dst[n][k] = *(const LAS bf16x8*)(lds + PG8_SB(b, h) + boff + n * 2048 + k * 1024); } while (0)
#define PG8_MMA(ai, bj, At, Bt) do { __builtin_amdgcn_s_setprio(1); _Pragma("unroll") for (int m = 0; m < 4; ++m) _Pragma("unroll") for (int n = 0; n < 2; ++n) _Pragma("unroll") for (int k = 0; k < 2; ++k) \
        acc[ai][bj][m][n] = __builtin_amdgcn_mfma_f32_16x16x32_bf16(Bt[n][k], At[m][k], acc[ai][bj][m][n], 0, 0, 0); __builtin_amdgcn_s_setprio(0); } while (0)
#define PG8_WAIT_V(n) asm volatile("s_waitcnt vmcnt(" #n ")" ::: "memory")
#define PG8_WAIT_L(n) asm volatile("s_waitcnt lgkmcnt(" #n ")" ::: "memory")
#define PG8_BAR __builtin_amdgcn_s_barrier()
#define PG8_SCHED __builtin_amdgcn_sched_barrier(0)
    Unit cur, nxt; int ui = 0;
    if (!S.next(0, cur)) return;
    f32x4 acc[2][2][4][2];
#pragma unroll
    for (int a = 0; a < 2; ++a)
#pragma unroll
        for (int b = 0; b < 2; ++b)
#pragma unroll
            for (int m = 0; m < 4; ++m)
#pragma unroll
                for (int n = 0; n < 2; ++n) acc[a][b][m][n] = (f32x4){0.f, 0.f, 0.f, 0.f};
    bf16x8 At[4][2], B0[2][2], B1[2][2];
    unsigned vA0[2], vA1[2], vN0[2], vN1[2];
    S.a_off(cur, Rr, Cc, K, vA0, vA1);
    const char* cB = S.b_ptr(cur, K);
    const char* cA = Abase;
    PG8_STAGE(PG8_SB(0, 0), cB, voffB); PG8_STAGE(PG8_SB(0, 1), cB + hstep, voffB); PG8_STAGE(PG8_SA(0, 0), cA, vA0); PG8_STAGE(PG8_SA(0, 1), cA, vA1);
    if (wr == 1) PG8_BAR;
    PG8_WAIT_V(2); PG8_BAR;
    PG8_STAGE(PG8_SB(1, 0), cB + kstep, voffB); PG8_STAGE(PG8_SA(1, 0), cA + kstep, vA0); PG8_STAGE(PG8_SB(1, 1), cB + hstep + kstep, voffB);
    PG8_WAIT_V(6); PG8_BAR;
    for (;;) {
        const bool has_next = S.next(ui + 1, nxt);
        const char* nB = cB;
        if (has_next) { S.a_off(nxt, Rr, Cc, K, vN0, vN1); nB = S.b_ptr(nxt, K); }
        else { vN0[0] = vA0[0]; vN0[1] = vA0[1]; vN1[0] = vA1[0]; vN1[1] = vA1[1]; }
        for (int t = 0; t < nt; t += 2) {
            const bool last = (t == nt - 2);
            const char* a1 = cA + (size_t)(t + 1) * kstep;
            const char* a2 = last ? cA : cA + (size_t)(t + 2) * kstep; const char* b2 = last ? nB : cB + (size_t)(t + 2) * kstep;
            const char* a3 = a2 + kstep; const char* b3 = b2 + kstep;
            unsigned w0[2], w1[2];
            w0[0] = last ? vN0[0] : vA0[0]; w0[1] = last ? vN0[1] : vA0[1]; w1[0] = last ? vN1[0] : vA1[0]; w1[1] = last ? vN1[1] : vA1[1];
            PG8_LDB(B0, 0, 0); PG8_LDB(B1, 0, 1); PG8_SCHED; PG8_LDA(At, 0, 0); PG8_STAGE(PG8_SA(1, 1), a1, vA1);
            PG8_WAIT_V(8); PG8_WAIT_L(0); PG8_BAR; PG8_MMA(0, 0, At, B0); PG8_MMA(0, 1, At, B1); PG8_BAR; PG8_SCHED;
            PG8_LDA(At, 0, 1); PG8_STAGE(PG8_SB(0, 0), b2, voffB); PG8_STAGE(PG8_SB(0, 1), b2 + hstep, voffB); PG8_STAGE(PG8_SA(0, 0), a2, w0);
            PG8_WAIT_V(8); PG8_WAIT_L(0); PG8_BAR; PG8_MMA(1, 0, At, B0); PG8_MMA(1, 1, At, B1); PG8_BAR; PG8_SCHED;
            PG8_LDB(B0, 1, 0); PG8_LDB(B1, 1, 1); PG8_SCHED; PG8_LDA(At, 1, 0); PG8_STAGE(PG8_SA(0, 1), a2, w1);
            PG8_WAIT_V(8); PG8_WAIT_L(0); PG8_BAR; PG8_MMA(0, 0, At, B0); PG8_MMA(0, 1, At, B1); PG8_BAR; PG8_SCHED;
            PG8_LDA(At, 1, 1); PG8_STAGE(PG8_SB(1, 0), b3, voffB); PG8_STAGE(PG8_SB(1, 1), b3 + hstep, voffB); PG8_STAGE(PG8_SA(1, 0), a3, w0);
            PG8_WAIT_V(8); PG8_WAIT_L(0); PG8_BAR; PG8_MMA(1, 0, At, B0); PG8_MMA(1, 1, At, B1); PG8_BAR; PG8_SCHED;
        }
        if constexpr (ALIGN_EPI) { if (wr == 0) PG8_BAR; }
        E(acc, cur, wr, wc, fr, fq);
        if (!has_next) break;
#pragma unroll
        for (int a = 0; a < 2; ++a)
#pragma unroll
            for (int b = 0; b < 2; ++b)
#pragma unroll
                for (int m = 0; m < 4; ++m)
#pragma unroll
                    for (int n = 0; n < 2; ++n) acc[a][b][m][n] = (f32x4){0.f, 0.f, 0.f, 0.f};
        cur = nxt; cB = nB; ++ui;
        vA0[0] = vN0[0]; vA0[1] = vN0[1]; vA1[0] = vN1[0]; vA1[1] = vN1[1];
        if constexpr (ALIGN_EPI) { if (wr == 1) PG8_BAR; }
    }
    PG8_WAIT_V(0);
    if constexpr (!ALIGN_EPI) { if (wr == 0) PG8_BAR; }
    PG8_BAR;
#undef PG8_SA
#undef PG8_SB
#undef PG8_STAGE
#undef PG8_LDA
#undef PG8_LDB
#undef PG8_MMA
#undef PG8_WAIT_V
#undef PG8_WAIT_L
#undef PG8_BAR
#undef PG8_SCHED
}

struct DenseOrder {
    int nM, nN, nwg, G, c; const char* Bt;
    __device__ __forceinline__ void init(int M, int N, int G_, int c_, const void* Bt_) { nM = M / BM; nN = N / BM; nwg = nM * nN; G = G_; c = c_; Bt = (const char*)Bt_; }
    __device__ __forceinline__ bool next(int i, Unit& u) const {
        const long L = (long)i * G + c; if (L >= nwg) return false;
        int wgid = (int)L; { const int q = nwg / 8, r = nwg % 8, xcd = wgid % 8, off = wgid / 8; wgid = (xcd < r ? xcd * (q + 1) : r * (q + 1) + (xcd - r) * q) + off; }
        const int nig = 8 * nN, gid = wgid / nig, fm = gid * 8, gsz = (nM - fm) < 8 ? (nM - fm) : 8;
        u.pm = fm + ((wgid % nig) % gsz); u.pn = (wgid % nig) / gsz; u.e = 0; u.nv = 256; return true;
    }
    __device__ __forceinline__ const char* b_ptr(const Unit& u, int K) const { return Bt + (size_t)u.pn * (256 * (size_t)K * 2); }
    __device__ __forceinline__ void a_off(const Unit& u, const int (&R)[2], const int (&C)[2], int K, unsigned (&v0)[2], unsigned (&v1)[2]) const {
#pragma unroll
        for (int i = 0; i < 2; ++i) { v0[i] = (unsigned)((u.pm * 256 + R[i]) * K + C[i]) * 2u; v1[i] = (unsigned)((u.pm * 256 + 128 + R[i]) * K + C[i]) * 2u; }
    }
};
struct MoeOrder {
    const LAS int* tstart;
    const LAS int* cnt;
    const int* list;
    const char* Bt; int npn, nrowsB, shiftA;
    int xg, j, nper;
    __device__ __forceinline__ bool next(int i, Unit& u) const {
        const int B = i * 8 + xg, rg = nper / npn, R = rg * B + j / npn;
        const int Rtot = tstart[NE];
        if (R >= Rtot) return false;
        int e = 0;
#pragma unroll 1
        for (int q = 1; q < NE; ++q) e += (tstart[q] <= R) ? 1 : 0;
        u.e = e; u.pm = R - tstart[e]; u.pn = j % npn; const int rem = cnt[e] - u.pm * 256; u.nv = rem < 256 ? rem : 256; return true;
    }
    __device__ __forceinline__ const char* b_ptr(const Unit& u, int K) const { return Bt + ((size_t)u.e * nrowsB + (size_t)u.pn * 256) * ((size_t)K * 2); }
    __device__ __forceinline__ void a_off(const Unit& u, const int (&R)[2], const int (&C)[2], int K, unsigned (&v0)[2], unsigned (&v1)[2]) const {
        const int* le = list + (size_t)u.e * LCAP + u.pm * 256;
#pragma unroll
        for (int i = 0; i < 2; ++i) {
            const int r0 = R[i] < u.nv ? R[i] : 0, r1 = (128 + R[i]) < u.nv ? (128 + R[i]) : 0;
            const int p0 = le[r0] >> shiftA, p1 = le[r1] >> shiftA;
            v0[i] = (unsigned)(p0 * K + C[i]) * 2u; v1[i] = (unsigned)(p1 * K + C[i]) * 2u; }
    }
};

struct EpiSplit {
    static constexpr bool PERM = true;
    bf16_t* O; size_t split_stride; float scale0;
    __device__ __forceinline__ void operator()(const f32x4 (&acc)[2][2][4][2], const Unit& u, int wr, int wc, int fr, int fq) const {
        const int row0 = u.pm * BM + wr * 64 + fr; int colt = u.pn * BM; const int t = colt / 512; bf16_t* base = O + (size_t)t * split_stride; colt -= t * 512;
        const float sc = (t == 0) ? scale0 : 1.f;
        const int col0 = colt + wc * 32 + 8 * fq;
#pragma unroll
        for (int ai = 0; ai < 2; ++ai)
#pragma unroll
            for (int m = 0; m < 4; ++m) { bf16_t* rowp = base + (size_t)(row0 + ai * HALF + m * 16) * 512 + col0;
#pragma unroll
                for (int bj = 0; bj < 2; ++bj) { const f32x4 v0 = acc[ai][bj][m][0] * sc, v1 = acc[ai][bj][m][1] * sc;
                    u32x4 w; w.x = cvt_pk_bf16(v0[0], v0[1]); w.y = cvt_pk_bf16(v0[2], v0[3]); w.z = cvt_pk_bf16(v1[0], v1[1]); w.w = cvt_pk_bf16(v1[2], v1[3]);
                    *(u32x4*)(rowp + bj * HALF) = w; } }
    }
};
struct EpiRes {
    static constexpr bool PERM = false;
    const float* base; float* out;
    __device__ __forceinline__ void operator()(const f32x4 (&acc)[2][2][4][2], const Unit& u, int wr, int wc, int fr, int fq) const {
        const int row0 = u.pm * BM + wr * 64 + fr, col0 = u.pn * BM + wc * 32 + 4 * fq;
#pragma unroll
        for (int ai = 0; ai < 2; ++ai)
#pragma unroll
            for (int m = 0; m < 4; ++m) { const size_t off = (size_t)(row0 + ai * HALF + m * 16) * D + col0;
#pragma unroll
                for (int bj = 0; bj < 2; ++bj)
#pragma unroll
                    for (int n = 0; n < 2; ++n) *(f32x4*)(out + off + bj * HALF + n * 16) = *(const f32x4*)(base + off + bj * HALF + n * 16) + acc[ai][bj][m][n]; }
    }
};
struct EpiGU {
    static constexpr bool PERM = true;
    bf16_t* hid; const int* list; const float* bg; const float* bu;
    __device__ __forceinline__ void operator()(const f32x4 (&acc)[2][2][4][2], const Unit& u, int wr, int wc, int fr, int fq) const {
        const int hc = u.pn * 128 + wc * 32 + 8 * fq;
        const float* pg = bg + (size_t)u.e * D + hc; const float* pu = bu + (size_t)u.e * D + hc;
        const f32x4 g0 = *(const f32x4*)pg, g1 = *(const f32x4*)(pg + 4), u0 = *(const f32x4*)pu, u1 = *(const f32x4*)(pu + 4);
        const int* le = list + (size_t)u.e * LCAP + u.pm * 256;
#pragma unroll
        for (int ai = 0; ai < 2; ++ai)
#pragma unroll
            for (int m = 0; m < 4; ++m) { const int r = ai * HALF + wr * 64 + m * 16 + fr;
                if (r < u.nv) { const int p = le[r];
                    float h[8];
#pragma unroll
                    for (int n = 0; n < 2; ++n)
#pragma unroll
                        for (int x = 0; x < 4; ++x) { float g = acc[ai][0][m][n][x] + (n ? g1[x] : g0[x]); float up = acc[ai][1][m][n][x] + (n ? u1[x] : u0[x]);
                            g = fminf(g, 7.0f); up = fminf(fmaxf(up, -7.0f), 7.0f); h[n * 4 + x] = (up + 1.0f) * (g * fsigmoid(1.702f * g)); }
                    u32x4 w; w.x = cvt_pk_bf16(h[0], h[1]); w.y = cvt_pk_bf16(h[2], h[3]); w.z = cvt_pk_bf16(h[4], h[5]); w.w = cvt_pk_bf16(h[6], h[7]);
                    *(u32x4*)(hid + (size_t)p * D + hc) = w; } }
    }
};
struct EpiDown {
    static constexpr bool PERM = true;
    bf16_t* o; const int* list; const float* bd;
    __device__ __forceinline__ void operator()(const f32x4 (&acc)[2][2][4][2], const Unit& u, int wr, int wc, int fr, int fq) const {
        const int c0 = u.pn * BM + wc * 32 + 8 * fq;
        const float* pb = bd + (size_t)u.e * D + c0;
        f32x4 bv[2][2];
#pragma unroll
        for (int bj = 0; bj < 2; ++bj)
#pragma unroll
            for (int n = 0; n < 2; ++n) bv[bj][n] = *(const f32x4*)(pb + bj * HALF + 4 * n);
        const int* le = list + (size_t)u.e * LCAP + u.pm * 256;
#pragma unroll
        for (int ai = 0; ai < 2; ++ai)
#pragma unroll
            for (int m = 0; m < 4; ++m) { const int r = ai * HALF + wr * 64 + m * 16 + fr;
                if (r < u.nv) { const int p = le[r]; bf16_t* rowp = o + (size_t)p * D + c0;
#pragma unroll
                    for (int bj = 0; bj < 2; ++bj) { const f32x4 v0 = acc[ai][bj][m][0] + bv[bj][0], v1 = acc[ai][bj][m][1] + bv[bj][1];
                        u32x4 w; w.x = cvt_pk_bf16(v0[0], v0[1]); w.y = cvt_pk_bf16(v0[2], v0[3]); w.z = cvt_pk_bf16(v1[0], v1[1]); w.w = cvt_pk_bf16(v1[2], v1[3]);
                        *(u32x4*)(rowp + bj * HALF) = w; } } }
    }
};
}

#define XB_TMO      128
#define XB_XCNT(j)  (256  + 64 * (j))
#define XB_XSUB(j)  (1280 + 64 * (j))
#define XB_XGEN(j)  (2304 + 64 * (j))
#define XB_TOP      3328
#define XB_TOPGEN   3392
#define XCD_BAR_WORDS 3456
#define XB_SPIN_CAP (1u << 18)
__device__ __forceinline__ unsigned xb_ld(unsigned* p)              { return __hip_atomic_load(p, __ATOMIC_RELAXED, __HIP_MEMORY_SCOPE_AGENT); }
__device__ __forceinline__ unsigned xb_add(unsigned* p, unsigned v) { return __hip_atomic_fetch_add(p, v, __ATOMIC_RELAXED, __HIP_MEMORY_SCOPE_AGENT); }
__device__ __forceinline__ unsigned xb_xcc_id() { return (unsigned)__builtin_amdgcn_s_getreg((3 << 11) | 20) & 0xFu; }
#define XB_SPIN(cond, bar) do { unsigned _sp = 0; while (cond) { __builtin_amdgcn_s_sleep(1); \
    if ((++_sp & 255u) == 0u) { if (xb_ld(&(bar)[XB_TMO])) break; if (_sp > XB_SPIN_CAP) { atomicAdd(&(bar)[XB_TMO], 1u); break; } } } } while (0)
struct XcdBarrier { unsigned* bar; unsigned x; volatile LAS unsigned* st; };
__device__ __forceinline__ XcdBarrier xcd_barrier_post(unsigned* bar, volatile LAS unsigned* st) {
    XcdBarrier b; b.bar = bar; b.x = xb_xcc_id(); b.st = st;
    if (threadIdx.x == 0) (void)xb_add(&bar[XB_XCNT(b.x)], 1u);
    return b;
}
__device__ __forceinline__ void xcd_barrier_complete(unsigned* bar, unsigned x, unsigned& nloc, unsigned& nx) {
    const unsigned G = gridDim.x * gridDim.y * gridDim.z;
    unsigned sum, cnt, mine, sp = 0u;
    for (;;) {
        sum = 0u; cnt = 0u; mine = 0u;
#pragma unroll
        for (unsigned j = 0; j < 16; ++j) { const unsigned c = xb_ld(&bar[XB_XCNT(j)]); sum += c; cnt += (c > 0u) ? 1u : 0u; mine = (j == x) ? c : mine; }
        if (sum == G) break;
        __builtin_amdgcn_s_sleep(1);
        if ((++sp & 255u) == 0u) { if (xb_ld(&bar[XB_TMO])) break; if (sp > XB_SPIN_CAP) { atomicAdd(&bar[XB_TMO], 1u); break; } }
    }
    nloc = mine > 0u ? mine : 1u; nx = cnt > 0u ? cnt : 1u;
}
__device__ __forceinline__ void xcd_barrier(const XcdBarrier& b) {
    asm volatile("s_waitcnt vmcnt(0)" ::: "memory");
    __syncthreads();
    if (threadIdx.x == 0) {
        unsigned* bar = b.bar;
        __builtin_amdgcn_s_waitcnt(0);
        unsigned nloc = b.st[0], nx = b.st[1];
        if (nloc == 0u) { xcd_barrier_complete(bar, b.x, nloc, nx); b.st[0] = nloc; b.st[1] = nx; }
        const unsigned old = xb_add(&bar[XB_XSUB(b.x)], 1u);
        const unsigned gen = old / nloc;
        if (old + 1u == (gen + 1u) * nloc) {
            __builtin_amdgcn_fence(__ATOMIC_RELEASE, "agent");
            asm volatile("s_waitcnt vmcnt(0)" ::: "memory");
            const unsigned og = xb_add(&bar[XB_TOP], 1u);
            const unsigned tg = og / nx;
            if (og + 1u == (tg + 1u) * nx) xb_add(&bar[XB_TOPGEN], 1u);
            else XB_SPIN(xb_ld(&bar[XB_TOPGEN]) == tg, bar);
            __builtin_amdgcn_fence(__ATOMIC_ACQUIRE, "agent");
            xb_add(&bar[XB_XGEN(b.x)], 1u);
            asm volatile("s_waitcnt vmcnt(0)" ::: "memory");
        } else {
            XB_SPIN(xb_ld(&bar[XB_XGEN(b.x)]) == gen, bar);
            __builtin_amdgcn_fence(__ATOMIC_ACQUIRE, "agent");
            asm volatile("s_waitcnt vmcnt(0)" ::: "memory");
        }
    }
    __syncthreads();
}

struct Frame {
    LAS unsigned char* lds;
    gu32* ctl;
    int tid, lane, wave, G, vcu;
};

__device__ __forceinline__ void transpose_item(const float* W, int N, int k0, int n0, bf16_t* dst, int K, LAS float* scr, int lane) {
    f32x4 v[8];
#pragma unroll
    for (int it = 0; it < 8; ++it) v[it] = *(const GAS f32x4*)(W + (size_t)(k0 + it * 8 + (lane >> 3)) * N + n0 + 4 * (lane & 7));
#pragma unroll
    for (int it = 0; it < 8; ++it) { LAS float* s = scr + (it * 8 + (lane >> 3)) * 33 + 4 * (lane & 7); s[0] = v[it].x; s[1] = v[it].y; s[2] = v[it].z; s[3] = v[it].w; }
    LDS_WAIT(); asm volatile("" ::: "memory");
    const int c = lane & 7;
#pragma unroll
    for (int j = 0; j < 4; ++j) { const int n = (lane >> 3) + 8 * j; const LAS float* s = scr + (8 * c) * 33 + n;
        u32x4 o; o.x = pk2(s[0 * 33], s[1 * 33]); o.y = pk2(s[2 * 33], s[3 * 33]); o.z = pk2(s[4 * 33], s[5 * 33]); o.w = pk2(s[6 * 33], s[7 * 33]);
        *(GAS u32x4*)(dst + (size_t)n * K + k0 + 8 * c) = o; }
    LDS_WAIT(); asm volatile("" ::: "memory");
}

struct Args { const float* in[19]; float* out; unsigned char* ws; int ph_lo, ph_hi; };

namespace att {
constexpr int SLOT = 8192, NSL = 5;
constexpr int L_K = 0, L_V = NSL * SLOT, L_WS = 2 * NSL * SLOT, L_BIAS = L_WS + 8 * 256, L_OST = L_BIAS + 1024, L_END = L_OST + 8 * 4096;
__device__ __forceinline__ int crow(int r, int hi) { return (r & 3) + 8 * (r >> 2) + 4 * hi; }
__device__ __forceinline__ s16x4 vtr(const LAS char* p) { typedef short v4i16_t __attribute__((ext_vector_type(4))); return __builtin_bit_cast(s16x4, __builtin_amdgcn_ds_read_tr16_b64_v4i16((LAS v4i16_t*)p)); }

__device__ __forceinline__ void unit(const Frame& F, int b, int h, int cg, const bf16_t* Q, const bf16_t* Kb, const bf16_t* Vb, bf16_t* MIX, const float* relb) {
    LAS char* lds = (LAS char*)F.lds;
    const int tid = F.tid, lane = F.lane, wid = F.wave, r32 = lane & 31, hi = lane >> 5;
    const int wp = wid >> 1, half = wid & 1;
    const int c = 4 * cg + wp;
    const long rowbase = (long)b * SEQ;
    LAS float* wsf = (LAS float*)(lds + L_WS) + wid * 64;
    LAS float* tb = (LAS float*)(lds + L_BIAS);
    if (tid < 256) { const int i = tid < NREL ? tid : NREL - 1; tb[tid] = relb[h * NREL + i] * LOG2E; }
    const float cbias = relb[h * NREL + NREL - 1] * LOG2E;
    const bf16_t* Qw = Q + (rowbase + c * 64 + half * 32 + r32) * DA + h * HD;
    bf16x8 qr[4];
#pragma unroll
    for (int d0 = 0; d0 < 4; ++d0) qr[d0] = *(const GAS bf16x8*)(Qw + d0 * 16 + hi * 8);
    const int kc0 = 4 * cg - 8;
    const int krow = tid & 63, kch = tid >> 6;
    const int vrow = tid >> 3, vch = tid & 7;
    const bf16_t* ksrc = Kb + (rowbase + krow) * DA + h * HD + kch * 8;
    const bf16_t* vsrc = Vb + (rowbase + vrow) * DA + h * HD + vch * 8;
    const int kdst = L_K + kch * 1024 + krow * 16, vdst = L_V + (vch >> 2) * 4096 + vrow * 64 + (vch & 3) * 16;
#pragma unroll
    for (int j = 0; j < 4; ++j) { const int kc = kc0 + j;
        if (kc >= 0) { const u32x4 kv = *(const GAS u32x4*)(ksrc + (long)kc * 64 * DA); const u32x4 vv = *(const GAS u32x4*)(vsrc + (long)kc * 64 * DA);
            *(LAS u32x4*)(lds + kdst + j * SLOT) = kv; *(LAS u32x4*)(lds + vdst + j * SLOT) = vv; } }
    float m_run = -INFINITY, l_run = 0.f; f32x16 o[2]; o[0] = f32x16{}; o[1] = f32x16{};
    const int qin = half * 32 + r32;
#pragma unroll 1
    for (int s = 0; s < 9; ++s) {
        __syncthreads();
        const int jn = s + 4, kcn = kc0 + jn; const bool ldn = (jn < 12) && (kcn >= 0);
        u32x4 kv = (u32x4){0u, 0u, 0u, 0u}, vv = (u32x4){0u, 0u, 0u, 0u};
        if (ldn) { kv = *(const GAS u32x4*)(ksrc + (long)kcn * 64 * DA); vv = *(const GAS u32x4*)(vsrc + (long)kcn * 64 * DA); }
        const int j = wp + s, kc = kc0 + j;
        if (kc >= 0) {
            const int slot = (j % NSL) * SLOT;
            const LAS char* kp = lds + L_K + slot + hi * 1024 + r32 * 16;
            f32x16 p0 = f32x16{}, p1 = f32x16{};
#pragma unroll
            for (int d0 = 0; d0 < 4; ++d0) {
                const bf16x8 b0 = *(const LAS bf16x8*)(kp + d0 * 2048), b1 = *(const LAS bf16x8*)(kp + d0 * 2048 + 512);
                p0 = __builtin_amdgcn_mfma_f32_32x32x16_bf16(b0, qr[d0], p0, 0, 0, 0); p1 = __builtin_amdgcn_mfma_f32_32x32x16_bf16(b1, qr[d0], p1, 0, 0, 0); }
            if (s >= 6) { const int ib = qin + 64 * (8 - s) + 63 - 4 * hi;
#pragma unroll
                for (int r = 0; r < 16; ++r) { const int off = (r & 3) + 8 * (r >> 2); p0[r] += tb[ib - off]; p1[r] += tb[ib - off - 32]; }
            } else {
#pragma unroll
                for (int r = 0; r < 16; ++r) { p0[r] += cbias; p1[r] += cbias; }
            }
            float mx = p0[0];
#pragma unroll
            for (int r = 1; r < 16; ++r) mx = fmaxf(mx, p0[r]);
#pragma unroll
            for (int r = 0; r < 16; ++r) mx = fmaxf(mx, p1[r]);
            mx = fmaxf(mx, __shfl_xor(mx, 32));
            const float m_new = fmaxf(m_run, mx);
            const float alpha = __builtin_amdgcn_exp2f(m_run - m_new);
            float rs = 0.f;
#pragma unroll
            for (int r = 0; r < 16; ++r) { p0[r] = __builtin_amdgcn_exp2f(p0[r] - m_new); p1[r] = __builtin_amdgcn_exp2f(p1[r] - m_new); rs += p0[r] + p1[r]; }
            l_run = l_run * alpha + rs;
            if (__any(m_new > m_run)) {
                if (hi == 0) wsf[r32] = alpha;
                LDS_WAIT();
#pragma unroll
                for (int r = 0; r < 16; ++r) { const float f = wsf[crow(r, hi)]; o[0][r] *= f; o[1][r] *= f; }
            }
            m_run = m_new;
            u32x4 pw[4];
#pragma unroll
            for (int q = 0; q < 4; ++q) { pw[0][q] = cvt_pk_bf16(p0[2 * q], p0[2 * q + 1]); pw[1][q] = cvt_pk_bf16(p0[8 + 2 * q], p0[8 + 2 * q + 1]);
                                          pw[2][q] = cvt_pk_bf16(p1[2 * q], p1[2 * q + 1]); pw[3][q] = cvt_pk_bf16(p1[8 + 2 * q], p1[8 + 2 * q + 1]); }
            const LAS char* vp = lds + L_V + slot + ((lane >> 4) & 1) * 32 + (lane & 3) * 8 + (4 * hi + ((lane & 15) >> 2)) * 64;
#pragma unroll
            for (int d0 = 0; d0 < 2; ++d0)
#pragma unroll
                for (int ks = 0; ks < 4; ++ks) {
                    const s16x4 lo = vtr(vp + d0 * 4096 + ks * 1024), hh = vtr(vp + d0 * 4096 + ks * 1024 + 512);
                    const bf16x8 vf = (bf16x8){lo[0], lo[1], lo[2], lo[3], hh[0], hh[1], hh[2], hh[3]};
                    o[d0] = __builtin_amdgcn_mfma_f32_32x32x16_bf16(__builtin_bit_cast(bf16x8, pw[ks]), vf, o[d0], 0, 0, 0); }
        }
        if (ldn) { const int sl = (jn % NSL) * SLOT; *(LAS u32x4*)(lds + kdst + sl) = kv; *(LAS u32x4*)(lds + vdst + sl) = vv; }
    }
    l_run += __shfl_xor(l_run, 32);
    if (hi == 0) wsf[32 + r32] = l_run;
    LDS_WAIT();
    LAS bf16_t* stg = (LAS bf16_t*)(lds + L_OST) + wid * 2048;
#pragma unroll
    for (int r = 0; r < 16; ++r) { const int orow = crow(r, hi); const float rl = __builtin_amdgcn_rcpf(wsf[32 + orow]);
#pragma unroll
        for (int d0 = 0; d0 < 2; ++d0) stg[orow * 64 + d0 * 32 + r32] = (bf16_t)f2bf(o[d0][r] * rl); }
    LDS_WAIT();
    bf16_t* Ow = MIX + (rowbase + c * 64 + half * 32) * D + h * HD;
#pragma unroll
    for (int i = 0; i < 4; ++i) { const int row = i * 8 + (lane >> 3), ch = lane & 7; const u32x4 v = *(const LAS u32x4*)(stg + row * 64 + ch * 8); *(GAS u32x4*)(Ow + (long)row * D + ch * 8) = v; }
    __syncthreads();
}
}

namespace cv {
constexpr int TT = 32, UR = TT + CW - 1;
constexpr int L_U = 0, L_Y = UR * DC * 2  , L_END = L_Y + TT * DC * 4;
__device__ __forceinline__ void unit(const Frame& F, int b, int tt, const bf16_t* Ab, const bf16_t* Gb, bf16_t* MIX, const float* dw_w, const float* dw_b, const float* ln_g, const float* ln_b) {
    LAS char* lds = (LAS char*)F.lds;
    const int tid = F.tid, lane = F.lane, wid = F.wave;
    const int t0 = tt * TT; const long rowbase = (long)b * SEQ;
    for (int idx = tid; idx < UR * 64; idx += 512) { const int r = idx >> 6, c8 = idx & 63; const int tok = t0 - (CW - 1) + r;
        u32x4 w = (u32x4){0u, 0u, 0u, 0u};
        if (tok >= 0) { const u32x4 av = *(const GAS u32x4*)(Ab + (rowbase + tok) * DC + c8 * 8), gv = *(const GAS u32x4*)(Gb + (rowbase + tok) * DC + c8 * 8);
#pragma unroll
            for (int q = 0; q < 4; ++q) { const float u0 = bf_lo(av[q]) * fsigmoid(bf_lo(gv[q])), u1 = bf_hi(av[q]) * fsigmoid(bf_hi(gv[q])); w[q] = cvt_pk_bf16(u0, u1); } }
        *(LAS u32x4*)(lds + L_U + r * (DC * 2) + c8 * 16) = w; }
    __syncthreads();
    { const int cp = tid & 255, th = tid >> 8;
      f32x2 w[CW];
#pragma unroll
      for (int j = 0; j < CW; ++j) w[j] = *(const GAS f32x2*)(dw_w + j * DC + 2 * cp);
      const f32x2 bias = *(const GAS f32x2*)(dw_b + 2 * cp);
#pragma unroll 1
      for (int blk = 0; blk < 2; ++blk) { const int tbk = th * 16 + blk * 8;
          f32x2 acc[8];
#pragma unroll
          for (int k = 0; k < 8; ++k) acc[k] = bias;
#pragma unroll
          for (int i = 0; i < 8 + CW - 1; ++i) { const unsigned uw = *(const LAS unsigned*)(lds + L_U + (tbk + i) * (DC * 2) + cp * 4); const f32x2 uv = (f32x2){bf_lo(uw), bf_hi(uw)};
#pragma unroll
              for (int k = 0; k < 8; ++k) { const int j = i - k; if (j >= 0 && j < CW) acc[k] += uv * w[j]; } }
#pragma unroll
          for (int k = 0; k < 8; ++k) *(LAS f32x2*)(lds + L_Y + (tbk + k) * (DC * 4) + cp * 8) = acc[k]; } }
    __syncthreads();
    { const f32x4 g0 = *(const GAS f32x4*)(ln_g + 8 * lane), g1 = *(const GAS f32x4*)(ln_g + 8 * lane + 4), b0 = *(const GAS f32x4*)(ln_b + 8 * lane), b1 = *(const GAS f32x4*)(ln_b + 8 * lane + 4);
#pragma unroll
      for (int q = 0; q < 4; ++q) { const int t = wid * 4 + q;
          f32x4 y0 = *(const LAS f32x4*)(lds + L_Y + t * (DC * 4) + lane * 32), y1 = *(const LAS f32x4*)(lds + L_Y + t * (DC * 4) + lane * 32 + 16);
          const float mean = wave_sum((y0.x + y0.y) + (y0.z + y0.w) + (y1.x + y1.y) + (y1.z + y1.w)) * (1.f / DC);
          y0 = y0 - mean; y1 = y1 - mean;
          const float var = wave_sum((y0.x * y0.x + y0.y * y0.y) + (y0.z * y0.z + y0.w * y0.w) + (y1.x * y1.x + y1.y * y1.y) + (y1.z * y1.z + y1.w * y1.w)) * (1.f / DC);
          const float rstd = 1.0f / sqrtf(var + LN_EPS);
          y0 = y0 * rstd * g0 + b0; y1 = y1 * rstd * g1 + b1;
          float z[8] = {y0.x, y0.y, y0.z, y0.w, y1.x, y1.y, y1.z, y1.w};
#pragma unroll
          for (int i = 0; i < 8; ++i) z[i] = z[i] * fsigmoid(z[i]);
          u32x4 w; w.x = cvt_pk_bf16(z[0], z[1]); w.y = cvt_pk_bf16(z[2], z[3]); w.z = cvt_pk_bf16(z[4], z[5]); w.w = cvt_pk_bf16(z[6], z[7]);
          *(GAS u32x4*)(MIX + (rowbase + t0 + t) * D + DA + 8 * lane) = w; } }
    __syncthreads();
}
}

__global__ void __launch_bounds__(NWAVES * 64, 2) hymba_fwd(Args args) {
    extern __shared__ __attribute__((aligned(16))) unsigned char lds_raw[];
    Frame F;
    F.lds = (LAS unsigned char*)lds_raw;
    F.tid = threadIdx.x; F.lane = F.tid & 63; F.wave = __builtin_amdgcn_readfirstlane(F.tid >> 6);
    F.G = gridDim.x; { const int bx = blockIdx.x; F.vcu = (F.G % 8 == 0) ? (bx % 8) * (F.G / 8) + bx / 8 : bx; }
    unsigned char* ws = args.ws;
    F.ctl = (gu32*)(ws + WS_CTL);
    volatile LAS unsigned* MISC = (volatile LAS unsigned*)(F.lds + LDSCTL_OFF);
    for (int u = F.tid; u < (LDS_BYTES - LDSCTL_OFF) / 4; u += NWAVES * 64) ((LAS unsigned*)(F.lds + LDSCTL_OFF))[u] = 0u;
    __syncthreads();
    const int lo = args.ph_lo, hi = args.ph_hi;
    const bool multi = (hi - lo) > 1;
    XcdBarrier bar; bar.bar = (unsigned*)(F.ctl + CW_BAR); bar.x = 0; bar.st = nullptr;
    if (multi) bar = xcd_barrier_post((unsigned*)(F.ctl + CW_BAR), MISC + 8);
#define IN(k) (lo <= (k) && (k) < hi)
#define BOTH(k) (IN(k) && IN((k) + 1))
#define GRID_BAR() xcd_barrier(bar)

    const float* x = args.in[0];
    bf16_t* Win_t = (bf16_t*)(ws + WS_WIN); bf16_t* Wout_t = (bf16_t*)(ws + WS_WOUT); bf16_t* Wgu_t = (bf16_t*)(ws + WS_WGU); bf16_t* Wd_t = (bf16_t*)(ws + WS_WD);
    float* X1 = (float*)(ws + WS_X1); bf16_t* XN = (bf16_t*)(ws + WS_XN);
    bf16_t* Qb = (bf16_t*)(ws + WS_Q); bf16_t* Kb = (bf16_t*)(ws + WS_K); bf16_t* Vb = (bf16_t*)(ws + WS_V); bf16_t* Ab = (bf16_t*)(ws + WS_A); bf16_t* Gb = (bf16_t*)(ws + WS_G);
    bf16_t* MIX = (bf16_t*)(ws + WS_MIX); bf16_t* HID = (bf16_t*)(ws + WS_HID); bf16_t* OB = (bf16_t*)(ws + WS_O);
    int* LIST = (int*)(ws + WS_LIST); float* TOPW = (float*)(ws + WS_TOPW); float* RWT = (float*)(ws + WS_RWT);
    const int gw = F.vcu * NWAVES + F.wave, NGW = F.G * NWAVES;

    if (IN(0)) {
        LAS float* scr = (LAS float*)(F.lds + F.wave * 16384);
        constexpr int I_IN = (D / 64) * (NIN / 32), I_OUT = (D / 64) * (D / 32), I_EXP = (D / 64) * (D / 32);
        constexpr int NITEMS = I_IN + I_OUT + NE * 3 * I_EXP;
        for (int it = gw; it < NITEMS; it += NGW) {
            int r = it;
            if (r < I_IN) { const int kb = r / (NIN / 32), nb = r % (NIN / 32); transpose_item(args.in[2], NIN, kb * 64, nb * 32, Win_t + (size_t)(nb * 32) * D, D, scr, F.lane); continue; } r -= I_IN;
            if (r < I_OUT) { const int kb = r / (D / 32), nb = r % (D / 32); transpose_item(args.in[8], D, kb * 64, nb * 32, Wout_t + (size_t)(nb * 32) * D, D, scr, F.lane); continue; } r -= I_OUT;
            const int em = r / I_EXP, ri = r % I_EXP, e = em / 3, mat = em % 3, kb = ri / (D / 32), nb = ri % (D / 32), n0 = nb * 32;
            if (mat == 2) transpose_item(args.in[16] + (size_t)e * D * D, D, kb * 64, n0, Wd_t + ((size_t)e * D + n0) * D, D, scr, F.lane);
            else { const float* src = (mat == 0 ? args.in[12] : args.in[14]) + (size_t)e * D * D;
                   const size_t drow = (size_t)e * 2048 + (size_t)(n0 >> 7) * 256 + (n0 & 127) + (mat == 1 ? 128 : 0);
                   transpose_item(src, D, kb * 64, n0, Wgu_t + drow * D, D, scr, F.lane); }
        }
        { const GAS f32x4* gp = (const GAS f32x4*)args.in[1] + F.lane; f32x4 g[4];
#pragma unroll
          for (int j = 0; j < 4; ++j) g[j] = gp[64 * j];
          for (int m = gw; m < T; m += NGW) { const GAS f32x4* xr = (const GAS f32x4*)(x + (size_t)m * D) + F.lane; f32x4 v[4]; float s = 0.f;
#pragma unroll
              for (int j = 0; j < 4; ++j) { v[j] = xr[64 * j]; s += (v[j].x * v[j].x + v[j].y * v[j].y) + (v[j].z * v[j].z + v[j].w * v[j].w); }
              const float r = 1.0f / sqrtf(wave_sum(s) * (1.f / D) + RMS_EPS);
              GAS u32x2* o8 = (GAS u32x2*)(XN + (size_t)m * D) + F.lane;
#pragma unroll
              for (int j = 0; j < 4; ++j) { const f32x4 y = v[j] * r * g[j]; o8[64 * j] = (u32x2){pk2(y.x, y.y), pk2(y.z, y.w)}; } } }
        for (int i = blockIdx.x * 512 + F.tid; i < NE * D; i += F.G * 512) { const int e = i / D, k = i % D; RWT[i] = args.in[10][k * NE + e]; }
        if (BOTH(0)) GRID_BAR();
    }

    if (IN(1)) {
        pg8::DenseOrder S; S.init(T, NIN, F.G, (int)blockIdx.x, Win_t);
        pg8::EpiSplit E{Qb, (size_t)(WS_K - WS_Q) / 2, QSCALE};
        pg8::gemm_phase<pg8::EpiSplit, pg8::DenseOrder, true>(F.lds, (const char*)XN, D, S, E);
        if (BOTH(1)) GRID_BAR();
    }

    if (IN(2)) {
        for (int u = blockIdx.x; u < 2 * NH * 32; u += F.G) { const int cg = u & 31, h = (u >> 5) & 7, b = u >> 8;
            att::unit(F, b, h, cg, Qb, Kb, Vb, MIX, args.in[7]); }
        for (int u = blockIdx.x; u < T / cv::TT; u += F.G) { const int b = u / (SEQ / cv::TT), tt = u % (SEQ / cv::TT);
            cv::unit(F, b, tt, Ab, Gb, MIX, args.in[3], args.in[4], args.in[5], args.in[6]); }
        if (BOTH(2)) GRID_BAR();
    }

    if (IN(3)) {
        pg8::DenseOrder S; S.init(T, D, F.G, (int)blockIdx.x, Wout_t);
        pg8::EpiRes E{x, X1};
        pg8::gemm_phase<pg8::EpiRes, pg8::DenseOrder, false>(F.lds, (const char*)MIX, D, S, E);
        if (BOTH(3)) GRID_BAR();
    }

    if (IN(4)) {
        LAS float* rw = (LAS float*)F.lds;
        LAS int* hist = (LAS int*)(F.lds + XTRA_OFF);
        LAS int* baseE = hist + 32;
        LAS int* selE = baseE + 32;
        LAS int* selP = selE + 1024;
        for (int i = F.tid; i < NE * D / 4; i += 512) ((LAS f32x4*)rw)[i] = ((const GAS f32x4*)RWT)[i];
        if (F.tid < 32) hist[F.tid] = 0;
        __syncthreads();
        const int TPB = (T + F.G - 1) / F.G; const int tok0 = blockIdx.x * TPB;
        const GAS f32x4* gp = (const GAS f32x4*)args.in[9] + F.lane; f32x4 g[4];
#pragma unroll
        for (int j = 0; j < 4; ++j) g[j] = gp[64 * j];
        const float rbias = args.in[11][F.lane & 31];
#pragma unroll 1
        for (int tl = F.wave; tl < TPB; tl += NWAVES) { const int tok = tok0 + tl; if (tok >= T) break;
            const GAS f32x4* xr = (const GAS f32x4*)(X1 + (size_t)tok * D) + F.lane; f32x4 v[4]; float s = 0.f;
#pragma unroll
            for (int j = 0; j < 4; ++j) { v[j] = xr[64 * j]; s += (v[j].x * v[j].x + v[j].y * v[j].y) + (v[j].z * v[j].z + v[j].w * v[j].w); }
            const float r = 1.0f / sqrtf(wave_sum(s) * (1.f / D) + RMS_EPS);
            GAS u32x2* o8 = (GAS u32x2*)(XN + (size_t)tok * D) + F.lane;
#pragma unroll
            for (int j = 0; j < 4; ++j) { v[j] = v[j] * r * g[j]; o8[64 * j] = (u32x2){pk2(v[j].x, v[j].y), pk2(v[j].z, v[j].w)}; }
            float a[32];
#pragma unroll
            for (int e = 0; e < 32; ++e) { float acc = 0.f;
#pragma unroll
                for (int j = 0; j < 4; ++j) { const f32x4 w = *(const LAS f32x4*)(rw + e * D + 4 * F.lane + 256 * j); acc += (v[j].x * w.x + v[j].y * w.y) + (v[j].z * w.z + v[j].w * w.w); }
                a[e] = acc; }
#define TR_STEP(N, XV) _Pragma("unroll") for (int i = 0; i < N; ++i) { const bool up = (F.lane & XV) != 0; const float send = up ? a[i] : a[i + N]; const float keep = up ? a[i + N] : a[i]; a[i] = keep + __shfl_xor(send, XV); }
            TR_STEP(16, 32) TR_STEP(8, 16) TR_STEP(4, 8) TR_STEP(2, 4) TR_STEP(1, 2)
#undef TR_STEP
            a[0] += __shfl_xor(a[0], 1);
            float val = __shfl(a[0], 2 * (F.lane & 31)) + rbias;
            float tv[4]; int te[4];
#pragma unroll
            for (int k = 0; k < 4; ++k) { float m = val;
#pragma unroll
                for (int o = 1; o < 32; o <<= 1) m = fmaxf(m, __shfl_xor(m, o));
                const unsigned long long ball = __ballot(val == m); const int es = (int)__builtin_ctzll(ball) & 31;
                tv[k] = m; te[k] = es; if ((F.lane & 31) == es) val = -INFINITY; }
            const float e1 = __expf(tv[1] - tv[0]), e2 = __expf(tv[2] - tv[0]), e3 = __expf(tv[3] - tv[0]); const float inv = 1.0f / (1.0f + e1 + e2 + e3);
            if (F.lane == 0) { *(GAS f32x4*)(TOPW + (size_t)tok * 4) = (f32x4){inv, e1 * inv, e2 * inv, e3 * inv};
#pragma unroll
                for (int k = 0; k < 4; ++k) { selE[tl * 4 + k] = te[k]; selP[tl * 4 + k] = __hip_atomic_fetch_add(&hist[te[k]], 1, __ATOMIC_RELAXED, __HIP_MEMORY_SCOPE_WORKGROUP); } }
        }
        __syncthreads();
        if (F.tid < 32) baseE[F.tid] = (int)__hip_atomic_fetch_add(F.ctl + CW_CNT + 64 * F.tid, (unsigned)hist[F.tid], RLX_AGENT);
        __syncthreads();
        for (int i = F.tid; i < TPB * 4; i += 512) { const int tok = tok0 + (i >> 2); if (tok < T) { const int e = selE[i]; LIST[(size_t)e * LCAP + baseE[e] + selP[i]] = tok * 4 + (i & 3); } }
        if (BOTH(4)) GRID_BAR();
    }

    LAS int* tstart = (LAS int*)(F.lds + XTRA_OFF + 12288);
    LAS int* ecnt = tstart + 64;
    if (IN(5) || IN(6)) {
        __syncthreads();
        if (F.tid < 32) ecnt[F.tid] = (int)__hip_atomic_load(F.ctl + CW_CNT + 64 * F.tid, RLX_AGENT);
        __syncthreads();
        if (F.tid == 0) { int s = 0; for (int e = 0; e < NE; ++e) { tstart[e] = s; s += (ecnt[e] + 255) >> 8; } tstart[NE] = s; }
        __syncthreads();
    }

    if (IN(5)) {
        pg8::MoeOrder S{tstart, ecnt, LIST, (const char*)Wgu_t, 8, 2048, 2, (int)(blockIdx.x % 8), (int)(blockIdx.x / 8), F.G / 8};
        pg8::EpiGU E{HID, LIST, args.in[13], args.in[15]};
        pg8::gemm_phase<pg8::EpiGU, pg8::MoeOrder, true>(F.lds, (const char*)XN, D, S, E);
        if (BOTH(5)) GRID_BAR();
    }

    if (IN(6)) {
        pg8::MoeOrder S{tstart, ecnt, LIST, (const char*)Wd_t, 4, 1024, 0, (int)(blockIdx.x % 8), (int)(blockIdx.x / 8), F.G / 8};
        pg8::EpiDown E{OB, LIST, args.in[17]};
        pg8::gemm_phase<pg8::EpiDown, pg8::MoeOrder, true>(F.lds, (const char*)HID, D, S, E);
        if (BOTH(6)) GRID_BAR();
    }

    if (IN(7)) {
        const GAS f32x4* gp = (const GAS f32x4*)args.in[18] + F.lane; f32x4 g[4];
#pragma unroll
        for (int j = 0; j < 4; ++j) g[j] = gp[64 * j];
        unsigned bad = __hip_atomic_load(F.ctl + CW_BAR + XB_TMO, RLX_AGENT);
        for (int m = gw; m < T; m += NGW) {
            const GAS f32x4* xr = (const GAS f32x4*)(X1 + (size_t)m * D) + F.lane; f32x4 v[4];
#pragma unroll
            for (int j = 0; j < 4; ++j) v[j] = xr[64 * j];
            const f32x4 tw = *(const GAS f32x4*)(TOPW + (size_t)m * 4);
#pragma unroll
            for (int k = 0; k < 4; ++k) { const GAS u32x2* orow = (const GAS u32x2*)(OB + ((size_t)m * 4 + k) * D) + F.lane; const float wk = tw[k];
#pragma unroll
                for (int j = 0; j < 4; ++j) { const u32x2 w = orow[64 * j]; v[j].x += wk * bf_lo(w.x); v[j].y += wk * bf_hi(w.x); v[j].z += wk * bf_lo(w.y); v[j].w += wk * bf_hi(w.y); } }
            float s = 0.f;
#pragma unroll
            for (int j = 0; j < 4; ++j) s += (v[j].x * v[j].x + v[j].y * v[j].y) + (v[j].z * v[j].z + v[j].w * v[j].w);
            float r = 1.0f / sqrtf(wave_sum(s) * (1.f / D) + RMS_EPS);
            if (bad) r = __builtin_nanf("");
            GAS f32x4* o = (GAS f32x4*)(args.out + (size_t)m * D) + F.lane;
#pragma unroll
            for (int j = 0; j < 4; ++j) o[64 * j] = v[j] * r * g[j];
        }
    }
#undef IN
#undef BOTH
#undef GRID_BAR
}

#ifndef MK_N_LAUNCHES
#define MK_N_LAUNCHES 1
#endif
extern "C" void kernel_launch(void* const* d_in, const int* in_sizes, int n_in, void* d_out, int out_size, void* d_ws, size_t ws_size, hipStream_t stream) {
    static int grid = 0;
    if (grid == 0) {
        if (n_in != 19 || in_sizes[0] != T * D || out_size != T * D || ws_size < WS_END) { fprintf(stderr, "kernel_launch: unexpected shapes (n_in %d, in0 %d, out %d, ws %zu); nothing launched\n", n_in, n_in > 0 ? in_sizes[0] : -1, out_size, ws_size); grid = -1; return; }
        int dev = 0, cus = 0, per_cu = 0;
        if (hipGetDevice(&dev) != hipSuccess || hipDeviceGetAttribute(&cus, hipDeviceAttributeMultiprocessorCount, dev) != hipSuccess) { fprintf(stderr, "kernel_launch: device query failed\n"); grid = -1; return; }
        if (hipFuncSetAttribute((const void*)hymba_fwd, hipFuncAttributeMaxDynamicSharedMemorySize, LDS_BYTES) != hipSuccess) { fprintf(stderr, "kernel_launch: hipFuncSetAttribute failed\n"); grid = -1; return; }
        if (hipOccupancyMaxActiveBlocksPerMultiprocessor(&per_cu, (const void*)hymba_fwd, NWAVES * 64, LDS_BYTES) != hipSuccess || per_cu < 1) fprintf(stderr, "kernel_launch: note: occupancy query reports %d workgroups per CU\n", per_cu);
        (void)hipGetLastError();
        grid = (cus / 64) * 64; if (grid > 256) grid = 256;
        if (grid < 64) { fprintf(stderr, "kernel_launch: %d CUs: unsupported\n", cus); grid = -1; return; }
    }
    if (grid < 0) return;
    if (hipMemsetAsync((char*)d_ws + WS_CTL, 0, CTL_ZERO_BYTES, stream) != hipSuccess) { fprintf(stderr, "kernel_launch: memset failed\n"); return; }
    Args a{};
    for (int i = 0; i < 19; ++i) a.in[i] = (const float*)d_in[i];
    a.out = (float*)d_out; a.ws = (unsigned char*)d_ws;
    constexpr int NPH = 8;
    if (MK_N_LAUNCHES == 1) { a.ph_lo = 0; a.ph_hi = NPH; hipLaunchKernelGGL(hymba_fwd, dim3(grid), dim3(NWAVES * 64), LDS_BYTES, stream, a); }
    else for (int p = 0; p < NPH; ++p) { a.ph_lo = p; a.ph_hi = p + 1; hipLaunchKernelGGL(hymba_fwd, dim3(grid), dim3(NWAVES * 64), LDS_BYTES, stream, a); }
    const hipError_t le = hipPeekAtLastError();
    if (le != hipSuccess) fprintf(stderr, "kernel_launch: launch failed: %s\n", hipGetErrorName(le));
}
```

```cpp
#include <hip/hip_runtime.h>
#include <cstdio>
#include <cstdint>

#define GAS __attribute__((address_space(1)))
#define LAS __attribute__((address_space(3)))
typedef unsigned short bf16_t;
typedef short bf16x8 __attribute__((ext_vector_type(8)));
typedef short s16x4 __attribute__((ext_vector_type(4)));
typedef float f32x2 __attribute__((ext_vector_type(2)));
typedef float f32x4 __attribute__((ext_vector_type(4)));
typedef float f32x16 __attribute__((ext_vector_type(16)));
typedef unsigned u32x2 __attribute__((ext_vector_type(2)));
typedef unsigned u32x4 __attribute__((ext_vector_type(4)));
typedef int i32x4 __attribute__((ext_vector_type(4)));
typedef int i32x8 __attribute__((ext_vector_type(8)));
typedef GAS unsigned gu32;
#define RLX_AGENT __ATOMIC_RELAXED, __HIP_MEMORY_SCOPE_AGENT
#define LDS_WAIT() asm volatile("s_waitcnt lgkmcnt(0)" ::: "memory")
#define VM_WAIT() asm volatile("s_waitcnt vmcnt(0)" ::: "memory")

constexpr int T = 16384, SEQ = 8192, D = 1024, NIN = 2560, DA = 512, NH = 8, HD = 64, DC = 512, CW = 31;
constexpr int NE = 32, TOPK = 4, NP = T * TOPK, LCAP = 16384, NREL = 192;
constexpr float RMS_EPS = 1e-5f, LN_EPS = 1e-5f, LOG2E = 1.4426950408889634f;
constexpr float QSCALE = 0.125f * LOG2E;
constexpr float SC_T = 16.0f, SC_W = 256.0f, SC_H = 4.0f;

constexpr size_t MiB = 1u << 20;
constexpr size_t WS_CTL = 0, CTL_ZERO_BYTES = 1 * MiB;
constexpr size_t WS_WIN = 1 * MiB, WS_WOUT = 6 * MiB, WS_WGU = 8 * MiB, WS_WD = 136 * MiB, WS_X1 = 200 * MiB, WS_XN = 264 * MiB;
constexpr size_t WS_Q = 296 * MiB, WS_K = 312 * MiB, WS_V = 328 * MiB, WS_A = 344 * MiB, WS_G = 360 * MiB, WS_MIX = 376 * MiB;
constexpr size_t WS_HID = 296 * MiB;
constexpr size_t WS_O = WS_WGU;
constexpr size_t WS_LIST = 424 * MiB, WS_TOPW = 426 * MiB, WS_RWT = 427 * MiB, WS_END = 428 * MiB;
constexpr int CW_TMO = 0, CW_BAR = 4096, CW_CNT = 8192;

constexpr int RING_BYTES = 131072, LDSCTL_OFF = RING_BYTES, XTRA_OFF = LDSCTL_OFF + 512, LDS_BYTES = 147456;
constexpr int NWAVES = 8;

__device__ __forceinline__ unsigned f2bf(float f) { unsigned u = __builtin_bit_cast(unsigned, f); return (u + 0x7fffu + ((u >> 16) & 1u)) >> 16; }
__device__ __forceinline__ unsigned pk2(float lo, float hi) { return f2bf(lo) | (f2bf(hi) << 16); }
__device__ __forceinline__ unsigned cvt_pk_bf16(float lo, float hi) { unsigned r; asm volatile("v_cvt_pk_bf16_f32 %0, %1, %2" : "=v"(r) : "v"(lo), "v"(hi)); return r; }
__device__ __forceinline__ float clamp448(float v) { return fminf(fmaxf(v, -448.0f), 448.0f); }
__device__ __forceinline__ unsigned pk4_fp8(float a, float b, float c, float d) {
    int r = __builtin_amdgcn_cvt_pk_fp8_f32(clamp448(a), clamp448(b), 0, false);
    r = __builtin_amdgcn_cvt_pk_fp8_f32(clamp448(c), clamp448(d), r, true);
    return (unsigned)r;
}
__device__ __forceinline__ float bf_lo(unsigned w) { return __uint_as_float(w << 16); }
__device__ __forceinline__ float bf_hi(unsigned w) { return __uint_as_float(w & 0xffff0000u); }
__device__ __forceinline__ float fsigmoid(float z) { return __builtin_amdgcn_rcpf(1.0f + __builtin_amdgcn_exp2f(-z * LOG2E)); }
__device__ __forceinline__ int lane_id() { int l; asm volatile("v_mbcnt_lo_u32_b32 %0, -1, 0\n\tv_mbcnt_hi_u32_b32 %0, -1, %0" : "=v"(l)); return l; }
__device__ __forceinline__ float wave_sum(float v) {
#pragma unroll
    for (int o = 1; o < 64; o <<= 1) v += __shfl_xor(v, o);
    return v;
}

namespace pg8 {
constexpr int BM = 256, BK = 64, HALF = 128, HTB = HALF * BK * 2, STAGE_BYTES = 8 * HTB;
__device__ __forceinline__ int lds_byte(int r, int c) { const int st = (r >> 4) * 2 + (c >> 5), rr = r & 15, cc = c & 31, ob = rr * 64 + cc * 2; return st * 1024 + (ob ^ (((ob >> 9) & 1) << 5)); }
__device__ __forceinline__ void stage_rc(int b, int& R, int& C) { const int st = b / 1024, sb = b % 1024, swz = sb ^ (((sb >> 9) & 1) << 5); R = (st >> 1) * 16 + swz / 64; C = (st & 1) * 32 + (swz % 64) / 2; }
__device__ __forceinline__ int perm32(int rho) { const int n = rho >> 4, i = rho & 15; return 8 * (i >> 2) + 4 * n + (i & 3); }

struct Unit { int pm, pn, e, nv; };

template <class Epi, class Sched, bool ALIGN_EPI, int ESZ>
__device__ __forceinline__ void gemm_phase(LAS unsigned char* lds, const char* Abase, const int K, const Sched& S, const Epi& E) {
    const int wid = __builtin_amdgcn_readfirstlane(threadIdx.x >> 6), lane = lane_id(), tid = wid * 64 + lane, wr = wid >> 2, wc = wid & 3, fr = lane & 15, fq = lane >> 4;
    const int RB = K * ESZ, nt = RB / 128;
    unsigned voffB[2];
#pragma unroll
    for (int i = 0; i < 2; ++i) { int R, C; stage_rc(tid * 16 + i * 8192, R, C); const int Rb = Epi::PERM ? ((R & ~31) + perm32(R & 31)) : R; voffB[i] = (unsigned)(Rb * RB + 2 * C); }
    const size_t kstep = (size_t)(BK * 2);
    const size_t hstep = (size_t)HALF * RB;
    const unsigned ldsw = (unsigned)wid * 1024u;
    const int aoff = lds_byte(wr * 64 + fr, fq * 8), boff = lds_byte(wc * 32 + fr, fq * 8);
#define PG8_SA(b, h) (((b) * 2 + (h)) * HTB)
#define PG8_SB(b, h) ((4 + (b) * 2 + (h)) * HTB)
#define PG8_STAGE(bufoff, gbase, voff) do { _Pragma("unroll") for (int _i = 0; _i < 2; ++_i) \
        __builtin_amdgcn_global_load_lds((const unsigned*)((const char*)(gbase) + (voff)[_i]), (LAS unsigned*)(lds + (bufoff) + ldsw + _i * 8192), 16, 0, 0); } while (0)
#define PG8_LD16(off) (*(const LAS i32x4*)(lds + (off)))
#define PG8_LDA(dst, b, h) do { _Pragma("unroll") for (int m = 0; m < 4; ++m) { const i32x4 _x = PG8_LD16(PG8_SA(b, h) + aoff + m * 2048), _y = PG8_LD16(PG8_SA(b, h) + aoff + m * 2048 + 1024); dst[m] = __builtin_shufflevector(_x, _y, 0, 1, 2, 3, 4, 5, 6, 7); } } while (0)
#define PG8_LDB(dst, b, h) do { _Pragma("unroll") for (int n = 0; n < 2; ++n) { const i32x4 _x = PG8_LD16(PG8_SB(b, h) + boff + n * 2048), _y = PG8_LD16(PG8_SB(b, h) + boff + n * 2048 + 1024); dst[n] = __builtin_shufflevector(_x, _y, 0, 1, 2, 3, 4, 5, 6, 7); } } while (0)
#define PG8_MMA(ai, bj, At, Bt) do { __builtin_amdgcn_s_setprio(1); _Pragma("unroll") for (int m = 0; m < 4; ++m) _Pragma("unroll") for (int n = 0; n < 2; ++n) _Pragma("unroll") for (int k = 0; k < 2; ++k) \
        acc[ai][bj][m][n] = __builtin_amdgcn_mfma_f32_16x16x32_bf16(PG8_HALF(Bt[n], k), PG8_HALF(At[m], k), acc[ai][bj][m][n], 0, 0, 0); __builtin_amdgcn_s_setprio(0); } while (0)
#define PG8_HALF(v, k) __builtin_bit_cast(bf16x8, (k) == 0 ? __builtin_shufflevector((v), (v), 0, 1, 2, 3) : __builtin_shufflevector((v), (v), 4, 5, 6, 7))
#define PG8_MMA8(ai, bj, At, Bt) do { __builtin_amdgcn_s_setprio(1); _Pragma("unroll") for (int m = 0; m < 4; ++m) _Pragma("unroll") for (int n = 0; n < 2; ++n) \
        acc[ai][bj][m][n] = __builtin_amdgcn_mfma_scale_f32_16x16x128_f8f6f4(Bt[n], At[m], acc[ai][bj][m][n], 0, 0, 0, 0x7f7f7f7f, 0, 0x7f7f7f7f); __builtin_amdgcn_s_setprio(0); } while (0)
#define PG8_MM(ai, bj, At, Bt) do { if constexpr (ESZ == 2) PG8_MMA(ai, bj, At, Bt); else PG8_MMA8(ai, bj, At, Bt); } while (0)
#define PG8_WAIT_V(n) asm volatile("s_waitcnt vmcnt(" #n ")" ::: "memory")
#define PG8_WAIT_L(n) asm volatile("s_waitcnt lgkmcnt(" #n ")" ::: "memory")
#define PG8_BAR __builtin_amdgcn_s_barrier()
#define PG8_SCHED __builtin_amdgcn_sched_barrier(0)
    Unit cur, nxt; int ui = 0;
    if (!S.next(0, cur)) return;
    f32x4 acc[2][2][4][2];
#pragma unroll
    for (int a = 0; a < 2; ++a)
#pragma unroll
        for (int b = 0; b < 2; ++b)
#pragma unroll
            for (int m = 0; m < 4; ++m)
#pragma unroll
                for (int n = 0; n < 2; ++n) acc[a][b][m][n] = (f32x4){0.f, 0.f, 0.f, 0.f};
    i32x8 At[4], B0[2], B1[2];
    unsigned vA0[2], vA1[2];
    LAS u32x4* const vslot = (LAS u32x4*)(lds + STAGE_BYTES + 512) + tid;
    S.a_off(cur, tid, RB, vA0, vA1);
    const char* cB = S.b_ptr(cur, RB);
    const char* cA = Abase;
    PG8_STAGE(PG8_SB(0, 0), cB, voffB); PG8_STAGE(PG8_SB(0, 1), cB + hstep, voffB); PG8_STAGE(PG8_SA(0, 0), cA, vA0); PG8_STAGE(PG8_SA(0, 1), cA, vA1);
    if (wr == 1) PG8_BAR;
    PG8_WAIT_V(2); PG8_BAR;
    PG8_STAGE(PG8_SB(1, 0), cB + kstep, voffB); PG8_STAGE(PG8_SA(1, 0), cA + kstep, vA0); PG8_STAGE(PG8_SB(1, 1), cB + hstep + kstep, voffB);
    PG8_WAIT_V(6); PG8_BAR;
    for (;;) {
        const bool has_next = S.next(ui + 1, nxt);
        const char* nB = cB;
        { unsigned n0[2] = {vA0[0], vA0[1]}, n1[2] = {vA1[0], vA1[1]};
          if (has_next) { S.a_off(nxt, tid, RB, n0, n1); nB = S.b_ptr(nxt, RB); }
          *vslot = (u32x4){n0[0], n0[1], n1[0], n1[1]}; }
#pragma clang loop unroll(disable)
        for (int t = 0; t < nt; t += 2) {
            const bool last = (t == nt - 2);
            const char* a1 = cA + (size_t)(t + 1) * kstep;
            const char* a2 = last ? cA : cA + (size_t)(t + 2) * kstep; const char* b2 = last ? nB : cB + (size_t)(t + 2) * kstep;
            const char* a3 = a2 + kstep; const char* b3 = b2 + kstep;
            PG8_LDB(B0, 0, 0); PG8_LDB(B1, 0, 1); PG8_SCHED; PG8_LDA(At, 0, 0); PG8_STAGE(PG8_SA(1, 1), a1, vA1);
            if (last) { const u32x4 nv = *vslot; vA0[0] = nv.x; vA0[1] = nv.y; vA1[0] = nv.z; vA1[1] = nv.w; }
            PG8_WAIT_V(8); PG8_WAIT_L(0); PG8_BAR; PG8_MM(0, 0, At, B0); PG8_MM(0, 1, At, B1); PG8_BAR; PG8_SCHED;
            PG8_LDA(At, 0, 1); PG8_STAGE(PG8_SB(0, 0), b2, voffB); PG8_STAGE(PG8_SB(0, 1), b2 + hstep, voffB); PG8_STAGE(PG8_SA(0, 0), a2, vA0);
            PG8_WAIT_V(8); PG8_WAIT_L(0); PG8_BAR; PG8_MM(1, 0, At, B0); PG8_MM(1, 1, At, B1); PG8_BAR; PG8_SCHED;
            PG8_LDB(B0, 1, 0); PG8_LDB(B1, 1, 1); PG8_SCHED; PG8_LDA(At, 1, 0); PG8_STAGE(PG8_SA(0, 1), a2, vA1);
            PG8_WAIT_V(8); PG8_WAIT_L(0); PG8_BAR; PG8_MM(0, 0, At, B0); PG8_MM(0, 1, At, B1); PG8_BAR; PG8_SCHED;
            PG8_LDA(At, 1, 1); PG8_STAGE(PG8_SB(1, 0), b3, voffB); PG8_STAGE(PG8_SB(1, 1), b3 + hstep, voffB); PG8_STAGE(PG8_SA(1, 0), a3, vA0);
            PG8_WAIT_V(8); PG8_WAIT_L(0); PG8_BAR; PG8_MM(1, 0, At, B0); PG8_MM(1, 1, At, B1); PG8_BAR; PG8_SCHED;
        }
        if constexpr (ALIGN_EPI) { if (wr == 0) PG8_BAR; }
        E(acc, cur, wr, wc, fr, fq);
        if (!has_next) break;
#pragma unroll
        for (int a = 0; a < 2; ++a)
#pragma unroll
            for (int b = 0; b < 2; ++b)
#pragma unroll
                for (int m = 0; m < 4; ++m)
#pragma unroll
                    for (int n = 0; n < 2; ++n) acc[a][b][m][n] = (f32x4){0.f, 0.f, 0.f, 0.f};
        cur = nxt; cB = nB; ++ui;
        if constexpr (ALIGN_EPI) { if (wr == 1) PG8_BAR; }
    }
    PG8_WAIT_V(0);
    if constexpr (!ALIGN_EPI) { if (wr == 0) PG8_BAR; }
    PG8_BAR;
#undef PG8_SA
#undef PG8_SB
#undef PG8_STAGE
#undef PG8_LDA
#undef PG8_LDB
#undef PG8_MMA
#undef PG8_MMA8
#undef PG8_MM
#undef PG8_HALF
#undef PG8_LD16
#undef PG8_WAIT_V
#undef PG8_WAIT_L
#undef PG8_BAR
#undef PG8_SCHED
}

struct DenseOrder {
    int nM, nN, nwg, G, c; const char* Bt;
    __device__ __forceinline__ void init(int M, int N, int G_, int c_, const void* Bt_) { nM = M / BM; nN = N / BM; nwg = nM * nN; G = G_; c = c_; Bt = (const char*)Bt_; }
    __device__ __forceinline__ bool next(int i, Unit& u) const {
        const long L = (long)i * G + c; if (L >= nwg) return false;
        int wgid = (int)L; { const int q = nwg / 8, r = nwg % 8, xcd = wgid % 8, off = wgid / 8; wgid = (xcd < r ? xcd * (q + 1) : r * (q + 1) + (xcd - r) * q) + off; }
        const int nig = 8 * nN, gid = wgid / nig, fm = gid * 8, gsz = (nM - fm) < 8 ? (nM - fm) : 8;
        u.pm = fm + ((wgid % nig) % gsz); u.pn = (wgid % nig) / gsz; u.e = 0; u.nv = 256; return true;
    }
    __device__ __forceinline__ const char* b_ptr(const Unit& u, int RB) const { return Bt + (size_t)u.pn * (256 * (size_t)RB); }
    __device__ __forceinline__ void a_off(const Unit& u, int tid, int RB, unsigned (&v0)[2], unsigned (&v1)[2]) const {
#pragma unroll
        for (int i = 0; i < 2; ++i) { int R, C; stage_rc(tid * 16 + i * 8192, R, C); v0[i] = (unsigned)((u.pm * 256 + R) * RB + 2 * C); v1[i] = (unsigned)((u.pm * 256 + 128 + R) * RB + 2 * C); }
    }
};
struct MoeOrder {
    const LAS int* tstart;
    const LAS int* cnt;
    const int* list;
    const char* Bt; int npn, nrowsB, shiftA;
    int xg, j, nper;
    __device__ __forceinline__ bool next(int i, Unit& u) const {
        const int B = i * 8 + xg, rg = nper / npn, R = rg * B + j / npn;
        const int Rtot = tstart[NE];
        if (R >= Rtot) return false;
        int e = 0;
#pragma unroll 1
        for (int q = 1; q < NE; ++q) e += (tstart[q] <= R) ? 1 : 0;
        u.e = e; u.pm = R - tstart[e]; u.pn = j % npn; const int rem = cnt[e] - u.pm * 256; u.nv = rem < 256 ? rem : 256; return true;
    }
    __device__ __forceinline__ const char* b_ptr(const Unit& u, int RB) const { return Bt + ((size_t)u.e * nrowsB + (size_t)u.pn * 256) * (size_t)RB; }
    __device__ __forceinline__ void a_off(const Unit& u, int tid, int RB, unsigned (&v0)[2], unsigned (&v1)[2]) const {
        const int* le = list + (size_t)u.e * LCAP + u.pm * 256;
#pragma unroll
        for (int i = 0; i < 2; ++i) { int R, C; stage_rc(tid * 16 + i * 8192, R, C);
            const int r0 = R < u.nv ? R : 0, r1 = (128 + R) < u.nv ? (128 + R) : 0;
            const int p0 = le[r0] >> shiftA, p1 = le[r1] >> shiftA;
            v0[i] = (unsigned)(p0 * RB + 2 * C); v1[i] = (unsigned)(p1 * RB + 2 * C); }
    }
};

struct EpiSplit {
    static constexpr bool PERM = true;
    bf16_t* O; size_t split_stride; float scale0;
    __device__ __forceinline__ void operator()(const f32x4 (&acc)[2][2][4][2], const Unit& u, int wr, int wc, int fr, int fq) const {
        const int row0 = u.pm * BM + wr * 64 + fr; int colt = u.pn * BM; const int t = colt / 512; bf16_t* base = O + (size_t)t * split_stride; colt -= t * 512;
        const float sc = (t == 0) ? scale0 : 1.f;
        const int col0 = colt + wc * 32 + 8 * fq;
#pragma unroll
        for (int ai = 0; ai < 2; ++ai)
#pragma unroll
            for (int m = 0; m < 4; ++m) { bf16_t* rowp = base + (size_t)(row0 + ai * HALF + m * 16) * 512 + col0;
#pragma unroll
                for (int bj = 0; bj < 2; ++bj) { const f32x4 v0 = acc[ai][bj][m][0] * sc, v1 = acc[ai][bj][m][1] * sc;
                    u32x4 w; w.x = cvt_pk_bf16(v0[0], v0[1]); w.y = cvt_pk_bf16(v0[2], v0[3]); w.z = cvt_pk_bf16(v1[0], v1[1]); w.w = cvt_pk_bf16(v1[2], v1[3]);
                    *(u32x4*)(rowp + bj * HALF) = w; } }
    }
};
struct EpiRes {
    static constexpr bool PERM = false;
    const float* base; float* out;
    __device__ __forceinline__ void operator()(const f32x4 (&acc)[2][2][4][2], const Unit& u, int wr, int wc, int fr, int fq) const {
        const int row0 = u.pm * BM + wr * 64 + fr, col0 = u.pn * BM + wc * 32 + 4 * fq;
#pragma unroll
        for (int ai = 0; ai < 2; ++ai)
#pragma unroll
            for (int m = 0; m < 4; ++m) { const size_t off = (size_t)(row0 + ai * HALF + m * 16) * D + col0;
#pragma unroll
                for (int bj = 0; bj < 2; ++bj)
#pragma unroll
                    for (int n = 0; n < 2; ++n) *(f32x4*)(out + off + bj * HALF + n * 16) = *(const f32x4*)(base + off + bj * HALF + n * 16) + acc[ai][bj][m][n]; }
    }
};
struct EpiGU {
    static constexpr bool PERM = true;
    unsigned char* hid; const int* list; const float* bg; const float* bu;
    __device__ __forceinline__ void operator()(const f32x4 (&acc)[2][2][4][2], const Unit& u, int wr, int wc, int fr, int fq) const {
        const int hc = u.pn * 128 + wc * 32 + 8 * fq;
        const float* pg = bg + (size_t)u.e * D + hc; const float* pu = bu + (size_t)u.e * D + hc;
        const f32x4 g0 = *(const f32x4*)pg, g1 = *(const f32x4*)(pg + 4), u0 = *(const f32x4*)pu, u1 = *(const f32x4*)(pu + 4);
        const int* le = list + (size_t)u.e * LCAP + u.pm * 256;
        constexpr float inv = 1.0f / (SC_T * SC_W);
#pragma unroll
        for (int ai = 0; ai < 2; ++ai)
#pragma unroll
            for (int m = 0; m < 4; ++m) { const int r = ai * HALF + wr * 64 + m * 16 + fr;
                if (r < u.nv) { const int p = le[r];
                    float h[8];
#pragma unroll
                    for (int n = 0; n < 2; ++n)
#pragma unroll
                        for (int x = 0; x < 4; ++x) { float g = acc[ai][0][m][n][x] * inv + (n ? g1[x] : g0[x]); float up = acc[ai][1][m][n][x] * inv + (n ? u1[x] : u0[x]);
                            g = fminf(g, 7.0f); up = fminf(fmaxf(up, -7.0f), 7.0f); h[n * 4 + x] = SC_H * (up + 1.0f) * (g * fsigmoid(1.702f * g)); }
                    u32x2 w; w.x = pk4_fp8(h[0], h[1], h[2], h[3]); w.y = pk4_fp8(h[4], h[5], h[6], h[7]);
                    *(u32x2*)(hid + (size_t)p * D + hc) = w; } }
    }
};
struct EpiDown {
    static constexpr bool PERM = true;
    bf16_t* o; const int* list; const float* bd;
    __device__ __forceinline__ void operator()(const f32x4 (&acc)[2][2][4][2], const Unit& u, int wr, int wc, int fr, int fq) const {
        constexpr float inv = 1.0f / (SC_H * SC_W);
        const int c0 = u.pn * BM + wc * 32 + 8 * fq;
        const float* pb = bd + (size_t)u.e * D + c0;
        f32x4 bv[2][2];
#pragma unroll
        for (int bj = 0; bj < 2; ++bj)
#pragma unroll
            for (int n = 0; n < 2; ++n) bv[bj][n] = *(const f32x4*)(pb + bj * HALF + 4 * n);
        const int* le = list + (size_t)u.e * LCAP + u.pm * 256;
#pragma unroll
        for (int ai = 0; ai < 2; ++ai)
#pragma unroll
            for (int m = 0; m < 4; ++m) { const int r = ai * HALF + wr * 64 + m * 16 + fr;
                if (r < u.nv) { const int p = le[r]; bf16_t* rowp = o + (size_t)p * D + c0;
#pragma unroll
                    for (int bj = 0; bj < 2; ++bj) { const f32x4 v0 = acc[ai][bj][m][0] * inv + bv[bj][0], v1 = acc[ai][bj][m][1] * inv + bv[bj][1];
                        u32x4 w; w.x = cvt_pk_bf16(v0[0], v0[1]); w.y = cvt_pk_bf16(v0[2], v0[3]); w.z = cvt_pk_bf16(v1[0], v1[1]); w.w = cvt_pk_bf16(v1[2], v1[3]);
                        *(u32x4*)(rowp + bj * HALF) = w; } } }
    }
};
}

#define XB_TMO      128
#define XB_XCNT(j)  (256  + 64 * (j))
#define XB_XSUB(j)  (1280 + 64 * (j))
#define XB_XGEN(j)  (2304 + 64 * (j))
#define XB_TOP      3328
#define XB_TOPGEN   3392
#define XCD_BAR_WORDS 3456
#define XB_SPIN_CAP (1u << 18)
__device__ __forceinline__ unsigned xb_ld(unsigned* p)              { return __hip_atomic_load(p, __ATOMIC_RELAXED, __HIP_MEMORY_SCOPE_AGENT); }
__device__ __forceinline__ unsigned xb_add(unsigned* p, unsigned v) { return __hip_atomic_fetch_add(p, v, __ATOMIC_RELAXED, __HIP_MEMORY_SCOPE_AGENT); }
__device__ __forceinline__ unsigned xb_xcc_id() { return (unsigned)__builtin_amdgcn_s_getreg((3 << 11) | 20) & 0xFu; }
#define XB_SPIN(cond, bar) do { unsigned _sp = 0; while (cond) { __builtin_amdgcn_s_sleep(1); \
    if ((++_sp & 255u) == 0u) { if (xb_ld(&(bar)[XB_TMO])) break; if (_sp > XB_SPIN_CAP) { atomicAdd(&(bar)[XB_TMO], 1u); break; } } } } while (0)
struct XcdBarrier { unsigned* bar; unsigned x; volatile LAS unsigned* st; };
__device__ __forceinline__ XcdBarrier xcd_barrier_post(unsigned* bar, volatile LAS unsigned* st) {
    XcdBarrier b; b.bar = bar; b.x = xb_xcc_id(); b.st = st;
    if (threadIdx.x == 0) (void)xb_add(&bar[XB_XCNT(b.x)], 1u);
    return b;
}
__device__ __forceinline__ void xcd_barrier_complete(unsigned* bar, unsigned x, unsigned& nloc, unsigned& nx) {
    const unsigned G = gridDim.x * gridDim.y * gridDim.z;
    unsigned sum, cnt, mine, sp = 0u;
    for (;;) {
        sum = 0u; cnt = 0u; mine = 0u;
#pragma unroll
        for (unsigned j = 0; j < 16; ++j) { const unsigned c = xb_ld(&bar[XB_XCNT(j)]); sum += c; cnt += (c > 0u) ? 1u : 0u; mine = (j == x) ? c : mine; }
        if (sum == G) break;
        __builtin_amdgcn_s_sleep(1);
        if ((++sp & 255u) == 0u) { if (xb_ld(&bar[XB_TMO])) break; if (sp > XB_SPIN_CAP) { atomicAdd(&bar[XB_TMO], 1u); break; } }
    }
    nloc = mine > 0u ? mine : 1u; nx = cnt > 0u ? cnt : 1u;
}
__device__ __forceinline__ void xcd_barrier(const XcdBarrier& b) {
    asm volatile("s_waitcnt vmcnt(0)" ::: "memory");
    __syncthreads();
    if (threadIdx.x == 0) {
        unsigned* bar = b.bar;
        __builtin_amdgcn_s_waitcnt(0);
        unsigned nloc = b.st[0], nx = b.st[1];
        if (nloc == 0u) { xcd_barrier_complete(bar, b.x, nloc, nx); b.st[0] = nloc; b.st[1] = nx; }
        const unsigned old = xb_add(&bar[XB_XSUB(b.x)], 1u);
        const unsigned gen = old / nloc;
        if (old + 1u == (gen + 1u) * nloc) {
            __builtin_amdgcn_fence(__ATOMIC_RELEASE, "agent");
            asm volatile("s_waitcnt vmcnt(0)" ::: "memory");
            const unsigned og = xb_add(&bar[XB_TOP], 1u);
            const unsigned tg = og / nx;
            if (og + 1u == (tg + 1u) * nx) xb_add(&bar[XB_TOPGEN], 1u);
            else XB_SPIN(xb_ld(&bar[XB_TOPGEN]) == tg, bar);
            __builtin_amdgcn_fence(__ATOMIC_ACQUIRE, "agent");
            xb_add(&bar[XB_XGEN(b.x)], 1u);
            asm volatile("s_waitcnt vmcnt(0)" ::: "memory");
        } else {
            XB_SPIN(xb_ld(&bar[XB_XGEN(b.x)]) == gen, bar);
            __builtin_amdgcn_fence(__ATOMIC_ACQUIRE, "agent");
            asm volatile("s_waitcnt vmcnt(0)" ::: "memory");
        }
    }
    __syncthreads();
}

struct Frame {
    LAS unsigned char* lds;
    gu32* ctl;
    int wave, G, vcu;
};

__device__ __forceinline__ void transpose_item(const float* W, int N, int k0, int n0, bf16_t* dst, int K, LAS float* scr, int lane) {
    f32x4 v[8];
#pragma unroll
    for (int it = 0; it < 8; ++it) v[it] = *(const GAS f32x4*)(W + (size_t)(k0 + it * 8 + (lane >> 3)) * N + n0 + 4 * (lane & 7));
#pragma unroll
    for (int it = 0; it < 8; ++it) { LAS float* s = scr + (it * 8 + (lane >> 3)) * 33 + 4 * (lane & 7); s[0] = v[it].x; s[1] = v[it].y; s[2] = v[it].z; s[3] = v[it].w; }
    LDS_WAIT(); asm volatile("" ::: "memory");
    const int c = lane & 7;
#pragma unroll
    for (int j = 0; j < 4; ++j) { const int n = (lane >> 3) + 8 * j; const LAS float* s = scr + (8 * c) * 33 + n;
        u32x4 o; o.x = pk2(s[0 * 33], s[1 * 33]); o.y = pk2(s[2 * 33], s[3 * 33]); o.z = pk2(s[4 * 33], s[5 * 33]); o.w = pk2(s[6 * 33], s[7 * 33]);
        *(GAS u32x4*)(dst + (size_t)n * K + k0 + 8 * c) = o; }
    LDS_WAIT(); asm volatile("" ::: "memory");
}

__device__ __forceinline__ void transpose_item_fp8(const float* W, int N, int k0, int n0, unsigned char* dst, int K, LAS float* scr, int lane) {
    f32x4 v[8];
#pragma unroll
    for (int it = 0; it < 8; ++it) v[it] = *(const GAS f32x4*)(W + (size_t)(k0 + it * 8 + (lane >> 3)) * N + n0 + 4 * (lane & 7));
#pragma unroll
    for (int it = 0; it < 8; ++it) { LAS float* s = scr + (it * 8 + (lane >> 3)) * 33 + 4 * (lane & 7); s[0] = v[it].x * SC_W; s[1] = v[it].y * SC_W; s[2] = v[it].z * SC_W; s[3] = v[it].w * SC_W; }
    LDS_WAIT(); asm volatile("" ::: "memory");
    const int c = lane & 7;
#pragma unroll
    for (int j = 0; j < 4; ++j) { const int n = (lane >> 3) + 8 * j; const LAS float* s = scr + (8 * c) * 33 + n;
        u32x2 o; o.x = pk4_fp8(s[0 * 33], s[1 * 33], s[2 * 33], s[3 * 33]); o.y = pk4_fp8(s[4 * 33], s[5 * 33], s[6 * 33], s[7 * 33]);
        *(GAS u32x2*)(dst + (size_t)n * K + k0 + 8 * c) = o; }
    LDS_WAIT(); asm volatile("" ::: "memory");
}

struct Args { const float* in[19]; float* out; unsigned char* ws; int ph_lo, ph_hi; };

namespace att {
constexpr int SLOT = 8192, NSL = 5;
constexpr int L_K = 0, L_V = NSL * SLOT, L_WS = 2 * NSL * SLOT, L_BIAS = L_WS + 8 * 256, L_OST = L_BIAS + 1024, L_END = L_OST + 8 * 4096;
__device__ __forceinline__ int crow(int r, int hi) { return (r & 3) + 8 * (r >> 2) + 4 * hi; }
__device__ __forceinline__ s16x4 vtr(const LAS char* p) { typedef short v4i16_t __attribute__((ext_vector_type(4))); return __builtin_bit_cast(s16x4, __builtin_amdgcn_ds_read_tr16_b64_v4i16((LAS v4i16_t*)p)); }

__device__ __forceinline__ void unit(const Frame& F, int b, int h, int cg, const bf16_t* Q, const bf16_t* Kb, const bf16_t* Vb, bf16_t* MIX, const float* relb) {
    LAS char* lds = (LAS char*)F.lds;
    const int wid = F.wave, lane = lane_id(), tid = wid * 64 + lane, r32 = lane & 31, hi = lane >> 5;
    const int wp = wid >> 1, half = wid & 1;
    const int c = 4 * cg + wp;
    const long rowbase = (long)b * SEQ;
    LAS float* wsf = (LAS float*)(lds + L_WS) + wid * 64;
    LAS float* tb = (LAS float*)(lds + L_BIAS);
    if (tid < 256) { const int i = tid < NREL ? tid : NREL - 1; tb[tid] = relb[h * NREL + i] * LOG2E; }
    const float cbias = relb[h * NREL + NREL - 1] * LOG2E;
    const bf16_t* Qw = Q + (rowbase + c * 64 + half * 32 + r32) * DA + h * HD;
    bf16x8 qr[4];
#pragma unroll
    for (int d0 = 0; d0 < 4; ++d0) qr[d0] = *(const GAS bf16x8*)(Qw + d0 * 16 + hi * 8);
    const int kc0 = 4 * cg - 8;
    const int krow = tid & 63, kch = tid >> 6;
    const int vrow = tid >> 3, vch = tid & 7;
    const bf16_t* ksrc = Kb + (rowbase + krow) * DA + h * HD + kch * 8;
    const bf16_t* vsrc = Vb + (rowbase + vrow) * DA + h * HD + vch * 8;
    const int kdst = L_K + kch * 1024 + krow * 16, vdst = L_V + (vch >> 2) * 4096 + vrow * 64 + (vch & 3) * 16;
#pragma unroll
    for (int j = 0; j < 4; ++j) { const int kc = kc0 + j;
        if (kc >= 0) { const u32x4 kv = *(const GAS u32x4*)(ksrc + (long)kc * 64 * DA); const u32x4 vv = *(const GAS u32x4*)(vsrc + (long)kc * 64 * DA);
            *(LAS u32x4*)(lds + kdst + j * SLOT) = kv; *(LAS u32x4*)(lds + vdst + j * SLOT) = vv; } }
    float m_run = -INFINITY, l_run = 0.f; f32x16 o[2]; o[0] = f32x16{}; o[1] = f32x16{};
    const int qin = half * 32 + r32;
#pragma unroll 1
    for (int s = 0; s < 9; ++s) {
        __syncthreads();
        const int jn = s + 4, kcn = kc0 + jn; const bool ldn = (jn < 12) && (kcn >= 0);
        u32x4 kv = (u32x4){0u, 0u, 0u, 0u}, vv = (u32x4){0u, 0u, 0u, 0u};
        if (ldn) { kv = *(const GAS u32x4*)(ksrc + (long)kcn * 64 * DA); vv = *(const GAS u32x4*)(vsrc + (long)kcn * 64 * DA); }
        const int j = wp + s, kc = kc0 + j;
        if (kc >= 0) {
            const int slot = (j % NSL) * SLOT;
            const LAS char* kp = lds + L_K + slot + hi * 1024 + r32 * 16;
            f32x16 p0 = f32x16{}, p1 = f32x16{};
#pragma unroll
            for (int d0 = 0; d0 < 4; ++d0) {
                const bf16x8 b0 = *(const LAS bf16x8*)(kp + d0 * 2048), b1 = *(const LAS bf16x8*)(kp + d0 * 2048 + 512);
                p0 = __builtin_amdgcn_mfma_f32_32x32x16_bf16(b0, qr[d0], p0, 0, 0, 0); p1 = __builtin_amdgcn_mfma_f32_32x32x16_bf16(b1, qr[d0], p1, 0, 0, 0); }
            if (s >= 6) { const int ib = qin + 64 * (8 - s) + 63 - 4 * hi;
#pragma unroll
                for (int r = 0; r < 16; ++r) { const int off = (r & 3) + 8 * (r >> 2); p0[r] += tb[ib - off]; p1[r] += tb[ib - off - 32]; }
            } else {
#pragma unroll
                for (int r = 0; r < 16; ++r) { p0[r] += cbias; p1[r] += cbias; }
            }
            float mx = p0[0];
#pragma unroll
            for (int r = 1; r < 16; ++r) mx = fmaxf(mx, p0[r]);
#pragma unroll
            for (int r = 0; r < 16; ++r) mx = fmaxf(mx, p1[r]);
            mx = fmaxf(mx, __shfl_xor(mx, 32));
            const float m_new = fmaxf(m_run, mx);
            const float alpha = __builtin_amdgcn_exp2f(m_run - m_new);
            float rs = 0.f;
#pragma unroll
            for (int r = 0; r < 16; ++r) { p0[r] = __builtin_amdgcn_exp2f(p0[r] - m_new); p1[r] = __builtin_amdgcn_exp2f(p1[r] - m_new); rs += p0[r] + p1[r]; }
            l_run = l_run * alpha + rs;
            if (__any(m_new > m_run)) {
                if (hi == 0) wsf[r32] = alpha;
                LDS_WAIT();
#pragma unroll
                for (int r = 0; r < 16; ++r) { const float f = wsf[crow(r, hi)]; o[0][r] *= f; o[1][r] *= f; }
            }
            m_run = m_new;
            u32x4 pw[4];
#pragma unroll
            for (int q = 0; q < 4; ++q) { pw[0][q] = cvt_pk_bf16(p0[2 * q], p0[2 * q + 1]); pw[1][q] = cvt_pk_bf16(p0[8 + 2 * q], p0[8 + 2 * q + 1]);
                                          pw[2][q] = cvt_pk_bf16(p1[2 * q], p1[2 * q + 1]); pw[3][q] = cvt_pk_bf16(p1[8 + 2 * q], p1[8 + 2 * q + 1]); }
            const LAS char* vp = lds + L_V + slot + ((lane >> 4) & 1) * 32 + (lane & 3) * 8 + (4 * hi + ((lane & 15) >> 2)) * 64;
#pragma unroll
            for (int d0 = 0; d0 < 2; ++d0)
#pragma unroll
                for (int ks = 0; ks < 4; ++ks) {
                    const s16x4 lo = vtr(vp + d0 * 4096 + ks * 1024), hh = vtr(vp + d0 * 4096 + ks * 1024 + 512);
                    const bf16x8 vf = (bf16x8){lo[0], lo[1], lo[2], lo[3], hh[0], hh[1], hh[2], hh[3]};
                    o[d0] = __builtin_amdgcn_mfma_f32_32x32x16_bf16(__builtin_bit_cast(bf16x8, pw[ks]), vf, o[d0], 0, 0, 0); }
        }
        if (ldn) { const int sl = (jn % NSL) * SLOT; *(LAS u32x4*)(lds + kdst + sl) = kv; *(LAS u32x4*)(lds + vdst + sl) = vv; }
    }
    l_run += __shfl_xor(l_run, 32);
    if (hi == 0) wsf[32 + r32] = l_run;
    LDS_WAIT();
    LAS bf16_t* stg = (LAS bf16_t*)(lds + L_OST) + wid * 2048;
#pragma unroll
    for (int r = 0; r < 16; ++r) { const int orow = crow(r, hi); const float rl = __builtin_amdgcn_rcpf(wsf[32 + orow]);
#pragma unroll
        for (int d0 = 0; d0 < 2; ++d0) stg[orow * 64 + d0 * 32 + r32] = (bf16_t)f2bf(o[d0][r] * rl); }
    LDS_WAIT();
    bf16_t* Ow = MIX + (rowbase + c * 64 + half * 32) * D + h * HD;
#pragma unroll
    for (int i = 0; i < 4; ++i) { const int row = i * 8 + (lane >> 3), ch = lane & 7; const u32x4 v = *(const LAS u32x4*)(stg + row * 64 + ch * 8); *(GAS u32x4*)(Ow + (long)row * D + ch * 8) = v; }
    __syncthreads();
}
}

namespace cv {
constexpr int TT = 32, UR = TT + CW - 1;
constexpr int L_U = 0, L_Y = UR * DC * 2  , L_END = L_Y + TT * DC * 4;
__device__ __forceinline__ void unit(const Frame& F, int b, int tt, const bf16_t* Ab, const bf16_t* Gb, bf16_t* MIX, const float* dw_w, const float* dw_b, const float* ln_g, const float* ln_b) {
    LAS char* lds = (LAS char*)F.lds;
    const int wid = F.wave, lane = lane_id(), tid = wid * 64 + lane;
    const int t0 = tt * TT; const long rowbase = (long)b * SEQ;
    for (int idx = tid; idx < UR * 64; idx += 512) { const int r = idx >> 6, c8 = idx & 63; const int tok = t0 - (CW - 1) + r;
        u32x4 w = (u32x4){0u, 0u, 0u, 0u};
        if (tok >= 0) { const u32x4 av = *(const GAS u32x4*)(Ab + (rowbase + tok) * DC + c8 * 8), gv = *(const GAS u32x4*)(Gb + (rowbase + tok) * DC + c8 * 8);
#pragma unroll
            for (int q = 0; q < 4; ++q) { const float u0 = bf_lo(av[q]) * fsigmoid(bf_lo(gv[q])), u1 = bf_hi(av[q]) * fsigmoid(bf_hi(gv[q])); w[q] = cvt_pk_bf16(u0, u1); } }
        *(LAS u32x4*)(lds + L_U + r * (DC * 2) + c8 * 16) = w; }
    __syncthreads();
    { const int cp = tid & 255, th = tid >> 8;
      f32x2 w[CW];
#pragma unroll
      for (int j = 0; j < CW; ++j) w[j] = *(const GAS f32x2*)(dw_w + j * DC + 2 * cp);
      const f32x2 bias = *(const GAS f32x2*)(dw_b + 2 * cp);
#pragma unroll 1
      for (int blk = 0; blk < 2; ++blk) { const int tbk = th * 16 + blk * 8;
          f32x2 acc[8];
#pragma unroll
          for (int k = 0; k < 8; ++k) acc[k] = bias;
#pragma unroll
          for (int i = 0; i < 8 + CW - 1; ++i) { const unsigned uw = *(const LAS unsigned*)(lds + L_U + (tbk + i) * (DC * 2) + cp * 4); const f32x2 uv = (f32x2){bf_lo(uw), bf_hi(uw)};
#pragma unroll
              for (int k = 0; k < 8; ++k) { const int j = i - k; if (j >= 0 && j < CW) acc[k] += uv * w[j]; } }
#pragma unroll
          for (int k = 0; k < 8; ++k) *(LAS f32x2*)(lds + L_Y + (tbk + k) * (DC * 4) + cp * 8) = acc[k]; } }
    __syncthreads();
    { const f32x4 g0 = *(const GAS f32x4*)(ln_g + 8 * lane), g1 = *(const GAS f32x4*)(ln_g + 8 * lane + 4), b0 = *(const GAS f32x4*)(ln_b + 8 * lane), b1 = *(const GAS f32x4*)(ln_b + 8 * lane + 4);
#pragma unroll
      for (int q = 0; q < 4; ++q) { const int t = wid * 4 + q;
          f32x4 y0 = *(const LAS f32x4*)(lds + L_Y + t * (DC * 4) + lane * 32), y1 = *(const LAS f32x4*)(lds + L_Y + t * (DC * 4) + lane * 32 + 16);
          const float mean = wave_sum((y0.x + y0.y) + (y0.z + y0.w) + (y1.x + y1.y) + (y1.z + y1.w)) * (1.f / DC);
          y0 = y0 - mean; y1 = y1 - mean;
          const float var = wave_sum((y0.x * y0.x + y0.y * y0.y) + (y0.z * y0.z + y0.w * y0.w) + (y1.x * y1.x + y1.y * y1.y) + (y1.z * y1.z + y1.w * y1.w)) * (1.f / DC);
          const float rstd = 1.0f / sqrtf(var + LN_EPS);
          y0 = y0 * rstd * g0 + b0; y1 = y1 * rstd * g1 + b1;
          float z[8] = {y0.x, y0.y, y0.z, y0.w, y1.x, y1.y, y1.z, y1.w};
#pragma unroll
          for (int i = 0; i < 8; ++i) z[i] = z[i] * fsigmoid(z[i]);
          u32x4 w; w.x = cvt_pk_bf16(z[0], z[1]); w.y = cvt_pk_bf16(z[2], z[3]); w.z = cvt_pk_bf16(z[4], z[5]); w.w = cvt_pk_bf16(z[6], z[7]);
          *(GAS u32x4*)(MIX + (rowbase + t0 + t) * D + DA + 8 * lane) = w; } }
    __syncthreads();
}
}

__global__ void __launch_bounds__(NWAVES * 64, 2) hymba_fwd(Args args) {
    extern __shared__ __attribute__((aligned(16))) unsigned char lds_raw[];
    Frame F;
    F.lds = (LAS unsigned char*)lds_raw;
    F.wave = __builtin_amdgcn_readfirstlane(threadIdx.x >> 6);
    F.G = gridDim.x; { const int bx = blockIdx.x; F.vcu = (F.G % 8 == 0) ? (bx % 8) * (F.G / 8) + bx / 8 : bx; }
    unsigned char* ws = args.ws;
    F.ctl = (gu32*)(ws + WS_CTL);
    volatile LAS unsigned* MISC = (volatile LAS unsigned*)(F.lds + LDSCTL_OFF);
    for (int u = threadIdx.x; u < (LDS_BYTES - LDSCTL_OFF) / 4; u += NWAVES * 64) ((LAS unsigned*)(F.lds + LDSCTL_OFF))[u] = 0u;
    __syncthreads();
    const int lo = args.ph_lo, hi = args.ph_hi;
    const bool multi = (hi - lo) > 1;
    XcdBarrier bar; bar.bar = (unsigned*)(F.ctl + CW_BAR); bar.x = 0; bar.st = nullptr;
    if (multi) bar = xcd_barrier_post((unsigned*)(F.ctl + CW_BAR), MISC + 8);
#define IN(k) (lo <= (k) && (k) < hi)
#define BOTH(k) (IN(k) && IN((k) + 1))
#define GRID_BAR() xcd_barrier(bar)

    const float* x = args.in[0];
    bf16_t* Win_t = (bf16_t*)(ws + WS_WIN); bf16_t* Wout_t = (bf16_t*)(ws + WS_WOUT); unsigned char* Wgu8 = ws + WS_WGU; unsigned char* Wd8 = ws + WS_WD;
    float* X1 = (float*)(ws + WS_X1); bf16_t* XN = (bf16_t*)(ws + WS_XN);
    bf16_t* Qb = (bf16_t*)(ws + WS_Q); bf16_t* Kb = (bf16_t*)(ws + WS_K); bf16_t* Vb = (bf16_t*)(ws + WS_V); bf16_t* Ab = (bf16_t*)(ws + WS_A); bf16_t* Gb = (bf16_t*)(ws + WS_G);
    bf16_t* MIX = (bf16_t*)(ws + WS_MIX); unsigned char* HID8 = ws + WS_HID; unsigned char* T8 = ws + WS_XN; bf16_t* OB = (bf16_t*)(ws + WS_O);
    int* LIST = (int*)(ws + WS_LIST); float* TOPW = (float*)(ws + WS_TOPW); float* RWT = (float*)(ws + WS_RWT);
    const int gw = F.vcu * NWAVES + F.wave, NGW = F.G * NWAVES;

    if (IN(0)) {
        const int lane = lane_id(), tid = F.wave * 64 + lane;
        LAS float* scr = (LAS float*)(F.lds + F.wave * 16384);
        constexpr int I_IN = (D / 64) * (NIN / 32), I_OUT = (D / 64) * (D / 32), I_EXP = (D / 64) * (D / 32);
        constexpr int NITEMS = I_IN + I_OUT + NE * 3 * I_EXP;
        for (int it = gw; it < NITEMS; it += NGW) {
            int r = it;
            if (r < I_IN) { const int kb = r / (NIN / 32), nb = r % (NIN / 32); transpose_item(args.in[2], NIN, kb * 64, nb * 32, Win_t + (size_t)(nb * 32) * D, D, scr, lane); continue; } r -= I_IN;
            if (r < I_OUT) { const int kb = r / (D / 32), nb = r % (D / 32); transpose_item(args.in[8], D, kb * 64, nb * 32, Wout_t + (size_t)(nb * 32) * D, D, scr, lane); continue; } r -= I_OUT;
            const int em = r / I_EXP, ri = r % I_EXP, e = em / 3, mat = em % 3, kb = ri / (D / 32), nb = ri % (D / 32), n0 = nb * 32;
            if (mat == 2) transpose_item_fp8(args.in[16] + (size_t)e * D * D, D, kb * 64, n0, Wd8 + ((size_t)e * D + n0) * D, D, scr, lane);
            else { const float* src = (mat == 0 ? args.in[12] : args.in[14]) + (size_t)e * D * D;
                   const size_t drow = (size_t)e * 2048 + (size_t)(n0 >> 7) * 256 + (n0 & 127) + (mat == 1 ? 128 : 0);
                   transpose_item_fp8(src, D, kb * 64, n0, Wgu8 + drow * D, D, scr, lane); }
        }
        { const GAS f32x4* gp = (const GAS f32x4*)args.in[1] + lane; f32x4 g[4];
#pragma unroll
          for (int j = 0; j < 4; ++j) g[j] = gp[64 * j];
          for (int m = gw; m < T; m += NGW) { const GAS f32x4* xr = (const GAS f32x4*)(x + (size_t)m * D) + lane; f32x4 v[4]; float s = 0.f;
#pragma unroll
              for (int j = 0; j < 4; ++j) { v[j] = xr[64 * j]; s += (v[j].x * v[j].x + v[j].y * v[j].y) + (v[j].z * v[j].z + v[j].w * v[j].w); }
              const float r = 1.0f / sqrtf(wave_sum(s) * (1.f / D) + RMS_EPS);
              GAS u32x2* o8 = (GAS u32x2*)(XN + (size_t)m * D) + lane;
#pragma unroll
              for (int j = 0; j < 4; ++j) { const f32x4 y = v[j] * r * g[j]; o8[64 * j] = (u32x2){pk2(y.x, y.y), pk2(y.z, y.w)}; } } }
        for (int i = blockIdx.x * 512 + tid; i < NE * D; i += F.G * 512) { const int e = i / D, k = i % D; RWT[i] = args.in[10][k * NE + e]; }
        if (BOTH(0)) GRID_BAR();
    }

    if (IN(1)) {
        pg8::DenseOrder S; S.init(T, NIN, F.G, (int)blockIdx.x, Win_t);
        pg8::EpiSplit E{Qb, (size_t)(WS_K - WS_Q) / 2, QSCALE};
        pg8::gemm_phase<pg8::EpiSplit, pg8::DenseOrder, true, 2>(F.lds, (const char*)XN, D, S, E);
        if (BOTH(1)) GRID_BAR();
    }

    if (IN(2)) {
        for (int u = blockIdx.x; u < 2 * NH * 32; u += F.G) { const int cg = u & 31, h = (u >> 5) & 7, b = u >> 8;
            att::unit(F, b, h, cg, Qb, Kb, Vb, MIX, args.in[7]); }
        for (int u = blockIdx.x; u < T / cv::TT; u += F.G) { const int b = u / (SEQ / cv::TT), tt = u % (SEQ / cv::TT);
            cv::unit(F, b, tt, Ab, Gb, MIX, args.in[3], args.in[4], args.in[5], args.in[6]); }
        if (BOTH(2)) GRID_BAR();
    }

    if (IN(3)) {
        pg8::DenseOrder S; S.init(T, D, F.G, (int)blockIdx.x, Wout_t);
        pg8::EpiRes E{x, X1};
        pg8::gemm_phase<pg8::EpiRes, pg8::DenseOrder, false, 2>(F.lds, (const char*)MIX, D, S, E);
        if (BOTH(3)) GRID_BAR();
    }

    if (IN(4)) {
        const int lane = lane_id(), tid = F.wave * 64 + lane;
        LAS float* rw = (LAS float*)F.lds;
        LAS int* hist = (LAS int*)(F.lds + XTRA_OFF);
        LAS int* baseE = hist + 32;
        LAS int* selE = baseE + 32;
        LAS int* selP = selE + 1024;
        for (int i = tid; i < NE * D / 4; i += 512) ((LAS f32x4*)rw)[i] = ((const GAS f32x4*)RWT)[i];
        if (tid < 32) hist[tid] = 0;
        __syncthreads();
        const int TPB = (T + F.G - 1) / F.G; const int tok0 = blockIdx.x * TPB;
        const GAS f32x4* gp = (const GAS f32x4*)args.in[9] + lane; f32x4 g[4];
#pragma unroll
        for (int j = 0; j < 4; ++j) g[j] = gp[64 * j];
        const float rbias = args.in[11][lane & 31];
#pragma unroll 1
        for (int tl = F.wave; tl < TPB; tl += NWAVES) { const int tok = tok0 + tl; if (tok >= T) break;
            const GAS f32x4* xr = (const GAS f32x4*)(X1 + (size_t)tok * D) + lane; f32x4 v[4]; float s = 0.f;
#pragma unroll
            for (int j = 0; j < 4; ++j) { v[j] = xr[64 * j]; s += (v[j].x * v[j].x + v[j].y * v[j].y) + (v[j].z * v[j].z + v[j].w * v[j].w); }
            const float r = 1.0f / sqrtf(wave_sum(s) * (1.f / D) + RMS_EPS);
            GAS unsigned* o8 = (GAS unsigned*)(T8 + (size_t)tok * D) + lane;
#pragma unroll
            for (int j = 0; j < 4; ++j) { v[j] = v[j] * r * g[j]; o8[64 * j] = pk4_fp8(v[j].x * SC_T, v[j].y * SC_T, v[j].z * SC_T, v[j].w * SC_T); }
            float a[32];
#pragma unroll
            for (int e = 0; e < 32; ++e) { float acc = 0.f;
#pragma unroll
                for (int j = 0; j < 4; ++j) { const f32x4 w = *(const LAS f32x4*)(rw + e * D + 4 * lane + 256 * j); acc += (v[j].x * w.x + v[j].y * w.y) + (v[j].z * w.z + v[j].w * w.w); }
                a[e] = acc; }
#define TR_STEP(N, XV) _Pragma("unroll") for (int i = 0; i < N; ++i) { const bool up = (lane & XV) != 0; const float send = up ? a[i] : a[i + N]; const float keep = up ? a[i + N] : a[i]; a[i] = keep + __shfl_xor(send, XV); }
            TR_STEP(16, 32) TR_STEP(8, 16) TR_STEP(4, 8) TR_STEP(2, 4) TR_STEP(1, 2)
#undef TR_STEP
            a[0] += __shfl_xor(a[0], 1);
            float val = __shfl(a[0], 2 * (lane & 31)) + rbias;
            float tv[4]; int te[4];
#pragma unroll
            for (int k = 0; k < 4; ++k) { float m = val;
#pragma unroll
                for (int o = 1; o < 32; o <<= 1) m = fmaxf(m, __shfl_xor(m, o));
                const unsigned long long ball = __ballot(val == m); const int es = (int)__builtin_ctzll(ball) & 31;
                tv[k] = m; te[k] = es; if ((lane & 31) == es) val = -INFINITY; }
            const float e1 = __expf(tv[1] - tv[0]), e2 = __expf(tv[2] - tv[0]), e3 = __expf(tv[3] - tv[0]); const float inv = 1.0f / (1.0f + e1 + e2 + e3);
            if (lane == 0) { *(GAS f32x4*)(TOPW + (size_t)tok * 4) = (f32x4){inv, e1 * inv, e2 * inv, e3 * inv};
#pragma unroll
                for (int k = 0; k < 4; ++k) { selE[tl * 4 + k] = te[k]; selP[tl * 4 + k] = __hip_atomic_fetch_add(&hist[te[k]], 1, __ATOMIC_RELAXED, __HIP_MEMORY_SCOPE_WORKGROUP); } }
        }
        __syncthreads();
        if (tid < 32) baseE[tid] = (int)__hip_atomic_fetch_add(F.ctl + CW_CNT + 64 * tid, (unsigned)hist[tid], RLX_AGENT);
        __syncthreads();
        for (int i = tid; i < TPB * 4; i += 512) { const int tok = tok0 + (i >> 2); if (tok < T) { const int e = selE[i]; LIST[(size_t)e * LCAP + baseE[e] + selP[i]] = tok * 4 + (i & 3); } }
        if (BOTH(4)) GRID_BAR();
    }

    LAS int* tstart = (LAS int*)(F.lds + XTRA_OFF + 12288);
    LAS int* ecnt = tstart + 64;
    if (IN(5) || IN(6)) {
        const int tid = F.wave * 64 + lane_id();
        __syncthreads();
        if (tid < 32) ecnt[tid] = (int)__hip_atomic_load(F.ctl + CW_CNT + 64 * tid, RLX_AGENT);
        __syncthreads();
        if (tid == 0) { int s = 0; for (int e = 0; e < NE; ++e) { tstart[e] = s; s += (ecnt[e] + 255) >> 8; } tstart[NE] = s; }
        __syncthreads();
    }

    if (IN(5)) {
        pg8::MoeOrder S{tstart, ecnt, LIST, (const char*)Wgu8, 8, 2048, 2, (int)(blockIdx.x % 8), (int)(blockIdx.x / 8), F.G / 8};
        pg8::EpiGU E{HID8, LIST, args.in[13], args.in[15]};
        pg8::gemm_phase<pg8::EpiGU, pg8::MoeOrder, true, 1>(F.lds, (const char*)T8, D, S, E);
        if (BOTH(5)) GRID_BAR();
    }

    if (IN(6)) {
        pg8::MoeOrder S{tstart, ecnt, LIST, (const char*)Wd8, 4, 1024, 0, (int)(blockIdx.x % 8), (int)(blockIdx.x / 8), F.G / 8};
        pg8::EpiDown E{OB, LIST, args.in[17]};
        pg8::gemm_phase<pg8::EpiDown, pg8::MoeOrder, true, 1>(F.lds, (const char*)HID8, D, S, E);
        if (BOTH(6)) GRID_BAR();
    }

    if (IN(7)) {
        const int lane = lane_id();
        const GAS f32x4* gp = (const GAS f32x4*)args.in[18] + lane; f32x4 g[4];
#pragma unroll
        for (int j = 0; j < 4; ++j) g[j] = gp[64 * j];
        unsigned bad = __hip_atomic_load(F.ctl + CW_BAR + XB_TMO, RLX_AGENT);
        for (int m = gw; m < T; m += NGW) {
            const GAS f32x4* xr = (const GAS f32x4*)(X1 + (size_t)m * D) + lane; f32x4 v[4];
#pragma unroll
            for (int j = 0; j < 4; ++j) v[j] = xr[64 * j];
            const f32x4 tw = *(const GAS f32x4*)(TOPW + (size_t)m * 4);
#pragma unroll
            for (int k = 0; k < 4; ++k) { const GAS u32x2* orow = (const GAS u32x2*)(OB + ((size_t)m * 4 + k) * D) + lane; const float wk = tw[k];
#pragma unroll
                for (int j = 0; j < 4; ++j) { const u32x2 w = orow[64 * j]; v[j].x += wk * bf_lo(w.x); v[j].y += wk * bf_hi(w.x); v[j].z += wk * bf_lo(w.y); v[j].w += wk * bf_hi(w.y); } }
            float s = 0.f;
#pragma unroll
            for (int j = 0; j < 4; ++j) s += (v[j].x * v[j].x + v[j].y * v[j].y) + (v[j].z * v[j].z + v[j].w * v[j].w);
            float r = 1.0f / sqrtf(wave_sum(s) * (1.f / D) + RMS_EPS);
            if (bad) r = __builtin_nanf("");
            GAS f32x4* o = (GAS f32x4*)(args.out + (size_t)m * D) + lane;
#pragma unroll
            for (int j = 0; j < 4; ++j) o[64 * j] = v[j] * r * g[j];
        }
    }
#undef IN
#undef BOTH
#undef GRID_BAR
}

#ifndef MK_N_LAUNCHES
#define MK_N_LAUNCHES 1
#endif
extern "C" void kernel_launch(void* const* d_in, const int* in_sizes, int n_in, void* d_out, int out_size, void* d_ws, size_t ws_size, hipStream_t stream) {
    static int grid = 0;
    if (grid == 0) {
        if (n_in != 19 || in_sizes[0] != T * D || out_size != T * D || ws_size < WS_END) { fprintf(stderr, "kernel_launch: unexpected shapes (n_in %d, in0 %d, out %d, ws %zu); nothing launched\n", n_in, n_in > 0 ? in_sizes[0] : -1, out_size, ws_size); grid = -1; return; }
        int dev = 0, cus = 0, per_cu = 0;
        if (hipGetDevice(&dev) != hipSuccess || hipDeviceGetAttribute(&cus, hipDeviceAttributeMultiprocessorCount, dev) != hipSuccess) { fprintf(stderr, "kernel_launch: device query failed\n"); grid = -1; return; }
        if (hipFuncSetAttribute((const void*)hymba_fwd, hipFuncAttributeMaxDynamicSharedMemorySize, LDS_BYTES) != hipSuccess) { fprintf(stderr, "kernel_launch: hipFuncSetAttribute failed\n"); grid = -1; return; }
        if (hipOccupancyMaxActiveBlocksPerMultiprocessor(&per_cu, (const void*)hymba_fwd, NWAVES * 64, LDS_BYTES) != hipSuccess || per_cu < 1) fprintf(stderr, "kernel_launch: note: occupancy query reports %d workgroups per CU\n", per_cu);
        (void)hipGetLastError();
        grid = (cus / 64) * 64; if (grid > 256) grid = 256;
        if (grid < 64) { fprintf(stderr, "kernel_launch: %d CUs: unsupported\n", cus); grid = -1; return; }
    }
    if (grid < 0) return;
    if (hipMemsetAsync((char*)d_ws + WS_CTL, 0, CTL_ZERO_BYTES, stream) != hipSuccess) { fprintf(stderr, "kernel_launch: memset failed\n"); return; }
    Args a{};
    for (int i = 0; i < 19; ++i) a.in[i] = (const float*)d_in[i];
    a.out = (float*)d_out; a.ws = (unsigned char*)d_ws;
    constexpr int NPH = 8;
    if (MK_N_LAUNCHES == 1) { a.ph_lo = 0; a.ph_hi = NPH; hipLaunchKernelGGL(hymba_fwd, dim3(grid), dim3(NWAVES * 64), LDS_BYTES, stream, a); }
    else for (int p = 0; p < NPH; ++p) { a.ph_lo = p; a.ph_hi = p + 1; hipLaunchKernelGGL(hymba_fwd, dim3(grid), dim3(NWAVES * 64), LDS_BYTES, stream, a); }
    const hipError_t le = hipPeekAtLastError();
    if (le != hipSuccess) fprintf(stderr, "kernel_launch: launch failed: %s\n", hipGetErrorName(le));
}
```

```cpp
#include <hip/hip_runtime.h>
#include <cstdio>
#include <cstdint>

#define GAS __attribute__((address_space(1)))
#define LAS __attribute__((address_space(3)))
typedef unsigned short bf16_t;
typedef short bf16x8 __attribute__((ext_vector_type(8)));
typedef short s16x4 __attribute__((ext_vector_type(4)));
typedef float f32x2 __attribute__((ext_vector_type(2)));
typedef float f32x4 __attribute__((ext_vector_type(4)));
typedef float f32x16 __attribute__((ext_vector_type(16)));
typedef unsigned u32x2 __attribute__((ext_vector_type(2)));
typedef unsigned u32x4 __attribute__((ext_vector_type(4)));
typedef int i32x4 __attribute__((ext_vector_type(4)));
typedef int i32x8 __attribute__((ext_vector_type(8)));
typedef GAS unsigned gu32;
#define RLX_AGENT __ATOMIC_RELAXED, __HIP_MEMORY_SCOPE_AGENT
#define LDS_WAIT() asm volatile("s_waitcnt lgkmcnt(0)" ::: "memory")
#define VM_WAIT() asm volatile("s_waitcnt vmcnt(0)" ::: "memory")

constexpr int T = 16384, SEQ = 8192, D = 1024, NIN = 2560, DA = 512, NH = 8, HD = 64, DC = 512, CW = 31;
constexpr int NE = 32, TOPK = 4, NP = T * TOPK, LCAP = 16384, NREL = 192;
constexpr float RMS_EPS = 1e-5f, LN_EPS = 1e-5f, LOG2E = 1.4426950408889634f;
constexpr float QSCALE = 0.125f * LOG2E;
constexpr float SC_T = 16.0f, SC_W = 256.0f, SC_H = 4.0f;

constexpr size_t MiB = 1u << 20;
constexpr size_t WS_CTL = 0, CTL_ZERO_BYTES = 1 * MiB;
constexpr size_t WS_WIN = 1 * MiB, WS_WOUT = 6 * MiB, WS_WGU = 8 * MiB, WS_WD = 136 * MiB, WS_X1 = 200 * MiB, WS_XN = 264 * MiB;
constexpr size_t WS_Q = 296 * MiB, WS_K = 312 * MiB, WS_V = 328 * MiB, WS_A = 344 * MiB, WS_G = 360 * MiB, WS_MIX = 376 * MiB;
constexpr size_t WS_HID = 296 * MiB;
constexpr size_t WS_O = WS_WGU;
constexpr size_t WS_LIST = 424 * MiB, WS_TOPW = 428 * MiB, WS_RWT = 429 * MiB, WS_END = 430 * MiB;
constexpr int CW_TMO = 0, CW_BAR = 4096, CW_CNT = 8192;

constexpr int RING_BYTES = 131072, XTRA_OFF = RING_BYTES, LDS_BYTES = 147456, LDSCTL_OFF = LDS_BYTES - 512;
constexpr int NWAVES = 8;

__device__ __forceinline__ unsigned f2bf(float f) { unsigned u = __builtin_bit_cast(unsigned, f); return (u + 0x7fffu + ((u >> 16) & 1u)) >> 16; }
__device__ __forceinline__ unsigned pk2(float lo, float hi) { return f2bf(lo) | (f2bf(hi) << 16); }
__device__ __forceinline__ unsigned cvt_pk_bf16(float lo, float hi) { unsigned r; asm volatile("v_cvt_pk_bf16_f32 %0, %1, %2" : "=v"(r) : "v"(lo), "v"(hi)); return r; }
__device__ __forceinline__ float clamp448(float v) { return fminf(fmaxf(v, -448.0f), 448.0f); }
__device__ __forceinline__ unsigned pk4_fp8(float a, float b, float c, float d) {
    int r = __builtin_amdgcn_cvt_pk_fp8_f32(clamp448(a), clamp448(b), 0, false);
    r = __builtin_amdgcn_cvt_pk_fp8_f32(clamp448(c), clamp448(d), r, true);
    return (unsigned)r;
}
__device__ __forceinline__ float bf_lo(unsigned w) { return __uint_as_float(w << 16); }
__device__ __forceinline__ float bf_hi(unsigned w) { return __uint_as_float(w & 0xffff0000u); }
__device__ __forceinline__ float fsigmoid(float z) { return __builtin_amdgcn_rcpf(1.0f + __builtin_amdgcn_exp2f(-z * LOG2E)); }
__device__ __forceinline__ int lane_id() { int l; asm volatile("v_mbcnt_lo_u32_b32 %0, -1, 0\n\tv_mbcnt_hi_u32_b32 %0, -1, %0" : "=v"(l)); return l; }
__device__ __forceinline__ float wave_sum(float v) {
#pragma unroll
    for (int o = 1; o < 64; o <<= 1) v += __shfl_xor(v, o);
    return v;
}

namespace pg8 {
constexpr int BM = 256, BK = 64, HALF = 128, HTB = HALF * BK * 2, STAGE_BYTES = 8 * HTB;
__device__ __forceinline__ int lds_byte(int r, int c) { const int st = (r >> 4) * 2 + (c >> 5), rr = r & 15, cc = c & 31, ob = rr * 64 + cc * 2; return st * 1024 + (ob ^ (((ob >> 9) & 1) << 5)); }
__device__ __forceinline__ void stage_rc(int b, int& R, int& C) { const int st = b / 1024, sb = b % 1024, swz = sb ^ (((sb >> 9) & 1) << 5); R = (st >> 1) * 16 + swz / 64; C = (st & 1) * 32 + (swz % 64) / 2; }
__device__ __forceinline__ int perm32(int rho) { const int n = rho >> 4, i = rho & 15; return 8 * (i >> 2) + 4 * n + (i & 3); }

struct Unit { int pm, pn, e, nv; };

template <class Epi, class Sched, bool ALIGN_EPI, int ESZ>
__device__ __forceinline__ void gemm_phase(LAS unsigned char* lds, const char* Abase, const int K, const Sched& S, const Epi& E) {
    const int wid = __builtin_amdgcn_readfirstlane(threadIdx.x >> 6), lane = lane_id(), tid = wid * 64 + lane, wr = wid >> 2, wc = wid & 3, fr = lane & 15, fq = lane >> 4;
    const int RB = K * ESZ, nt = RB / 128;
    unsigned voffB[2];
#pragma unroll
    for (int i = 0; i < 2; ++i) { int R, C; stage_rc(tid * 16 + i * 8192, R, C); const int Rb = Epi::PERM ? ((R & ~31) + perm32(R & 31)) : R; voffB[i] = (unsigned)(Rb * RB + 2 * C); }
    const size_t kstep = (size_t)(BK * 2);
    const size_t hstep = (size_t)HALF * RB;
    const unsigned ldsw = (unsigned)wid * 1024u;
    const int aoff = lds_byte(wr * 64 + fr, fq * 8), boff = lds_byte(wc * 32 + fr, fq * 8);
#define PG8_SA(b, h) (((b) * 2 + (h)) * HTB)
#define PG8_SB(b, h) ((4 + (b) * 2 + (h)) * HTB)
#define PG8_STAGE(bufoff, gbase, voff) do { _Pragma("unroll") for (int _i = 0; _i < 2; ++_i) \
        __builtin_amdgcn_global_load_lds((const unsigned*)((const char*)(gbase) + (voff)[_i]), (LAS unsigned*)(lds + (bufoff) + ldsw + _i * 8192), 16, 0, 0); } while (0)
#define PG8_LD16(off) (*(const LAS i32x4*)(lds + (off)))
#define PG8_LDA(dst, b, h) do { _Pragma("unroll") for (int m = 0; m < 4; ++m) { const i32x4 _x = PG8_LD16(PG8_SA(b, h) + aoff + m * 2048), _y = PG8_LD16(PG8_SA(b, h) + aoff + m * 2048 + 1024); dst[m] = __builtin_shufflevector(_x, _y, 0, 1, 2, 3, 4, 5, 6, 7); } } while (0)
#define PG8_LDB(dst, b, h) do { _Pragma("unroll") for (int n = 0; n < 2; ++n) { const i32x4 _x = PG8_LD16(PG8_SB(b, h) + boff + n * 2048), _y = PG8_LD16(PG8_SB(b, h) + boff + n * 2048 + 1024); dst[n] = __builtin_shufflevector(_x, _y, 0, 1, 2, 3, 4, 5, 6, 7); } } while (0)
#define PG8_MMA(ai, bj, At, Bt) do { __builtin_amdgcn_s_setprio(1); _Pragma("unroll") for (int m = 0; m < 4; ++m) _Pragma("unroll") for (int n = 0; n < 2; ++n) _Pragma("unroll") for (int k = 0; k < 2; ++k) \
        acc[ai][bj][m][n] = __builtin_amdgcn_mfma_f32_16x16x32_bf16(PG8_HALF(Bt[n], k), PG8_HALF(At[m], k), acc[ai][bj][m][n], 0, 0, 0); __builtin_amdgcn_s_setprio(0); } while (0)
#define PG8_HALF(v, k) __builtin_bit_cast(bf16x8, (k) == 0 ? __builtin_shufflevector((v), (v), 0, 1, 2, 3) : __builtin_shufflevector((v), (v), 4, 5, 6, 7))
#define PG8_MMA8(ai, bj, At, Bt) do { __builtin_amdgcn_s_setprio(1); _Pragma("unroll") for (int m = 0; m < 4; ++m) _Pragma("unroll") for (int n = 0; n < 2; ++n) \
        acc[ai][bj][m][n] = __builtin_amdgcn_mfma_scale_f32_16x16x128_f8f6f4(Bt[n], At[m], acc[ai][bj][m][n], 0, 0, 0, 0x7f7f7f7f, 0, 0x7f7f7f7f); __builtin_amdgcn_s_setprio(0); } while (0)
#define PG8_MM(ai, bj, At, Bt) do { if constexpr (ESZ == 2) PG8_MMA(ai, bj, At, Bt); else PG8_MMA8(ai, bj, At, Bt); } while (0)
#define PG8_WAIT_V(n) asm volatile("s_waitcnt vmcnt(" #n ")" ::: "memory")
#define PG8_WAIT_L(n) asm volatile("s_waitcnt lgkmcnt(" #n ")" ::: "memory")
#define PG8_BAR __builtin_amdgcn_s_barrier()
#define PG8_SCHED __builtin_amdgcn_sched_barrier(0)
    Unit cur, nxt; int ui = 0;
    if (!S.next(0, cur)) return;
    f32x4 acc[2][2][4][2];
#pragma unroll
    for (int a = 0; a < 2; ++a)
#pragma unroll
        for (int b = 0; b < 2; ++b)
#pragma unroll
            for (int m = 0; m < 4; ++m)
#pragma unroll
                for (int n = 0; n < 2; ++n) acc[a][b][m][n] = (f32x4){0.f, 0.f, 0.f, 0.f};
    i32x8 At[4], B0[2], B1[2];
    unsigned vA0[2], vA1[2];
    LAS u32x4* const vslot = (LAS u32x4*)(lds + STAGE_BYTES) + tid;
    LAS u32x2* const rowtab = (LAS u32x2*)(lds + STAGE_BYTES + 8192);
    LAS f32x4* const biastab = (LAS f32x4*)(lds + STAGE_BYTES + 8192 + 4096);
    if constexpr (Sched::GATHER) {
        if (tid < 256) rowtab[tid] = *S.entry_ptr(cur, tid);
        else if (tid < 320) biastab[tid - 256] = *(const f32x4*)S.bias_ptr(cur, tid - 256);
        __syncthreads();
        S.a_off_tab(rowtab, cur.nv, tid, RB, vA0, vA1);
    } else S.a_off(cur, tid, RB, vA0, vA1);
    const char* cB = S.b_ptr(cur, RB);
    const char* cA = Abase;
    PG8_STAGE(PG8_SB(0, 0), cB, voffB); PG8_STAGE(PG8_SB(0, 1), cB + hstep, voffB); PG8_STAGE(PG8_SA(0, 0), cA, vA0); PG8_STAGE(PG8_SA(0, 1), cA, vA1);
    if (wr == 1) PG8_BAR;
    PG8_WAIT_V(2); PG8_BAR;
    PG8_STAGE(PG8_SB(1, 0), cB + kstep, voffB); PG8_STAGE(PG8_SA(1, 0), cA + kstep, vA0); PG8_STAGE(PG8_SB(1, 1), cB + hstep + kstep, voffB);
    PG8_WAIT_V(6); PG8_BAR;
    for (;;) {
        const bool has_next = S.next(ui + 1, nxt);
        const char* nB = cB;
        const int par = ui & 1;
        if constexpr (Sched::GATHER) {
            if (has_next) nB = S.b_ptr(nxt, RB);
            else *vslot = (u32x4){vA0[0], vA0[1], vA1[0], vA1[1]};
        } else {
            unsigned n0[2] = {vA0[0], vA0[1]}, n1[2] = {vA1[0], vA1[1]};
            if (has_next) { S.a_off(nxt, tid, RB, n0, n1); nB = S.b_ptr(nxt, RB); }
            *vslot = (u32x4){n0[0], n0[1], n1[0], n1[1]};
        }
#pragma clang loop unroll(disable)
        for (int t = 0; t < nt; t += 2) {
            const bool last = (t == nt - 2);
            if constexpr (Sched::GATHER) {
                if (has_next && t == 2) { const int l2 = lane_id();
                    if (wid < 2) __builtin_amdgcn_global_load_lds((const unsigned*)((const char*)S.entry_ptr(nxt, 0) + (wid * 64 + l2) * 16), (LAS unsigned*)((LAS char*)(rowtab + (par ^ 1) * 256) + wid * 1024), 16, 0, 0);
                    if (wid == 4) __builtin_amdgcn_global_load_lds((const unsigned*)S.bias_ptr(nxt, l2), (LAS unsigned*)(biastab + (par ^ 1) * 64), 16, 0, 0); }
                if (has_next && t == 4) { unsigned n0[2], n1[2]; const int t2 = wid * 64 + lane_id(); S.a_off_tab(rowtab + (par ^ 1) * 256, nxt.nv, t2, RB, n0, n1); ((LAS u32x4*)(lds + STAGE_BYTES))[t2] = (u32x4){n0[0], n0[1], n1[0], n1[1]}; }
            }
            const char* a1 = cA + (size_t)(t + 1) * kstep;
            const char* a2 = last ? cA : cA + (size_t)(t + 2) * kstep; const char* b2 = last ? nB : cB + (size_t)(t + 2) * kstep;
            const char* a3 = a2 + kstep; const char* b3 = b2 + kstep;
            PG8_LDB(B0, 0, 0); PG8_LDB(B1, 0, 1); PG8_SCHED; PG8_LDA(At, 0, 0); PG8_STAGE(PG8_SA(1, 1), a1, vA1);
            if (last) { const u32x4 nv = *vslot; vA0[0] = nv.x; vA0[1] = nv.y; vA1[0] = nv.z; vA1[1] = nv.w; }
            PG8_WAIT_V(8); PG8_WAIT_L(0); PG8_BAR; PG8_MM(0, 0, At, B0); PG8_MM(0, 1, At, B1); PG8_BAR; PG8_SCHED;
            PG8_LDA(At, 0, 1); PG8_STAGE(PG8_SB(0, 0), b2, voffB); PG8_STAGE(PG8_SB(0, 1), b2 + hstep, voffB); PG8_STAGE(PG8_SA(0, 0), a2, vA0);
            PG8_WAIT_V(8); PG8_WAIT_L(0); PG8_BAR; PG8_MM(1, 0, At, B0); PG8_MM(1, 1, At, B1); PG8_BAR; PG8_SCHED;
            PG8_LDB(B0, 1, 0); PG8_LDB(B1, 1, 1); PG8_SCHED; PG8_LDA(At, 1, 0); PG8_STAGE(PG8_SA(0, 1), a2, vA1);
            PG8_WAIT_V(8); PG8_WAIT_L(0); PG8_BAR; PG8_MM(0, 0, At, B0); PG8_MM(0, 1, At, B1); PG8_BAR; PG8_SCHED;
            PG8_LDA(At, 1, 1); PG8_STAGE(PG8_SB(1, 0), b3, voffB); PG8_STAGE(PG8_SB(1, 1), b3 + hstep, voffB); PG8_STAGE(PG8_SA(1, 0), a3, vA0);
            PG8_WAIT_V(8); PG8_WAIT_L(0); PG8_BAR; PG8_MM(1, 0, At, B0); PG8_MM(1, 1, At, B1); PG8_BAR; PG8_SCHED;
        }
        if constexpr (ALIGN_EPI) { if (wr == 0) PG8_BAR; }
        if constexpr (Sched::GATHER) E(acc, cur, wr, wc, fr, fq, rowtab + par * 256, biastab + par * 64); else E(acc, cur, wr, wc, fr, fq);
        if (!has_next) break;
#pragma unroll
        for (int a = 0; a < 2; ++a)
#pragma unroll
            for (int b = 0; b < 2; ++b)
#pragma unroll
                for (int m = 0; m < 4; ++m)
#pragma unroll
                    for (int n = 0; n < 2; ++n) acc[a][b][m][n] = (f32x4){0.f, 0.f, 0.f, 0.f};
        cur = nxt; cB = nB; ++ui;
        if constexpr (ALIGN_EPI) { if (wr == 1) PG8_BAR; }
    }
    PG8_WAIT_V(0);
    if constexpr (!ALIGN_EPI) { if (wr == 0) PG8_BAR; }
    PG8_BAR;
#undef PG8_SA
#undef PG8_SB
#undef PG8_STAGE
#undef PG8_LDA
#undef PG8_LDB
#undef PG8_MMA
#undef PG8_MMA8
#undef PG8_MM
#undef PG8_HALF
#undef PG8_LD16
#undef PG8_WAIT_V
#undef PG8_WAIT_L
#undef PG8_BAR
#undef PG8_SCHED
}

struct DenseOrder {
    static constexpr bool GATHER = false;
    int nM, nN, nwg, G, c; const char* Bt;
    __device__ __forceinline__ void init(int M, int N, int G_, int c_, const void* Bt_) { nM = M / BM; nN = N / BM; nwg = nM * nN; G = G_; c = c_; Bt = (const char*)Bt_; }
    __device__ __forceinline__ bool next(int i, Unit& u) const {
        const long L = (long)i * G + c; if (L >= nwg) return false;
        int wgid = (int)L; { const int q = nwg / 8, r = nwg % 8, xcd = wgid % 8, off = wgid / 8; wgid = (xcd < r ? xcd * (q + 1) : r * (q + 1) + (xcd - r) * q) + off; }
        const int nig = 8 * nN, gid = wgid / nig, fm = gid * 8, gsz = (nM - fm) < 8 ? (nM - fm) : 8;
        u.pm = fm + ((wgid % nig) % gsz); u.pn = (wgid % nig) / gsz; u.e = 0; u.nv = 256; return true;
    }
    __device__ __forceinline__ const char* b_ptr(const Unit& u, int RB) const { return Bt + (size_t)u.pn * (256 * (size_t)RB); }
    __device__ __forceinline__ void a_off(const Unit& u, int tid, int RB, unsigned (&v0)[2], unsigned (&v1)[2]) const {
#pragma unroll
        for (int i = 0; i < 2; ++i) { int R, C; stage_rc(tid * 16 + i * 8192, R, C); v0[i] = (unsigned)((u.pm * 256 + R) * RB + 2 * C); v1[i] = (unsigned)((u.pm * 256 + 128 + R) * RB + 2 * C); }
    }
};
struct MoeOrder {
    static constexpr bool GATHER = true;
    const LAS int* tstart;
    const LAS int* cnt;
    const u32x2* list;
    const char* Bt; int npn, nrowsB, shiftA;
    const float* bias0; const float* bias1; int bcols;
    int xg, j, nper;
    __device__ __forceinline__ bool next(int i, Unit& u) const {
        const int B = i * 8 + xg, rg = nper / npn, R = rg * B + j / npn;
        const int Rtot = tstart[NE];
        if (R >= Rtot) return false;
        int e = 0;
#pragma unroll 1
        for (int q = 1; q < NE; ++q) e += (tstart[q] <= R) ? 1 : 0;
        u.e = e; u.pm = R - tstart[e]; u.pn = j % npn; const int rem = cnt[e] - u.pm * 256; u.nv = rem < 256 ? rem : 256; return true;
    }
    __device__ __forceinline__ const char* b_ptr(const Unit& u, int RB) const { return Bt + ((size_t)u.e * nrowsB + (size_t)u.pn * 256) * (size_t)RB; }
    __device__ __forceinline__ const u32x2* entry_ptr(const Unit& u, int t) const { return list + (size_t)u.e * LCAP + u.pm * 256 + t; }
    __device__ __forceinline__ const float* bias_ptr(const Unit& u, int i) const {
        return (bcols == 128) ? ((i < 32 ? bias0 : bias1) + (size_t)u.e * D + u.pn * 128 + 4 * (i & 31)) : (bias0 + (size_t)u.e * D + u.pn * 256 + 4 * i); }
    __device__ __forceinline__ void a_off_tab(const LAS u32x2* rt, int nv, int tid, int RB, unsigned (&v0)[2], unsigned (&v1)[2]) const {
#pragma unroll
        for (int i = 0; i < 2; ++i) { int R, C; stage_rc(tid * 16 + i * 8192, R, C);
            const int p0 = (int)rt[R < nv ? R : 0].x >> shiftA, p1 = (int)rt[(128 + R) < nv ? (128 + R) : 0].x >> shiftA;
            v0[i] = (unsigned)(p0 * RB + 2 * C); v1[i] = (unsigned)(p1 * RB + 2 * C); }
    }
};

struct EpiSplit {
    static constexpr bool PERM = true;
    bf16_t* O; size_t split_stride; float scale0;
    __device__ __forceinline__ void operator()(const f32x4 (&acc)[2][2][4][2], const Unit& u, int wr, int wc, int fr, int fq) const {
        const int row0 = u.pm * BM + wr * 64 + fr; int colt = u.pn * BM; const int t = colt / 512; bf16_t* base = O + (size_t)t * split_stride; colt -= t * 512;
        const float sc = (t == 0) ? scale0 : 1.f;
        const int col0 = colt + wc * 32 + 8 * fq;
#pragma unroll
        for (int ai = 0; ai < 2; ++ai)
#pragma unroll
            for (int m = 0; m < 4; ++m) { bf16_t* rowp = base + (size_t)(row0 + ai * HALF + m * 16) * 512 + col0;
#pragma unroll
                for (int bj = 0; bj < 2; ++bj) { const f32x4 v0 = acc[ai][bj][m][0] * sc, v1 = acc[ai][bj][m][1] * sc;
                    u32x4 w; w.x = cvt_pk_bf16(v0[0], v0[1]); w.y = cvt_pk_bf16(v0[2], v0[3]); w.z = cvt_pk_bf16(v1[0], v1[1]); w.w = cvt_pk_bf16(v1[2], v1[3]);
                    *(u32x4*)(rowp + bj * HALF) = w; } }
    }
};
struct EpiRes {
    static constexpr bool PERM = true;
    const float* base; float* out; unsigned char* t8; const float* gain;
    __device__ __forceinline__ void operator()(const f32x4 (&acc)[2][2][4][2], const Unit& u, int wr, int wc, int fr, int fq) const {
        const int row0 = u.pm * BM + wr * 64 + fr, col0 = u.pn * BM + wc * 32 + 8 * fq;
        f32x4 gv[2][2];
#pragma unroll
        for (int bj = 0; bj < 2; ++bj)
#pragma unroll
            for (int n = 0; n < 2; ++n) gv[bj][n] = *(const f32x4*)(gain + col0 + bj * HALF + 4 * n) * SC_T;
#pragma unroll
        for (int ai = 0; ai < 2; ++ai)
#pragma unroll
            for (int m = 0; m < 4; ++m) { const size_t off = (size_t)(row0 + ai * HALF + m * 16) * D + col0;
#pragma unroll
                for (int bj = 0; bj < 2; ++bj) { const f32x4 v0 = *(const f32x4*)(base + off + bj * HALF) + acc[ai][bj][m][0], v1 = *(const f32x4*)(base + off + bj * HALF + 4) + acc[ai][bj][m][1];
                    *(f32x4*)(out + off + bj * HALF) = v0; *(f32x4*)(out + off + bj * HALF + 4) = v1;
                    const f32x4 s0 = v0 * gv[bj][0], s1 = v1 * gv[bj][1];
                    *(u32x2*)(t8 + off + bj * HALF) = (u32x2){pk4_fp8(s0[0], s0[1], s0[2], s0[3]), pk4_fp8(s1[0], s1[1], s1[2], s1[3])}; } }
    }
};
struct EpiGU {
    static constexpr bool PERM = true;
    unsigned char* hid;
    __device__ __forceinline__ void operator()(const f32x4 (&acc)[2][2][4][2], const Unit& u, int wr, int wc, int fr, int fq, const LAS u32x2* rt, const LAS f32x4* bt) const {
        const int hc = u.pn * 128 + wc * 32 + 8 * fq;
        const f32x4 g0 = bt[8 * wc + 2 * fq], g1 = bt[8 * wc + 2 * fq + 1], u0 = bt[32 + 8 * wc + 2 * fq], u1 = bt[32 + 8 * wc + 2 * fq + 1];
        constexpr float inv = 1.0f / (SC_T * SC_W);
#pragma unroll
        for (int ai = 0; ai < 2; ++ai)
#pragma unroll
            for (int m = 0; m < 4; ++m) { const int r = ai * HALF + wr * 64 + m * 16 + fr;
                const u32x2 en = rt[r]; const float rs = __uint_as_float(en.y) * inv;
                float h[8];
#pragma unroll
                for (int n = 0; n < 2; ++n)
#pragma unroll
                    for (int x = 0; x < 4; ++x) { float g = acc[ai][0][m][n][x] * rs + (n ? g1[x] : g0[x]); float up = acc[ai][1][m][n][x] * rs + (n ? u1[x] : u0[x]);
                        g = fminf(g, 7.0f); up = fminf(fmaxf(up, -7.0f), 7.0f); h[n * 4 + x] = SC_H * (up + 1.0f) * (g * fsigmoid(1.702f * g)); }
                u32x2 w; w.x = pk4_fp8(h[0], h[1], h[2], h[3]); w.y = pk4_fp8(h[4], h[5], h[6], h[7]);
                if (r < u.nv) *(u32x2*)(hid + (size_t)en.x * D + hc) = w; }
    }
};
struct EpiDown {
    static constexpr bool PERM = true;
    bf16_t* o;
    __device__ __forceinline__ void operator()(const f32x4 (&acc)[2][2][4][2], const Unit& u, int wr, int wc, int fr, int fq, const LAS u32x2* rt, const LAS f32x4* bt) const {
        constexpr float inv = 1.0f / (SC_H * SC_W);
        const int c0 = u.pn * BM + wc * 32 + 8 * fq;
        f32x4 bv[2][2];
#pragma unroll
        for (int bj = 0; bj < 2; ++bj)
#pragma unroll
            for (int n = 0; n < 2; ++n) bv[bj][n] = bt[bj * 32 + wc * 8 + 2 * fq + n];
#pragma unroll
        for (int ai = 0; ai < 2; ++ai)
#pragma unroll
            for (int m = 0; m < 4; ++m) { const int r = ai * HALF + wr * 64 + m * 16 + fr;
                const unsigned p = rt[r].x; bf16_t* rowp = o + (size_t)p * D + c0;
#pragma unroll
                for (int bj = 0; bj < 2; ++bj) { const f32x4 v0 = acc[ai][bj][m][0] * inv + bv[bj][0], v1 = acc[ai][bj][m][1] * inv + bv[bj][1];
                    u32x4 w; w.x = cvt_pk_bf16(v0[0], v0[1]); w.y = cvt_pk_bf16(v0[2], v0[3]); w.z = cvt_pk_bf16(v1[0], v1[1]); w.w = cvt_pk_bf16(v1[2], v1[3]);
                    if (r < u.nv) *(u32x4*)(rowp + bj * HALF) = w; } }
    }
};
}

#define XB_TMO      128
#define XB_XCNT(j)  (256  + 64 * (j))
#define XB_XSUB(j)  (1280 + 64 * (j))
#define XB_XGEN(j)  (2304 + 64 * (j))
#define XB_TOP      3328
#define XB_TOPGEN   3392
#define XCD_BAR_WORDS 3456
#define XB_SPIN_CAP (1u << 18)
__device__ __forceinline__ unsigned xb_ld(unsigned* p)              { return __hip_atomic_load(p, __ATOMIC_RELAXED, __HIP_MEMORY_SCOPE_AGENT); }
__device__ __forceinline__ unsigned xb_add(unsigned* p, unsigned v) { return __hip_atomic_fetch_add(p, v, __ATOMIC_RELAXED, __HIP_MEMORY_SCOPE_AGENT); }
__device__ __forceinline__ unsigned xb_xcc_id() { return (unsigned)__builtin_amdgcn_s_getreg((3 << 11) | 20) & 0xFu; }
#define XB_SPIN(cond, bar) do { unsigned _sp = 0; while (cond) { __builtin_amdgcn_s_sleep(1); \
    if ((++_sp & 255u) == 0u) { if (xb_ld(&(bar)[XB_TMO])) break; if (_sp > XB_SPIN_CAP) { atomicAdd(&(bar)[XB_TMO], 1u); break; } } } } while (0)
struct XcdBarrier { unsigned* bar; unsigned x; volatile LAS unsigned* st; };
__device__ __forceinline__ XcdBarrier xcd_barrier_post(unsigned* bar, volatile LAS unsigned* st) {
    XcdBarrier b; b.bar = bar; b.x = xb_xcc_id(); b.st = st;
    if (threadIdx.x == 0) (void)xb_add(&bar[XB_XCNT(b.x)], 1u);
    return b;
}
__device__ __forceinline__ void xcd_barrier_complete(unsigned* bar, unsigned x, unsigned& nloc, unsigned& nx) {
    const unsigned G = gridDim.x * gridDim.y * gridDim.z;
    unsigned sum, cnt, mine, sp = 0u;
    for (;;) {
        sum = 0u; cnt = 0u; mine = 0u;
#pragma unroll
        for (unsigned j = 0; j < 16; ++j) { const unsigned c = xb_ld(&bar[XB_XCNT(j)]); sum += c; cnt += (c > 0u) ? 1u : 0u; mine = (j == x) ? c : mine; }
        if (sum == G) break;
        __builtin_amdgcn_s_sleep(1);
        if ((++sp & 255u) == 0u) { if (xb_ld(&bar[XB_TMO])) break; if (sp > XB_SPIN_CAP) { atomicAdd(&bar[XB_TMO], 1u); break; } }
    }
    nloc = mine > 0u ? mine : 1u; nx = cnt > 0u ? cnt : 1u;
}
__device__ __forceinline__ void xcd_barrier(const XcdBarrier& b) {
    asm volatile("s_waitcnt vmcnt(0)" ::: "memory");
    __syncthreads();
    if (threadIdx.x == 0) {
        unsigned* bar = b.bar;
        __builtin_amdgcn_s_waitcnt(0);
        unsigned nloc = b.st[0], nx = b.st[1];
        if (nloc == 0u) { xcd_barrier_complete(bar, b.x, nloc, nx); b.st[0] = nloc; b.st[1] = nx; }
        const unsigned old = xb_add(&bar[XB_XSUB(b.x)], 1u);
        const unsigned gen = old / nloc;
        if (old + 1u == (gen + 1u) * nloc) {
            __builtin_amdgcn_fence(__ATOMIC_RELEASE, "agent");
            asm volatile("s_waitcnt vmcnt(0)" ::: "memory");
            const unsigned og = xb_add(&bar[XB_TOP], 1u);
            const unsigned tg = og / nx;
            if (og + 1u == (tg + 1u) * nx) xb_add(&bar[XB_TOPGEN], 1u);
            else XB_SPIN(xb_ld(&bar[XB_TOPGEN]) == tg, bar);
            __builtin_amdgcn_fence(__ATOMIC_ACQUIRE, "agent");
            xb_add(&bar[XB_XGEN(b.x)], 1u);
            asm volatile("s_waitcnt vmcnt(0)" ::: "memory");
        } else {
            XB_SPIN(xb_ld(&bar[XB_XGEN(b.x)]) == gen, bar);
            __builtin_amdgcn_fence(__ATOMIC_ACQUIRE, "agent");
            asm volatile("s_waitcnt vmcnt(0)" ::: "memory");
        }
    }
    __syncthreads();
}

struct Frame {
    LAS unsigned char* lds;
    gu32* ctl;
    int wave, G, vcu;
};

__device__ __forceinline__ void transpose_item(const float* W, int N, int k0, int n0, bf16_t* dst, int K, LAS float* scr, int lane) {
    f32x4 v[8];
#pragma unroll
    for (int it = 0; it < 8; ++it) v[it] = *(const GAS f32x4*)(W + (size_t)(k0 + it * 8 + (lane >> 3)) * N + n0 + 4 * (lane & 7));
#pragma unroll
    for (int it = 0; it < 8; ++it) { LAS float* s = scr + (it * 8 + (lane >> 3)) * 33 + 4 * (lane & 7); s[0] = v[it].x; s[1] = v[it].y; s[2] = v[it].z; s[3] = v[it].w; }
    LDS_WAIT(); asm volatile("" ::: "memory");
    const int c = lane & 7;
#pragma unroll
    for (int j = 0; j < 4; ++j) { const int n = (lane >> 3) + 8 * j; const LAS float* s = scr + (8 * c) * 33 + n;
        u32x4 o; o.x = pk2(s[0 * 33], s[1 * 33]); o.y = pk2(s[2 * 33], s[3 * 33]); o.z = pk2(s[4 * 33], s[5 * 33]); o.w = pk2(s[6 * 33], s[7 * 33]);
        *(GAS u32x4*)(dst + (size_t)n * K + k0 + 8 * c) = o; }
    LDS_WAIT(); asm volatile("" ::: "memory");
}

__device__ __forceinline__ void transpose_item_fp8(const float* W, int N, int k0, int n0, unsigned char* dst, int K, LAS float* scr, int lane) {
    f32x4 v[8];
#pragma unroll
    for (int it = 0; it < 8; ++it) v[it] = *(const GAS f32x4*)(W + (size_t)(k0 + it * 8 + (lane >> 3)) * N + n0 + 4 * (lane & 7));
#pragma unroll
    for (int it = 0; it < 8; ++it) { LAS float* s = scr + (it * 8 + (lane >> 3)) * 33 + 4 * (lane & 7); s[0] = v[it].x * SC_W; s[1] = v[it].y * SC_W; s[2] = v[it].z * SC_W; s[3] = v[it].w * SC_W; }
    LDS_WAIT(); asm volatile("" ::: "memory");
    const int c = lane & 7;
#pragma unroll
    for (int j = 0; j < 4; ++j) { const int n = (lane >> 3) + 8 * j; const LAS float* s = scr + (8 * c) * 33 + n;
        u32x2 o; o.x = pk4_fp8(s[0 * 33], s[1 * 33], s[2 * 33], s[3 * 33]); o.y = pk4_fp8(s[4 * 33], s[5 * 33], s[6 * 33], s[7 * 33]);
        *(GAS u32x2*)(dst + (size_t)n * K + k0 + 8 * c) = o; }
    LDS_WAIT(); asm volatile("" ::: "memory");
}

struct Args { const float* in[19]; float* out; unsigned char* ws; int ph_lo, ph_hi; };

namespace att {
constexpr int SLOT = 8192, NSL = 5;
constexpr int L_K = 0, L_V = NSL * SLOT, L_WS = 2 * NSL * SLOT, L_BIAS = L_WS + 8 * 256, L_OST = L_BIAS + 1024, L_END = L_OST + 8 * 4096;
__device__ __forceinline__ int crow(int r, int hi) { return (r & 3) + 8 * (r >> 2) + 4 * hi; }
__device__ __forceinline__ s16x4 vtr(const LAS char* p) { typedef short v4i16_t __attribute__((ext_vector_type(4))); return __builtin_bit_cast(s16x4, __builtin_amdgcn_ds_read_tr16_b64_v4i16((LAS v4i16_t*)p)); }

__device__ __forceinline__ void unit(const Frame& F, int b, int h, int cg, const bf16_t* Q, const bf16_t* Kb, const bf16_t* Vb, bf16_t* MIX, const float* relb) {
    LAS char* lds = (LAS char*)F.lds;
    const int wid = F.wave, lane = lane_id(), tid = wid * 64 + lane, r32 = lane & 31, hi = lane >> 5;
    const int wp = wid >> 1, half = wid & 1;
    const int c = 4 * cg + wp;
    const long rowbase = (long)b * SEQ;
    LAS float* wsf = (LAS float*)(lds + L_WS) + wid * 64;
    LAS float* tb = (LAS float*)(lds + L_BIAS);
    if (tid < 256) { const int i = tid < NREL ? tid : NREL - 1; tb[tid] = relb[h * NREL + i] * LOG2E; }
    const float cbias = relb[h * NREL + NREL - 1] * LOG2E;
    const bf16_t* Qw = Q + (rowbase + c * 64 + half * 32 + r32) * DA + h * HD;
    bf16x8 qr[4];
#pragma unroll
    for (int d0 = 0; d0 < 4; ++d0) qr[d0] = *(const GAS bf16x8*)(Qw + d0 * 16 + hi * 8);
    const int kc0 = 4 * cg - 8;
    const int krow = tid & 63, kch = tid >> 6;
    const int vrow = tid >> 3, vch = tid & 7;
    const bf16_t* ksrc = Kb + (rowbase + krow) * DA + h * HD + kch * 8;
    const bf16_t* vsrc = Vb + (rowbase + vrow) * DA + h * HD + vch * 8;
    const int kdst = L_K + kch * 1024 + krow * 16, vdst = L_V + (vch >> 2) * 4096 + vrow * 64 + (vch & 3) * 16;
#pragma unroll
    for (int j = 0; j < 4; ++j) { const int kc = kc0 + j;
        if (kc >= 0) { const u32x4 kv = *(const GAS u32x4*)(ksrc + (long)kc * 64 * DA); const u32x4 vv = *(const GAS u32x4*)(vsrc + (long)kc * 64 * DA);
            *(LAS u32x4*)(lds + kdst + j * SLOT) = kv; *(LAS u32x4*)(lds + vdst + j * SLOT) = vv; } }
    float m_run = -INFINITY, l_run = 0.f; f32x16 o[2]; o[0] = f32x16{}; o[1] = f32x16{};
    const int qin = half * 32 + r32;
#pragma unroll 1
    for (int s = 0; s < 9; ++s) {
        __syncthreads();
        const int jn = s + 4, kcn = kc0 + jn; const bool ldn = (jn < 12) && (kcn >= 0);
        u32x4 kv = (u32x4){0u, 0u, 0u, 0u}, vv = (u32x4){0u, 0u, 0u, 0u};
        if (ldn) { kv = *(const GAS u32x4*)(ksrc + (long)kcn * 64 * DA); vv = *(const GAS u32x4*)(vsrc + (long)kcn * 64 * DA); }
        const int j = wp + s, kc = kc0 + j;
        if (kc >= 0) {
            const int slot = (j % NSL) * SLOT;
            const LAS char* kp = lds + L_K + slot + hi * 1024 + r32 * 16;
            f32x16 p0 = f32x16{}, p1 = f32x16{};
#pragma unroll
            for (int d0 = 0; d0 < 4; ++d0) {
                const bf16x8 b0 = *(const LAS bf16x8*)(kp + d0 * 2048), b1 = *(const LAS bf16x8*)(kp + d0 * 2048 + 512);
                p0 = __builtin_amdgcn_mfma_f32_32x32x16_bf16(b0, qr[d0], p0, 0, 0, 0); p1 = __builtin_amdgcn_mfma_f32_32x32x16_bf16(b1, qr[d0], p1, 0, 0, 0); }
            if (s >= 6) { const int ib = qin + 64 * (8 - s) + 63 - 4 * hi;
#pragma unroll
                for (int r = 0; r < 16; ++r) { const int off = (r & 3) + 8 * (r >> 2); p0[r] += tb[ib - off]; p1[r] += tb[ib - off - 32]; }
            } else {
#pragma unroll
                for (int r = 0; r < 16; ++r) { p0[r] += cbias; p1[r] += cbias; }
            }
            float mx = p0[0];
#pragma unroll
            for (int r = 1; r < 16; ++r) mx = fmaxf(mx, p0[r]);
#pragma unroll
            for (int r = 0; r < 16; ++r) mx = fmaxf(mx, p1[r]);
            mx = fmaxf(mx, __shfl_xor(mx, 32));
            const float m_new = fmaxf(m_run, mx);
            const float alpha = __builtin_amdgcn_exp2f(m_run - m_new);
            float rs = 0.f;
#pragma unroll
            for (int r = 0; r < 16; ++r) { p0[r] = __builtin_amdgcn_exp2f(p0[r] - m_new); p1[r] = __builtin_amdgcn_exp2f(p1[r] - m_new); rs += p0[r] + p1[r]; }
            l_run = l_run * alpha + rs;
            if (__any(m_new > m_run)) {
                if (hi == 0) wsf[r32] = alpha;
                LDS_WAIT();
#pragma unroll
                for (int r = 0; r < 16; ++r) { const float f = wsf[crow(r, hi)]; o[0][r] *= f; o[1][r] *= f; }
            }
            m_run = m_new;
            u32x4 pw[4];
#pragma unroll
            for (int q = 0; q < 4; ++q) { pw[0][q] = cvt_pk_bf16(p0[2 * q], p0[2 * q + 1]); pw[1][q] = cvt_pk_bf16(p0[8 + 2 * q], p0[8 + 2 * q + 1]);
                                          pw[2][q] = cvt_pk_bf16(p1[2 * q], p1[2 * q + 1]); pw[3][q] = cvt_pk_bf16(p1[8 + 2 * q], p1[8 + 2 * q + 1]); }
            const LAS char* vp = lds + L_V + slot + ((lane >> 4) & 1) * 32 + (lane & 3) * 8 + (4 * hi + ((lane & 15) >> 2)) * 64;
#pragma unroll
            for (int d0 = 0; d0 < 2; ++d0)
#pragma unroll
                for (int ks = 0; ks < 4; ++ks) {
                    const s16x4 lo = vtr(vp + d0 * 4096 + ks * 1024), hh = vtr(vp + d0 * 4096 + ks * 1024 + 512);
                    const bf16x8 vf = (bf16x8){lo[0], lo[1], lo[2], lo[3], hh[0], hh[1], hh[2], hh[3]};
                    o[d0] = __builtin_amdgcn_mfma_f32_32x32x16_bf16(__builtin_bit_cast(bf16x8, pw[ks]), vf, o[d0], 0, 0, 0); }
        }
        if (ldn) { const int sl = (jn % NSL) * SLOT; *(LAS u32x4*)(lds + kdst + sl) = kv; *(LAS u32x4*)(lds + vdst + sl) = vv; }
    }
    l_run += __shfl_xor(l_run, 32);
    if (hi == 0) wsf[32 + r32] = l_run;
    LDS_WAIT();
    LAS bf16_t* stg = (LAS bf16_t*)(lds + L_OST) + wid * 2048;
#pragma unroll
    for (int r = 0; r < 16; ++r) { const int orow = crow(r, hi); const float rl = __builtin_amdgcn_rcpf(wsf[32 + orow]);
#pragma unroll
        for (int d0 = 0; d0 < 2; ++d0) stg[orow * 64 + d0 * 32 + r32] = (bf16_t)f2bf(o[d0][r] * rl); }
    LDS_WAIT();
    bf16_t* Ow = MIX + (rowbase + c * 64 + half * 32) * D + h * HD;
#pragma unroll
    for (int i = 0; i < 4; ++i) { const int row = i * 8 + (lane >> 3), ch = lane & 7; const u32x4 v = *(const LAS u32x4*)(stg + row * 64 + ch * 8); *(GAS u32x4*)(Ow + (long)row * D + ch * 8) = v; }
    __syncthreads();
}
}

namespace cv {
constexpr int TT = 32, UR = TT + CW - 1;
constexpr int L_U = 0, L_Y = UR * DC * 2  , L_END = L_Y + TT * DC * 4;
__device__ __forceinline__ void unit(const Frame& F, int b, int tt, const bf16_t* Ab, const bf16_t* Gb, bf16_t* MIX, const float* dw_w, const float* dw_b, const float* ln_g, const float* ln_b) {
    LAS char* lds = (LAS char*)F.lds;
    const int wid = F.wave, lane = lane_id(), tid = wid * 64 + lane;
    const int t0 = tt * TT; const long rowbase = (long)b * SEQ;
    for (int idx = tid; idx < UR * 64; idx += 512) { const int r = idx >> 6, c8 = idx & 63; const int tok = t0 - (CW - 1) + r;
        u32x4 w = (u32x4){0u, 0u, 0u, 0u};
        if (tok >= 0) { const u32x4 av = *(const GAS u32x4*)(Ab + (rowbase + tok) * DC + c8 * 8), gv = *(const GAS u32x4*)(Gb + (rowbase + tok) * DC + c8 * 8);
#pragma unroll
            for (int q = 0; q < 4; ++q) { const float u0 = bf_lo(av[q]) * fsigmoid(bf_lo(gv[q])), u1 = bf_hi(av[q]) * fsigmoid(bf_hi(gv[q])); w[q] = cvt_pk_bf16(u0, u1); } }
        *(LAS u32x4*)(lds + L_U + r * (DC * 2) + c8 * 16) = w; }
    __syncthreads();
    { const int cp = tid & 255, th = tid >> 8;
      f32x2 w[CW];
#pragma unroll
      for (int j = 0; j < CW; ++j) w[j] = *(const GAS f32x2*)(dw_w + j * DC + 2 * cp);
      const f32x2 bias = *(const GAS f32x2*)(dw_b + 2 * cp);
#pragma unroll 1
      for (int blk = 0; blk < 2; ++blk) { const int tbk = th * 16 + blk * 8;
          f32x2 acc[8];
#pragma unroll
          for (int k = 0; k < 8; ++k) acc[k] = bias;
#pragma unroll
          for (int i = 0; i < 8 + CW - 1; ++i) { const unsigned uw = *(const LAS unsigned*)(lds + L_U + (tbk + i) * (DC * 2) + cp * 4); const f32x2 uv = (f32x2){bf_lo(uw), bf_hi(uw)};
#pragma unroll
              for (int k = 0; k < 8; ++k) { const int j = i - k; if (j >= 0 && j < CW) acc[k] += uv * w[j]; } }
#pragma unroll
          for (int k = 0; k < 8; ++k) *(LAS f32x2*)(lds + L_Y + (tbk + k) * (DC * 4) + cp * 8) = acc[k]; } }
    __syncthreads();
    { const f32x4 g0 = *(const GAS f32x4*)(ln_g + 8 * lane), g1 = *(const GAS f32x4*)(ln_g + 8 * lane + 4), b0 = *(const GAS f32x4*)(ln_b + 8 * lane), b1 = *(const GAS f32x4*)(ln_b + 8 * lane + 4);
#pragma unroll
      for (int q = 0; q < 4; ++q) { const int t = wid * 4 + q;
          f32x4 y0 = *(const LAS f32x4*)(lds + L_Y + t * (DC * 4) + lane * 32), y1 = *(const LAS f32x4*)(lds + L_Y + t * (DC * 4) + lane * 32 + 16);
          const float mean = wave_sum((y0.x + y0.y) + (y0.z + y0.w) + (y1.x + y1.y) + (y1.z + y1.w)) * (1.f / DC);
          y0 = y0 - mean; y1 = y1 - mean;
          const float var = wave_sum((y0.x * y0.x + y0.y * y0.y) + (y0.z * y0.z + y0.w * y0.w) + (y1.x * y1.x + y1.y * y1.y) + (y1.z * y1.z + y1.w * y1.w)) * (1.f / DC);
          const float rstd = 1.0f / sqrtf(var + LN_EPS);
          y0 = y0 * rstd * g0 + b0; y1 = y1 * rstd * g1 + b1;
          float z[8] = {y0.x, y0.y, y0.z, y0.w, y1.x, y1.y, y1.z, y1.w};
#pragma unroll
          for (int i = 0; i < 8; ++i) z[i] = z[i] * fsigmoid(z[i]);
          u32x4 w; w.x = cvt_pk_bf16(z[0], z[1]); w.y = cvt_pk_bf16(z[2], z[3]); w.z = cvt_pk_bf16(z[4], z[5]); w.w = cvt_pk_bf16(z[6], z[7]);
          *(GAS u32x4*)(MIX + (rowbase + t0 + t) * D + DA + 8 * lane) = w; } }
    __syncthreads();
}
}

__global__ void __launch_bounds__(NWAVES * 64, 2) hymba_fwd(Args args) {
    extern __shared__ __attribute__((aligned(16))) unsigned char lds_raw[];
    Frame F;
    F.lds = (LAS unsigned char*)lds_raw;
    F.wave = __builtin_amdgcn_readfirstlane(threadIdx.x >> 6);
    F.G = gridDim.x; { const int bx = blockIdx.x; F.vcu = (F.G % 8 == 0) ? (bx % 8) * (F.G / 8) + bx / 8 : bx; }
    unsigned char* ws = args.ws;
    F.ctl = (gu32*)(ws + WS_CTL);
    volatile LAS unsigned* MISC = (volatile LAS unsigned*)(F.lds + LDSCTL_OFF);
    for (int u = threadIdx.x; u < (LDS_BYTES - LDSCTL_OFF) / 4; u += NWAVES * 64) ((LAS unsigned*)(F.lds + LDSCTL_OFF))[u] = 0u;
    __syncthreads();
    const int lo = args.ph_lo, hi = args.ph_hi;
    const bool multi = (hi - lo) > 1;
    XcdBarrier bar; bar.bar = (unsigned*)(F.ctl + CW_BAR); bar.x = 0; bar.st = nullptr;
    if (multi) bar = xcd_barrier_post((unsigned*)(F.ctl + CW_BAR), MISC + 8);
#define IN(k) (lo <= (k) && (k) < hi)
#define BOTH(k) (IN(k) && IN((k) + 1))
#define GRID_BAR() xcd_barrier(bar)

    const float* x = args.in[0];
    bf16_t* Win_t = (bf16_t*)(ws + WS_WIN); bf16_t* Wout_t = (bf16_t*)(ws + WS_WOUT); unsigned char* Wgu8 = ws + WS_WGU; unsigned char* Wd8 = ws + WS_WD;
    float* X1 = (float*)(ws + WS_X1); bf16_t* XN = (bf16_t*)(ws + WS_XN);
    bf16_t* Qb = (bf16_t*)(ws + WS_Q); bf16_t* Kb = (bf16_t*)(ws + WS_K); bf16_t* Vb = (bf16_t*)(ws + WS_V); bf16_t* Ab = (bf16_t*)(ws + WS_A); bf16_t* Gb = (bf16_t*)(ws + WS_G);
    bf16_t* MIX = (bf16_t*)(ws + WS_MIX); unsigned char* HID8 = ws + WS_HID; unsigned char* T8 = ws + WS_XN; bf16_t* OB = (bf16_t*)(ws + WS_O);
    u32x2* LIST = (u32x2*)(ws + WS_LIST); float* TOPW = (float*)(ws + WS_TOPW); bf16_t* RWB = (bf16_t*)(ws + WS_RWT);
    const int gw = F.vcu * NWAVES + F.wave, NGW = F.G * NWAVES;

    if (IN(0)) {
        const int lane = lane_id(), tid = F.wave * 64 + lane;
        LAS float* scr = (LAS float*)(F.lds + F.wave * 16384);
        constexpr int I_IN = (D / 64) * (NIN / 32), I_OUT = (D / 64) * (D / 32), I_EXP = (D / 64) * (D / 32);
        for (int it = gw; it < I_IN + I_OUT; it += NGW) {
            int r = it;
            if (r < I_IN) { const int kb = r / (NIN / 32), nb = r % (NIN / 32); transpose_item(args.in[2], NIN, kb * 64, nb * 32, Win_t + (size_t)(nb * 32) * D, D, scr, lane); continue; } r -= I_IN;
            const int kb = r / (D / 32), nb = r % (D / 32); transpose_item(args.in[8], D, kb * 64, nb * 32, Wout_t + (size_t)(nb * 32) * D, D, scr, lane);
        }
        { constexpr int NEXP = NE * 3 * I_EXP;
          f32x4 v[8], w[8];
          auto src_of = [&](int r) -> const float* { const int em = r / I_EXP, ri = r % I_EXP, e = em / 3, mat = em % 3, kb = ri / (D / 32), nb = ri % (D / 32);
              const float* base = (mat == 0 ? args.in[12] : mat == 1 ? args.in[14] : args.in[16]) + (size_t)e * D * D;
              return base + (size_t)(kb * 64 + (lane >> 3)) * D + nb * 32 + 4 * (lane & 7); };
          int it = gw;
          if (it < NEXP) { const float* sp = src_of(it);
#pragma unroll
              for (int q = 0; q < 8; ++q) v[q] = *(const GAS f32x4*)(sp + (size_t)q * 8 * D); }
#pragma unroll 1
          for (; it < NEXP; it += NGW) {
              const int nx = it + NGW;
              if (nx < NEXP) { const float* sp = src_of(nx);
#pragma unroll
                  for (int q = 0; q < 8; ++q) w[q] = *(const GAS f32x4*)(sp + (size_t)q * 8 * D); }
              const int em = it / I_EXP, ri = it % I_EXP, e = em / 3, mat = em % 3, kb = ri / (D / 32), nb = ri % (D / 32), n0 = nb * 32, k0 = kb * 64;
              unsigned char* dst = (mat == 2) ? Wd8 + ((size_t)e * D + n0) * D : Wgu8 + ((size_t)e * 2048 + (size_t)(n0 >> 7) * 256 + (n0 & 127) + (mat == 1 ? 128 : 0)) * D;
#pragma unroll
              for (int q = 0; q < 8; ++q) { LAS float* sl = scr + (q * 8 + (lane >> 3)) * 33 + 4 * (lane & 7); sl[0] = v[q].x * SC_W; sl[1] = v[q].y * SC_W; sl[2] = v[q].z * SC_W; sl[3] = v[q].w * SC_W; }
              LDS_WAIT(); asm volatile("" ::: "memory");
              const int c = lane & 7;
#pragma unroll
              for (int j = 0; j < 4; ++j) { const int n = (lane >> 3) + 8 * j; const LAS float* sl = scr + (8 * c) * 33 + n;
                  u32x2 o; o.x = pk4_fp8(sl[0 * 33], sl[1 * 33], sl[2 * 33], sl[3 * 33]); o.y = pk4_fp8(sl[4 * 33], sl[5 * 33], sl[6 * 33], sl[7 * 33]);
                  *(GAS u32x2*)(dst + (size_t)n * D + k0 + 8 * c) = o; }
              LDS_WAIT(); asm volatile("" ::: "memory");
#pragma unroll
              for (int q = 0; q < 8; ++q) v[q] = w[q];
          } }
        { const GAS f32x4* gp = (const GAS f32x4*)args.in[1] + lane; f32x4 g[4];
#pragma unroll
          for (int j = 0; j < 4; ++j) g[j] = gp[64 * j];
          for (int m = gw; m < T; m += 2 * NGW) { const int m2 = m + NGW;
              const GAS f32x4* xr = (const GAS f32x4*)(x + (size_t)m * D) + lane; const GAS f32x4* xr2 = (const GAS f32x4*)(x + (size_t)(m2 < T ? m2 : m) * D) + lane; f32x4 v[4], v2[4]; float s = 0.f, s2 = 0.f;
#pragma unroll
              for (int j = 0; j < 4; ++j) { v[j] = xr[64 * j]; v2[j] = xr2[64 * j]; }
#pragma unroll
              for (int j = 0; j < 4; ++j) { s += (v[j].x * v[j].x + v[j].y * v[j].y) + (v[j].z * v[j].z + v[j].w * v[j].w); s2 += (v2[j].x * v2[j].x + v2[j].y * v2[j].y) + (v2[j].z * v2[j].z + v2[j].w * v2[j].w); }
              const float r = 1.0f / sqrtf(wave_sum(s) * (1.f / D) + RMS_EPS), r2 = 1.0f / sqrtf(wave_sum(s2) * (1.f / D) + RMS_EPS);
              GAS u32x2* o8 = (GAS u32x2*)(XN + (size_t)m * D) + lane;
#pragma unroll
              for (int j = 0; j < 4; ++j) { const f32x4 y = v[j] * r * g[j]; o8[64 * j] = (u32x2){pk2(y.x, y.y), pk2(y.z, y.w)}; }
              if (m2 < T) { GAS u32x2* o82 = (GAS u32x2*)(XN + (size_t)m2 * D) + lane;
#pragma unroll
                  for (int j = 0; j < 4; ++j) { const f32x4 y = v2[j] * r2 * g[j]; o82[64 * j] = (u32x2){pk2(y.x, y.y), pk2(y.z, y.w)}; } } } }
        for (int i = blockIdx.x * 512 + tid; i < NE * D; i += F.G * 512) { const int e = i / D, k = i % D; const float v = args.in[10][k * NE + e] * args.in[9][k];
            const unsigned h = f2bf(v); RWB[i] = (bf16_t)h; RWB[NE * D + i] = (bf16_t)f2bf(v - __uint_as_float(h << 16)); }
        if (BOTH(0)) GRID_BAR();
    }

    if (IN(1)) {
        pg8::DenseOrder S; S.init(T, NIN, F.G, (int)blockIdx.x, Win_t);
        pg8::EpiSplit E{Qb, (size_t)(WS_K - WS_Q) / 2, QSCALE};
        pg8::gemm_phase<pg8::EpiSplit, pg8::DenseOrder, true, 2>(F.lds, (const char*)XN, D, S, E);
        if (BOTH(1)) GRID_BAR();
    }

    if (IN(2)) {
        for (int u = blockIdx.x; u < 2 * NH * 32; u += F.G) { const int cg = u & 31, h = (u >> 5) & 7, b = u >> 8;
            att::unit(F, b, h, cg, Qb, Kb, Vb, MIX, args.in[7]); }
        for (int u = blockIdx.x; u < T / cv::TT; u += F.G) { const int b = u / (SEQ / cv::TT), tt = u % (SEQ / cv::TT);
            cv::unit(F, b, tt, Ab, Gb, MIX, args.in[3], args.in[4], args.in[5], args.in[6]); }
        if (BOTH(2)) GRID_BAR();
    }

    if (IN(3)) {
        pg8::DenseOrder S; S.init(T, D, F.G, (int)blockIdx.x, Wout_t);
        pg8::EpiRes E{x, X1, T8, args.in[9]};
        pg8::gemm_phase<pg8::EpiRes, pg8::DenseOrder, false, 2>(F.lds, (const char*)MIX, D, S, E);
        if (BOTH(3)) GRID_BAR();
    }

    if (IN(4)) {
        const int lane = lane_id(), tid = F.wave * 64 + lane, fr = lane & 15, fq = lane >> 4;
        LAS unsigned char* rwl = F.lds;
        LAS int* hist = (LAS int*)(F.lds + XTRA_OFF);
        LAS int* baseE = hist + 32;
        LAS int* selE = baseE + 32;
        LAS int* selP = selE + 256;
        LAS float* selR = (LAS float*)(selP + 256);
        LAS float* part = selR + 64;
        for (int i = tid; i < 8192; i += 512) { const int row = i >> 7, ch = i & 127; const u32x4 v = ((const GAS u32x4*)RWB)[i];
            *(LAS u32x4*)(rwl + row * 2048 + (((ch & ~15) | ((ch ^ row) & 15)) * 16)) = v; }
        const int w4 = F.wave & 3, kh = F.wave >> 2;
        const float rb0 = args.in[11][fr], rb1 = args.in[11][16 + fr];
#pragma unroll 1
        for (int tb = blockIdx.x * 4; tb < T / 16; tb += F.G * 4) {
            if (tid < 32) hist[tid] = 0;
            __syncthreads();
            const int task = tb + w4;
            const float* xrow = X1 + (size_t)(task * 16 + fr) * D + kh * 512 + 8 * fq;
            f32x4 acc0 = (f32x4){0.f, 0.f, 0.f, 0.f}, acc1 = acc0; float ss = 0.f;
#pragma unroll 4
            for (int ks = 0; ks < 16; ++ks) {
                const f32x4 xa = *(const GAS f32x4*)(xrow + 32 * ks), xb = *(const GAS f32x4*)(xrow + 32 * ks + 4);
                ss += (xa.x * xa.x + xa.y * xa.y) + (xa.z * xa.z + xa.w * xa.w) + (xb.x * xb.x + xb.y * xb.y) + (xb.z * xb.z + xb.w * xb.w);
                u32x4 hi, lo;
                hi.x = cvt_pk_bf16(xa.x, xa.y); hi.y = cvt_pk_bf16(xa.z, xa.w); hi.z = cvt_pk_bf16(xb.x, xb.y); hi.w = cvt_pk_bf16(xb.z, xb.w);
                lo.x = cvt_pk_bf16(xa.x - bf_lo(hi.x), xa.y - bf_hi(hi.x)); lo.y = cvt_pk_bf16(xa.z - bf_lo(hi.y), xa.w - bf_hi(hi.y));
                lo.z = cvt_pk_bf16(xb.x - bf_lo(hi.z), xb.y - bf_hi(hi.z)); lo.w = cvt_pk_bf16(xb.z - bf_lo(hi.w), xb.w - bf_hi(hi.w));
                const bf16x8 ah = __builtin_bit_cast(bf16x8, hi), al = __builtin_bit_cast(bf16x8, lo);
                const int ch = kh * 64 + 4 * ks + fq;
                const int o0 = fr * 2048 + (((ch & ~15) | ((ch ^ fr) & 15)) * 16), o1 = o0 + 16 * 2048;
                const bf16x8 bh0 = *(const LAS bf16x8*)(rwl + o0), bl0 = *(const LAS bf16x8*)(rwl + 65536 + o0), bh1 = *(const LAS bf16x8*)(rwl + o1), bl1 = *(const LAS bf16x8*)(rwl + 65536 + o1);
                acc0 = __builtin_amdgcn_mfma_f32_16x16x32_bf16(ah, bh0, acc0, 0, 0, 0); acc1 = __builtin_amdgcn_mfma_f32_16x16x32_bf16(ah, bh1, acc1, 0, 0, 0);
                acc0 = __builtin_amdgcn_mfma_f32_16x16x32_bf16(al, bh0, acc0, 0, 0, 0); acc1 = __builtin_amdgcn_mfma_f32_16x16x32_bf16(al, bh1, acc1, 0, 0, 0);
                acc0 = __builtin_amdgcn_mfma_f32_16x16x32_bf16(ah, bl0, acc0, 0, 0, 0); acc1 = __builtin_amdgcn_mfma_f32_16x16x32_bf16(ah, bl1, acc1, 0, 0, 0);
            }
            ss += __shfl_xor(ss, 16); ss += __shfl_xor(ss, 32);
            if (kh == 1) { LAS float* pp = part + w4 * 576 + lane;
#pragma unroll
                for (int q = 0; q < 4; ++q) { pp[64 * q] = acc0[q]; pp[64 * (4 + q)] = acc1[q]; }
                pp[64 * 8] = ss; }
            __syncthreads();
            if (kh == 0) { const LAS float* pp = part + w4 * 576 + lane;
#pragma unroll
                for (int q = 0; q < 4; ++q) { acc0[q] += pp[64 * q]; acc1[q] += pp[64 * (4 + q)]; }
                ss += pp[64 * 8];
                const float rrow = 1.0f / sqrtf(ss * (1.f / D) + RMS_EPS);
#pragma unroll
                for (int q = 0; q < 4; ++q) {
                    const float rt = __shfl(rrow, 4 * fq + q);
                    float c0 = acc0[q] * rt + rb0, c1 = acc1[q] * rt + rb1;
                    float tv[4]; int te[4];
#pragma unroll
                    for (int k = 0; k < 4; ++k) { float v = c0; int e = fr; if (c1 > c0) { v = c1; e = 16 + fr; }
#pragma unroll
                        for (int o = 1; o < 16; o <<= 1) { const float v2 = __shfl_xor(v, o); const int e2 = __shfl_xor(e, o); if (v2 > v || (v2 == v && e2 < e)) { v = v2; e = e2; } }
                        tv[k] = v; te[k] = e; if (e == fr) c0 = -INFINITY; if (e == 16 + fr) c1 = -INFINITY; }
                    const float e1 = __expf(tv[1] - tv[0]), e2 = __expf(tv[2] - tv[0]), e3 = __expf(tv[3] - tv[0]); const float inv = 1.0f / (1.0f + e1 + e2 + e3);
                    const int tl = w4 * 16 + 4 * fq + q, tok = task * 16 + 4 * fq + q;
                    if (fr == 0) { *(GAS f32x4*)(TOPW + (size_t)tok * 4) = (f32x4){inv, e1 * inv, e2 * inv, e3 * inv}; selR[tl] = rt; }
                    if (fr < 4) { const int em = fr == 0 ? te[0] : fr == 1 ? te[1] : fr == 2 ? te[2] : te[3];
                        selE[tl * 4 + fr] = em; selP[tl * 4 + fr] = __hip_atomic_fetch_add(&hist[em], 1, __ATOMIC_RELAXED, __HIP_MEMORY_SCOPE_WORKGROUP); }
                } }
            __syncthreads();
            if (tid < 32) baseE[tid] = (int)__hip_atomic_fetch_add(F.ctl + CW_CNT + 64 * tid, (unsigned)hist[tid], RLX_AGENT);
            __syncthreads();
            if (tid < 256) { const int e = selE[tid]; LIST[(size_t)e * LCAP + baseE[e] + selP[tid]] = (u32x2){(unsigned)((tb * 16 + (tid >> 2)) * 4 + (tid & 3)), __float_as_uint(selR[tid >> 2])}; }
            __syncthreads();
        }
        if (BOTH(4)) GRID_BAR();
    }

    LAS int* tstart = (LAS int*)(F.lds + XTRA_OFF + 14336);
    LAS int* ecnt = tstart + 64;
    if (IN(5) || IN(6)) {
        const int tid = F.wave * 64 + lane_id();
        __syncthreads();
        if (tid < 32) ecnt[tid] = (int)__hip_atomic_load(F.ctl + CW_CNT + 64 * tid, RLX_AGENT);
        __syncthreads();
        if (tid == 0) { int s = 0; for (int e = 0; e < NE; ++e) { tstart[e] = s; s += (ecnt[e] + 255) >> 8; } tstart[NE] = s; }
        __syncthreads();
    }

    if (IN(5)) {
        pg8::MoeOrder S{tstart, ecnt, LIST, (const char*)Wgu8, 8, 2048, 2, args.in[13], args.in[15], 128, (int)(blockIdx.x % 8), (int)(blockIdx.x / 8), F.G / 8};
        pg8::EpiGU E{HID8};
        pg8::gemm_phase<pg8::EpiGU, pg8::MoeOrder, true, 1>(F.lds, (const char*)T8, D, S, E);
        if (BOTH(5)) GRID_BAR();
    }

    if (IN(6)) {
        pg8::MoeOrder S{tstart, ecnt, LIST, (const char*)Wd8, 4, 1024, 0, args.in[17], args.in[17], 256, (int)(blockIdx.x % 8), (int)(blockIdx.x / 8), F.G / 8};
        pg8::EpiDown E{OB};
        pg8::gemm_phase<pg8::EpiDown, pg8::MoeOrder, true, 1>(F.lds, (const char*)HID8, D, S, E);
        if (BOTH(6)) GRID_BAR();
    }

    if (IN(7)) {
        const int lane = lane_id();
        const GAS f32x4* gp = (const GAS f32x4*)args.in[18] + lane; f32x4 g[4];
#pragma unroll
        for (int j = 0; j < 4; ++j) g[j] = gp[64 * j];
        unsigned bad = __hip_atomic_load(F.ctl + CW_BAR + XB_TMO, RLX_AGENT);
        for (int m = gw; m < T; m += NGW) {
            const GAS f32x4* xr = (const GAS f32x4*)(X1 + (size_t)m * D) + lane; f32x4 v[4];
#pragma unroll
            for (int j = 0; j < 4; ++j) v[j] = xr[64 * j];
            const f32x4 tw = *(const GAS f32x4*)(TOPW + (size_t)m * 4);
#pragma unroll
            for (int k = 0; k < 4; ++k) { const GAS u32x2* orow = (const GAS u32x2*)(OB + ((size_t)m * 4 + k) * D) + lane; const float wk = tw[k];
#pragma unroll
                for (int j = 0; j < 4; ++j) { const u32x2 w = orow[64 * j]; v[j].x += wk * bf_lo(w.x); v[j].y += wk * bf_hi(w.x); v[j].z += wk * bf_lo(w.y); v[j].w += wk * bf_hi(w.y); } }
            float s = 0.f;
#pragma unroll
            for (int j = 0; j < 4; ++j) s += (v[j].x * v[j].x + v[j].y * v[j].y) + (v[j].z * v[j].z + v[j].w * v[j].w);
            float r = 1.0f / sqrtf(wave_sum(s) * (1.f / D) + RMS_EPS);
            if (bad) r = __builtin_nanf("");
            GAS f32x4* o = (GAS f32x4*)(args.out + (size_t)m * D) + lane;
#pragma unroll
            for (int j = 0; j < 4; ++j) o[64 * j] = v[j] * r * g[j];
        }
    }
#undef IN
#undef BOTH
#undef GRID_BAR
}

#ifndef MK_N_LAUNCHES
#define MK_N_LAUNCHES 1
#endif
extern "C" void kernel_launch(void* const* d_in, const int* in_sizes, int n_in, void* d_out, int out_size, void* d_ws, size_t ws_size, hipStream_t stream) {
    static int grid = 0;
    if (grid == 0) {
        if (n_in != 19 || in_sizes[0] != T * D || out_size != T * D || ws_size < WS_END) { fprintf(stderr, "kernel_launch: unexpected shapes (n_in %d, in0 %d, out %d, ws %zu); nothing launched\n", n_in, n_in > 0 ? in_sizes[0] : -1, out_size, ws_size); grid = -1; return; }
        int dev = 0, cus = 0, per_cu = 0;
        if (hipGetDevice(&dev) != hipSuccess || hipDeviceGetAttribute(&cus, hipDeviceAttributeMultiprocessorCount, dev) != hipSuccess) { fprintf(stderr, "kernel_launch: device query failed\n"); grid = -1; return; }
        if (hipFuncSetAttribute((const void*)hymba_fwd, hipFuncAttributeMaxDynamicSharedMemorySize, LDS_BYTES) != hipSuccess) { fprintf(stderr, "kernel_launch: hipFuncSetAttribute failed\n"); grid = -1; return; }
        if (hipOccupancyMaxActiveBlocksPerMultiprocessor(&per_cu, (const void*)hymba_fwd, NWAVES * 64, LDS_BYTES) != hipSuccess || per_cu < 1) fprintf(stderr, "kernel_launch: note: occupancy query reports %d workgroups per CU\n", per_cu);
        (void)hipGetLastError();
        grid = (cus / 64) * 64; if (grid > 256) grid = 256;
        if (grid < 64) { fprintf(stderr, "kernel_launch: %d CUs: unsupported\n", cus); grid = -1; return; }
    }
    if (grid < 0) return;
    if (hipMemsetAsync((char*)d_ws + WS_CTL, 0, CTL_ZERO_BYTES, stream) != hipSuccess) { fprintf(stderr, "kernel_launch: memset failed\n"); return; }
    Args a{};
    for (int i = 0; i < 19; ++i) a.in[i] = (const float*)d_in[i];
    a.out = (float*)d_out; a.ws = (unsigned char*)d_ws;
    constexpr int NPH = 8;
    if (MK_N_LAUNCHES == 1) { a.ph_lo = 0; a.ph_hi = NPH; hipLaunchKernelGGL(hymba_fwd, dim3(grid), dim3(NWAVES * 64), LDS_BYTES, stream, a); }
    else for (int p = 0; p < NPH; ++p) { a.ph_lo = p; a.ph_hi = p + 1; hipLaunchKernelGGL(hymba_fwd, dim3(grid), dim3(NWAVES * 64), LDS_BYTES, stream, a); }
    const hipError_t le = hipPeekAtLastError();
    if (le != hipSuccess) fprintf(stderr, "kernel_launch: launch failed: %s\n", hipGetErrorName(le));
}
```

```cpp
#include <hip/hip_runtime.h>
#include <cstdio>
#include <cstdint>

#define GAS __attribute__((address_space(1)))
#define LAS __attribute__((address_space(3)))
typedef unsigned short bf16_t;
typedef short bf16x8 __attribute__((ext_vector_type(8)));
typedef short s16x4 __attribute__((ext_vector_type(4)));
typedef float f32x2 __attribute__((ext_vector_type(2)));
typedef float f32x4 __attribute__((ext_vector_type(4)));
typedef float f32x16 __attribute__((ext_vector_type(16)));
typedef unsigned u32x2 __attribute__((ext_vector_type(2)));
typedef unsigned u32x4 __attribute__((ext_vector_type(4)));
typedef int i32x4 __attribute__((ext_vector_type(4)));
typedef int i32x8 __attribute__((ext_vector_type(8)));
typedef GAS unsigned gu32;
#define RLX_AGENT __ATOMIC_RELAXED, __HIP_MEMORY_SCOPE_AGENT
#define LDS_WAIT() asm volatile("s_waitcnt lgkmcnt(0)" ::: "memory")
#define VM_WAIT() asm volatile("s_waitcnt vmcnt(0)" ::: "memory")

constexpr int T = 16384, SEQ = 8192, D = 1024, NIN = 2560, DA = 512, NH = 8, HD = 64, DC = 512, CW = 31;
constexpr int NE = 32, TOPK = 4, NP = T * TOPK, LCAP = 16384, NREL = 192;
constexpr float RMS_EPS = 1e-5f, LN_EPS = 1e-5f, LOG2E = 1.4426950408889634f;
constexpr float QSCALE = 0.125f * LOG2E;
constexpr float SC_T = 16.0f, SC_W = 256.0f, SC_H = 4.0f;

constexpr size_t MiB = 1u << 20;
constexpr size_t WS_CTL = 0, CTL_ZERO_BYTES = 1 * MiB;
constexpr size_t WS_WIN = 1 * MiB, WS_WOUT = 6 * MiB, WS_WGU = 8 * MiB, WS_WD = 136 * MiB, WS_X1 = 200 * MiB, WS_XN = 264 * MiB;
constexpr size_t WS_Q = 296 * MiB, WS_K = 312 * MiB, WS_V = 328 * MiB, WS_A = 344 * MiB, WS_G = 360 * MiB, WS_MIX = 376 * MiB;
constexpr size_t WS_HID = 296 * MiB;
constexpr size_t WS_O = WS_WGU;
constexpr size_t WS_LIST = 424 * MiB, WS_TOPW = 428 * MiB, WS_RWT = 429 * MiB, WS_END = 430 * MiB;
constexpr int CW_TMO = 0, CW_BAR = 4096, CW_CNT = 8192;

constexpr int RING_BYTES = 131072, XTRA_OFF = RING_BYTES, LDS_BYTES = 147456, LDSCTL_OFF = LDS_BYTES - 512;
constexpr int NWAVES = 8;

__device__ __forceinline__ unsigned f2bf(float f) { unsigned u = __builtin_bit_cast(unsigned, f); return (u + 0x7fffu + ((u >> 16) & 1u)) >> 16; }
__device__ __forceinline__ unsigned pk2(float lo, float hi) { return f2bf(lo) | (f2bf(hi) << 16); }
__device__ __forceinline__ unsigned cvt_pk_bf16(float lo, float hi) { unsigned r; asm volatile("v_cvt_pk_bf16_f32 %0, %1, %2" : "=v"(r) : "v"(lo), "v"(hi)); return r; }
__device__ __forceinline__ float clamp448(float v) { return fminf(fmaxf(v, -448.0f), 448.0f); }
__device__ __forceinline__ unsigned pk4_fp8(float a, float b, float c, float d) {
    int r = __builtin_amdgcn_cvt_pk_fp8_f32(clamp448(a), clamp448(b), 0, false);
    r = __builtin_amdgcn_cvt_pk_fp8_f32(clamp448(c), clamp448(d), r, true);
    return (unsigned)r;
}
__device__ __forceinline__ float bf_lo(unsigned w) { return __uint_as_float(w << 16); }
__device__ __forceinline__ float bf_hi(unsigned w) { return __uint_as_float(w & 0xffff0000u); }
__device__ __forceinline__ float fsigmoid(float z) { return __builtin_amdgcn_rcpf(1.0f + __builtin_amdgcn_exp2f(-z * LOG2E)); }
__device__ __forceinline__ int lane_id() { int l; asm volatile("v_mbcnt_lo_u32_b32 %0, -1, 0\n\tv_mbcnt_hi_u32_b32 %0, -1, %0" : "=v"(l)); return l; }
__device__ __forceinline__ float wave_sum(float v) {
#pragma unroll
    for (int o = 1; o < 64; o <<= 1) v += __shfl_xor(v, o);
    return v;
}

namespace pg8 {
constexpr int BM = 256, BK = 64, HALF = 128, HTB = HALF * BK * 2, STAGE_BYTES = 8 * HTB;
__device__ __forceinline__ int lds_byte(int r, int c) { const int st = (r >> 4) * 2 + (c >> 5), rr = r & 15, cc = c & 31, ob = rr * 64 + cc * 2; return st * 1024 + (ob ^ (((ob >> 9) & 1) << 5)); }
__device__ __forceinline__ void stage_rc(int b, int& R, int& C) { const int st = b / 1024, sb = b % 1024, swz = sb ^ (((sb >> 9) & 1) << 5); R = (st >> 1) * 16 + swz / 64; C = (st & 1) * 32 + (swz % 64) / 2; }
__device__ __forceinline__ int perm32(int rho) { const int n = rho >> 4, i = rho & 15; return 8 * (i >> 2) + 4 * n + (i & 3); }

struct Unit { int pm, pn, e, nv; };

template <class Epi, class Sched, bool ALIGN_EPI, int ESZ>
__device__ __forceinline__ void gemm_phase(LAS unsigned char* lds, const char* Abase, const int K, const Sched& S, const Epi& E) {
    const int wid = __builtin_amdgcn_readfirstlane(threadIdx.x >> 6), lane = lane_id(), tid = wid * 64 + lane, wr = wid >> 2, wc = wid & 3, fr = lane & 15, fq = lane >> 4;
    const int RB = K * ESZ, nt = RB / 128;
    unsigned voffB[2];
#pragma unroll
    for (int i = 0; i < 2; ++i) { int R, C; stage_rc(tid * 16 + i * 8192, R, C); const int Rb = Epi::PERM ? ((R & ~31) + perm32(R & 31)) : R; voffB[i] = (unsigned)(Rb * RB + 2 * C); }
    const size_t kstep = (size_t)(BK * 2);
    const size_t hstep = (size_t)HALF * RB;
    const unsigned ldsw = (unsigned)wid * 1024u;
    const int aoff = lds_byte(wr * 64 + fr, fq * 8), boff = lds_byte(wc * 32 + fr, fq * 8);
#define PG8_SA(b, h) (((b) * 2 + (h)) * HTB)
#define PG8_SB(b, h) ((4 + (b) * 2 + (h)) * HTB)
#define PG8_STAGE(bufoff, gbase, voff) do { _Pragma("unroll") for (int _i = 0; _i < 2; ++_i) \
        __builtin_amdgcn_global_load_lds((const unsigned*)((const char*)(gbase) + (voff)[_i]), (LAS unsigned*)(lds + (bufoff) + ldsw + _i * 8192), 16, 0, 0); } while (0)
#define PG8_LD16(off) (*(const LAS i32x4*)(lds + (off)))
#define PG8_LDA(dst, b, h) do { _Pragma("unroll") for (int m = 0; m < 4; ++m) { const i32x4 _x = PG8_LD16(PG8_SA(b, h) + aoff + m * 2048), _y = PG8_LD16(PG8_SA(b, h) + aoff + m * 2048 + 1024); dst[m] = __builtin_shufflevector(_x, _y, 0, 1, 2, 3, 4, 5, 6, 7); } } while (0)
#define PG8_LDB(dst, b, h) do { _Pragma("unroll") for (int n = 0; n < 2; ++n) { const i32x4 _x = PG8_LD16(PG8_SB(b, h) + boff + n * 2048), _y = PG8_LD16(PG8_SB(b, h) + boff + n * 2048 + 1024); dst[n] = __builtin_shufflevector(_x, _y, 0, 1, 2, 3, 4, 5, 6, 7); } } while (0)
#define PG8_MMA(ai, bj, At, Bt) do { __builtin_amdgcn_s_setprio(1); _Pragma("unroll") for (int m = 0; m < 4; ++m) _Pragma("unroll") for (int n = 0; n < 2; ++n) _Pragma("unroll") for (int k = 0; k < 2; ++k) \
        acc[ai][bj][m][n] = __builtin_amdgcn_mfma_f32_16x16x32_bf16(PG8_HALF(Bt[n], k), PG8_HALF(At[m], k), acc[ai][bj][m][n], 0, 0, 0); __builtin_amdgcn_s_setprio(0); } while (0)
#define PG8_HALF(v, k) __builtin_bit_cast(bf16x8, (k) == 0 ? __builtin_shufflevector((v), (v), 0, 1, 2, 3) : __builtin_shufflevector((v), (v), 4, 5, 6, 7))
#define PG8_MMA8(ai, bj, At, Bt) do { __builtin_amdgcn_s_setprio(1); _Pragma("unroll") for (int m = 0; m < 4; ++m) _Pragma("unroll") for (int n = 0; n < 2; ++n) \
        acc[ai][bj][m][n] = __builtin_amdgcn_mfma_scale_f32_16x16x128_f8f6f4(Bt[n], At[m], acc[ai][bj][m][n], 0, 0, 0, 0x7f7f7f7f, 0, 0x7f7f7f7f); __builtin_amdgcn_s_setprio(0); } while (0)
#define PG8_MM(ai, bj, At, Bt) do { if constexpr (ESZ == 2) PG8_MMA(ai, bj, At, Bt); else PG8_MMA8(ai, bj, At, Bt); } while (0)
#define PG8_WAIT_V(n) asm volatile("s_waitcnt vmcnt(" #n ")" ::: "memory")
#define PG8_WAIT_L(n) asm volatile("s_waitcnt lgkmcnt(" #n ")" ::: "memory")
#define PG8_BAR __builtin_amdgcn_s_barrier()
#define PG8_SCHED __builtin_amdgcn_sched_barrier(0)
    Unit cur, nxt; int ui = 0;
    if (!S.next(0, cur)) return;
    f32x4 acc[2][2][4][2];
#pragma unroll
    for (int a = 0; a < 2; ++a)
#pragma unroll
        for (int b = 0; b < 2; ++b)
#pragma unroll
            for (int m = 0; m < 4; ++m)
#pragma unroll
                for (int n = 0; n < 2; ++n) acc[a][b][m][n] = (f32x4){0.f, 0.f, 0.f, 0.f};
    i32x8 At[4], B0[2], B1[2];
    unsigned vA0[2], vA1[2];
    LAS u32x4* const vslot = (LAS u32x4*)(lds + STAGE_BYTES) + tid;
    LAS u32x2* const rowtab = (LAS u32x2*)(lds + STAGE_BYTES + 8192);
    LAS f32x4* const biastab = (LAS f32x4*)(lds + STAGE_BYTES + 8192 + 4096);
    if constexpr (Sched::GATHER) {
        if (tid < 256) rowtab[tid] = *S.entry_ptr(cur, tid);
        else if (tid < 320) biastab[tid - 256] = *(const f32x4*)S.bias_ptr(cur, tid - 256);
        __syncthreads();
        S.a_off_tab(rowtab, cur.nv, tid, RB, vA0, vA1);
    } else S.a_off(cur, tid, RB, vA0, vA1);
    const char* cB = S.b_ptr(cur, RB);
    const char* cA = Abase;
    PG8_STAGE(PG8_SB(0, 0), cB, voffB); PG8_STAGE(PG8_SB(0, 1), cB + hstep, voffB); PG8_STAGE(PG8_SA(0, 0), cA, vA0); PG8_STAGE(PG8_SA(0, 1), cA, vA1);
    if (wr == 1) PG8_BAR;
    PG8_WAIT_V(2); PG8_BAR;
    PG8_STAGE(PG8_SB(1, 0), cB + kstep, voffB); PG8_STAGE(PG8_SA(1, 0), cA + kstep, vA0); PG8_STAGE(PG8_SB(1, 1), cB + hstep + kstep, voffB);
    PG8_WAIT_V(6); PG8_BAR;
    for (;;) {
        const bool has_next = S.next(ui + 1, nxt);
        const char* nB = cB;
        const int par = ui & 1;
        if constexpr (Sched::GATHER) {
            if (has_next) nB = S.b_ptr(nxt, RB);
            else *vslot = (u32x4){vA0[0], vA0[1], vA1[0], vA1[1]};
        } else {
            unsigned n0[2] = {vA0[0], vA0[1]}, n1[2] = {vA1[0], vA1[1]};
            if (has_next) { S.a_off(nxt, tid, RB, n0, n1); nB = S.b_ptr(nxt, RB); }
            *vslot = (u32x4){n0[0], n0[1], n1[0], n1[1]};
        }
#pragma clang loop unroll(disable)
        for (int t = 0; t < nt; t += 2) {
            const bool last = (t == nt - 2);
            if constexpr (Sched::GATHER) {
                if (has_next && t == 2) { const int l2 = lane_id();
                    if (wid < 2) __builtin_amdgcn_global_load_lds((const unsigned*)((const char*)S.entry_ptr(nxt, 0) + (wid * 64 + l2) * 16), (LAS unsigned*)((LAS char*)(rowtab + (par ^ 1) * 256) + wid * 1024), 16, 0, 0);
                    if (wid == 4) __builtin_amdgcn_global_load_lds((const unsigned*)S.bias_ptr(nxt, l2), (LAS unsigned*)(biastab + (par ^ 1) * 64), 16, 0, 0); }
                if (has_next && t == 4) { unsigned n0[2], n1[2]; const int t2 = wid * 64 + lane_id(); S.a_off_tab(rowtab + (par ^ 1) * 256, nxt.nv, t2, RB, n0, n1); ((LAS u32x4*)(lds + STAGE_BYTES))[t2] = (u32x4){n0[0], n0[1], n1[0], n1[1]}; }
            }
            const char* a1 = cA + (size_t)(t + 1) * kstep;
            const char* a2 = last ? cA : cA + (size_t)(t + 2) * kstep; const char* b2 = last ? nB : cB + (size_t)(t + 2) * kstep;
            const char* a3 = a2 + kstep; const char* b3 = b2 + kstep;
            PG8_LDB(B0, 0, 0); PG8_LDB(B1, 0, 1); PG8_SCHED; PG8_LDA(At, 0, 0); PG8_STAGE(PG8_SA(1, 1), a1, vA1);
            if (last) { const u32x4 nv = *vslot; vA0[0] = nv.x; vA0[1] = nv.y; vA1[0] = nv.z; vA1[1] = nv.w; }
            PG8_WAIT_V(8); PG8_WAIT_L(0); PG8_BAR; PG8_MM(0, 0, At, B0); PG8_MM(0, 1, At, B1); PG8_BAR; PG8_SCHED;
            PG8_LDA(At, 0, 1); PG8_STAGE(PG8_SB(0, 0), b2, voffB); PG8_STAGE(PG8_SB(0, 1), b2 + hstep, voffB); PG8_STAGE(PG8_SA(0, 0), a2, vA0);
            PG8_WAIT_V(8); PG8_WAIT_L(0); PG8_BAR; PG8_MM(1, 0, At, B0); PG8_MM(1, 1, At, B1); PG8_BAR; PG8_SCHED;
            PG8_LDB(B0, 1, 0); PG8_LDB(B1, 1, 1); PG8_SCHED; PG8_LDA(At, 1, 0); PG8_STAGE(PG8_SA(0, 1), a2, vA1);
            PG8_WAIT_V(8); PG8_WAIT_L(0); PG8_BAR; PG8_MM(0, 0, At, B0); PG8_MM(0, 1, At, B1); PG8_BAR; PG8_SCHED;
            PG8_LDA(At, 1, 1); PG8_STAGE(PG8_SB(1, 0), b3, voffB); PG8_STAGE(PG8_SB(1, 1), b3 + hstep, voffB); PG8_STAGE(PG8_SA(1, 0), a3, vA0);
            PG8_WAIT_V(8); PG8_WAIT_L(0); PG8_BAR; PG8_MM(1, 0, At, B0); PG8_MM(1, 1, At, B1); PG8_BAR; PG8_SCHED;
        }
        if constexpr (ALIGN_EPI) { if (wr == 0) PG8_BAR; }
        if constexpr (Sched::GATHER) E(acc, cur, wr, wc, fr, fq, rowtab + par * 256, biastab + par * 64); else E(acc, cur, wr, wc, fr, fq);
        if (!has_next) break;
#pragma unroll
        for (int a = 0; a < 2; ++a)
#pragma unroll
            for (int b = 0; b < 2; ++b)
#pragma unroll
                for (int m = 0; m < 4; ++m)
#pragma unroll
                    for (int n = 0; n < 2; ++n) acc[a][b][m][n] = (f32x4){0.f, 0.f, 0.f, 0.f};
        cur = nxt; cB = nB; ++ui;
        if constexpr (ALIGN_EPI) { if (wr == 1) PG8_BAR; }
    }
    PG8_WAIT_V(0);
    if constexpr (!ALIGN_EPI) { if (wr == 0) PG8_BAR; }
    PG8_BAR;
#undef PG8_SA
#undef PG8_SB
#undef PG8_STAGE
#undef PG8_LDA
#undef PG8_LDB
#undef PG8_MMA
#undef PG8_MMA8
#undef PG8_MM
#undef PG8_HALF
#undef PG8_LD16
#undef PG8_WAIT_V
#undef PG8_WAIT_L
#undef PG8_BAR
#undef PG8_SCHED
}

struct DenseOrder {
    static constexpr bool GATHER = false;
    int nM, nN, nwg, G, c; const char* Bt;
    __device__ __forceinline__ void init(int M, int N, int G_, int c_, const void* Bt_) { nM = M / BM; nN = N / BM; nwg = nM * nN; G = G_; c = c_; Bt = (const char*)Bt_; }
    __device__ __forceinline__ bool next(int i, Unit& u) const {
        const long L = (long)i * G + c; if (L >= nwg) return false;
        int wgid = (int)L; { const int q = nwg / 8, r = nwg % 8, xcd = wgid % 8, off = wgid / 8; wgid = (xcd < r ? xcd * (q + 1) : r * (q + 1) + (xcd - r) * q) + off; }
        const int nig = 8 * nN, gid = wgid / nig, fm = gid * 8, gsz = (nM - fm) < 8 ? (nM - fm) : 8;
        u.pm = fm + ((wgid % nig) % gsz); u.pn = (wgid % nig) / gsz; u.e = 0; u.nv = 256; return true;
    }
    __device__ __forceinline__ const char* b_ptr(const Unit& u, int RB) const { return Bt + (size_t)u.pn * (256 * (size_t)RB); }
    __device__ __forceinline__ void a_off(const Unit& u, int tid, int RB, unsigned (&v0)[2], unsigned (&v1)[2]) const {
#pragma unroll
        for (int i = 0; i < 2; ++i) { int R, C; stage_rc(tid * 16 + i * 8192, R, C); v0[i] = (unsigned)((u.pm * 256 + R) * RB + 2 * C); v1[i] = (unsigned)((u.pm * 256 + 128 + R) * RB + 2 * C); }
    }
};
struct MoeOrder {
    static constexpr bool GATHER = true;
    const LAS int* tstart;
    const LAS int* cnt;
    const u32x2* list;
    const char* Bt; int npn, nrowsB, shiftA;
    const float* bias0; const float* bias1; int bcols;
    int xg, j, nper;
    __device__ __forceinline__ bool next(int i, Unit& u) const {
        const int B = i * 8 + xg, rg = nper / npn, R = rg * B + j / npn;
        const int Rtot = tstart[NE];
        if (R >= Rtot) return false;
        int e = 0;
#pragma unroll 1
        for (int q = 1; q < NE; ++q) e += (tstart[q] <= R) ? 1 : 0;
        u.e = e; u.pm = R - tstart[e]; u.pn = j % npn; const int rem = cnt[e] - u.pm * 256; u.nv = rem < 256 ? rem : 256; return true;
    }
    __device__ __forceinline__ const char* b_ptr(const Unit& u, int RB) const { return Bt + ((size_t)u.e * nrowsB + (size_t)u.pn * 256) * (size_t)RB; }
    __device__ __forceinline__ const u32x2* entry_ptr(const Unit& u, int t) const { return list + (size_t)u.e * LCAP + u.pm * 256 + t; }
    __device__ __forceinline__ const float* bias_ptr(const Unit& u, int i) const {
        return (bcols == 128) ? ((i < 32 ? bias0 : bias1) + (size_t)u.e * D + u.pn * 128 + 4 * (i & 31)) : (bias0 + (size_t)u.e * D + u.pn * 256 + 4 * i); }
    __device__ __forceinline__ void a_off_tab(const LAS u32x2* rt, int nv, int tid, int RB, unsigned (&v0)[2], unsigned (&v1)[2]) const {
#pragma unroll
        for (int i = 0; i < 2; ++i) { int R, C; stage_rc(tid * 16 + i * 8192, R, C);
            const int p0 = (int)rt[R < nv ? R : 0].x >> shiftA, p1 = (int)rt[(128 + R) < nv ? (128 + R) : 0].x >> shiftA;
            v0[i] = (unsigned)(p0 * RB + 2 * C); v1[i] = (unsigned)(p1 * RB + 2 * C); }
    }
};

struct EpiSplit {
    static constexpr bool PERM = true;
    bf16_t* O; size_t split_stride; float scale0;
    __device__ __forceinline__ void operator()(const f32x4 (&acc)[2][2][4][2], const Unit& u, int wr, int wc, int fr, int fq) const {
        const int row0 = u.pm * BM + wr * 64 + fr; int colt = u.pn * BM; const int t = colt / 512; bf16_t* base = O + (size_t)t * split_stride; colt -= t * 512;
        const float sc = (t == 0) ? scale0 : 1.f;
        const int col0 = colt + wc * 32 + 8 * fq;
#pragma unroll
        for (int ai = 0; ai < 2; ++ai)
#pragma unroll
            for (int m = 0; m < 4; ++m) { bf16_t* rowp = base + (size_t)(row0 + ai * HALF + m * 16) * 512 + col0;
#pragma unroll
                for (int bj = 0; bj < 2; ++bj) { const f32x4 v0 = acc[ai][bj][m][0] * sc, v1 = acc[ai][bj][m][1] * sc;
                    u32x4 w; w.x = cvt_pk_bf16(v0[0], v0[1]); w.y = cvt_pk_bf16(v0[2], v0[3]); w.z = cvt_pk_bf16(v1[0], v1[1]); w.w = cvt_pk_bf16(v1[2], v1[3]);
                    *(u32x4*)(rowp + bj * HALF) = w; } }
    }
};
struct EpiRes {
    static constexpr bool PERM = true;
    const float* base; float* out; unsigned char* t8; const float* gain;
    __device__ __forceinline__ void operator()(const f32x4 (&acc)[2][2][4][2], const Unit& u, int wr, int wc, int fr, int fq) const {
        const int row0 = u.pm * BM + wr * 64 + fr, col0 = u.pn * BM + wc * 32 + 8 * fq;
        f32x4 gv[2][2];
#pragma unroll
        for (int bj = 0; bj < 2; ++bj)
#pragma unroll
            for (int n = 0; n < 2; ++n) gv[bj][n] = *(const f32x4*)(gain + col0 + bj * HALF + 4 * n) * SC_T;
#pragma unroll
        for (int ai = 0; ai < 2; ++ai)
#pragma unroll
            for (int m = 0; m < 4; ++m) { const size_t off = (size_t)(row0 + ai * HALF + m * 16) * D + col0;
#pragma unroll
                for (int bj = 0; bj < 2; ++bj) { const f32x4 v0 = *(const f32x4*)(base + off + bj * HALF) + acc[ai][bj][m][0], v1 = *(const f32x4*)(base + off + bj * HALF + 4) + acc[ai][bj][m][1];
                    *(f32x4*)(out + off + bj * HALF) = v0; *(f32x4*)(out + off + bj * HALF + 4) = v1;
                    const f32x4 s0 = v0 * gv[bj][0], s1 = v1 * gv[bj][1];
                    *(u32x2*)(t8 + off + bj * HALF) = (u32x2){pk4_fp8(s0[0], s0[1], s0[2], s0[3]), pk4_fp8(s1[0], s1[1], s1[2], s1[3])}; } }
    }
};
struct EpiGU {
    static constexpr bool PERM = true;
    unsigned char* hid;
    __device__ __forceinline__ void operator()(const f32x4 (&acc)[2][2][4][2], const Unit& u, int wr, int wc, int fr, int fq, const LAS u32x2* rt, const LAS f32x4* bt) const {
        const int hc = u.pn * 128 + wc * 32 + 8 * fq;
        const f32x4 g0 = bt[8 * wc + 2 * fq], g1 = bt[8 * wc + 2 * fq + 1], u0 = bt[32 + 8 * wc + 2 * fq], u1 = bt[32 + 8 * wc + 2 * fq + 1];
        constexpr float inv = 1.0f / (SC_T * SC_W);
#pragma unroll
        for (int ai = 0; ai < 2; ++ai)
#pragma unroll
            for (int m = 0; m < 4; ++m) { const int r = ai * HALF + wr * 64 + m * 16 + fr;
                const u32x2 en = rt[r]; const float rs = __uint_as_float(en.y) * inv;
                float h[8];
#pragma unroll
                for (int n = 0; n < 2; ++n)
#pragma unroll
                    for (int x = 0; x < 4; ++x) { float g = acc[ai][0][m][n][x] * rs + (n ? g1[x] : g0[x]); float up = acc[ai][1][m][n][x] * rs + (n ? u1[x] : u0[x]);
                        g = fminf(g, 7.0f); up = fminf(fmaxf(up, -7.0f), 7.0f); h[n * 4 + x] = SC_H * (up + 1.0f) * (g * fsigmoid(1.702f * g)); }
                u32x2 w; w.x = pk4_fp8(h[0], h[1], h[2], h[3]); w.y = pk4_fp8(h[4], h[5], h[6], h[7]);
                if (r < u.nv) *(u32x2*)(hid + (size_t)en.x * D + hc) = w; }
    }
};
struct EpiDown {
    static constexpr bool PERM = true;
    bf16_t* o;
    __device__ __forceinline__ void operator()(const f32x4 (&acc)[2][2][4][2], const Unit& u, int wr, int wc, int fr, int fq, const LAS u32x2* rt, const LAS f32x4* bt) const {
        constexpr float inv = 1.0f / (SC_H * SC_W);
        const int c0 = u.pn * BM + wc * 32 + 8 * fq;
        f32x4 bv[2][2];
#pragma unroll
        for (int bj = 0; bj < 2; ++bj)
#pragma unroll
            for (int n = 0; n < 2; ++n) bv[bj][n] = bt[bj * 32 + wc * 8 + 2 * fq + n];
#pragma unroll
        for (int ai = 0; ai < 2; ++ai)
#pragma unroll
            for (int m = 0; m < 4; ++m) { const int r = ai * HALF + wr * 64 + m * 16 + fr;
                const unsigned p = rt[r].x; bf16_t* rowp = o + (size_t)p * D + c0;
#pragma unroll
                for (int bj = 0; bj < 2; ++bj) { const f32x4 v0 = acc[ai][bj][m][0] * inv + bv[bj][0], v1 = acc[ai][bj][m][1] * inv + bv[bj][1];
                    u32x4 w; w.x = cvt_pk_bf16(v0[0], v0[1]); w.y = cvt_pk_bf16(v0[2], v0[3]); w.z = cvt_pk_bf16(v1[0], v1[1]); w.w = cvt_pk_bf16(v1[2], v1[3]);
                    if (r < u.nv) *(u32x4*)(rowp + bj * HALF) = w; } }
    }
};
}

#define XB_TMO      128
#define XB_XCNT(j)  (256  + 64 * (j))
#define XB_XSUB(j)  (1280 + 64 * (j))
#define XB_XGEN(j)  (2304 + 64 * (j))
#define XB_TOP      3328
#define XB_TOPGEN   3392
#define XCD_BAR_WORDS 3456
#define XB_SPIN_CAP (1u << 18)
__device__ __forceinline__ unsigned xb_ld(unsigned* p)              { return __hip_atomic_load(p, __ATOMIC_RELAXED, __HIP_MEMORY_SCOPE_AGENT); }
__device__ __forceinline__ unsigned xb_add(unsigned* p, unsigned v) { return __hip_atomic_fetch_add(p, v, __ATOMIC_RELAXED, __HIP_MEMORY_SCOPE_AGENT); }
__device__ __forceinline__ unsigned xb_xcc_id() { return (unsigned)__builtin_amdgcn_s_getreg((3 << 11) | 20) & 0xFu; }
#define XB_SPIN(cond, bar) do { unsigned _sp = 0; while (cond) { __builtin_amdgcn_s_sleep(1); \
    if ((++_sp & 255u) == 0u) { if (xb_ld(&(bar)[XB_TMO])) break; if (_sp > XB_SPIN_CAP) { atomicAdd(&(bar)[XB_TMO], 1u); break; } } } } while (0)
struct XcdBarrier { unsigned* bar; unsigned x; volatile LAS unsigned* st; };
__device__ __forceinline__ XcdBarrier xcd_barrier_post(unsigned* bar, volatile LAS unsigned* st) {
    XcdBarrier b; b.bar = bar; b.x = xb_xcc_id(); b.st = st;
    if (threadIdx.x == 0) (void)xb_add(&bar[XB_XCNT(b.x)], 1u);
    return b;
}
__device__ __forceinline__ void xcd_barrier_complete(unsigned* bar, unsigned x, unsigned& nloc, unsigned& nx) {
    const unsigned G = gridDim.x * gridDim.y * gridDim.z;
    unsigned sum, cnt, mine, sp = 0u;
    for (;;) {
        sum = 0u; cnt = 0u; mine = 0u;
#pragma unroll
        for (unsigned j = 0; j < 16; ++j) { const unsigned c = xb_ld(&bar[XB_XCNT(j)]); sum += c; cnt += (c > 0u) ? 1u : 0u; mine = (j == x) ? c : mine; }
        if (sum == G) break;
        __builtin_amdgcn_s_sleep(1);
        if ((++sp & 255u) == 0u) { if (xb_ld(&bar[XB_TMO])) break; if (sp > XB_SPIN_CAP) { atomicAdd(&bar[XB_TMO], 1u); break; } }
    }
    nloc = mine > 0u ? mine : 1u; nx = cnt > 0u ? cnt : 1u;
}
__device__ __forceinline__ void xcd_barrier(const XcdBarrier& b) {
    asm volatile("s_waitcnt vmcnt(0)" ::: "memory");
    __syncthreads();
    if (threadIdx.x == 0) {
        unsigned* bar = b.bar;
        __builtin_amdgcn_s_waitcnt(0);
        unsigned nloc = b.st[0], nx = b.st[1];
        if (nloc == 0u) { xcd_barrier_complete(bar, b.x, nloc, nx); b.st[0] = nloc; b.st[1] = nx; }
        const unsigned old = xb_add(&bar[XB_XSUB(b.x)], 1u);
        const unsigned gen = old / nloc;
        if (old + 1u == (gen + 1u) * nloc) {
            __builtin_amdgcn_fence(__ATOMIC_RELEASE, "agent");
            asm volatile("s_waitcnt vmcnt(0)" ::: "memory");
            const unsigned og = xb_add(&bar[XB_TOP], 1u);
            const unsigned tg = og / nx;
            if (og + 1u == (tg + 1u) * nx) xb_add(&bar[XB_TOPGEN], 1u);
            else XB_SPIN(xb_ld(&bar[XB_TOPGEN]) == tg, bar);
            __builtin_amdgcn_fence(__ATOMIC_ACQUIRE, "agent");
            xb_add(&bar[XB_XGEN(b.x)], 1u);
            asm volatile("s_waitcnt vmcnt(0)" ::: "memory");
        } else {
            XB_SPIN(xb_ld(&bar[XB_XGEN(b.x)]) == gen, bar);
            __builtin_amdgcn_fence(__ATOMIC_ACQUIRE, "agent");
            asm volatile("s_waitcnt vmcnt(0)" ::: "memory");
        }
    }
    __syncthreads();
}

struct Frame {
    LAS unsigned char* lds;
    gu32* ctl;
    int wave, G, vcu;
};

__device__ __forceinline__ void transpose_item(const float* W, int N, int k0, int n0, bf16_t* dst, int K, LAS float* scr, int lane) {
    f32x4 v[8];
#pragma unroll
    for (int it = 0; it < 8; ++it) v[it] = *(const GAS f32x4*)(W + (size_t)(k0 + it * 8 + (lane >> 3)) * N + n0 + 4 * (lane & 7));
#pragma unroll
    for (int it = 0; it < 8; ++it) { LAS float* s = scr + (it * 8 + (lane >> 3)) * 33 + 4 * (lane & 7); s[0] = v[it].x; s[1] = v[it].y; s[2] = v[it].z; s[3] = v[it].w; }
    LDS_WAIT(); asm volatile("" ::: "memory");
    const int c = lane & 7;
#pragma unroll
    for (int j = 0; j < 4; ++j) { const int n = (lane >> 3) + 8 * j; const LAS float* s = scr + (8 * c) * 33 + n;
        u32x4 o; o.x = pk2(s[0 * 33], s[1 * 33]); o.y = pk2(s[2 * 33], s[3 * 33]); o.z = pk2(s[4 * 33], s[5 * 33]); o.w = pk2(s[6 * 33], s[7 * 33]);
        *(GAS u32x4*)(dst + (size_t)n * K + k0 + 8 * c) = o; }
    LDS_WAIT(); asm volatile("" ::: "memory");
}

__device__ __forceinline__ void transpose_item_fp8(const float* W, int N, int k0, int n0, unsigned char* dst, int K, LAS float* scr, int lane) {
    f32x4 v[8];
#pragma unroll
    for (int it = 0; it < 8; ++it) v[it] = *(const GAS f32x4*)(W + (size_t)(k0 + it * 8 + (lane >> 3)) * N + n0 + 4 * (lane & 7));
#pragma unroll
    for (int it = 0; it < 8; ++it) { LAS float* s = scr + (it * 8 + (lane >> 3)) * 33 + 4 * (lane & 7); s[0] = v[it].x * SC_W; s[1] = v[it].y * SC_W; s[2] = v[it].z * SC_W; s[3] = v[it].w * SC_W; }
    LDS_WAIT(); asm volatile("" ::: "memory");
    const int c = lane & 7;
#pragma unroll
    for (int j = 0; j < 4; ++j) { const int n = (lane >> 3) + 8 * j; const LAS float* s = scr + (8 * c) * 33 + n;
        u32x2 o; o.x = pk4_fp8(s[0 * 33], s[1 * 33], s[2 * 33], s[3 * 33]); o.y = pk4_fp8(s[4 * 33], s[5 * 33], s[6 * 33], s[7 * 33]);
        *(GAS u32x2*)(dst + (size_t)n * K + k0 + 8 * c) = o; }
    LDS_WAIT(); asm volatile("" ::: "memory");
}

struct Args { const float* in[19]; float* out; unsigned char* ws; int ph_lo, ph_hi; };

namespace att {
constexpr int SLOT = 8192, NSL = 5;
constexpr int L_K = 0, L_V = NSL * SLOT, L_WS = 2 * NSL * SLOT, L_BIAS = L_WS + 8 * 256, L_OST = L_BIAS + 1024, L_END = L_OST + 8 * 4096;
__device__ __forceinline__ int crow(int r, int hi) { return (r & 3) + 8 * (r >> 2) + 4 * hi; }
__device__ __forceinline__ s16x4 vtr(const LAS char* p) { typedef short v4i16_t __attribute__((ext_vector_type(4))); return __builtin_bit_cast(s16x4, __builtin_amdgcn_ds_read_tr16_b64_v4i16((LAS v4i16_t*)p)); }

__device__ __forceinline__ void unit(const Frame& F, int b, int h, int cg, const bf16_t* Q, const bf16_t* Kb, const bf16_t* Vb, bf16_t* MIX, const float* relb) {
    LAS char* lds = (LAS char*)F.lds;
    const int wid = F.wave, lane = lane_id(), tid = wid * 64 + lane, r32 = lane & 31, hi = lane >> 5;
    const int wp = wid >> 1, half = wid & 1;
    const int c = 4 * cg + wp;
    const long rowbase = (long)b * SEQ;
    LAS float* wsf = (LAS float*)(lds + L_WS) + wid * 64;
    LAS float* tb = (LAS float*)(lds + L_BIAS);
    if (tid < 256) { const int i = tid < NREL ? tid : NREL - 1; tb[tid] = relb[h * NREL + i] * LOG2E; }
    const float cbias = relb[h * NREL + NREL - 1] * LOG2E;
    const bf16_t* Qw = Q + (rowbase + c * 64 + half * 32 + r32) * DA + h * HD;
    bf16x8 qr[4];
#pragma unroll
    for (int d0 = 0; d0 < 4; ++d0) qr[d0] = *(const GAS bf16x8*)(Qw + d0 * 16 + hi * 8);
    const int kc0 = 4 * cg - 8;
    const int krow = tid & 63, kch = tid >> 6;
    const int vrow = tid >> 3, vch = tid & 7;
    const bf16_t* ksrc = Kb + (rowbase + krow) * DA + h * HD + kch * 8;
    const bf16_t* vsrc = Vb + (rowbase + vrow) * DA + h * HD + vch * 8;
    const int kdst = L_K + kch * 1024 + krow * 16, vdst = L_V + (vch >> 2) * 4096 + vrow * 64 + (vch & 3) * 16;
#pragma unroll
    for (int j = 0; j < 4; ++j) { const int kc = kc0 + j;
        if (kc >= 0) { const u32x4 kv = *(const GAS u32x4*)(ksrc + (long)kc * 64 * DA); const u32x4 vv = *(const GAS u32x4*)(vsrc + (long)kc * 64 * DA);
            *(LAS u32x4*)(lds + kdst + j * SLOT) = kv; *(LAS u32x4*)(lds + vdst + j * SLOT) = vv; } }
    float m_run = -INFINITY, l_run = 0.f; f32x16 o[2]; o[0] = f32x16{}; o[1] = f32x16{};
    const int qin = half * 32 + r32;
#pragma unroll 1
    for (int s = 0; s < 9; ++s) {
        __syncthreads();
        const int jn = s + 4, kcn = kc0 + jn; const bool ldn = (jn < 12) && (kcn >= 0);
        u32x4 kv = (u32x4){0u, 0u, 0u, 0u}, vv = (u32x4){0u, 0u, 0u, 0u};
        if (ldn) { kv = *(const GAS u32x4*)(ksrc + (long)kcn * 64 * DA); vv = *(const GAS u32x4*)(vsrc + (long)kcn * 64 * DA); }
        const int j = wp + s, kc = kc0 + j;
        if (kc >= 0) {
            const int slot = (j % NSL) * SLOT;
            const LAS char* kp = lds + L_K + slot + hi * 1024 + r32 * 16;
            f32x16 p0 = f32x16{}, p1 = f32x16{};
#pragma unroll
            for (int d0 = 0; d0 < 4; ++d0) {
                const bf16x8 b0 = *(const LAS bf16x8*)(kp + d0 * 2048), b1 = *(const LAS bf16x8*)(kp + d0 * 2048 + 512);
                p0 = __builtin_amdgcn_mfma_f32_32x32x16_bf16(b0, qr[d0], p0, 0, 0, 0); p1 = __builtin_amdgcn_mfma_f32_32x32x16_bf16(b1, qr[d0], p1, 0, 0, 0); }
            if (s >= 6) { const int ib = qin + 64 * (8 - s) + 63 - 4 * hi;
#pragma unroll
                for (int r = 0; r < 16; ++r) { const int off = (r & 3) + 8 * (r >> 2); p0[r] += tb[ib - off]; p1[r] += tb[ib - off - 32]; }
            } else {
#pragma unroll
                for (int r = 0; r < 16; ++r) { p0[r] += cbias; p1[r] += cbias; }
            }
            float mx = p0[0];
#pragma unroll
            for (int r = 1; r < 16; ++r) mx = fmaxf(mx, p0[r]);
#pragma unroll
            for (int r = 0; r < 16; ++r) mx = fmaxf(mx, p1[r]);
            mx = fmaxf(mx, __shfl_xor(mx, 32));
            const float m_new = fmaxf(m_run, mx);
            const float alpha = __builtin_amdgcn_exp2f(m_run - m_new);
            float rs = 0.f;
#pragma unroll
            for (int r = 0; r < 16; ++r) { p0[r] = __builtin_amdgcn_exp2f(p0[r] - m_new); p1[r] = __builtin_amdgcn_exp2f(p1[r] - m_new); rs += p0[r] + p1[r]; }
            l_run = l_run * alpha + rs;
            if (__any(m_new > m_run)) {
                if (hi == 0) wsf[r32] = alpha;
                LDS_WAIT();
#pragma unroll
                for (int r = 0; r < 16; ++r) { const float f = wsf[crow(r, hi)]; o[0][r] *= f; o[1][r] *= f; }
            }
            m_run = m_new;
            u32x4 pw[4];
#pragma unroll
            for (int q = 0; q < 4; ++q) { pw[0][q] = cvt_pk_bf16(p0[2 * q], p0[2 * q + 1]); pw[1][q] = cvt_pk_bf16(p0[8 + 2 * q], p0[8 + 2 * q + 1]);
                                          pw[2][q] = cvt_pk_bf16(p1[2 * q], p1[2 * q + 1]); pw[3][q] = cvt_pk_bf16(p1[8 + 2 * q], p1[8 + 2 * q + 1]); }
            const LAS char* vp = lds + L_V + slot + ((lane >> 4) & 1) * 32 + (lane & 3) * 8 + (4 * hi + ((lane & 15) >> 2)) * 64;
#pragma unroll
            for (int d0 = 0; d0 < 2; ++d0)
#pragma unroll
                for (int ks = 0; ks < 4; ++ks) {
                    const s16x4 lo = vtr(vp + d0 * 4096 + ks * 1024), hh = vtr(vp + d0 * 4096 + ks * 1024 + 512);
                    const bf16x8 vf = (bf16x8){lo[0], lo[1], lo[2], lo[3], hh[0], hh[1], hh[2], hh[3]};
                    o[d0] = __builtin_amdgcn_mfma_f32_32x32x16_bf16(__builtin_bit_cast(bf16x8, pw[ks]), vf, o[d0], 0, 0, 0); }
        }
        if (ldn) { const int sl = (jn % NSL) * SLOT; *(LAS u32x4*)(lds + kdst + sl) = kv; *(LAS u32x4*)(lds + vdst + sl) = vv; }
    }
    l_run += __shfl_xor(l_run, 32);
    if (hi == 0) wsf[32 + r32] = l_run;
    LDS_WAIT();
    LAS bf16_t* stg = (LAS bf16_t*)(lds + L_OST) + wid * 2048;
#pragma unroll
    for (int r = 0; r < 16; ++r) { const int orow = crow(r, hi); const float rl = __builtin_amdgcn_rcpf(wsf[32 + orow]);
#pragma unroll
        for (int d0 = 0; d0 < 2; ++d0) stg[orow * 64 + d0 * 32 + r32] = (bf16_t)f2bf(o[d0][r] * rl); }
    LDS_WAIT();
    bf16_t* Ow = MIX + (rowbase + c * 64 + half * 32) * D + h * HD;
#pragma unroll
    for (int i = 0; i < 4; ++i) { const int row = i * 8 + (lane >> 3), ch = lane & 7; const u32x4 v = *(const LAS u32x4*)(stg + row * 64 + ch * 8); *(GAS u32x4*)(Ow + (long)row * D + ch * 8) = v; }
    __syncthreads();
}
}

namespace cv {
constexpr int TT = 32, UR = TT + CW - 1;
constexpr int L_U = 0, L_Y = UR * DC * 2  , L_END = L_Y + TT * DC * 4;
__device__ __forceinline__ void unit(const Frame& F, int b, int tt, const bf16_t* Ab, const bf16_t* Gb, bf16_t* MIX, const float* dw_w, const float* dw_b, const float* ln_g, const float* ln_b) {
    LAS char* lds = (LAS char*)F.lds;
    const int wid = F.wave, lane = lane_id(), tid = wid * 64 + lane;
    const int t0 = tt * TT; const long rowbase = (long)b * SEQ;
    for (int idx = tid; idx < UR * 64; idx += 512) { const int r = idx >> 6, c8 = idx & 63; const int tok = t0 - (CW - 1) + r;
        u32x4 w = (u32x4){0u, 0u, 0u, 0u};
        if (tok >= 0) { const u32x4 av = *(const GAS u32x4*)(Ab + (rowbase + tok) * DC + c8 * 8), gv = *(const GAS u32x4*)(Gb + (rowbase + tok) * DC + c8 * 8);
#pragma unroll
            for (int q = 0; q < 4; ++q) { const float u0 = bf_lo(av[q]) * fsigmoid(bf_lo(gv[q])), u1 = bf_hi(av[q]) * fsigmoid(bf_hi(gv[q])); w[q] = cvt_pk_bf16(u0, u1); } }
        *(LAS u32x4*)(lds + L_U + r * (DC * 2) + c8 * 16) = w; }
    __syncthreads();
    { const int cp = tid & 255, th = tid >> 8;
      f32x2 w[CW];
#pragma unroll
      for (int j = 0; j < CW; ++j) w[j] = *(const GAS f32x2*)(dw_w + j * DC + 2 * cp);
      const f32x2 bias = *(const GAS f32x2*)(dw_b + 2 * cp);
#pragma unroll 1
      for (int blk = 0; blk < 2; ++blk) { const int tbk = th * 16 + blk * 8;
          f32x2 acc[8];
#pragma unroll
          for (int k = 0; k < 8; ++k) acc[k] = bias;
#pragma unroll
          for (int i = 0; i < 8 + CW - 1; ++i) { const unsigned uw = *(const LAS unsigned*)(lds + L_U + (tbk + i) * (DC * 2) + cp * 4); const f32x2 uv = (f32x2){bf_lo(uw), bf_hi(uw)};
#pragma unroll
              for (int k = 0; k < 8; ++k) { const int j = i - k; if (j >= 0 && j < CW) acc[k] += uv * w[j]; } }
#pragma unroll
          for (int k = 0; k < 8; ++k) *(LAS f32x2*)(lds + L_Y + (tbk + k) * (DC * 4) + cp * 8) = acc[k]; } }
    __syncthreads();
    { const f32x4 g0 = *(const GAS f32x4*)(ln_g + 8 * lane), g1 = *(const GAS f32x4*)(ln_g + 8 * lane + 4), b0 = *(const GAS f32x4*)(ln_b + 8 * lane), b1 = *(const GAS f32x4*)(ln_b + 8 * lane + 4);
#pragma unroll
      for (int q = 0; q < 4; ++q) { const int t = wid * 4 + q;
          f32x4 y0 = *(const LAS f32x4*)(lds + L_Y + t * (DC * 4) + lane * 32), y1 = *(const LAS f32x4*)(lds + L_Y + t * (DC * 4) + lane * 32 + 16);
          const float mean = wave_sum((y0.x + y0.y) + (y0.z + y0.w) + (y1.x + y1.y) + (y1.z + y1.w)) * (1.f / DC);
          y0 = y0 - mean; y1 = y1 - mean;
          const float var = wave_sum((y0.x * y0.x + y0.y * y0.y) + (y0.z * y0.z + y0.w * y0.w) + (y1.x * y1.x + y1.y * y1.y) + (y1.z * y1.z + y1.w * y1.w)) * (1.f / DC);
          const float rstd = 1.0f / sqrtf(var + LN_EPS);
          y0 = y0 * rstd * g0 + b0; y1 = y1 * rstd * g1 + b1;
          float z[8] = {y0.x, y0.y, y0.z, y0.w, y1.x, y1.y, y1.z, y1.w};
#pragma unroll
          for (int i = 0; i < 8; ++i) z[i] = z[i] * fsigmoid(z[i]);
          u32x4 w; w.x = cvt_pk_bf16(z[0], z[1]); w.y = cvt_pk_bf16(z[2], z[3]); w.z = cvt_pk_bf16(z[4], z[5]); w.w = cvt_pk_bf16(z[6], z[7]);
          *(GAS u32x4*)(MIX + (rowbase + t0 + t) * D + DA + 8 * lane) = w; } }
    __syncthreads();
}
}

__global__ void __launch_bounds__(NWAVES * 64, 2) hymba_fwd(Args args) {
    extern __shared__ __attribute__((aligned(16))) unsigned char lds_raw[];
    Frame F;
    F.lds = (LAS unsigned char*)lds_raw;
    F.wave = __builtin_amdgcn_readfirstlane(threadIdx.x >> 6);
    F.G = gridDim.x; { const int bx = blockIdx.x; F.vcu = (F.G % 8 == 0) ? (bx % 8) * (F.G / 8) + bx / 8 : bx; }
    unsigned char* ws = args.ws;
    F.ctl = (gu32*)(ws + WS_CTL);
    volatile LAS unsigned* MISC = (volatile LAS unsigned*)(F.lds + LDSCTL_OFF);
    for (int u = threadIdx.x; u < (LDS_BYTES - LDSCTL_OFF) / 4; u += NWAVES * 64) ((LAS unsigned*)(F.lds + LDSCTL_OFF))[u] = 0u;
    __syncthreads();
    const int lo = args.ph_lo, hi = args.ph_hi;
    const bool multi = (hi - lo) > 1;
    XcdBarrier bar; bar.bar = (unsigned*)(F.ctl + CW_BAR); bar.x = 0; bar.st = nullptr;
    if (multi) bar = xcd_barrier_post((unsigned*)(F.ctl + CW_BAR), MISC + 8);
#define IN(k) (lo <= (k) && (k) < hi)
#define BOTH(k) (IN(k) && IN((k) + 1))
#define GRID_BAR() xcd_barrier(bar)

    const float* x = args.in[0];
    bf16_t* Win_t = (bf16_t*)(ws + WS_WIN); bf16_t* Wout_t = (bf16_t*)(ws + WS_WOUT); unsigned char* Wgu8 = ws + WS_WGU; unsigned char* Wd8 = ws + WS_WD;
    float* X1 = (float*)(ws + WS_X1); bf16_t* XN = (bf16_t*)(ws + WS_XN);
    bf16_t* Qb = (bf16_t*)(ws + WS_Q); bf16_t* Kb = (bf16_t*)(ws + WS_K); bf16_t* Vb = (bf16_t*)(ws + WS_V); bf16_t* Ab = (bf16_t*)(ws + WS_A); bf16_t* Gb = (bf16_t*)(ws + WS_G);
    bf16_t* MIX = (bf16_t*)(ws + WS_MIX); unsigned char* HID8 = ws + WS_HID; unsigned char* T8 = ws + WS_XN; bf16_t* OB = (bf16_t*)(ws + WS_O);
    u32x2* LIST = (u32x2*)(ws + WS_LIST); float* TOPW = (float*)(ws + WS_TOPW); bf16_t* RWB = (bf16_t*)(ws + WS_RWT);
    const int gw = F.vcu * NWAVES + F.wave, NGW = F.G * NWAVES;

    if (IN(0)) {
        const int lane = lane_id(), tid = F.wave * 64 + lane;
        LAS float* scr = (LAS float*)(F.lds + F.wave * 16896);
        constexpr int I_IN = (D / 64) * (NIN / 32), I_OUT = (D / 64) * (D / 32), I_EXP = (D / 64) * (D / 32);
        for (int it = gw; it < I_IN + I_OUT; it += NGW) {
            int r = it;
            if (r < I_IN) { const int kb = r / (NIN / 32), nb = r % (NIN / 32); transpose_item(args.in[2], NIN, kb * 64, nb * 32, Win_t + (size_t)(nb * 32) * D, D, scr, lane); continue; } r -= I_IN;
            const int kb = r / (D / 32), nb = r % (D / 32); transpose_item(args.in[8], D, kb * 64, nb * 32, Wout_t + (size_t)(nb * 32) * D, D, scr, lane);
        }
        { const GAS f32x4* gp = (const GAS f32x4*)args.in[1] + lane; f32x4 g[4];
#pragma unroll
          for (int j = 0; j < 4; ++j) g[j] = gp[64 * j];
          for (int m = gw; m < T; m += 2 * NGW) { const int m2 = m + NGW;
              const GAS f32x4* xr = (const GAS f32x4*)(x + (size_t)m * D) + lane; const GAS f32x4* xr2 = (const GAS f32x4*)(x + (size_t)(m2 < T ? m2 : m) * D) + lane; f32x4 v[4], v2[4]; float s = 0.f, s2 = 0.f;
#pragma unroll
              for (int j = 0; j < 4; ++j) { v[j] = xr[64 * j]; v2[j] = xr2[64 * j]; }
#pragma unroll
              for (int j = 0; j < 4; ++j) { s += (v[j].x * v[j].x + v[j].y * v[j].y) + (v[j].z * v[j].z + v[j].w * v[j].w); s2 += (v2[j].x * v2[j].x + v2[j].y * v2[j].y) + (v2[j].z * v2[j].z + v2[j].w * v2[j].w); }
              const float r = 1.0f / sqrtf(wave_sum(s) * (1.f / D) + RMS_EPS), r2 = 1.0f / sqrtf(wave_sum(s2) * (1.f / D) + RMS_EPS);
              GAS u32x2* o8 = (GAS u32x2*)(XN + (size_t)m * D) + lane;
#pragma unroll
              for (int j = 0; j < 4; ++j) { const f32x4 y = v[j] * r * g[j]; o8[64 * j] = (u32x2){pk2(y.x, y.y), pk2(y.z, y.w)}; }
              if (m2 < T) { GAS u32x2* o82 = (GAS u32x2*)(XN + (size_t)m2 * D) + lane;
#pragma unroll
                  for (int j = 0; j < 4; ++j) { const f32x4 y = v2[j] * r2 * g[j]; o82[64 * j] = (u32x2){pk2(y.x, y.y), pk2(y.z, y.w)}; } } } }
        for (int i = blockIdx.x * 512 + tid; i < NE * D; i += F.G * 512) { const int e = i / D, k = i % D; const float v = args.in[10][k * NE + e] * args.in[9][k];
            const unsigned h = f2bf(v); RWB[i] = (bf16_t)h; RWB[NE * D + i] = (bf16_t)f2bf(v - __uint_as_float(h << 16)); }
        if (BOTH(0)) GRID_BAR();
    }

    if (IN(1)) {
        const int xg = (int)(blockIdx.x % 8), jb = (int)(blockIdx.x / 8), half = F.G / 16;
        if (jb < half) {
            pg8::DenseOrder S; S.init(T, NIN, F.G / 2, xg + 8 * jb, Win_t);
            pg8::EpiSplit E{Qb, (size_t)(WS_K - WS_Q) / 2, QSCALE};
            pg8::gemm_phase<pg8::EpiSplit, pg8::DenseOrder, true, 2>(F.lds, (const char*)XN, D, S, E);
        } else {
            const int cgw = (xg * half + (jb - half)) * NWAVES + F.wave, CNGW = (F.G / 2) * NWAVES;
        { constexpr int NIT = NE * 3 * 8 * 32;
          LAS float* scr2 = (LAS float*)(F.lds + F.wave * 16896); const int lane = lane_id();
          f32x4 v[16], w[16];
          auto src_of = [&](int r) -> const float* { const int em = r >> 8, ri = r & 255, e = em / 3, mat = em % 3, kb = ri >> 5, nb = ri & 31;
              const float* base = (mat == 0 ? args.in[12] : mat == 1 ? args.in[14] : args.in[16]) + (size_t)e * D * D;
              return base + (size_t)(kb * 128 + (lane >> 3)) * D + nb * 32 + 4 * (lane & 7); };
          int it = cgw;
          if (it < NIT) { const float* sp = src_of(it);
#pragma unroll
              for (int q = 0; q < 16; ++q) v[q] = *(const GAS f32x4*)(sp + (size_t)q * 8 * D); }
#pragma unroll 1
          for (; it < NIT; it += CNGW) {
              const int nx = it + CNGW;
              if (nx < NIT) { const float* sp = src_of(nx);
#pragma unroll
                  for (int q = 0; q < 16; ++q) w[q] = *(const GAS f32x4*)(sp + (size_t)q * 8 * D); }
              const int em = it >> 8, ri = it & 255, e = em / 3, mat = em % 3, kb = ri >> 5, nb = ri & 31, n0 = nb * 32, k0 = kb * 128;
              unsigned char* dst = (mat == 2) ? Wd8 + ((size_t)e * D + n0) * D : Wgu8 + ((size_t)e * 2048 + (size_t)(n0 >> 7) * 256 + (n0 & 127) + (mat == 1 ? 128 : 0)) * D;
#pragma unroll
              for (int q = 0; q < 16; ++q) { LAS float* sl = scr2 + (q * 8 + (lane >> 3)) * 33 + 4 * (lane & 7); sl[0] = v[q].x * SC_W; sl[1] = v[q].y * SC_W; sl[2] = v[q].z * SC_W; sl[3] = v[q].w * SC_W; }
              LDS_WAIT(); asm volatile("" ::: "memory");
              const int c = lane & 7;
#pragma unroll
              for (int j = 0; j < 4; ++j) { const int n = (lane >> 3) + 8 * j; const LAS float* sl = scr2 + (16 * c) * 33 + n;
                  u32x4 o; o.x = pk4_fp8(sl[0 * 33], sl[1 * 33], sl[2 * 33], sl[3 * 33]); o.y = pk4_fp8(sl[4 * 33], sl[5 * 33], sl[6 * 33], sl[7 * 33]);
                  o.z = pk4_fp8(sl[8 * 33], sl[9 * 33], sl[10 * 33], sl[11 * 33]); o.w = pk4_fp8(sl[12 * 33], sl[13 * 33], sl[14 * 33], sl[15 * 33]);
                  *(GAS u32x4*)(dst + (size_t)n * D + k0 + 16 * c) = o; }
              LDS_WAIT(); asm volatile("" ::: "memory");
#pragma unroll
              for (int q = 0; q < 16; ++q) v[q] = w[q];
          } }
        }
        if (BOTH(1)) GRID_BAR();
    }

    if (IN(2)) {
        for (int u = blockIdx.x; u < 2 * NH * 32; u += F.G) { const int cg = u & 31, h = (u >> 5) & 7, b = u >> 8;
            att::unit(F, b, h, cg, Qb, Kb, Vb, MIX, args.in[7]); }
        for (int u = blockIdx.x; u < T / cv::TT; u += F.G) { const int b = u / (SEQ / cv::TT), tt = u % (SEQ / cv::TT);
            cv::unit(F, b, tt, Ab, Gb, MIX, args.in[3], args.in[4], args.in[5], args.in[6]); }
        if (BOTH(2)) GRID_BAR();
    }

    if (IN(3)) {
        pg8::DenseOrder S; S.init(T, D, F.G, (int)blockIdx.x, Wout_t);
        pg8::EpiRes E{x, X1, T8, args.in[9]};
        pg8::gemm_phase<pg8::EpiRes, pg8::DenseOrder, false, 2>(F.lds, (const char*)MIX, D, S, E);
        if (BOTH(3)) GRID_BAR();
    }

    if (IN(4)) {
        const int lane = lane_id(), tid = F.wave * 64 + lane, fr = lane & 15, fq = lane >> 4;
        LAS unsigned char* rwl = F.lds;
        LAS int* hist = (LAS int*)(F.lds + XTRA_OFF);
        LAS int* baseE = hist + 32;
        LAS int* selE = baseE + 32;
        LAS int* selP = selE + 256;
        LAS float* selR = (LAS float*)(selP + 256);
        LAS float* part = selR + 64;
        for (int i = tid; i < 8192; i += 512) { const int row = i >> 7, ch = i & 127; const u32x4 v = ((const GAS u32x4*)RWB)[i];
            *(LAS u32x4*)(rwl + row * 2048 + (((ch & ~15) | ((ch ^ row) & 15)) * 16)) = v; }
        const int w4 = F.wave & 3, kh = F.wave >> 2;
        const float rb0 = args.in[11][fr], rb1 = args.in[11][16 + fr];
#pragma unroll 1
        for (int tb = blockIdx.x * 4; tb < T / 16; tb += F.G * 4) {
            if (tid < 32) hist[tid] = 0;
            __syncthreads();
            const int task = tb + w4;
            const float* xrow = X1 + (size_t)(task * 16 + fr) * D + kh * 512 + 8 * fq;
            f32x4 acc0 = (f32x4){0.f, 0.f, 0.f, 0.f}, acc1 = acc0; float ss = 0.f;
#pragma unroll 4
            for (int ks = 0; ks < 16; ++ks) {
                const f32x4 xa = *(const GAS f32x4*)(xrow + 32 * ks), xb = *(const GAS f32x4*)(xrow + 32 * ks + 4);
                ss += (xa.x * xa.x + xa.y * xa.y) + (xa.z * xa.z + xa.w * xa.w) + (xb.x * xb.x + xb.y * xb.y) + (xb.z * xb.z + xb.w * xb.w);
                u32x4 hi, lo;
                hi.x = cvt_pk_bf16(xa.x, xa.y); hi.y = cvt_pk_bf16(xa.z, xa.w); hi.z = cvt_pk_bf16(xb.x, xb.y); hi.w = cvt_pk_bf16(xb.z, xb.w);
                lo.x = cvt_pk_bf16(xa.x - bf_lo(hi.x), xa.y - bf_hi(hi.x)); lo.y = cvt_pk_bf16(xa.z - bf_lo(hi.y), xa.w - bf_hi(hi.y));
                lo.z = cvt_pk_bf16(xb.x - bf_lo(hi.z), xb.y - bf_hi(hi.z)); lo.w = cvt_pk_bf16(xb.z - bf_lo(hi.w), xb.w - bf_hi(hi.w));
                const bf16x8 ah = __builtin_bit_cast(bf16x8, hi), al = __builtin_bit_cast(bf16x8, lo);
                const int ch = kh * 64 + 4 * ks + fq;
                const int o0 = fr * 2048 + (((ch & ~15) | ((ch ^ fr) & 15)) * 16), o1 = o0 + 16 * 2048;
                const bf16x8 bh0 = *(const LAS bf16x8*)(rwl + o0), bl0 = *(const LAS bf16x8*)(rwl + 65536 + o0), bh1 = *(const LAS bf16x8*)(rwl + o1), bl1 = *(const LAS bf16x8*)(rwl + 65536 + o1);
                acc0 = __builtin_amdgcn_mfma_f32_16x16x32_bf16(ah, bh0, acc0, 0, 0, 0); acc1 = __builtin_amdgcn_mfma_f32_16x16x32_bf16(ah, bh1, acc1, 0, 0, 0);
                acc0 = __builtin_amdgcn_mfma_f32_16x16x32_bf16(al, bh0, acc0, 0, 0, 0); acc1 = __builtin_amdgcn_mfma_f32_16x16x32_bf16(al, bh1, acc1, 0, 0, 0);
                acc0 = __builtin_amdgcn_mfma_f32_16x16x32_bf16(ah, bl0, acc0, 0, 0, 0); acc1 = __builtin_amdgcn_mfma_f32_16x16x32_bf16(ah, bl1, acc1, 0, 0, 0);
            }
            ss += __shfl_xor(ss, 16); ss += __shfl_xor(ss, 32);
            if (kh == 1) { LAS float* pp = part + w4 * 576 + lane;
#pragma unroll
                for (int q = 0; q < 4; ++q) { pp[64 * q] = acc0[q]; pp[64 * (4 + q)] = acc1[q]; }
                pp[64 * 8] = ss; }
            __syncthreads();
            if (kh == 0) { const LAS float* pp = part + w4 * 576 + lane;
#pragma unroll
                for (int q = 0; q < 4; ++q) { acc0[q] += pp[64 * q]; acc1[q] += pp[64 * (4 + q)]; }
                ss += pp[64 * 8];
                const float rrow = 1.0f / sqrtf(ss * (1.f / D) + RMS_EPS);
#pragma unroll
                for (int q = 0; q < 4; ++q) {
                    const float rt = __shfl(rrow, 4 * fq + q);
                    float c0 = acc0[q] * rt + rb0, c1 = acc1[q] * rt + rb1;
                    float tv[4]; int te[4];
#pragma unroll
                    for (int k = 0; k < 4; ++k) { float v = c0; int e = fr; if (c1 > c0) { v = c1; e = 16 + fr; }
#pragma unroll
                        for (int o = 1; o < 16; o <<= 1) { const float v2 = __shfl_xor(v, o); const int e2 = __shfl_xor(e, o); if (v2 > v || (v2 == v && e2 < e)) { v = v2; e = e2; } }
                        tv[k] = v; te[k] = e; if (e == fr) c0 = -INFINITY; if (e == 16 + fr) c1 = -INFINITY; }
                    const float e1 = __expf(tv[1] - tv[0]), e2 = __expf(tv[2] - tv[0]), e3 = __expf(tv[3] - tv[0]); const float inv = 1.0f / (1.0f + e1 + e2 + e3);
                    const int tl = w4 * 16 + 4 * fq + q, tok = task * 16 + 4 * fq + q;
                    if (fr == 0) { *(GAS f32x4*)(TOPW + (size_t)tok * 4) = (f32x4){inv, e1 * inv, e2 * inv, e3 * inv}; selR[tl] = rt; }
                    if (fr < 4) { const int em = fr == 0 ? te[0] : fr == 1 ? te[1] : fr == 2 ? te[2] : te[3];
                        selE[tl * 4 + fr] = em; selP[tl * 4 + fr] = __hip_atomic_fetch_add(&hist[em], 1, __ATOMIC_RELAXED, __HIP_MEMORY_SCOPE_WORKGROUP); }
                } }
            __syncthreads();
            if (tid < 32) baseE[tid] = (int)__hip_atomic_fetch_add(F.ctl + CW_CNT + 64 * tid, (unsigned)hist[tid], RLX_AGENT);
            __syncthreads();
            if (tid < 256) { const int e = selE[tid]; LIST[(size_t)e * LCAP + baseE[e] + selP[tid]] = (u32x2){(unsigned)((tb * 16 + (tid >> 2)) * 4 + (tid & 3)), __float_as_uint(selR[tid >> 2])}; }
            __syncthreads();
        }
        if (BOTH(4)) GRID_BAR();
    }

    LAS int* tstart = (LAS int*)(F.lds + XTRA_OFF + 14336);
    LAS int* ecnt = tstart + 64;
    if (IN(5) || IN(6)) {
        const int tid = F.wave * 64 + lane_id();
        __syncthreads();
        if (tid < 32) ecnt[tid] = (int)__hip_atomic_load(F.ctl + CW_CNT + 64 * tid, RLX_AGENT);
        __syncthreads();
        if (tid == 0) { int s = 0; for (int e = 0; e < NE; ++e) { tstart[e] = s; s += (ecnt[e] + 255) >> 8; } tstart[NE] = s; }
        __syncthreads();
    }

    if (IN(5)) {
        pg8::MoeOrder S{tstart, ecnt, LIST, (const char*)Wgu8, 8, 2048, 2, args.in[13], args.in[15], 128, (int)(blockIdx.x % 8), (int)(blockIdx.x / 8), F.G / 8};
        pg8::EpiGU E{HID8};
        pg8::gemm_phase<pg8::EpiGU, pg8::MoeOrder, true, 1>(F.lds, (const char*)T8, D, S, E);
        if (BOTH(5)) GRID_BAR();
    }

    if (IN(6)) {
        pg8::MoeOrder S{tstart, ecnt, LIST, (const char*)Wd8, 4, 1024, 0, args.in[17], args.in[17], 256, (int)(blockIdx.x % 8), (int)(blockIdx.x / 8), F.G / 8};
        pg8::EpiDown E{OB};
        pg8::gemm_phase<pg8::EpiDown, pg8::MoeOrder, true, 1>(F.lds, (const char*)HID8, D, S, E);
        if (BOTH(6)) GRID_BAR();
    }

    if (IN(7)) {
        const int lane = lane_id();
        const GAS f32x4* gp = (const GAS f32x4*)args.in[18] + lane; f32x4 g[4];
#pragma unroll
        for (int j = 0; j < 4; ++j) g[j] = gp[64 * j];
        unsigned bad = __hip_atomic_load(F.ctl + CW_BAR + XB_TMO, RLX_AGENT);
        for (int m = gw; m < T; m += NGW) {
            const GAS f32x4* xr = (const GAS f32x4*)(X1 + (size_t)m * D) + lane; f32x4 v[4];
#pragma unroll
            for (int j = 0; j < 4; ++j) v[j] = xr[64 * j];
            const f32x4 tw = *(const GAS f32x4*)(TOPW + (size_t)m * 4);
#pragma unroll
            for (int k = 0; k < 4; ++k) { const GAS u32x2* orow = (const GAS u32x2*)(OB + ((size_t)m * 4 + k) * D) + lane; const float wk = tw[k];
#pragma unroll
                for (int j = 0; j < 4; ++j) { const u32x2 w = orow[64 * j]; v[j].x += wk * bf_lo(w.x); v[j].y += wk * bf_hi(w.x); v[j].z += wk * bf_lo(w.y); v[j].w += wk * bf_hi(w.y); } }
            float s = 0.f;
#pragma unroll
            for (int j = 0; j < 4; ++j) s += (v[j].x * v[j].x + v[j].y * v[j].y) + (v[j].z * v[j].z + v[j].w * v[j].w);
            float r = 1.0f / sqrtf(wave_sum(s) * (1.f / D) + RMS_EPS);
            if (bad) r = __builtin_nanf("");
            GAS f32x4* o = (GAS f32x4*)(args.out + (size_t)m * D) + lane;
#pragma unroll
            for (int j = 0; j < 4; ++j) o[64 * j] = v[j] * r * g[j];
        }
    }
#undef IN
#undef BOTH
#undef GRID_BAR
}

#ifndef MK_N_LAUNCHES
#define MK_N_LAUNCHES 1
#endif
extern "C" void kernel_launch(void* const* d_in, const int* in_sizes, int n_in, void* d_out, int out_size, void* d_ws, size_t ws_size, hipStream_t stream) {
    static int grid = 0;
    if (grid == 0) {
        if (n_in != 19 || in_sizes[0] != T * D || out_size != T * D || ws_size < WS_END) { fprintf(stderr, "kernel_launch: unexpected shapes (n_in %d, in0 %d, out %d, ws %zu); nothing launched\n", n_in, n_in > 0 ? in_sizes[0] : -1, out_size, ws_size); grid = -1; return; }
        int dev = 0, cus = 0, per_cu = 0;
        if (hipGetDevice(&dev) != hipSuccess || hipDeviceGetAttribute(&cus, hipDeviceAttributeMultiprocessorCount, dev) != hipSuccess) { fprintf(stderr, "kernel_launch: device query failed\n"); grid = -1; return; }
        if (hipFuncSetAttribute((const void*)hymba_fwd, hipFuncAttributeMaxDynamicSharedMemorySize, LDS_BYTES) != hipSuccess) { fprintf(stderr, "kernel_launch: hipFuncSetAttribute failed\n"); grid = -1; return; }
        if (hipOccupancyMaxActiveBlocksPerMultiprocessor(&per_cu, (const void*)hymba_fwd, NWAVES * 64, LDS_BYTES) != hipSuccess || per_cu < 1) fprintf(stderr, "kernel_launch: note: occupancy query reports %d workgroups per CU\n", per_cu);
        (void)hipGetLastError();
        grid = (cus / 64) * 64; if (grid > 256) grid = 256;
        if (grid < 64) { fprintf(stderr, "kernel_launch: %d CUs: unsupported\n", cus); grid = -1; return; }
    }
    if (grid < 0) return;
    if (hipMemsetAsync((char*)d_ws + WS_CTL, 0, CTL_ZERO_BYTES, stream) != hipSuccess) { fprintf(stderr, "kernel_launch: memset failed\n"); return; }
    Args a{};
    for (int i = 0; i < 19; ++i) a.in[i] = (const float*)d_in[i];
    a.out = (float*)d_out; a.ws = (unsigned char*)d_ws;
    constexpr int NPH = 8;
    if (MK_N_LAUNCHES == 1) { a.ph_lo = 0; a.ph_hi = NPH; hipLaunchKernelGGL(hymba_fwd, dim3(grid), dim3(NWAVES * 64), LDS_BYTES, stream, a); }
    else for (int p = 0; p < NPH; ++p) { a.ph_lo = p; a.ph_hi = p + 1; hipLaunchKernelGGL(hymba_fwd, dim3(grid), dim3(NWAVES * 64), LDS_BYTES, stream, a); }
    const hipError_t le = hipPeekAtLastError();
    if (le != hipSuccess) fprintf(stderr, "kernel_launch: launch failed: %s\n", hipGetErrorName(le));
}
```

```cpp
#include <hip/hip_runtime.h>
#include <cstdio>
#include <cstdint>

#define GAS __attribute__((address_space(1)))
#define LAS __attribute__((address_space(3)))
typedef unsigned short bf16_t;
typedef short bf16x8 __attribute__((ext_vector_type(8)));
typedef short s16x4 __attribute__((ext_vector_type(4)));
typedef float f32x2 __attribute__((ext_vector_type(2)));
typedef float f32x4 __attribute__((ext_vector_type(4)));
typedef float f32x16 __attribute__((ext_vector_type(16)));
typedef unsigned u32x2 __attribute__((ext_vector_type(2)));
typedef unsigned u32x4 __attribute__((ext_vector_type(4)));
typedef int i32x4 __attribute__((ext_vector_type(4)));
typedef int i32x8 __attribute__((ext_vector_type(8)));
typedef GAS unsigned gu32;
#define RLX_AGENT __ATOMIC_RELAXED, __HIP_MEMORY_SCOPE_AGENT
#define LDS_WAIT() asm volatile("s_waitcnt lgkmcnt(0)" ::: "memory")
#define VM_WAIT() asm volatile("s_waitcnt vmcnt(0)" ::: "memory")

constexpr int T = 16384, SEQ = 8192, D = 1024, NIN = 2560, DA = 512, NH = 8, HD = 64, DC = 512, CW = 31;
constexpr int NE = 32, TOPK = 4, NP = T * TOPK, LCAP = 16384, NREL = 192;
constexpr float RMS_EPS = 1e-5f, LN_EPS = 1e-5f, LOG2E = 1.4426950408889634f;
constexpr float QSCALE = 0.125f * LOG2E;
constexpr float SC_T = 16.0f, SC_W = 256.0f, SC_H = 4.0f, SC_O = 32.0f;

constexpr size_t MiB = 1u << 20;
constexpr size_t WS_CTL = 0, CTL_ZERO_BYTES = 64 * 1024;
constexpr size_t WS_WIN = 1 * MiB, WS_WOUT = 6 * MiB, WS_WGU = 8 * MiB, WS_WD = 136 * MiB, WS_X1 = 200 * MiB, WS_XN = 264 * MiB;
constexpr size_t WS_Q = 296 * MiB, WS_K = 312 * MiB, WS_V = 328 * MiB, WS_A = 344 * MiB, WS_G = 360 * MiB, WS_MIX = 376 * MiB;
constexpr size_t WS_HID = 296 * MiB;
constexpr size_t WS_O = WS_WGU;
constexpr size_t WS_LIST = 424 * MiB, WS_TOPW = 428 * MiB, WS_RWT = 429 * MiB, WS_END = 430 * MiB;
constexpr int CW_TMO = 0, CW_BAR = 4096, CW_CNT = 8192;

constexpr int RING_BYTES = 131072, XTRA_OFF = RING_BYTES, LDS_BYTES = 147456, LDSCTL_OFF = LDS_BYTES - 512;
constexpr int NWAVES = 8;

__device__ __forceinline__ unsigned f2bf(float f) { unsigned u = __builtin_bit_cast(unsigned, f); return (u + 0x7fffu + ((u >> 16) & 1u)) >> 16; }
__device__ __forceinline__ unsigned pk2(float lo, float hi) { return f2bf(lo) | (f2bf(hi) << 16); }
__device__ __forceinline__ unsigned cvt_pk_bf16(float lo, float hi) { unsigned r; asm volatile("v_cvt_pk_bf16_f32 %0, %1, %2" : "=v"(r) : "v"(lo), "v"(hi)); return r; }
__device__ __forceinline__ float clamp448(float v) { return fminf(fmaxf(v, -448.0f), 448.0f); }
__device__ __forceinline__ unsigned pk4_fp8(float a, float b, float c, float d) {
    int r = __builtin_amdgcn_cvt_pk_fp8_f32(clamp448(a), clamp448(b), 0, false);
    r = __builtin_amdgcn_cvt_pk_fp8_f32(clamp448(c), clamp448(d), r, true);
    return (unsigned)r;
}
__device__ __forceinline__ unsigned pk4_fp8_nc(float a, float b, float c, float d) {
    int r = __builtin_amdgcn_cvt_pk_fp8_f32(a, b, 0, false);
    r = __builtin_amdgcn_cvt_pk_fp8_f32(c, d, r, true);
    return (unsigned)r;
}
__device__ __forceinline__ float bf_lo(unsigned w) { return __uint_as_float(w << 16); }
__device__ __forceinline__ float bf_hi(unsigned w) { return __uint_as_float(w & 0xffff0000u); }
__device__ __forceinline__ float fsigmoid(float z) { return __builtin_amdgcn_rcpf(1.0f + __builtin_amdgcn_exp2f(-z * LOG2E)); }
__device__ __forceinline__ int lane_id() { int l; asm volatile("v_mbcnt_lo_u32_b32 %0, -1, 0\n\tv_mbcnt_hi_u32_b32 %0, -1, %0" : "=v"(l)); return l; }
__device__ __forceinline__ float wave_sum(float v) {
#define WS_DPP(x, ctrl) __builtin_bit_cast(float, __builtin_amdgcn_update_dpp(0, __builtin_bit_cast(int, (x)), (ctrl), 0xf, 0xf, false))
    v += WS_DPP(v, 0xB1);
    v += WS_DPP(v, 0x4E);
    v += WS_DPP(v, 0x124);
    v += WS_DPP(v, 0x128);
#undef WS_DPP
    const float r0 = __builtin_bit_cast(float, __builtin_amdgcn_readlane(__builtin_bit_cast(int, v), 0)), r1 = __builtin_bit_cast(float, __builtin_amdgcn_readlane(__builtin_bit_cast(int, v), 16));
    const float r2 = __builtin_bit_cast(float, __builtin_amdgcn_readlane(__builtin_bit_cast(int, v), 32)), r3 = __builtin_bit_cast(float, __builtin_amdgcn_readlane(__builtin_bit_cast(int, v), 48));
    return (r0 + r1) + (r2 + r3);
}

namespace pg8 {
constexpr int BM = 256, BK = 64, HALF = 128, HTB = HALF * BK * 2, STAGE_BYTES = 8 * HTB;
__device__ __forceinline__ int lds_byte(int r, int c) { const int st = (r >> 4) * 2 + (c >> 5), rr = r & 15, cc = c & 31, ob = rr * 64 + cc * 2; return st * 1024 + (ob ^ (((ob >> 9) & 1) << 5)); }
__device__ __forceinline__ void stage_rc(int b, int& R, int& C) { const int st = b / 1024, sb = b % 1024, swz = sb ^ (((sb >> 9) & 1) << 5); R = (st >> 1) * 16 + swz / 64; C = (st & 1) * 32 + (swz % 64) / 2; }
__device__ __forceinline__ int perm32(int rho) { const int n = rho >> 4, i = rho & 15; return 8 * (i >> 2) + 4 * n + (i & 3); }

struct Unit { int pm, pn, e, nv; };
template <int N> __device__ __forceinline__ void wait_vm() { asm volatile("s_waitcnt vmcnt(%0)" :: "n"(N) : "memory"); }
template <int NFRESH, int NSTEADY> __device__ __forceinline__ void wait_vm_sel(int fresh) {
    asm volatile("s_cmp_eq_u32 %0, 0\n\ts_cbranch_scc1 .Lwvs_a_%=\n\ts_waitcnt vmcnt(%1)\n\ts_branch .Lwvs_b_%=\n.Lwvs_a_%=:\n\ts_waitcnt vmcnt(%2)\n.Lwvs_b_%=:" :: "s"(__builtin_amdgcn_readfirstlane(fresh)), "n"(NFRESH), "n"(NSTEADY) : "scc", "memory"); }

template <class Epi, class Sched, bool ALIGN_EPI, int ESZ>
__device__ __forceinline__ void gemm_phase(LAS unsigned char* lds, const char* Abase, const int K, const Sched& S, const Epi& E) {
    const int wid = __builtin_amdgcn_readfirstlane(threadIdx.x >> 6), lane = lane_id(), tid = wid * 64 + lane, wr = wid >> 2, wc = wid & 3, fr = lane & 15, fq = lane >> 4;
    const int RB = K * ESZ, nt = RB / 128;
    unsigned voffB[2];
#pragma unroll
    for (int i = 0; i < 2; ++i) { int R, C; stage_rc(tid * 16 + i * 8192, R, C); const int Rb = Epi::PERM ? ((R & ~31) + perm32(R & 31)) : R; voffB[i] = (unsigned)(Rb * RB + 2 * C); }
    const size_t kstep = (size_t)(BK * 2);
    const size_t hstep = (size_t)HALF * RB;
    const unsigned ldsw = (unsigned)wid * 1024u;
    const int aoff = lds_byte(wr * 64 + fr, fq * 8), boff = lds_byte(wc * 32 + fr, fq * 8);
#define PG8_SA(b, h) (((b) * 2 + (h)) * HTB)
#define PG8_SB(b, h) ((4 + (b) * 2 + (h)) * HTB)
#define PG8_STAGE(bufoff, gbase, voff) do { _Pragma("unroll") for (int _i = 0; _i < 2; ++_i) \
        __builtin_amdgcn_global_load_lds((const unsigned*)((const char*)(gbase) + (voff)[_i]), (LAS unsigned*)(lds + (bufoff) + ldsw + _i * 8192), 16, 0, 0); } while (0)
#define PG8_LD16(off) (*(const LAS i32x4*)(lds + (off)))
#define PG8_LDA(dst, b, h) do { _Pragma("unroll") for (int m = 0; m < 4; ++m) { const i32x4 _x = PG8_LD16(PG8_SA(b, h) + aoff + m * 2048), _y = PG8_LD16(PG8_SA(b, h) + aoff + m * 2048 + 1024); dst[m] = __builtin_shufflevector(_x, _y, 0, 1, 2, 3, 4, 5, 6, 7); } } while (0)
#define PG8_LDB(dst, b, h) do { _Pragma("unroll") for (int n = 0; n < 2; ++n) { const i32x4 _x = PG8_LD16(PG8_SB(b, h) + boff + n * 2048), _y = PG8_LD16(PG8_SB(b, h) + boff + n * 2048 + 1024); dst[n] = __builtin_shufflevector(_x, _y, 0, 1, 2, 3, 4, 5, 6, 7); } } while (0)
#define PG8_MMA(ai, bj, At, Bt) do { __builtin_amdgcn_s_setprio(1); _Pragma("unroll") for (int m = 0; m < 4; ++m) _Pragma("unroll") for (int n = 0; n < 2; ++n) _Pragma("unroll") for (int k = 0; k < 2; ++k) \
        acc[ai][bj][m][n] = __builtin_amdgcn_mfma_f32_16x16x32_bf16(PG8_HALF(Bt[n], k), PG8_HALF(At[m], k), acc[ai][bj][m][n], 0, 0, 0); __builtin_amdgcn_s_setprio(0); } while (0)
#define PG8_HALF(v, k) __builtin_bit_cast(bf16x8, (k) == 0 ? __builtin_shufflevector((v), (v), 0, 1, 2, 3) : __builtin_shufflevector((v), (v), 4, 5, 6, 7))
#define PG8_MMA8(ai, bj, At, Bt) do { __builtin_amdgcn_s_setprio(1); _Pragma("unroll") for (int m = 0; m < 4; ++m) _Pragma("unroll") for (int n = 0; n < 2; ++n) \
        acc[ai][bj][m][n] = __builtin_amdgcn_mfma_scale_f32_16x16x128_f8f6f4(Bt[n], At[m], acc[ai][bj][m][n], 0, 0, 0, 0, 0, 0);     __builtin_amdgcn_s_setprio(0); } while (0)
#define PG8_MM(ai, bj, At, Bt) do { if constexpr (ESZ == 2) PG8_MMA(ai, bj, At, Bt); else PG8_MMA8(ai, bj, At, Bt); } while (0)
#define PG8_WAIT_V(n) asm volatile("s_waitcnt vmcnt(" #n ")" ::: "memory")
#define PG8_WAIT_L(n) asm volatile("s_waitcnt lgkmcnt(" #n ")" ::: "memory")
#define PG8_BAR __builtin_amdgcn_s_barrier()
#define PG8_SCHED __builtin_amdgcn_sched_barrier(0)
    Unit cur, nxt; int ui = 0;
    if (!S.next(0, cur)) return;
    f32x4 acc[2][2][4][2];
#pragma unroll
    for (int a = 0; a < 2; ++a)
#pragma unroll
        for (int b = 0; b < 2; ++b)
#pragma unroll
            for (int m = 0; m < 4; ++m)
#pragma unroll
                for (int n = 0; n < 2; ++n) acc[a][b][m][n] = (f32x4){0.f, 0.f, 0.f, 0.f};
    i32x8 At[4], B0[2], B1[2];
    unsigned vA0[2], vA1[2];
    LAS u32x4* const vslot = (LAS u32x4*)(lds + STAGE_BYTES) + tid;
    LAS u32x2* const rowtab = (LAS u32x2*)(lds + STAGE_BYTES + 8192);
    LAS f32x4* const biastab = (LAS f32x4*)(lds + STAGE_BYTES + 8192 + 4096);
    if constexpr (Sched::GATHER) {
        if (tid < 256) rowtab[tid] = *S.entry_ptr(cur, tid);
        else if (tid < 320) biastab[tid - 256] = *(const f32x4*)S.bias_ptr(cur, tid - 256);
        __syncthreads();
        S.a_off_tab(rowtab, cur.nv, tid, RB, vA0, vA1);
    } else S.a_off(cur, tid, RB, vA0, vA1);
    const char* cB = S.b_ptr(cur, RB);
    const char* cA = Abase;
    PG8_STAGE(PG8_SB(0, 0), cB, voffB); PG8_STAGE(PG8_SB(0, 1), cB + hstep, voffB); PG8_STAGE(PG8_SA(0, 0), cA, vA0); PG8_STAGE(PG8_SA(0, 1), cA, vA1);
    if (wr == 1) PG8_BAR;
    PG8_WAIT_V(2); PG8_BAR;
    PG8_STAGE(PG8_SB(1, 0), cB + kstep, voffB); PG8_STAGE(PG8_SA(1, 0), cA + kstep, vA0); PG8_STAGE(PG8_SB(1, 1), cB + hstep + kstep, voffB);
    PG8_WAIT_V(6); PG8_BAR;
    for (;;) {
        const bool has_next = S.next(ui + 1, nxt);
        const char* nB = cB;
        const int par = ui & 1;
        if constexpr (Sched::GATHER) {
            if (has_next) nB = S.b_ptr(nxt, RB);
            else *vslot = (u32x4){vA0[0], vA0[1], vA1[0], vA1[1]};
        } else {
            unsigned n0[2] = {vA0[0], vA0[1]}, n1[2] = {vA1[0], vA1[1]};
            if (has_next) { S.a_off(nxt, tid, RB, n0, n1); nB = S.b_ptr(nxt, RB); }
            *vslot = (u32x4){n0[0], n0[1], n1[0], n1[1]};
        }
#pragma clang loop unroll(disable)
        for (int t = 0; t < nt; t += 2) {
            const bool last = (t == nt - 2);
            const int fresh = ((ui > 0) && (t == 0)) ? 1 : 0;
            if constexpr (Sched::GATHER) {
                if (has_next && t == 2) { const int l2 = lane_id();
                    if (wid < 2) __builtin_amdgcn_global_load_lds((const unsigned*)((const char*)S.entry_ptr(nxt, 0) + (wid * 64 + l2) * 16), (LAS unsigned*)((LAS char*)(rowtab + (par ^ 1) * 256) + wid * 1024), 16, 0, 0);
                    if (wid == 4) __builtin_amdgcn_global_load_lds((const unsigned*)S.bias_ptr(nxt, l2), (LAS unsigned*)(biastab + (par ^ 1) * 64), 16, 0, 0); }
                if (has_next && t == 4) { unsigned n0[2], n1[2]; const int t2 = wid * 64 + lane_id(); S.a_off_tab(rowtab + (par ^ 1) * 256, nxt.nv, t2, RB, n0, n1); ((LAS u32x4*)(lds + STAGE_BYTES))[t2] = (u32x4){n0[0], n0[1], n1[0], n1[1]}; }
            }
            const char* a1 = cA + (size_t)(t + 1) * kstep;
            const char* a2 = last ? cA : cA + (size_t)(t + 2) * kstep; const char* b2 = last ? nB : cB + (size_t)(t + 2) * kstep;
            const char* a3 = a2 + kstep; const char* b3 = b2 + kstep;
            PG8_LDB(B0, 0, 0); PG8_LDB(B1, 0, 1); PG8_SCHED; PG8_LDA(At, 0, 0); PG8_STAGE(PG8_SA(1, 1), a1, vA1);
            if (last) { const u32x4 nv = *vslot; vA0[0] = nv.x; vA0[1] = nv.y; vA1[0] = nv.z; vA1[1] = nv.w; }
            wait_vm_sel<8 + Epi::NSTORE, 8>(fresh); PG8_WAIT_L(0); PG8_BAR; PG8_MM(0, 0, At, B0); PG8_MM(0, 1, At, B1); PG8_BAR; PG8_SCHED;
            PG8_LDA(At, 0, 1); PG8_STAGE(PG8_SB(0, 0), b2, voffB); PG8_STAGE(PG8_SB(0, 1), b2 + hstep, voffB); PG8_STAGE(PG8_SA(0, 0), a2, vA0);
            wait_vm_sel<8 + Epi::NSTORE, 8>(fresh); PG8_WAIT_L(0); PG8_BAR; PG8_MM(1, 0, At, B0); PG8_MM(1, 1, At, B1); PG8_BAR; PG8_SCHED;
            PG8_LDB(B0, 1, 0); PG8_LDB(B1, 1, 1); PG8_SCHED; PG8_LDA(At, 1, 0); PG8_STAGE(PG8_SA(0, 1), a2, vA1);
            PG8_WAIT_V(8); PG8_WAIT_L(0); PG8_BAR; PG8_MM(0, 0, At, B0); PG8_MM(0, 1, At, B1); PG8_BAR; PG8_SCHED;
            PG8_LDA(At, 1, 1); PG8_STAGE(PG8_SB(1, 0), b3, voffB); PG8_STAGE(PG8_SB(1, 1), b3 + hstep, voffB); PG8_STAGE(PG8_SA(1, 0), a3, vA0);
            PG8_WAIT_V(8); PG8_WAIT_L(0); PG8_BAR; PG8_MM(1, 0, At, B0); PG8_MM(1, 1, At, B1); PG8_BAR; PG8_SCHED;
        }
        if constexpr (ALIGN_EPI) { if (wr == 0) PG8_BAR; }
        if constexpr (Sched::GATHER) { int zofs; asm volatile("s_mov_b32 %0, 0" : "=s"(zofs));
            E(acc, cur, wr, wc, fr, fq, rowtab + par * 256 + zofs, biastab + par * 64 + zofs); } else E(acc, cur, wr, wc, fr, fq);
        if (!has_next) break;
#pragma unroll
        for (int a = 0; a < 2; ++a)
#pragma unroll
            for (int b = 0; b < 2; ++b)
#pragma unroll
                for (int m = 0; m < 4; ++m)
#pragma unroll
                    for (int n = 0; n < 2; ++n) acc[a][b][m][n] = (f32x4){0.f, 0.f, 0.f, 0.f};
        cur = nxt; cB = nB; ++ui;
        if constexpr (ALIGN_EPI) { if (wr == 1) PG8_BAR; }
    }
    PG8_WAIT_V(0);
    if constexpr (!ALIGN_EPI) { if (wr == 0) PG8_BAR; }
    PG8_BAR;
#undef PG8_SA
#undef PG8_SB
#undef PG8_STAGE
#undef PG8_LDA
#undef PG8_LDB
#undef PG8_MMA
#undef PG8_MMA8
#undef PG8_MM
#undef PG8_HALF
#undef PG8_LD16
#undef PG8_WAIT_V
#undef PG8_WAIT_L
#undef PG8_BAR
#undef PG8_SCHED
}

struct DenseOrder {
    static constexpr bool GATHER = false;
    int nM, nN, nwg, G, c; const char* Bt;
    __device__ __forceinline__ void init(int M, int N, int G_, int c_, const void* Bt_) { nM = M / BM; nN = N / BM; nwg = nM * nN; G = G_; c = c_; Bt = (const char*)Bt_; }
    __device__ __forceinline__ bool next(int i, Unit& u) const {
        const long L = (long)i * G + c; if (L >= nwg) return false;
        int wgid = (int)L; { const int q = nwg / 8, r = nwg % 8, xcd = wgid % 8, off = wgid / 8; wgid = (xcd < r ? xcd * (q + 1) : r * (q + 1) + (xcd - r) * q) + off; }
        const int nig = 8 * nN, gid = wgid / nig, fm = gid * 8, gsz = (nM - fm) < 8 ? (nM - fm) : 8;
        u.pm = fm + ((wgid % nig) % gsz); u.pn = (wgid % nig) / gsz; u.e = 0; u.nv = 256; return true;
    }
    __device__ __forceinline__ const char* b_ptr(const Unit& u, int RB) const { return Bt + (size_t)u.pn * (256 * (size_t)RB); }
    __device__ __forceinline__ void a_off(const Unit& u, int tid, int RB, unsigned (&v0)[2], unsigned (&v1)[2]) const {
#pragma unroll
        for (int i = 0; i < 2; ++i) { int R, C; stage_rc(tid * 16 + i * 8192, R, C); v0[i] = (unsigned)((u.pm * 256 + R) * RB + 2 * C); v1[i] = (unsigned)((u.pm * 256 + 128 + R) * RB + 2 * C); }
    }
};
struct MoeOrder {
    static constexpr bool GATHER = true;
    const LAS i32x4* ul;
    const u32x2* list;
    const char* Bt; int npn, nrowsB, shiftA;
    const float* bias0; const float* bias1; int bcols;
    __device__ __forceinline__ bool next(int i, Unit& u) const {
        if (i >= 32) return false;
        const i32x4 v = ul[i];
        u.e = __builtin_amdgcn_readfirstlane(v.x); u.pm = __builtin_amdgcn_readfirstlane(v.y); u.pn = __builtin_amdgcn_readfirstlane(v.z); u.nv = __builtin_amdgcn_readfirstlane(v.w);
        return u.nv > 0;
    }
    __device__ __forceinline__ const char* b_ptr(const Unit& u, int RB) const { return Bt + ((size_t)u.e * nrowsB + (size_t)u.pn * 256) * (size_t)RB; }
    __device__ __forceinline__ const u32x2* entry_ptr(const Unit& u, int t) const { return list + (size_t)u.e * LCAP + u.pm * 256 + t; }
    __device__ __forceinline__ const float* bias_ptr(const Unit& u, int i) const {
        return (bcols == 128) ? ((i < 32 ? bias0 : bias1) + (size_t)u.e * D + u.pn * 128 + 4 * (i & 31)) : (bias0 + (size_t)u.e * D + u.pn * 256 + 4 * i); }
    __device__ __forceinline__ void a_off_tab(const LAS u32x2* rt, int nv, int tid, int RB, unsigned (&v0)[2], unsigned (&v1)[2]) const {
#pragma unroll
        for (int i = 0; i < 2; ++i) { int R, C; stage_rc(tid * 16 + i * 8192, R, C);
            const int p0 = (int)rt[R < nv ? R : 0].x >> shiftA, p1 = (int)rt[(128 + R) < nv ? (128 + R) : 0].x >> shiftA;
            v0[i] = (unsigned)(p0 * RB + 2 * C); v1[i] = (unsigned)(p1 * RB + 2 * C); }
    }
};

struct EpiSplit {
    static constexpr bool PERM = true; static constexpr int NSTORE = 16;
    bf16_t* O; size_t split_stride; float scale0;
    __device__ __forceinline__ void operator()(const f32x4 (&acc)[2][2][4][2], const Unit& u, int wr, int wc, int fr, int fq) const {
        const int row0 = u.pm * BM + wr * 64 + fr; int colt = u.pn * BM; const int t = colt / 512; bf16_t* base = O + (size_t)t * split_stride; colt -= t * 512;
        const float sc = (t == 0) ? scale0 : 1.f;
        const int col0 = colt + wc * 32 + 8 * fq;
#pragma unroll
        for (int ai = 0; ai < 2; ++ai)
#pragma unroll
            for (int m = 0; m < 4; ++m) { bf16_t* rowp = base + (size_t)(row0 + ai * HALF + m * 16) * 512 + col0;
#pragma unroll
                for (int bj = 0; bj < 2; ++bj) { const f32x4 v0 = acc[ai][bj][m][0] * sc, v1 = acc[ai][bj][m][1] * sc;
                    u32x4 w; w.x = cvt_pk_bf16(v0[0], v0[1]); w.y = cvt_pk_bf16(v0[2], v0[3]); w.z = cvt_pk_bf16(v1[0], v1[1]); w.w = cvt_pk_bf16(v1[2], v1[3]);
                    *(u32x4*)(rowp + bj * HALF) = w; } }
    }
};
struct EpiRes {
    static constexpr bool PERM = true; static constexpr int NSTORE = 0;
    const float* base; bf16_t* out; unsigned char* t8; const float* gain;
    __device__ __forceinline__ void operator()(const f32x4 (&acc)[2][2][4][2], const Unit& u, int wr, int wc, int fr, int fq) const {
        const int row0 = u.pm * BM + wr * 64 + fr, col0 = u.pn * BM + wc * 32 + 8 * fq;
        f32x4 gv[2][2];
#pragma unroll
        for (int bj = 0; bj < 2; ++bj)
#pragma unroll
            for (int n = 0; n < 2; ++n) gv[bj][n] = *(const f32x4*)(gain + col0 + bj * HALF + 4 * n) * SC_T;
#pragma unroll
        for (int ai = 0; ai < 2; ++ai)
#pragma unroll
            for (int m = 0; m < 4; ++m) { const size_t off = (size_t)(row0 + ai * HALF + m * 16) * D + col0;
#pragma unroll
                for (int bj = 0; bj < 2; ++bj) { const f32x4 v0 = __builtin_nontemporal_load((const f32x4*)(base + off + bj * HALF)) + acc[ai][bj][m][0], v1 = __builtin_nontemporal_load((const f32x4*)(base + off + bj * HALF + 4)) + acc[ai][bj][m][1];
                    *(u32x4*)(out + off + bj * HALF) = (u32x4){cvt_pk_bf16(v0[0], v0[1]), cvt_pk_bf16(v0[2], v0[3]), cvt_pk_bf16(v1[0], v1[1]), cvt_pk_bf16(v1[2], v1[3])};
                    const f32x4 s0 = v0 * gv[bj][0], s1 = v1 * gv[bj][1];
                    *(u32x2*)(t8 + off + bj * HALF) = (u32x2){pk4_fp8(s0[0], s0[1], s0[2], s0[3]), pk4_fp8(s1[0], s1[1], s1[2], s1[3])}; } }
    }
};
struct EpiGU {
    static constexpr bool PERM = true; static constexpr int NSTORE = 8;
    unsigned char* hid;
    __device__ __forceinline__ void operator()(const f32x4 (&acc)[2][2][4][2], const Unit& u, int wr, int wc, int fr, int fq, const LAS u32x2* rt, const LAS f32x4* bt) const {
        const int hc = u.pn * 128 + wc * 32 + 8 * fq;
        const f32x4 g0 = bt[8 * wc + 2 * fq], g1 = bt[8 * wc + 2 * fq + 1], u0 = bt[32 + 8 * wc + 2 * fq], u1 = bt[32 + 8 * wc + 2 * fq + 1];
        constexpr float inv = 1.0f / (SC_T * SC_W);
#pragma unroll
        for (int ai = 0; ai < 2; ++ai)
#pragma unroll
            for (int m = 0; m < 4; ++m) { const int r = ai * HALF + wr * 64 + m * 16 + fr;
                const u32x2 en = rt[r]; const float rs = __uint_as_float(en.y) * inv;
                f32x2 h[4];
#pragma unroll
                for (int n = 0; n < 2; ++n)
#pragma unroll
                    for (int x = 0; x < 2; ++x) { const f32x4 ga = acc[ai][0][m][n], ua = acc[ai][1][m][n], gb = n ? g1 : g0, ub = n ? u1 : u0;
                        f32x2 g = (f32x2){ga[2 * x], ga[2 * x + 1]} * rs + (f32x2){gb[2 * x], gb[2 * x + 1]}, up = (f32x2){ua[2 * x], ua[2 * x + 1]} * rs + (f32x2){ub[2 * x], ub[2 * x + 1]};
                        g.x = fminf(g.x, 7.0f); g.y = fminf(g.y, 7.0f); up.x = __builtin_amdgcn_fmed3f(up.x, -7.0f, 7.0f); up.y = __builtin_amdgcn_fmed3f(up.y, -7.0f, 7.0f);
                        const f32x2 z = g * (-1.702f * LOG2E); f32x2 t; t.x = __builtin_amdgcn_exp2f(z.x); t.y = __builtin_amdgcn_exp2f(z.y); t = t + 1.0f;
                        f32x2 sg; sg.x = __builtin_amdgcn_rcpf(t.x); sg.y = __builtin_amdgcn_rcpf(t.y);
                        h[n * 2 + x] = (up * SC_H + SC_H) * (g * sg); }
                u32x2 w; w.x = pk4_fp8_nc(h[0].x, h[0].y, h[1].x, h[1].y); w.y = pk4_fp8_nc(h[2].x, h[2].y, h[3].x, h[3].y);
                *(u32x2*)(hid + (size_t)(r < u.nv ? en.x : (unsigned)NP) * D + hc) = w; }
    }
};
struct EpiDown {
    static constexpr bool PERM = true; static constexpr int NSTORE = 16;
    unsigned char* o;
    __device__ __forceinline__ void operator()(const f32x4 (&acc)[2][2][4][2], const Unit& u, int wr, int wc, int fr, int fq, const LAS u32x2* rt, const LAS f32x4* bt) const {
        constexpr float inv = SC_O / (SC_H * SC_W);
        const int c0 = u.pn * BM + wc * 32 + 8 * fq;
        f32x4 bv[2][2];
#pragma unroll
        for (int bj = 0; bj < 2; ++bj)
#pragma unroll
            for (int n = 0; n < 2; ++n) bv[bj][n] = bt[bj * 32 + wc * 8 + 2 * fq + n] * SC_O;
#pragma unroll
        for (int ai = 0; ai < 2; ++ai)
#pragma unroll
            for (int m = 0; m < 4; ++m) { const int r = ai * HALF + wr * 64 + m * 16 + fr;
                const unsigned p = (r < u.nv) ? rt[r].x : (unsigned)NP; unsigned char* rowp = o + (size_t)p * D + c0;
#pragma unroll
                for (int bj = 0; bj < 2; ++bj) { const f32x4 v0 = acc[ai][bj][m][0] * inv + bv[bj][0], v1 = acc[ai][bj][m][1] * inv + bv[bj][1];
                    *(u32x2*)(rowp + bj * HALF) = (u32x2){pk4_fp8(v0[0], v0[1], v0[2], v0[3]), pk4_fp8(v1[0], v1[1], v1[2], v1[3])}; } }
    }
};
}

#define XB_TMO      128
#define XB_XCNT(j)  (256  + 64 * (j))
#define XB_XSUB(j)  (1280 + 64 * (j))
#define XB_XGEN(j)  (2304 + 64 * (j))
#define XB_TOP      3328
#define XB_TOPGEN   3392
#define XCD_BAR_WORDS 3456
#define XB_SPIN_CAP (1u << 18)
__device__ __forceinline__ unsigned xb_ld(unsigned* p)              { return __hip_atomic_load(p, __ATOMIC_RELAXED, __HIP_MEMORY_SCOPE_AGENT); }
__device__ __forceinline__ unsigned xb_add(unsigned* p, unsigned v) { return __hip_atomic_fetch_add(p, v, __ATOMIC_RELAXED, __HIP_MEMORY_SCOPE_AGENT); }
__device__ __forceinline__ unsigned xb_xcc_id() { return (unsigned)__builtin_amdgcn_s_getreg((3 << 11) | 20) & 0xFu; }
#define XB_SPIN(cond, bar) do { unsigned _sp = 0; while (cond) { __builtin_amdgcn_s_sleep(1); \
    if ((++_sp & 255u) == 0u) { if (xb_ld(&(bar)[XB_TMO])) break; if (_sp > XB_SPIN_CAP) { atomicAdd(&(bar)[XB_TMO], 1u); break; } } } } while (0)
struct XcdBarrier { unsigned* bar; unsigned x; volatile LAS unsigned* st; };
__device__ __forceinline__ XcdBarrier xcd_barrier_post(unsigned* bar, volatile LAS unsigned* st) {
    XcdBarrier b; b.bar = bar; b.x = xb_xcc_id(); b.st = st;
    if (threadIdx.x == 0) (void)xb_add(&bar[XB_XCNT(b.x)], 1u);
    return b;
}
__device__ __forceinline__ void xcd_barrier_complete(unsigned* bar, unsigned x, unsigned& nloc, unsigned& nx) {
    const unsigned G = gridDim.x * gridDim.y * gridDim.z;
    unsigned sum, cnt, mine, sp = 0u;
    for (;;) {
        sum = 0u; cnt = 0u; mine = 0u;
#pragma unroll
        for (unsigned j = 0; j < 16; ++j) { const unsigned c = xb_ld(&bar[XB_XCNT(j)]); sum += c; cnt += (c > 0u) ? 1u : 0u; mine = (j == x) ? c : mine; }
        if (sum == G) break;
        __builtin_amdgcn_s_sleep(1);
        if ((++sp & 255u) == 0u) { if (xb_ld(&bar[XB_TMO])) break; if (sp > XB_SPIN_CAP) { atomicAdd(&bar[XB_TMO], 1u); break; } }
    }
    nloc = mine > 0u ? mine : 1u; nx = cnt > 0u ? cnt : 1u;
}
__device__ __forceinline__ void xcd_barrier(const XcdBarrier& b) {
    asm volatile("s_waitcnt vmcnt(0)" ::: "memory");
    __syncthreads();
    if (threadIdx.x == 0) {
        unsigned* bar = b.bar;
        __builtin_amdgcn_s_waitcnt(0);
        unsigned nloc = b.st[0], nx = b.st[1];
        if (nloc == 0u) { xcd_barrier_complete(bar, b.x, nloc, nx); b.st[0] = nloc; b.st[1] = nx; }
        const unsigned old = xb_add(&bar[XB_XSUB(b.x)], 1u);
        const unsigned gen = old / nloc;
        if (old + 1u == (gen + 1u) * nloc) {
            __builtin_amdgcn_fence(__ATOMIC_RELEASE, "agent");
            asm volatile("s_waitcnt vmcnt(0)" ::: "memory");
            const unsigned og = xb_add(&bar[XB_TOP], 1u);
            const unsigned tg = og / nx;
            if (og + 1u == (tg + 1u) * nx) xb_add(&bar[XB_TOPGEN], 1u);
            else XB_SPIN(xb_ld(&bar[XB_TOPGEN]) == tg, bar);
            __builtin_amdgcn_fence(__ATOMIC_ACQUIRE, "agent");
            xb_add(&bar[XB_XGEN(b.x)], 1u);
            asm volatile("s_waitcnt vmcnt(0)" ::: "memory");
        } else {
            XB_SPIN(xb_ld(&bar[XB_XGEN(b.x)]) == gen, bar);
            __builtin_amdgcn_fence(__ATOMIC_ACQUIRE, "agent");
            asm volatile("s_waitcnt vmcnt(0)" ::: "memory");
        }
    }
    __syncthreads();
}

struct Frame {
    LAS unsigned char* lds;
    gu32* ctl;
    int wave, G, vcu;
};

__device__ __forceinline__ void transpose_item(const float* W, int N, int k0, int n0, bf16_t* dst, int K, LAS float* scr, int lane) {
    f32x4 v[8];
#pragma unroll
    for (int it = 0; it < 8; ++it) v[it] = *(const GAS f32x4*)(W + (size_t)(k0 + it * 8 + (lane >> 3)) * N + n0 + 4 * (lane & 7));
#pragma unroll
    for (int it = 0; it < 8; ++it) { LAS float* s = scr + (it * 8 + (lane >> 3)) * 33 + 4 * (lane & 7); s[0] = v[it].x; s[1] = v[it].y; s[2] = v[it].z; s[3] = v[it].w; }
    LDS_WAIT(); asm volatile("" ::: "memory");
    const int c = lane & 7;
#pragma unroll
    for (int j = 0; j < 4; ++j) { const int n = (lane >> 3) + 8 * j; const LAS float* s = scr + (8 * c) * 33 + n;
        u32x4 o; o.x = pk2(s[0 * 33], s[1 * 33]); o.y = pk2(s[2 * 33], s[3 * 33]); o.z = pk2(s[4 * 33], s[5 * 33]); o.w = pk2(s[6 * 33], s[7 * 33]);
        *(GAS u32x4*)(dst + (size_t)n * K + k0 + 8 * c) = o; }
    LDS_WAIT(); asm volatile("" ::: "memory");
}

struct Args { const float* in[19]; float* out; unsigned char* ws; int ph_lo, ph_hi; };

namespace att {
constexpr int SLOT = 8192, NSL = 5;
constexpr int L_K = 0, L_V = NSL * SLOT, L_WS = 2 * NSL * SLOT, L_BIAS = L_WS + 8 * 256, L_OST = L_BIAS + 1024, L_END = L_OST + 8 * 4096;
__device__ __forceinline__ int crow(int r, int hi) { return (r & 3) + 8 * (r >> 2) + 4 * hi; }
__device__ __forceinline__ s16x4 vtr(const LAS char* p) { typedef short v4i16_t __attribute__((ext_vector_type(4))); return __builtin_bit_cast(s16x4, __builtin_amdgcn_ds_read_tr16_b64_v4i16((LAS v4i16_t*)p)); }

template <bool FIRST>
__device__ __forceinline__ void tile_step(const LAS char* lds, int slot, int s, int lane, int r32, int hi, int qin, const bf16x8 (&qr)[4], const LAS float* tb, LAS float* wsf,
                                          float& m_run, float& l_run, f32x16 (&o)[2], f32x16& negm) {
    constexpr float THR = 8.0f;
    const LAS char* kp = lds + L_K + slot + hi * 1024 + r32 * 16;
    f32x16 p0, p1;
#pragma unroll
    for (int d0 = 0; d0 < 4; ++d0) {
        const bf16x8 b0 = *(const LAS bf16x8*)(kp + d0 * 2048), b1 = *(const LAS bf16x8*)(kp + d0 * 2048 + 512);
        p0 = __builtin_amdgcn_mfma_f32_32x32x16_bf16(b0, qr[d0], d0 == 0 ? negm : p0, 0, 0, 0); p1 = __builtin_amdgcn_mfma_f32_32x32x16_bf16(b1, qr[d0], d0 == 0 ? negm : p1, 0, 0, 0); }
    if (s >= 6) { const int ib = qin + 64 * (8 - s) + 63 - 4 * hi;
#pragma unroll
        for (int r = 0; r < 16; ++r) { const int off = (r & 3) + 8 * (r >> 2); p0[r] += tb[ib - off]; p1[r] += tb[ib - off - 32]; } }
    float mx = __builtin_fmaxf(__builtin_fmaxf(p0[0], p0[1]), p1[0]), my = __builtin_fmaxf(__builtin_fmaxf(p0[2], p0[3]), p1[1]);
    mx = __builtin_fmaxf(__builtin_fmaxf(mx, p1[2]), p1[3]);
#pragma unroll
    for (int r = 4; r < 16; r += 4) { mx = __builtin_fmaxf(__builtin_fmaxf(mx, p0[r]), p0[r + 1]); my = __builtin_fmaxf(__builtin_fmaxf(my, p0[r + 2]), p0[r + 3]);
                                      mx = __builtin_fmaxf(__builtin_fmaxf(mx, p1[r]), p1[r + 1]); my = __builtin_fmaxf(__builtin_fmaxf(my, p1[r + 2]), p1[r + 3]); }
    mx = fmaxf(mx, my); mx = fmaxf(mx, __shfl_xor(mx, 32));
    if constexpr (FIRST) {
        m_run = mx;
#pragma unroll
        for (int r = 0; r < 16; ++r) { p0[r] -= mx; p1[r] -= mx; negm[r] = -mx; }
    } else if (__any(mx > THR)) {
        const float d = mx > THR ? mx : 0.f, f = __builtin_amdgcn_exp2f(-d);
        m_run += d; l_run *= f;
#pragma unroll
        for (int r = 0; r < 16; ++r) { p0[r] -= d; p1[r] -= d; negm[r] = -m_run; }
        if (hi == 0) wsf[r32] = f;
        LDS_WAIT();
#pragma unroll
        for (int r = 0; r < 16; ++r) { const float g = wsf[crow(r, hi)]; o[0][r] *= g; o[1][r] *= g; }
    }
    float rs = 0.f, rs2 = 0.f;
#pragma unroll
    for (int r = 0; r < 16; ++r) { p0[r] = __builtin_amdgcn_exp2f(p0[r]); p1[r] = __builtin_amdgcn_exp2f(p1[r]); rs += p0[r]; rs2 += p1[r]; }
    l_run += rs + rs2;
    u32x4 pw[4];
#pragma unroll
    for (int q = 0; q < 4; ++q) { pw[0][q] = cvt_pk_bf16(p0[2 * q], p0[2 * q + 1]); pw[1][q] = cvt_pk_bf16(p0[8 + 2 * q], p0[8 + 2 * q + 1]);
                                  pw[2][q] = cvt_pk_bf16(p1[2 * q], p1[2 * q + 1]); pw[3][q] = cvt_pk_bf16(p1[8 + 2 * q], p1[8 + 2 * q + 1]); }
    const unsigned vb = (unsigned)(uintptr_t)(lds + L_V + slot + ((lane >> 4) & 1) * 32 + (lane & 3) * 8 + (4 * hi + ((lane & 15) >> 2)) * 64);
#pragma unroll
    for (int d0 = 0; d0 < 2; ++d0) { s16x4 lo[4], hh[4];
#pragma unroll
        for (int ks = 0; ks < 4; ++ks) {
            asm volatile("ds_read_b64_tr_b16 %0, %1 offset:%c2" : "=&v"(lo[ks]) : "v"(vb), "i"(d0 * 4096 + ks * 1024) : "memory");
            asm volatile("ds_read_b64_tr_b16 %0, %1 offset:%c2" : "=&v"(hh[ks]) : "v"(vb), "i"(d0 * 4096 + ks * 1024 + 512) : "memory"); }
        asm volatile("s_waitcnt lgkmcnt(0)" ::: "memory"); __builtin_amdgcn_sched_barrier(0);
#pragma unroll
        for (int ks = 0; ks < 4; ++ks) { const bf16x8 vf = (bf16x8){lo[ks][0], lo[ks][1], lo[ks][2], lo[ks][3], hh[ks][0], hh[ks][1], hh[ks][2], hh[ks][3]};
            o[d0] = __builtin_amdgcn_mfma_f32_32x32x16_bf16(__builtin_bit_cast(bf16x8, pw[ks]), vf, o[d0], 0, 0, 0); } }
}

template <bool EDGE>
__device__ __forceinline__ void unit(const Frame& F, int b, int h, int cg, const bf16_t* Q, const bf16_t* Kb, const bf16_t* Vb, bf16_t* MIX, const float* relb) {
    LAS char* lds = (LAS char*)F.lds;
    const int wid = F.wave, lane = lane_id(), tid = wid * 64 + lane, r32 = lane & 31, hi = lane >> 5;
    const int wp = wid >> 1, half = wid & 1;
    const int c = 4 * cg + wp;
    const long rowbase = (long)b * SEQ;
    LAS float* wsf = (LAS float*)(lds + L_WS) + wid * 64;
    LAS float* tb = (LAS float*)(lds + L_BIAS);
    if (tid < 256) { const int i = tid < NREL ? tid : NREL - 1; tb[tid] = (relb[h * NREL + i] - relb[h * NREL + NREL - 1]) * LOG2E; }
    const bf16_t* Qw = Q + (rowbase + c * 64 + half * 32 + r32) * DA + h * HD;
    bf16x8 qr[4];
#pragma unroll
    for (int d0 = 0; d0 < 4; ++d0) qr[d0] = *(const GAS bf16x8*)(Qw + d0 * 16 + hi * 8);
    const int kc0 = 4 * cg - 8;
    const int krow = tid & 63, kch = tid >> 6;
    const int vrow = tid >> 3, vch = tid & 7;
    const bf16_t* ksrc = Kb + (rowbase + krow) * DA + h * HD + kch * 8;
    const bf16_t* vsrc = Vb + (rowbase + vrow) * DA + h * HD + vch * 8;
    const int kdst = L_K + kch * 1024 + krow * 16, vdst = L_V + (vch >> 2) * 4096 + vrow * 64 + (vch & 3) * 16;
#pragma unroll
    for (int j = 0; j < 4; ++j) { const int kc = kc0 + j;
        if (!EDGE || kc >= 0) { const u32x4 kv = *(const GAS u32x4*)(ksrc + (long)kc * 64 * DA); const u32x4 vv = *(const GAS u32x4*)(vsrc + (long)kc * 64 * DA);
            *(LAS u32x4*)(lds + kdst + j * SLOT) = kv; *(LAS u32x4*)(lds + vdst + j * SLOT) = vv; } }
    float m_run = 0.f, l_run = 0.f; f32x16 o[2]; o[0] = f32x16{}; o[1] = f32x16{}; f32x16 negm = f32x16{};
    const int qin = half * 32 + r32;
    if constexpr (!EDGE) {
        __syncthreads();
        { u32x4 kv = *(const GAS u32x4*)(ksrc + (long)(kc0 + 4) * 64 * DA), vv = *(const GAS u32x4*)(vsrc + (long)(kc0 + 4) * 64 * DA);
          tile_step<true>(lds, (wp % NSL) * SLOT, 0, lane, r32, hi, qin, qr, tb, wsf, m_run, l_run, o, negm);
          *(LAS u32x4*)(lds + kdst + 4 * SLOT) = kv; *(LAS u32x4*)(lds + vdst + 4 * SLOT) = vv; }
#pragma unroll 1
        for (int s = 1; s < 9; ++s) {
            __syncthreads();
            const int jn = s + 4; const bool ldn = jn < 12;
            u32x4 kv = (u32x4){0u, 0u, 0u, 0u}, vv = (u32x4){0u, 0u, 0u, 0u};
            if (ldn) { kv = *(const GAS u32x4*)(ksrc + (long)(kc0 + jn) * 64 * DA); vv = *(const GAS u32x4*)(vsrc + (long)(kc0 + jn) * 64 * DA); }
            tile_step<false>(lds, ((wp + s) % NSL) * SLOT, s, lane, r32, hi, qin, qr, tb, wsf, m_run, l_run, o, negm);
            if (ldn) { const int sl = (jn % NSL) * SLOT; *(LAS u32x4*)(lds + kdst + sl) = kv; *(LAS u32x4*)(lds + vdst + sl) = vv; }
        }
    } else {
        bool first = true;
#pragma unroll 1
        for (int s = 0; s < 9; ++s) {
            __syncthreads();
            const int jn = s + 4, kcn = kc0 + jn; const bool ldn = (jn < 12) && (kcn >= 0);
            u32x4 kv = (u32x4){0u, 0u, 0u, 0u}, vv = (u32x4){0u, 0u, 0u, 0u};
            if (ldn) { kv = *(const GAS u32x4*)(ksrc + (long)kcn * 64 * DA); vv = *(const GAS u32x4*)(vsrc + (long)kcn * 64 * DA); }
            const int j = wp + s, kc = kc0 + j;
            if (kc >= 0) { if (first) { tile_step<true>(lds, (j % NSL) * SLOT, s, lane, r32, hi, qin, qr, tb, wsf, m_run, l_run, o, negm); first = false; }
                           else tile_step<false>(lds, (j % NSL) * SLOT, s, lane, r32, hi, qin, qr, tb, wsf, m_run, l_run, o, negm); }
            if (ldn) { const int sl = (jn % NSL) * SLOT; *(LAS u32x4*)(lds + kdst + sl) = kv; *(LAS u32x4*)(lds + vdst + sl) = vv; }
        }
    }
    l_run += __shfl_xor(l_run, 32);
    if (hi == 0) wsf[32 + r32] = l_run;
    LDS_WAIT();
    LAS bf16_t* stg = (LAS bf16_t*)(lds + L_OST) + wid * 2048;
#pragma unroll
    for (int r = 0; r < 16; ++r) { const int orow = crow(r, hi); const float rl = __builtin_amdgcn_rcpf(wsf[32 + orow]);
#pragma unroll
        for (int d0 = 0; d0 < 2; ++d0) stg[orow * 64 + d0 * 32 + r32] = (bf16_t)f2bf(o[d0][r] * rl); }
    LDS_WAIT();
    bf16_t* Ow = MIX + (rowbase + c * 64 + half * 32) * D + h * HD;
#pragma unroll
    for (int i = 0; i < 4; ++i) { const int row = i * 8 + (lane >> 3), ch = lane & 7; const u32x4 v = *(const LAS u32x4*)(stg + row * 64 + ch * 8); *(GAS u32x4*)(Ow + (long)row * D + ch * 8) = v; }
    __syncthreads();
}
}

namespace cv {
constexpr int TT = 32, UR = TT + CW - 1;
constexpr int L_U = 0, L_Y = UR * DC * 2  , L_END = L_Y + TT * DC * 4;
__device__ __forceinline__ void unit(const Frame& F, int b, int tt, const bf16_t* Ab, const bf16_t* Gb, bf16_t* MIX, const float* dw_w, const float* dw_b, const float* ln_g, const float* ln_b) {
    LAS char* lds = (LAS char*)F.lds;
    const int wid = F.wave, lane = lane_id(), tid = wid * 64 + lane;
    const int t0 = tt * TT; const long rowbase = (long)b * SEQ;
    for (int idx = tid; idx < UR * 64; idx += 512) { const int r = idx >> 6, c8 = idx & 63; const int tok = t0 - (CW - 1) + r;
        u32x4 w = (u32x4){0u, 0u, 0u, 0u};
        if (tok >= 0) { const u32x4 av = *(const GAS u32x4*)(Ab + (rowbase + tok) * DC + c8 * 8), gv = *(const GAS u32x4*)(Gb + (rowbase + tok) * DC + c8 * 8);
#pragma unroll
            for (int q = 0; q < 4; ++q) { const float u0 = bf_lo(av[q]) * fsigmoid(bf_lo(gv[q])), u1 = bf_hi(av[q]) * fsigmoid(bf_hi(gv[q])); w[q] = cvt_pk_bf16(u0, u1); } }
        *(LAS u32x4*)(lds + L_U + r * (DC * 2) + c8 * 16) = w; }
    __syncthreads();
    { const int cp = tid & 255, th = tid >> 8;
      f32x2 w[CW];
#pragma unroll
      for (int j = 0; j < CW; ++j) w[j] = *(const GAS f32x2*)(dw_w + j * DC + 2 * cp);
      const f32x2 bias = *(const GAS f32x2*)(dw_b + 2 * cp);
#pragma unroll 1
      for (int blk = 0; blk < 2; ++blk) { const int tbk = th * 16 + blk * 8;
          f32x2 acc[8];
#pragma unroll
          for (int k = 0; k < 8; ++k) acc[k] = bias;
#pragma unroll
          for (int i = 0; i < 8 + CW - 1; ++i) { const unsigned uw = *(const LAS unsigned*)(lds + L_U + (tbk + i) * (DC * 2) + cp * 4); const f32x2 uv = (f32x2){bf_lo(uw), bf_hi(uw)};
#pragma unroll
              for (int k = 0; k < 8; ++k) { const int j = i - k; if (j >= 0 && j < CW) acc[k] += uv * w[j]; } }
#pragma unroll
          for (int k = 0; k < 8; ++k) *(LAS f32x2*)(lds + L_Y + (tbk + k) * (DC * 4) + cp * 8) = acc[k]; } }
    __syncthreads();
    { const f32x4 g0 = *(const GAS f32x4*)(ln_g + 8 * lane), g1 = *(const GAS f32x4*)(ln_g + 8 * lane + 4), b0 = *(const GAS f32x4*)(ln_b + 8 * lane), b1 = *(const GAS f32x4*)(ln_b + 8 * lane + 4);
#pragma unroll
      for (int q = 0; q < 4; ++q) { const int t = wid * 4 + q;
          f32x4 y0 = *(const LAS f32x4*)(lds + L_Y + t * (DC * 4) + lane * 32), y1 = *(const LAS f32x4*)(lds + L_Y + t * (DC * 4) + lane * 32 + 16);
          const float mean = wave_sum((y0.x + y0.y) + (y0.z + y0.w) + (y1.x + y1.y) + (y1.z + y1.w)) * (1.f / DC);
          y0 = y0 - mean; y1 = y1 - mean;
          const float var = wave_sum((y0.x * y0.x + y0.y * y0.y) + (y0.z * y0.z + y0.w * y0.w) + (y1.x * y1.x + y1.y * y1.y) + (y1.z * y1.z + y1.w * y1.w)) * (1.f / DC);
          const float rstd = 1.0f / sqrtf(var + LN_EPS);
          y0 = y0 * rstd * g0 + b0; y1 = y1 * rstd * g1 + b1;
          float z[8] = {y0.x, y0.y, y0.z, y0.w, y1.x, y1.y, y1.z, y1.w};
#pragma unroll
          for (int i = 0; i < 8; ++i) z[i] = z[i] * fsigmoid(z[i]);
          u32x4 w; w.x = cvt_pk_bf16(z[0], z[1]); w.y = cvt_pk_bf16(z[2], z[3]); w.z = cvt_pk_bf16(z[4], z[5]); w.w = cvt_pk_bf16(z[6], z[7]);
          *(GAS u32x4*)(MIX + (rowbase + t0 + t) * D + DA + 8 * lane) = w; } }
    __syncthreads();
}
}

__global__ void __launch_bounds__(NWAVES * 64, 2) hymba_fwd(Args args) {
    extern __shared__ __attribute__((aligned(16))) unsigned char lds_raw[];
    Frame F;
    F.lds = (LAS unsigned char*)lds_raw;
    F.wave = __builtin_amdgcn_readfirstlane(threadIdx.x >> 6);
    F.G = gridDim.x; { const int bx = blockIdx.x; F.vcu = (F.G % 8 == 0) ? (bx % 8) * (F.G / 8) + bx / 8 : bx; }
    unsigned char* ws = args.ws;
    F.ctl = (gu32*)(ws + WS_CTL);
    volatile LAS unsigned* MISC = (volatile LAS unsigned*)(F.lds + LDSCTL_OFF);
    for (int u = threadIdx.x; u < (LDS_BYTES - LDSCTL_OFF) / 4; u += NWAVES * 64) ((LAS unsigned*)(F.lds + LDSCTL_OFF))[u] = 0u;
    __syncthreads();
    const int lo = args.ph_lo, hi = args.ph_hi;
    const bool multi = (hi - lo) > 1;
    XcdBarrier bar; bar.bar = (unsigned*)(F.ctl + CW_BAR); bar.x = 0; bar.st = nullptr;
    if (multi) bar = xcd_barrier_post((unsigned*)(F.ctl + CW_BAR), MISC + 8);
#define IN(k) (lo <= (k) && (k) < hi)
#define BOTH(k) (IN(k) && IN((k) + 1))
#define GRID_BAR() xcd_barrier(bar)

    const float* x = args.in[0];
    bf16_t* Win_t = (bf16_t*)(ws + WS_WIN); bf16_t* Wout_t = (bf16_t*)(ws + WS_WOUT); unsigned char* Wgu8 = ws + WS_WGU; unsigned char* Wd8 = ws + WS_WD;
    bf16_t* X1 = (bf16_t*)(ws + WS_X1); bf16_t* XN = (bf16_t*)(ws + WS_XN);
    bf16_t* Qb = (bf16_t*)(ws + WS_Q); bf16_t* Kb = (bf16_t*)(ws + WS_K); bf16_t* Vb = (bf16_t*)(ws + WS_V); bf16_t* Ab = (bf16_t*)(ws + WS_A); bf16_t* Gb = (bf16_t*)(ws + WS_G);
    bf16_t* MIX = (bf16_t*)(ws + WS_MIX); unsigned char* HID8 = ws + WS_HID; unsigned char* T8 = ws + WS_XN; unsigned char* OB = ws + WS_O;
    u32x2* LIST = (u32x2*)(ws + WS_LIST); float* TOPW = (float*)(ws + WS_TOPW); bf16_t* RWB = (bf16_t*)(ws + WS_RWT);
    const int gw = F.vcu * NWAVES + F.wave, NGW = F.G * NWAVES;

    if (IN(0)) {
        const int lane = lane_id(), tid = F.wave * 64 + lane;
        LAS float* scr = (LAS float*)(F.lds + F.wave * 16896);
        constexpr int I_IN = (D / 64) * (NIN / 32), I_OUT = (D / 64) * (D / 32), I_EXP = (D / 64) * (D / 32);
        for (int it = gw; it < I_IN + I_OUT; it += NGW) {
            int r = it;
            if (r < I_IN) { const int kb = r / (NIN / 32), nb = r % (NIN / 32); transpose_item(args.in[2], NIN, kb * 64, nb * 32, Win_t + (size_t)(nb * 32) * D, D, scr, lane); continue; } r -= I_IN;
            const int kb = r / (D / 32), nb = r % (D / 32); transpose_item(args.in[8], D, kb * 64, nb * 32, Wout_t + (size_t)(nb * 32) * D, D, scr, lane);
        }
        { const GAS f32x4* gp = (const GAS f32x4*)args.in[1] + lane; f32x4 g[4];
#pragma unroll
          for (int j = 0; j < 4; ++j) g[j] = gp[64 * j];
          for (int m = gw; m < T; m += 2 * NGW) { const int m2 = m + NGW;
              const GAS f32x4* xr = (const GAS f32x4*)(x + (size_t)m * D) + lane; const GAS f32x4* xr2 = (const GAS f32x4*)(x + (size_t)(m2 < T ? m2 : m) * D) + lane; f32x4 v[4], v2[4]; float s = 0.f, s2 = 0.f;
#pragma unroll
              for (int j = 0; j < 4; ++j) { v[j] = __builtin_nontemporal_load(xr + 64 * j); v2[j] = __builtin_nontemporal_load(xr2 + 64 * j); }
#pragma unroll
              for (int j = 0; j < 4; ++j) { s += (v[j].x * v[j].x + v[j].y * v[j].y) + (v[j].z * v[j].z + v[j].w * v[j].w); s2 += (v2[j].x * v2[j].x + v2[j].y * v2[j].y) + (v2[j].z * v2[j].z + v2[j].w * v2[j].w); }
              const float r = 1.0f / sqrtf(wave_sum(s) * (1.f / D) + RMS_EPS), r2 = 1.0f / sqrtf(wave_sum(s2) * (1.f / D) + RMS_EPS);
              GAS u32x2* o8 = (GAS u32x2*)(XN + (size_t)m * D) + lane;
#pragma unroll
              for (int j = 0; j < 4; ++j) { const f32x4 y = v[j] * r * g[j]; o8[64 * j] = (u32x2){pk2(y.x, y.y), pk2(y.z, y.w)}; }
              if (m2 < T) { GAS u32x2* o82 = (GAS u32x2*)(XN + (size_t)m2 * D) + lane;
#pragma unroll
                  for (int j = 0; j < 4; ++j) { const f32x4 y = v2[j] * r2 * g[j]; o82[64 * j] = (u32x2){pk2(y.x, y.y), pk2(y.z, y.w)}; } } } }
        for (int i = blockIdx.x * 512 + tid; i < NE * D; i += F.G * 512) { const int e = i / D, k = i % D; const float v = args.in[10][k * NE + e] * args.in[9][k];
            const unsigned h = f2bf(v); RWB[i] = (bf16_t)h; RWB[NE * D + i] = (bf16_t)f2bf(v - __uint_as_float(h << 16)); }
        if (BOTH(0)) GRID_BAR();
    }

    if (IN(1)) {
        const int xg = (int)(blockIdx.x % 8), jb = (int)(blockIdx.x / 8), half = F.G / 16;
        if (jb < half) {
            pg8::DenseOrder S; S.init(T, NIN, F.G / 2, xg + 8 * jb, Win_t);
            pg8::EpiSplit E{Qb, (size_t)(WS_K - WS_Q) / 2, QSCALE};
            pg8::gemm_phase<pg8::EpiSplit, pg8::DenseOrder, true, 2>(F.lds, (const char*)XN, D, S, E);
        } else {
            const int cgw = (xg * half + (jb - half)) * NWAVES + F.wave, CNGW = (F.G / 2) * NWAVES;
        { constexpr int NIT = NE * 3 * 8 * 32;
          LAS unsigned* tile = (LAS unsigned*)(F.lds + F.wave * 4352); const int lane = lane_id();
          f32x4 v[16], w[16];
          auto src_of = [&](int r) -> const float* { const int em = r >> 8, ri = r & 255, e = em / 3, mat = em % 3, kb = ri >> 5, nb = ri & 31;
              const float* base = (mat == 0 ? args.in[12] : mat == 1 ? args.in[14] : args.in[16]) + (size_t)e * D * D;
              return base + (size_t)(kb * 128 + (lane >> 3)) * D + nb * 32 + 4 * (lane & 7); };
          int it = cgw;
          if (it < NIT) { const float* sp = src_of(it);
#pragma unroll
              for (int q = 0; q < 16; ++q) v[q] = __builtin_nontemporal_load((const GAS f32x4*)(sp + (size_t)q * 8 * D)); }
#pragma unroll 1
          for (; it < NIT; it += CNGW) {
              const int nx = it + CNGW;
              if (nx < NIT) { const float* sp = src_of(nx);
#pragma unroll
                  for (int q = 0; q < 16; ++q) w[q] = __builtin_nontemporal_load((const GAS f32x4*)(sp + (size_t)q * 8 * D)); }
              const int em = it >> 8, ri = it & 255, e = em / 3, mat = em % 3, kb = ri >> 5, nb = ri & 31, n0 = nb * 32, k0 = kb * 128;
              unsigned char* dst = (mat == 2) ? Wd8 + ((size_t)e * D + n0) * D : Wgu8 + ((size_t)e * 2048 + (size_t)(n0 >> 7) * 256 + (n0 & 127) + (mat == 1 ? 128 : 0)) * D;
#pragma unroll
              for (int q = 0; q < 16; ++q) tile[(lane & 7) * 132 + q * 8 + (lane >> 3)] = pk4_fp8(v[q].x * SC_W, v[q].y * SC_W, v[q].z * SC_W, v[q].w * SC_W);
              LDS_WAIT(); asm volatile("" ::: "memory");
              const int nq = lane >> 3, c = lane & 7;
              u32x4 r[4];
#pragma unroll
              for (int i = 0; i < 4; ++i) r[i] = *(const LAS u32x4*)(tile + nq * 132 + 16 * c + 4 * i);
              LDS_WAIT(); asm volatile("" ::: "memory");
              u32x4 o[4];
#pragma unroll
              for (int i = 0; i < 4; ++i) {
                  const unsigned x01 = __builtin_amdgcn_perm(r[i].y, r[i].x, 0x05010400u), y01 = __builtin_amdgcn_perm(r[i].y, r[i].x, 0x07030602u);
                  const unsigned x23 = __builtin_amdgcn_perm(r[i].w, r[i].z, 0x05010400u), y23 = __builtin_amdgcn_perm(r[i].w, r[i].z, 0x07030602u);
                  o[0][i] = __builtin_amdgcn_perm(x23, x01, 0x05040100u); o[1][i] = __builtin_amdgcn_perm(x23, x01, 0x07060302u);
                  o[2][i] = __builtin_amdgcn_perm(y23, y01, 0x05040100u); o[3][i] = __builtin_amdgcn_perm(y23, y01, 0x07060302u); }
#pragma unroll
              for (int j = 0; j < 4; ++j) __builtin_nontemporal_store(o[j], (GAS u32x4*)(dst + (size_t)(4 * nq + j) * D + k0 + 16 * c));
#pragma unroll
              for (int q = 0; q < 16; ++q) v[q] = w[q];
          } }
        }
        if (BOTH(1)) GRID_BAR();
    }

    if (IN(2)) {
        for (int u = blockIdx.x; u < 2 * NH * 32; u += F.G) { const int cg = u & 31, h = (u >> 5) & 7, b = u >> 8;
            if (cg < 2) att::unit<true>(F, b, h, cg, Qb, Kb, Vb, MIX, args.in[7]); else att::unit<false>(F, b, h, cg, Qb, Kb, Vb, MIX, args.in[7]); }
        for (int u = blockIdx.x; u < T / cv::TT; u += F.G) { const int b = u / (SEQ / cv::TT), tt = u % (SEQ / cv::TT);
            cv::unit(F, b, tt, Ab, Gb, MIX, args.in[3], args.in[4], args.in[5], args.in[6]); }
        if (BOTH(2)) GRID_BAR();
    }

    if (IN(3)) {
        pg8::DenseOrder S; S.init(T, D, F.G, (int)blockIdx.x, Wout_t);
        pg8::EpiRes E{x, X1, T8, args.in[9]};
        pg8::gemm_phase<pg8::EpiRes, pg8::DenseOrder, false, 2>(F.lds, (const char*)MIX, D, S, E);
        if (BOTH(3)) {
            const int tid = F.wave * 64 + lane_id();
            for (int i = tid; i < 8192; i += 512) { const int row = i >> 7, ch = i & 127; const u32x4 v = ((const GAS u32x4*)RWB)[i];
                *(LAS u32x4*)(F.lds + row * 2048 + (((ch & ~15) | ((ch ^ row) & 15)) * 16)) = v; }
            GRID_BAR(); }
    }

    if (IN(4)) {
        const int lane = lane_id(), tid = F.wave * 64 + lane, fr = lane & 15, fq = lane >> 4;
        LAS unsigned char* rwl = F.lds;
        LAS int* hist = (LAS int*)(F.lds + XTRA_OFF);
        LAS int* baseE = hist + 32;
        LAS int* selE = baseE + 32;
        LAS int* selP = selE + 256;
        LAS float* selR = (LAS float*)(selP + 256);
        LAS float* part = selR + 64;
        const int w4 = F.wave & 3, kh = F.wave >> 2;
        const float rb0 = args.in[11][fr], rb1 = args.in[11][16 + fr];
        bool filled = false;
#pragma unroll 1
        for (int tb = blockIdx.x * 4; tb < T / 16; tb += F.G * 4) {
            const int task = tb + w4;
            const bf16_t* xrow = X1 + (size_t)(task * 16 + fr) * D + kh * 512 + 8 * fq;
            u32x4 xv[16];
#pragma unroll
            for (int ks = 0; ks < 16; ++ks) xv[ks] = *(const GAS u32x4*)(xrow + 32 * ks);
            if (!filled && !BOTH(3)) {
                for (int i = tid; i < 8192; i += 512) { const int row = i >> 7, ch = i & 127; const u32x4 v = ((const GAS u32x4*)RWB)[i];
                    *(LAS u32x4*)(rwl + row * 2048 + (((ch & ~15) | ((ch ^ row) & 15)) * 16)) = v; } }
            filled = true;
            if (tid < 32) hist[tid] = 0;
            __syncthreads();
            f32x4 acc0 = (f32x4){0.f, 0.f, 0.f, 0.f}, acc1 = acc0; float ss = 0.f;
#pragma unroll
            for (int ks = 0; ks < 16; ++ks) {
                const u32x4 hi = xv[ks];
                { const float a0 = bf_lo(hi.x), a1 = bf_hi(hi.x), a2 = bf_lo(hi.y), a3 = bf_hi(hi.y), a4 = bf_lo(hi.z), a5 = bf_hi(hi.z), a6 = bf_lo(hi.w), a7 = bf_hi(hi.w);
                  ss += (a0 * a0 + a1 * a1) + (a2 * a2 + a3 * a3) + (a4 * a4 + a5 * a5) + (a6 * a6 + a7 * a7); }
                const bf16x8 ah = __builtin_bit_cast(bf16x8, hi);
                const int ch = kh * 64 + 4 * ks + fq;
                const int o0 = fr * 2048 + (((ch & ~15) | ((ch ^ fr) & 15)) * 16), o1 = o0 + 16 * 2048;
                const bf16x8 bh0 = *(const LAS bf16x8*)(rwl + o0), bl0 = *(const LAS bf16x8*)(rwl + 65536 + o0), bh1 = *(const LAS bf16x8*)(rwl + o1), bl1 = *(const LAS bf16x8*)(rwl + 65536 + o1);
                acc0 = __builtin_amdgcn_mfma_f32_16x16x32_bf16(ah, bh0, acc0, 0, 0, 0); acc1 = __builtin_amdgcn_mfma_f32_16x16x32_bf16(ah, bh1, acc1, 0, 0, 0);
                acc0 = __builtin_amdgcn_mfma_f32_16x16x32_bf16(ah, bl0, acc0, 0, 0, 0); acc1 = __builtin_amdgcn_mfma_f32_16x16x32_bf16(ah, bl1, acc1, 0, 0, 0);
            }
            ss += __shfl_xor(ss, 16); ss += __shfl_xor(ss, 32);
            if (kh == 1) { LAS float* pp = part + w4 * 576 + lane;
#pragma unroll
                for (int q = 0; q < 4; ++q) { pp[64 * q] = acc0[q]; pp[64 * (4 + q)] = acc1[q]; }
                pp[64 * 8] = ss; }
            __syncthreads();
            if (kh == 0) { const LAS float* pp = part + w4 * 576 + lane;
#pragma unroll
                for (int q = 0; q < 4; ++q) { acc0[q] += pp[64 * q]; acc1[q] += pp[64 * (4 + q)]; }
                ss += pp[64 * 8];
                const float rrow = 1.0f / sqrtf(ss * (1.f / D) + RMS_EPS);
                float c0[4], c1[4], rt[4], tv[4][4]; int te[4][4];
#pragma unroll
                for (int q = 0; q < 4; ++q) { rt[q] = __shfl(rrow, 4 * fq + q); c0[q] = acc0[q] * rt[q] + rb0; c1[q] = acc1[q] * rt[q] + rb1; }
#pragma unroll
                for (int k = 0; k < 4; ++k) { float v[4]; int e[4];
#pragma unroll
                    for (int q = 0; q < 4; ++q) { v[q] = c0[q]; e[q] = fr; if (c1[q] > c0[q]) { v[q] = c1[q]; e[q] = 16 + fr; } }
#define RT_STEP(CTRL) _Pragma("unroll") for (int q = 0; q < 4; ++q) { const float v2 = __builtin_bit_cast(float, __builtin_amdgcn_update_dpp(0, __builtin_bit_cast(int, v[q]), CTRL, 0xf, 0xf, false)); \
                        const int e2 = __builtin_amdgcn_update_dpp(0, e[q], CTRL, 0xf, 0xf, false); if (v2 > v[q] || (v2 == v[q] && e2 < e[q])) { v[q] = v2; e[q] = e2; } }
                    RT_STEP(0x128) RT_STEP(0x124) RT_STEP(0x122) RT_STEP(0x121)
#undef RT_STEP
#pragma unroll
                    for (int q = 0; q < 4; ++q) { tv[q][k] = v[q]; te[q][k] = e[q]; if (e[q] == fr) c0[q] = -INFINITY; if (e[q] == 16 + fr) c1[q] = -INFINITY; } }
#pragma unroll
                for (int q = 0; q < 4; ++q) {
                    const float e1 = __expf(tv[q][1] - tv[q][0]), e2 = __expf(tv[q][2] - tv[q][0]), e3 = __expf(tv[q][3] - tv[q][0]); const float inv = 1.0f / (1.0f + e1 + e2 + e3);
                    const int tl = w4 * 16 + 4 * fq + q, tok = task * 16 + 4 * fq + q;
                    if (fr == 0) { *(GAS f32x4*)(TOPW + (size_t)tok * 4) = (f32x4){inv, e1 * inv, e2 * inv, e3 * inv}; selR[tl] = rt[q]; }
                    if (fr < 4) { const int em = fr == 0 ? te[q][0] : fr == 1 ? te[q][1] : fr == 2 ? te[q][2] : te[q][3];
                        selE[tl * 4 + fr] = em; selP[tl * 4 + fr] = __hip_atomic_fetch_add(&hist[em], 1, __ATOMIC_RELAXED, __HIP_MEMORY_SCOPE_WORKGROUP); }
                } }
            __syncthreads();
            if (tid < 32) baseE[tid] = (int)__hip_atomic_fetch_add(F.ctl + CW_CNT + 64 * tid, (unsigned)hist[tid], RLX_AGENT);
            __syncthreads();
            if (tid < 256) { const int e = selE[tid]; LIST[(size_t)e * LCAP + baseE[e] + selP[tid]] = (u32x2){(unsigned)((tb * 16 + (tid >> 2)) * 4 + (tid & 3)), __float_as_uint(selR[tid >> 2])}; }
            __syncthreads();
        }
        if (BOTH(4)) GRID_BAR();
    }

    LAS int* tstart = (LAS int*)(F.lds + XTRA_OFF + 14336);
    LAS int* ecnt = tstart + 64;
    LAS i32x4* ulist = (LAS i32x4*)(tstart + 128);
    if (IN(5) || IN(6)) {
        const int tid = F.wave * 64 + lane_id();
        __syncthreads();
        if (tid < 32) ecnt[tid] = (int)__hip_atomic_load(F.ctl + CW_CNT + 64 * tid, RLX_AGENT);
        __syncthreads();
        if (tid == 0) { int s = 0; for (int e = 0; e < NE; ++e) { tstart[e] = s; s += (ecnt[e] + 255) >> 8; } tstart[NE] = s; }
        __syncthreads();
        if (tid < 64) {
            const int which = tid >> 5, i = tid & 31, npn = which ? 4 : 8, nper = F.G / 8, xg = (int)(blockIdx.x % 8), j = (int)(blockIdx.x / 8);
            const int R = (nper / npn) * (i * 8 + xg) + j / npn, Rtot = tstart[NE];
            int e = 0; for (int q = 1; q < NE; ++q) e += (tstart[q] <= R) ? 1 : 0;
            i32x4 u = (i32x4){0, 0, 0, 0};
            if (R < Rtot) { const int pm = R - tstart[e], rem = ecnt[e] - pm * 256; u = (i32x4){e, pm, j % npn, rem < 256 ? rem : 256}; }
            ulist[which * 32 + i] = u; }
        __syncthreads();
    }

    if (IN(5)) {
        pg8::MoeOrder S{ulist, LIST, (const char*)Wgu8, 8, 2048, 2, args.in[13], args.in[15], 128};
        pg8::EpiGU E{HID8};
        pg8::gemm_phase<pg8::EpiGU, pg8::MoeOrder, true, 1>(F.lds, (const char*)T8, D, S, E);
        if (BOTH(5)) GRID_BAR();
    }

    if (IN(6)) {
        pg8::MoeOrder S{ulist + 32, LIST, (const char*)Wd8, 4, 1024, 0, args.in[17], args.in[17], 256};
        pg8::EpiDown E{OB};
        pg8::gemm_phase<pg8::EpiDown, pg8::MoeOrder, true, 1>(F.lds, (const char*)HID8, D, S, E);
        if (BOTH(6)) GRID_BAR();
    }

    if (IN(7)) {
        const int lane = lane_id();
        const GAS f32x4* gp = (const GAS f32x4*)args.in[18] + lane; f32x4 g[4];
#pragma unroll
        for (int j = 0; j < 4; ++j) g[j] = gp[64 * j];
        unsigned bad = __hip_atomic_load(F.ctl + CW_BAR + XB_TMO, RLX_AGENT);
        for (int m = gw; m < T; m += NGW) {
            const GAS u32x2* xr = (const GAS u32x2*)(X1 + (size_t)m * D) + lane; f32x4 v[4];
#pragma unroll
            for (int j = 0; j < 4; ++j) { const u32x2 w = __builtin_nontemporal_load(xr + 64 * j); v[j] = (f32x4){bf_lo(w.x), bf_hi(w.x), bf_lo(w.y), bf_hi(w.y)}; }
            const f32x4 tw = *(const GAS f32x4*)(TOPW + (size_t)m * 4);
#pragma unroll
            for (int k = 0; k < 4; ++k) { const GAS unsigned* orow = (const GAS unsigned*)(OB + ((size_t)m * 4 + k) * D) + lane; const float wk = tw[k] * (1.0f / SC_O);
#pragma unroll
                for (int j = 0; j < 4; ++j) { const unsigned w = __builtin_nontemporal_load(orow + 64 * j); const f32x2 lo = __builtin_amdgcn_cvt_pk_f32_fp8((int)w, false), hi = __builtin_amdgcn_cvt_pk_f32_fp8((int)w, true);
                    v[j].x += wk * lo.x; v[j].y += wk * lo.y; v[j].z += wk * hi.x; v[j].w += wk * hi.y; } }
            float s = 0.f;
#pragma unroll
            for (int j = 0; j < 4; ++j) s += (v[j].x * v[j].x + v[j].y * v[j].y) + (v[j].z * v[j].z + v[j].w * v[j].w);
            float r = 1.0f / sqrtf(wave_sum(s) * (1.f / D) + RMS_EPS);
            if (bad) r = __builtin_nanf("");
            GAS f32x4* o = (GAS f32x4*)(args.out + (size_t)m * D) + lane;
#pragma unroll
            for (int j = 0; j < 4; ++j) __builtin_nontemporal_store(v[j] * r * g[j], o + 64 * j);
        }
    }
#undef IN
#undef BOTH
#undef GRID_BAR
}

#ifndef MK_N_LAUNCHES
#define MK_N_LAUNCHES 1
#endif
extern "C" void kernel_launch(void* const* d_in, const int* in_sizes, int n_in, void* d_out, int out_size, void* d_ws, size_t ws_size, hipStream_t stream) {
    static int grid = 0;
    if (grid == 0) {
        if (n_in != 19 || in_sizes[0] != T * D || out_size != T * D || ws_size < WS_END) { fprintf(stderr, "kernel_launch: unexpected shapes (n_in %d, in0 %d, out %d, ws %zu); nothing launched\n", n_in, n_in > 0 ? in_sizes[0] : -1, out_size, ws_size); grid = -1; return; }
        int dev = 0, cus = 0, per_cu = 0;
        if (hipGetDevice(&dev) != hipSuccess || hipDeviceGetAttribute(&cus, hipDeviceAttributeMultiprocessorCount, dev) != hipSuccess) { fprintf(stderr, "kernel_launch: device query failed\n"); grid = -1; return; }
        if (hipFuncSetAttribute((const void*)hymba_fwd, hipFuncAttributeMaxDynamicSharedMemorySize, LDS_BYTES) != hipSuccess) { fprintf(stderr, "kernel_launch: hipFuncSetAttribute failed\n"); grid = -1; return; }
        if (hipOccupancyMaxActiveBlocksPerMultiprocessor(&per_cu, (const void*)hymba_fwd, NWAVES * 64, LDS_BYTES) != hipSuccess || per_cu < 1) fprintf(stderr, "kernel_launch: note: occupancy query reports %d workgroups per CU\n", per_cu);
        (void)hipGetLastError();
        grid = (cus / 64) * 64; if (grid > 256) grid = 256;
        if (grid < 64) { fprintf(stderr, "kernel_launch: %d CUs: unsupported\n", cus); grid = -1; return; }
    }
    if (grid < 0) return;
    if (hipMemsetAsync((char*)d_ws + WS_CTL, 0, CTL_ZERO_BYTES, stream) != hipSuccess) { fprintf(stderr, "kernel_launch: memset failed\n"); return; }
    Args a{};
    for (int i = 0; i < 19; ++i) a.in[i] = (const float*)d_in[i];
    a.out = (float*)d_out; a.ws = (unsigned char*)d_ws;
    constexpr int NPH = 8;
    if (MK_N_LAUNCHES == 1) { a.ph_lo = 0; a.ph_hi = NPH; hipLaunchKernelGGL(hymba_fwd, dim3(grid), dim3(NWAVES * 64), LDS_BYTES, stream, a); }
    else for (int p = 0; p < NPH; ++p) { a.ph_lo = p; a.ph_hi = p + 1; hipLaunchKernelGGL(hymba_fwd, dim3(grid), dim3(NWAVES * 64), LDS_BYTES, stream, a); }
    const hipError_t le = hipPeekAtLastError();
    if (le != hipSuccess) fprintf(stderr, "kernel_launch: launch failed: %s\n", hipGetErrorName(le));
}
```

```cpp
#include <hip/hip_runtime.h>
#include <cstdio>
#include <cstdint>

#define GAS __attribute__((address_space(1)))
#define LAS __attribute__((address_space(3)))
typedef unsigned short bf16_t;
typedef short bf16x8 __attribute__((ext_vector_type(8)));
typedef short s16x4 __attribute__((ext_vector_type(4)));
typedef float f32x2 __attribute__((ext_vector_type(2)));
typedef float f32x4 __attribute__((ext_vector_type(4)));
typedef float f32x16 __attribute__((ext_vector_type(16)));
typedef unsigned u32x2 __attribute__((ext_vector_type(2)));
typedef unsigned u32x4 __attribute__((ext_vector_type(4)));
typedef int i32x4 __attribute__((ext_vector_type(4)));
typedef int i32x8 __attribute__((ext_vector_type(8)));
typedef GAS unsigned gu32;
#define RLX_AGENT __ATOMIC_RELAXED, __HIP_MEMORY_SCOPE_AGENT
#define LDS_WAIT() asm volatile("s_waitcnt lgkmcnt(0)" ::: "memory")
#define VM_WAIT() asm volatile("s_waitcnt vmcnt(0)" ::: "memory")

constexpr int T = 16384, SEQ = 8192, D = 1024, NIN = 2560, DA = 512, NH = 8, HD = 64, DC = 512, CW = 31;
constexpr int NE = 32, TOPK = 4, NP = T * TOPK, LCAP = 16384, NREL = 192;
constexpr float RMS_EPS = 1e-5f, LN_EPS = 1e-5f, LOG2E = 1.4426950408889634f;
constexpr float QSCALE = 0.125f * LOG2E;
constexpr float SC_T = 16.0f, SC_W = 256.0f, SC_H = 4.0f, SC_O = 32.0f;

constexpr size_t MiB = 1u << 20;
constexpr size_t WS_CTL = 0, CTL_ZERO_BYTES = 64 * 1024;
constexpr size_t WS_WIN = 1 * MiB, WS_WOUT = 6 * MiB, WS_WGU = 8 * MiB, WS_WD = 136 * MiB, WS_X1 = 200 * MiB, WS_XN = 264 * MiB;
constexpr size_t WS_Q = 296 * MiB, WS_K = 312 * MiB, WS_V = 328 * MiB, WS_A = 344 * MiB, WS_G = 360 * MiB, WS_MIX = 376 * MiB;
constexpr size_t WS_HID = 296 * MiB;
constexpr size_t WS_O = WS_WGU;
constexpr size_t WS_LIST = 424 * MiB, WS_TOPW = 428 * MiB, WS_RWT = 429 * MiB, WS_END = 430 * MiB;
constexpr int CW_TMO = 0, CW_BAR = 4096, CW_CNT = 8192;

constexpr int RING_BYTES = 131072, XTRA_OFF = RING_BYTES, LDS_BYTES = 147456, LDSCTL_OFF = LDS_BYTES - 512;
constexpr int NWAVES = 8;

__device__ __forceinline__ unsigned f2bf(float f) { unsigned u = __builtin_bit_cast(unsigned, f); return (u + 0x7fffu + ((u >> 16) & 1u)) >> 16; }
__device__ __forceinline__ unsigned pk2(float lo, float hi) { return f2bf(lo) | (f2bf(hi) << 16); }
__device__ __forceinline__ unsigned cvt_pk_bf16(float lo, float hi) { unsigned r; asm volatile("v_cvt_pk_bf16_f32 %0, %1, %2" : "=v"(r) : "v"(lo), "v"(hi)); return r; }
__device__ __forceinline__ float clamp448(float v) { return fminf(fmaxf(v, -448.0f), 448.0f); }
__device__ __forceinline__ unsigned pk4_fp8(float a, float b, float c, float d) {
    int r = __builtin_amdgcn_cvt_pk_fp8_f32(clamp448(a), clamp448(b), 0, false);
    r = __builtin_amdgcn_cvt_pk_fp8_f32(clamp448(c), clamp448(d), r, true);
    return (unsigned)r;
}
__device__ __forceinline__ unsigned pk4_fp8_nc(float a, float b, float c, float d) {
    int r = __builtin_amdgcn_cvt_pk_fp8_f32(a, b, 0, false);
    r = __builtin_amdgcn_cvt_pk_fp8_f32(c, d, r, true);
    return (unsigned)r;
}
__device__ __forceinline__ float bf_lo(unsigned w) { return __uint_as_float(w << 16); }
__device__ __forceinline__ float bf_hi(unsigned w) { return __uint_as_float(w & 0xffff0000u); }
__device__ __forceinline__ float fsigmoid(float z) { return __builtin_amdgcn_rcpf(1.0f + __builtin_amdgcn_exp2f(-z * LOG2E)); }
__device__ __forceinline__ int lane_id() { int l; asm volatile("v_mbcnt_lo_u32_b32 %0, -1, 0\n\tv_mbcnt_hi_u32_b32 %0, -1, %0" : "=v"(l)); return l; }
__device__ __forceinline__ float wave_sum(float v) {
#define WS_DPP(x, ctrl) __builtin_bit_cast(float, __builtin_amdgcn_update_dpp(0, __builtin_bit_cast(int, (x)), (ctrl), 0xf, 0xf, false))
    v += WS_DPP(v, 0xB1);
    v += WS_DPP(v, 0x4E);
    v += WS_DPP(v, 0x124);
    v += WS_DPP(v, 0x128);
#undef WS_DPP
    const float r0 = __builtin_bit_cast(float, __builtin_amdgcn_readlane(__builtin_bit_cast(int, v), 0)), r1 = __builtin_bit_cast(float, __builtin_amdgcn_readlane(__builtin_bit_cast(int, v), 16));
    const float r2 = __builtin_bit_cast(float, __builtin_amdgcn_readlane(__builtin_bit_cast(int, v), 32)), r3 = __builtin_bit_cast(float, __builtin_amdgcn_readlane(__builtin_bit_cast(int, v), 48));
    return (r0 + r1) + (r2 + r3);
}

namespace pg8 {
constexpr int BM = 256, BK = 64, HALF = 128, HTB = HALF * BK * 2, STAGE_BYTES = 8 * HTB;
__device__ __forceinline__ int lds_byte(int r, int c) { const int st = (r >> 4) * 2 + (c >> 5), rr = r & 15, cc = c & 31, ob = rr * 64 + cc * 2; return st * 1024 + (ob ^ (((ob >> 9) & 1) << 5)); }
__device__ __forceinline__ void stage_rc(int b, int& R, int& C) { const int st = b / 1024, sb = b % 1024, swz = sb ^ (((sb >> 9) & 1) << 5); R = (st >> 1) * 16 + swz / 64; C = (st & 1) * 32 + (swz % 64) / 2; }
__device__ __forceinline__ int perm32(int rho) { const int n = rho >> 4, i = rho & 15; return 8 * (i >> 2) + 4 * n + (i & 3); }

struct Unit { int pm, pn, e, nv; };
template <int N> __device__ __forceinline__ void wait_vm() { asm volatile("s_waitcnt vmcnt(%0)" :: "n"(N) : "memory"); }
template <int NFRESH, int NSTEADY> __device__ __forceinline__ void wait_vm_sel(int fresh) {
    asm volatile("s_cmp_eq_u32 %0, 0\n\ts_cbranch_scc1 .Lwvs_a_%=\n\ts_waitcnt vmcnt(%1)\n\ts_branch .Lwvs_b_%=\n.Lwvs_a_%=:\n\ts_waitcnt vmcnt(%2)\n.Lwvs_b_%=:" :: "s"(__builtin_amdgcn_readfirstlane(fresh)), "n"(NFRESH), "n"(NSTEADY) : "scc", "memory"); }

template <class Epi, class Sched, bool ALIGN_EPI, int ESZ>
__device__ __forceinline__ void gemm_phase(LAS unsigned char* lds, const char* Abase, const int K, const Sched& S, const Epi& E) {
    const int wid = __builtin_amdgcn_readfirstlane(threadIdx.x >> 6), lane = lane_id(), tid = wid * 64 + lane, wr = wid >> 2, wc = wid & 3, fr = lane & 15, fq = lane >> 4;
    const int RB = K * ESZ, nt = RB / 128;
    unsigned voffB[2];
#pragma unroll
    for (int i = 0; i < 2; ++i) { int R, C; stage_rc(tid * 16 + i * 8192, R, C); const int Rb = Epi::PERM ? ((R & ~31) + perm32(R & 31)) : R; voffB[i] = (unsigned)(Rb * RB + 2 * C); }
    const size_t kstep = (size_t)(BK * 2);
    const size_t hstep = (size_t)HALF * RB;
    const unsigned ldsw = (unsigned)wid * 1024u;
    const int aoff = lds_byte(wr * 64 + fr, fq * 8), boff = lds_byte(wc * 32 + fr, fq * 8);
#define PG8_SA(b, h) (((b) * 2 + (h)) * HTB)
#define PG8_SB(b, h) ((4 + (b) * 2 + (h)) * HTB)
#define PG8_STAGE(bufoff, gbase, voff) do { _Pragma("unroll") for (int _i = 0; _i < 2; ++_i) \
        __builtin_amdgcn_global_load_lds((const unsigned*)((const char*)(gbase) + (voff)[_i]), (LAS unsigned*)(lds + (bufoff) + ldsw + _i * 8192), 16, 0, 0); } while (0)
#define PG8_LD16(off) (*(const LAS i32x4*)(lds + (off)))
#define PG8_LDA(dst, b, h) do { _Pragma("unroll") for (int m = 0; m < 4; ++m) { const i32x4 _x = PG8_LD16(PG8_SA(b, h) + aoff + m * 2048), _y = PG8_LD16(PG8_SA(b, h) + aoff + m * 2048 + 1024); dst[m] = __builtin_shufflevector(_x, _y, 0, 1, 2, 3, 4, 5, 6, 7); } } while (0)
#define PG8_LDB(dst, b, h) do { _Pragma("unroll") for (int n = 0; n < 2; ++n) { const i32x4 _x = PG8_LD16(PG8_SB(b, h) + boff + n * 2048), _y = PG8_LD16(PG8_SB(b, h) + boff + n * 2048 + 1024); dst[n] = __builtin_shufflevector(_x, _y, 0, 1, 2, 3, 4, 5, 6, 7); } } while (0)
#define PG8_MMA(ai, bj, At, Bt) do { __builtin_amdgcn_s_setprio(1); _Pragma("unroll") for (int m = 0; m < 4; ++m) _Pragma("unroll") for (int n = 0; n < 2; ++n) _Pragma("unroll") for (int k = 0; k < 2; ++k) \
        acc[ai][bj][m][n] = __builtin_amdgcn_mfma_f32_16x16x32_bf16(PG8_HALF(Bt[n], k), PG8_HALF(At[m], k), acc[ai][bj][m][n], 0, 0, 0); __builtin_amdgcn_s_setprio(0); } while (0)
#define PG8_HALF(v, k) __builtin_bit_cast(bf16x8, (k) == 0 ? __builtin_shufflevector((v), (v), 0, 1, 2, 3) : __builtin_shufflevector((v), (v), 4, 5, 6, 7))
#define PG8_MMA8(ai, bj, At, Bt) do { __builtin_amdgcn_s_setprio(1); _Pragma("unroll") for (int m = 0; m < 4; ++m) _Pragma("unroll") for (int n = 0; n < 2; ++n) \
        acc[ai][bj][m][n] = __builtin_amdgcn_mfma_scale_f32_16x16x128_f8f6f4(Bt[n], At[m], acc[ai][bj][m][n], 0, 0, 0, 0, 0, 0);     __builtin_amdgcn_s_setprio(0); } while (0)
#define PG8_MM(ai, bj, At, Bt) do { if constexpr (ESZ == 2) PG8_MMA(ai, bj, At, Bt); else PG8_MMA8(ai, bj, At, Bt); } while (0)
#define PG8_WAIT_V(n) asm volatile("s_waitcnt vmcnt(" #n ")" ::: "memory")
#define PG8_WAIT_L(n) asm volatile("s_waitcnt lgkmcnt(" #n ")" ::: "memory")
#define PG8_BAR __builtin_amdgcn_s_barrier()
#define PG8_SCHED __builtin_amdgcn_sched_barrier(0)
    Unit cur, nxt; int ui = 0;
    if (!S.next(0, cur)) return;
    f32x4 acc[2][2][4][2];
#pragma unroll
    for (int a = 0; a < 2; ++a)
#pragma unroll
        for (int b = 0; b < 2; ++b)
#pragma unroll
            for (int m = 0; m < 4; ++m)
#pragma unroll
                for (int n = 0; n < 2; ++n) acc[a][b][m][n] = (f32x4){0.f, 0.f, 0.f, 0.f};
    i32x8 At[4], B0[2], B1[2];
    unsigned vA0[2], vA1[2];
    LAS u32x4* const vslot = (LAS u32x4*)(lds + STAGE_BYTES) + tid;
    LAS u32x2* const rowtab = (LAS u32x2*)(lds + STAGE_BYTES + 8192);
    LAS f32x4* const biastab = (LAS f32x4*)(lds + STAGE_BYTES + 8192 + 4096);
    if constexpr (Sched::GATHER) {
        if (tid < 256) rowtab[tid] = *S.entry_ptr(cur, tid);
        else if (tid < 320) biastab[tid - 256] = *(const f32x4*)S.bias_ptr(cur, tid - 256);
        __syncthreads();
        S.a_off_tab(rowtab, cur.nv, tid, RB, vA0, vA1);
    } else S.a_off(cur, tid, RB, vA0, vA1);
    const char* cB = S.b_ptr(cur, RB);
    const char* cA = Abase;
    PG8_STAGE(PG8_SB(0, 0), cB, voffB); PG8_STAGE(PG8_SB(0, 1), cB + hstep, voffB); PG8_STAGE(PG8_SA(0, 0), cA, vA0); PG8_STAGE(PG8_SA(0, 1), cA, vA1);
    if (wr == 1) PG8_BAR;
    PG8_WAIT_V(2); PG8_BAR;
    PG8_STAGE(PG8_SB(1, 0), cB + kstep, voffB); PG8_STAGE(PG8_SA(1, 0), cA + kstep, vA0); PG8_STAGE(PG8_SB(1, 1), cB + hstep + kstep, voffB);
    PG8_WAIT_V(6); PG8_BAR;
    for (;;) {
        const bool has_next = S.next(ui + 1, nxt);
        const char* nB = cB;
        const int par = ui & 1;
        if constexpr (Sched::GATHER) {
            if (has_next) nB = S.b_ptr(nxt, RB);
            else *vslot = (u32x4){vA0[0], vA0[1], vA1[0], vA1[1]};
        } else {
            unsigned n0[2] = {vA0[0], vA0[1]}, n1[2] = {vA1[0], vA1[1]};
            if (has_next) { S.a_off(nxt, tid, RB, n0, n1); nB = S.b_ptr(nxt, RB); }
            *vslot = (u32x4){n0[0], n0[1], n1[0], n1[1]};
        }
#pragma clang loop unroll(disable)
        for (int t = 0; t < nt; t += 2) {
            const bool last = (t == nt - 2);
            const int fresh = ((ui > 0) && (t == 0)) ? 1 : 0;
            if constexpr (Sched::GATHER) {
                if (has_next && t == 2) { const int l2 = lane_id();
                    if (wid < 2) __builtin_amdgcn_global_load_lds((const unsigned*)((const char*)S.entry_ptr(nxt, 0) + (wid * 64 + l2) * 16), (LAS unsigned*)((LAS char*)(rowtab + (par ^ 1) * 256) + wid * 1024), 16, 0, 0);
                    if (wid == 4) __builtin_amdgcn_global_load_lds((const unsigned*)S.bias_ptr(nxt, l2), (LAS unsigned*)(biastab + (par ^ 1) * 64), 16, 0, 0); }
                if (has_next && t == 4) { unsigned n0[2], n1[2]; const int t2 = wid * 64 + lane_id(); S.a_off_tab_nowait(rowtab + (par ^ 1) * 256, nxt.nv, t2, RB, n0, n1); ((LAS u32x4*)(lds + STAGE_BYTES))[t2] = (u32x4){n0[0], n0[1], n1[0], n1[1]}; }
            }
            const char* a1 = cA + (size_t)(t + 1) * kstep;
            const char* a2 = last ? cA : cA + (size_t)(t + 2) * kstep; const char* b2 = last ? nB : cB + (size_t)(t + 2) * kstep;
            const char* a3 = a2 + kstep; const char* b3 = b2 + kstep;
            PG8_LDB(B0, 0, 0); PG8_LDB(B1, 0, 1); PG8_SCHED; PG8_LDA(At, 0, 0); PG8_STAGE(PG8_SA(1, 1), a1, vA1);
            if (last) { const u32x4 nv = *vslot; vA0[0] = nv.x; vA0[1] = nv.y; vA1[0] = nv.z; vA1[1] = nv.w; }
            wait_vm_sel<8 + Epi::NSTORE, 8>(fresh); PG8_WAIT_L(0); PG8_BAR; PG8_MM(0, 0, At, B0); PG8_MM(0, 1, At, B1); PG8_BAR; PG8_SCHED;
            PG8_LDA(At, 0, 1); PG8_STAGE(PG8_SB(0, 0), b2, voffB); PG8_STAGE(PG8_SB(0, 1), b2 + hstep, voffB); PG8_STAGE(PG8_SA(0, 0), a2, vA0);
            wait_vm_sel<8 + Epi::NSTORE, 8>(fresh); PG8_WAIT_L(0); PG8_BAR; PG8_MM(1, 0, At, B0); PG8_MM(1, 1, At, B1); PG8_BAR; PG8_SCHED;
            PG8_LDB(B0, 1, 0); PG8_LDB(B1, 1, 1); PG8_SCHED; PG8_LDA(At, 1, 0); PG8_STAGE(PG8_SA(0, 1), a2, vA1);
            PG8_WAIT_V(8); PG8_WAIT_L(0); PG8_BAR; PG8_MM(0, 0, At, B0); PG8_MM(0, 1, At, B1); PG8_BAR; PG8_SCHED;
            PG8_LDA(At, 1, 1); PG8_STAGE(PG8_SB(1, 0), b3, voffB); PG8_STAGE(PG8_SB(1, 1), b3 + hstep, voffB); PG8_STAGE(PG8_SA(1, 0), a3, vA0);
            PG8_WAIT_V(8); PG8_WAIT_L(0); PG8_BAR; PG8_MM(1, 0, At, B0); PG8_MM(1, 1, At, B1); PG8_BAR; PG8_SCHED;
        }
        if constexpr (ALIGN_EPI) { if (wr == 0) PG8_BAR; }
        if constexpr (Sched::GATHER) { int zofs; asm volatile("s_mov_b32 %0, 0" : "=s"(zofs));
            E(acc, cur, wr, wc, fr, fq, rowtab + par * 256 + zofs, biastab + par * 64 + zofs); } else E(acc, cur, wr, wc, fr, fq);
        if (!has_next) break;
#pragma unroll
        for (int a = 0; a < 2; ++a)
#pragma unroll
            for (int b = 0; b < 2; ++b)
#pragma unroll
                for (int m = 0; m < 4; ++m)
#pragma unroll
                    for (int n = 0; n < 2; ++n) acc[a][b][m][n] = (f32x4){0.f, 0.f, 0.f, 0.f};
        cur = nxt; cB = nB; ++ui;
        if constexpr (ALIGN_EPI) { if (wr == 1) PG8_BAR; }
    }
    PG8_WAIT_V(0);
    if constexpr (!ALIGN_EPI) { if (wr == 0) PG8_BAR; }
    PG8_BAR;
#undef PG8_SA
#undef PG8_SB
#undef PG8_STAGE
#undef PG8_LDA
#undef PG8_LDB
#undef PG8_MMA
#undef PG8_MMA8
#undef PG8_MM
#undef PG8_HALF
#undef PG8_LD16
#undef PG8_WAIT_V
#undef PG8_WAIT_L
#undef PG8_BAR
#undef PG8_SCHED
}

struct DenseOrder {
    static constexpr bool GATHER = false;
    int nM, nN, nwg, G, c; const char* Bt;
    __device__ __forceinline__ void init(int M, int N, int G_, int c_, const void* Bt_) { nM = M / BM; nN = N / BM; nwg = nM * nN; G = G_; c = c_; Bt = (const char*)Bt_; }
    __device__ __forceinline__ bool next(int i, Unit& u) const {
        const long L = (long)i * G + c; if (L >= nwg) return false;
        int wgid = (int)L; { const int q = nwg / 8, r = nwg % 8, xcd = wgid % 8, off = wgid / 8; wgid = (xcd < r ? xcd * (q + 1) : r * (q + 1) + (xcd - r) * q) + off; }
        const int nig = 8 * nN, gid = wgid / nig, fm = gid * 8, gsz = (nM - fm) < 8 ? (nM - fm) : 8;
        u.pm = fm + ((wgid % nig) % gsz); u.pn = (wgid % nig) / gsz; u.e = 0; u.nv = 256; return true;
    }
    __device__ __forceinline__ const char* b_ptr(const Unit& u, int RB) const { return Bt + (size_t)u.pn * (256 * (size_t)RB); }
    __device__ __forceinline__ void a_off(const Unit& u, int tid, int RB, unsigned (&v0)[2], unsigned (&v1)[2]) const {
#pragma unroll
        for (int i = 0; i < 2; ++i) { int R, C; stage_rc(tid * 16 + i * 8192, R, C); v0[i] = (unsigned)((u.pm * 256 + R) * RB + 2 * C); v1[i] = (unsigned)((u.pm * 256 + 128 + R) * RB + 2 * C); }
    }
};
struct MoeOrder {
    static constexpr bool GATHER = true;
    const LAS i32x4* ul;
    const u32x2* list;
    const char* Bt; int npn, nrowsB, shiftA;
    const float* bias0; const float* bias1; int bcols;
    __device__ __forceinline__ bool next(int i, Unit& u) const {
        if (i >= 32) return false;
        const i32x4 v = ul[i];
        u.e = __builtin_amdgcn_readfirstlane(v.x); u.pm = __builtin_amdgcn_readfirstlane(v.y); u.pn = __builtin_amdgcn_readfirstlane(v.z); u.nv = __builtin_amdgcn_readfirstlane(v.w);
        return u.nv > 0;
    }
    __device__ __forceinline__ const char* b_ptr(const Unit& u, int RB) const { return Bt + ((size_t)u.e * nrowsB + (size_t)u.pn * 256) * (size_t)RB; }
    __device__ __forceinline__ const u32x2* entry_ptr(const Unit& u, int t) const { return list + (size_t)u.e * LCAP + u.pm * 256 + t; }
    __device__ __forceinline__ const float* bias_ptr(const Unit& u, int i) const {
        return (bcols == 128) ? ((i < 32 ? bias0 : bias1) + (size_t)u.e * D + u.pn * 128 + 4 * (i & 31)) : (bias0 + (size_t)u.e * D + u.pn * 256 + 4 * i); }
    __device__ __forceinline__ void a_off_tab(const LAS u32x2* rt, int nv, int tid, int RB, unsigned (&v0)[2], unsigned (&v1)[2]) const {
#pragma unroll
        for (int i = 0; i < 2; ++i) { int R, C; stage_rc(tid * 16 + i * 8192, R, C);
            const int p0 = (int)rt[R < nv ? R : 0].x >> shiftA, p1 = (int)rt[(128 + R) < nv ? (128 + R) : 0].x >> shiftA;
            v0[i] = (unsigned)(p0 * RB + 2 * C); v1[i] = (unsigned)(p1 * RB + 2 * C); }
    }
    __device__ __forceinline__ void a_off_tab_nowait(const LAS u32x2* rt, int nv, int tid, int RB, unsigned (&v0)[2], unsigned (&v1)[2]) const {
        unsigned pr[4]; int Cc[2];
#pragma unroll
        for (int i = 0; i < 2; ++i) { int R, C; stage_rc(tid * 16 + i * 8192, R, C); Cc[i] = C;
            const unsigned a0 = (unsigned)(uintptr_t)(rt + (R < nv ? R : 0)), a1 = (unsigned)(uintptr_t)(rt + ((128 + R) < nv ? (128 + R) : 0));
            asm volatile("ds_read_b32 %0, %1" : "=v"(pr[2 * i]) : "v"(a0) : "memory"); asm volatile("ds_read_b32 %0, %1" : "=v"(pr[2 * i + 1]) : "v"(a1) : "memory"); }
        asm volatile("s_waitcnt lgkmcnt(0)" : "+v"(pr[0]), "+v"(pr[1]), "+v"(pr[2]), "+v"(pr[3]) :: "memory");
#pragma unroll
        for (int i = 0; i < 2; ++i) { v0[i] = (unsigned)(((int)pr[2 * i] >> shiftA) * RB + 2 * Cc[i]); v1[i] = (unsigned)(((int)pr[2 * i + 1] >> shiftA) * RB + 2 * Cc[i]); }
    }
};

struct EpiSplit {
    static constexpr bool PERM = true; static constexpr int NSTORE = 16;
    bf16_t* O; size_t split_stride; float scale0;
    __device__ __forceinline__ void operator()(const f32x4 (&acc)[2][2][4][2], const Unit& u, int wr, int wc, int fr, int fq) const {
        const int row0 = u.pm * BM + wr * 64 + fr; int colt = u.pn * BM; const int t = colt / 512; bf16_t* base = O + (size_t)t * split_stride; colt -= t * 512;
        const float sc = (t == 0) ? scale0 : 1.f;
        const int col0 = colt + wc * 32 + 8 * fq;
#pragma unroll
        for (int ai = 0; ai < 2; ++ai)
#pragma unroll
            for (int m = 0; m < 4; ++m) { bf16_t* rowp = base + (size_t)(row0 + ai * HALF + m * 16) * 512 + col0;
#pragma unroll
                for (int bj = 0; bj < 2; ++bj) { const f32x4 v0 = acc[ai][bj][m][0] * sc, v1 = acc[ai][bj][m][1] * sc;
                    u32x4 w; w.x = cvt_pk_bf16(v0[0], v0[1]); w.y = cvt_pk_bf16(v0[2], v0[3]); w.z = cvt_pk_bf16(v1[0], v1[1]); w.w = cvt_pk_bf16(v1[2], v1[3]);
                    *(u32x4*)(rowp + bj * HALF) = w; } }
    }
};
struct EpiRes {
    static constexpr bool PERM = true; static constexpr int NSTORE = 0;
    const float* base; bf16_t* out; unsigned char* t8; const float* gain;
    __device__ __forceinline__ void operator()(const f32x4 (&acc)[2][2][4][2], const Unit& u, int wr, int wc, int fr, int fq) const {
        const int row0 = u.pm * BM + wr * 64 + fr, col0 = u.pn * BM + wc * 32 + 8 * fq;
        f32x4 gv[2][2];
#pragma unroll
        for (int bj = 0; bj < 2; ++bj)
#pragma unroll
            for (int n = 0; n < 2; ++n) gv[bj][n] = *(const f32x4*)(gain + col0 + bj * HALF + 4 * n) * SC_T;
#pragma unroll
        for (int ai = 0; ai < 2; ++ai)
#pragma unroll
            for (int m = 0; m < 4; ++m) { const size_t off = (size_t)(row0 + ai * HALF + m * 16) * D + col0;
#pragma unroll
                for (int bj = 0; bj < 2; ++bj) { const f32x4 v0 = __builtin_nontemporal_load((const f32x4*)(base + off + bj * HALF)) + acc[ai][bj][m][0], v1 = __builtin_nontemporal_load((const f32x4*)(base + off + bj * HALF + 4)) + acc[ai][bj][m][1];
                    *(u32x4*)(out + off + bj * HALF) = (u32x4){cvt_pk_bf16(v0[0], v0[1]), cvt_pk_bf16(v0[2], v0[3]), cvt_pk_bf16(v1[0], v1[1]), cvt_pk_bf16(v1[2], v1[3])};
                    const f32x4 s0 = v0 * gv[bj][0], s1 = v1 * gv[bj][1];
                    *(u32x2*)(t8 + off + bj * HALF) = (u32x2){pk4_fp8(s0[0], s0[1], s0[2], s0[3]), pk4_fp8(s1[0], s1[1], s1[2], s1[3])}; } }
    }
};
struct EpiGU {
    static constexpr bool PERM = true; static constexpr int NSTORE = 8;
    unsigned char* hid;
    __device__ __forceinline__ void operator()(const f32x4 (&acc)[2][2][4][2], const Unit& u, int wr, int wc, int fr, int fq, const LAS u32x2* rt, const LAS f32x4* bt) const {
        const int hc = u.pn * 128 + wc * 32 + 8 * fq;
        const f32x4 g0 = bt[8 * wc + 2 * fq], g1 = bt[8 * wc + 2 * fq + 1], u0 = bt[32 + 8 * wc + 2 * fq], u1 = bt[32 + 8 * wc + 2 * fq + 1];
        constexpr float inv = 1.0f / (SC_T * SC_W);
#pragma unroll
        for (int ai = 0; ai < 2; ++ai)
#pragma unroll
            for (int m = 0; m < 4; ++m) { const int r = ai * HALF + wr * 64 + m * 16 + fr;
                const u32x2 en = rt[r]; const float rs = __uint_as_float(en.y) * inv;
                f32x2 h[4];
#pragma unroll
                for (int n = 0; n < 2; ++n)
#pragma unroll
                    for (int x = 0; x < 2; ++x) { const f32x4 ga = acc[ai][0][m][n], ua = acc[ai][1][m][n], gb = n ? g1 : g0, ub = n ? u1 : u0;
                        f32x2 g = (f32x2){ga[2 * x], ga[2 * x + 1]} * rs + (f32x2){gb[2 * x], gb[2 * x + 1]}, up = (f32x2){ua[2 * x], ua[2 * x + 1]} * rs + (f32x2){ub[2 * x], ub[2 * x + 1]};
                        g.x = fminf(g.x, 7.0f); g.y = fminf(g.y, 7.0f); up.x = __builtin_amdgcn_fmed3f(up.x, -7.0f, 7.0f); up.y = __builtin_amdgcn_fmed3f(up.y, -7.0f, 7.0f);
                        const f32x2 z = g * (-1.702f * LOG2E); f32x2 t; t.x = __builtin_amdgcn_exp2f(z.x); t.y = __builtin_amdgcn_exp2f(z.y); t = t + 1.0f;
                        f32x2 sg; sg.x = __builtin_amdgcn_rcpf(t.x); sg.y = __builtin_amdgcn_rcpf(t.y);
                        h[n * 2 + x] = (up * SC_H + SC_H) * (g * sg); }
                u32x2 w; w.x = pk4_fp8_nc(h[0].x, h[0].y, h[1].x, h[1].y); w.y = pk4_fp8_nc(h[2].x, h[2].y, h[3].x, h[3].y);
                *(u32x2*)(hid + (size_t)(r < u.nv ? en.x : (unsigned)NP) * D + hc) = w; }
    }
};
struct EpiDown {
    static constexpr bool PERM = true; static constexpr int NSTORE = 16;
    unsigned char* o;
    __device__ __forceinline__ void operator()(const f32x4 (&acc)[2][2][4][2], const Unit& u, int wr, int wc, int fr, int fq, const LAS u32x2* rt, const LAS f32x4* bt) const {
        constexpr float inv = SC_O / (SC_H * SC_W);
        const int c0 = u.pn * BM + wc * 32 + 8 * fq;
        f32x4 bv[2][2];
#pragma unroll
        for (int bj = 0; bj < 2; ++bj)
#pragma unroll
            for (int n = 0; n < 2; ++n) bv[bj][n] = bt[bj * 32 + wc * 8 + 2 * fq + n] * SC_O;
#pragma unroll
        for (int ai = 0; ai < 2; ++ai)
#pragma unroll
            for (int m = 0; m < 4; ++m) { const int r = ai * HALF + wr * 64 + m * 16 + fr;
                const unsigned p = (r < u.nv) ? rt[r].x : (unsigned)NP; unsigned char* rowp = o + (size_t)p * D + c0;
#pragma unroll
                for (int bj = 0; bj < 2; ++bj) { const f32x4 v0 = acc[ai][bj][m][0] * inv + bv[bj][0], v1 = acc[ai][bj][m][1] * inv + bv[bj][1];
                    *(u32x2*)(rowp + bj * HALF) = (u32x2){pk4_fp8(v0[0], v0[1], v0[2], v0[3]), pk4_fp8(v1[0], v1[1], v1[2], v1[3])}; } }
    }
};
}

#define XB_TMO      128
#define XB_XCNT(j)  (256  + 64 * (j))
#define XB_XSUB(j)  (1280 + 64 * (j))
#define XB_XGEN(j)  (2304 + 64 * (j))
#define XB_TOP      3328
#define XB_TOPGEN   3392
#define XCD_BAR_WORDS 3456
#define XB_SPIN_CAP (1u << 18)
__device__ __forceinline__ unsigned xb_ld(unsigned* p)              { return __hip_atomic_load(p, __ATOMIC_RELAXED, __HIP_MEMORY_SCOPE_AGENT); }
__device__ __forceinline__ unsigned xb_add(unsigned* p, unsigned v) { return __hip_atomic_fetch_add(p, v, __ATOMIC_RELAXED, __HIP_MEMORY_SCOPE_AGENT); }
__device__ __forceinline__ unsigned xb_xcc_id() { return (unsigned)__builtin_amdgcn_s_getreg((3 << 11) | 20) & 0xFu; }
#define XB_SPIN(cond, bar) do { unsigned _sp = 0; while (cond) { __builtin_amdgcn_s_sleep(1); \
    if ((++_sp & 255u) == 0u) { if (xb_ld(&(bar)[XB_TMO])) break; if (_sp > XB_SPIN_CAP) { atomicAdd(&(bar)[XB_TMO], 1u); break; } } } } while (0)
struct XcdBarrier { unsigned* bar; unsigned x; volatile LAS unsigned* st; };
__device__ __forceinline__ XcdBarrier xcd_barrier_post(unsigned* bar, volatile LAS unsigned* st) {
    XcdBarrier b; b.bar = bar; b.x = xb_xcc_id(); b.st = st;
    if (threadIdx.x == 0) (void)xb_add(&bar[XB_XCNT(b.x)], 1u);
    return b;
}
__device__ __forceinline__ void xcd_barrier_complete(unsigned* bar, unsigned x, unsigned& nloc, unsigned& nx) {
    const unsigned G = gridDim.x * gridDim.y * gridDim.z;
    unsigned sum, cnt, mine, sp = 0u;
    for (;;) {
        sum = 0u; cnt = 0u; mine = 0u;
#pragma unroll
        for (unsigned j = 0; j < 16; ++j) { const unsigned c = xb_ld(&bar[XB_XCNT(j)]); sum += c; cnt += (c > 0u) ? 1u : 0u; mine = (j == x) ? c : mine; }
        if (sum == G) break;
        __builtin_amdgcn_s_sleep(1);
        if ((++sp & 255u) == 0u) { if (xb_ld(&bar[XB_TMO])) break; if (sp > XB_SPIN_CAP) { atomicAdd(&bar[XB_TMO], 1u); break; } }
    }
    nloc = mine > 0u ? mine : 1u; nx = cnt > 0u ? cnt : 1u;
}
__device__ __forceinline__ void xcd_barrier(const XcdBarrier& b) {
    asm volatile("s_waitcnt vmcnt(0)" ::: "memory");
    __syncthreads();
    if (threadIdx.x == 0) {
        unsigned* bar = b.bar;
        __builtin_amdgcn_s_waitcnt(0);
        unsigned nloc = b.st[0], nx = b.st[1];
        if (nloc == 0u) { xcd_barrier_complete(bar, b.x, nloc, nx); b.st[0] = nloc; b.st[1] = nx; }
        const unsigned old = xb_add(&bar[XB_XSUB(b.x)], 1u);
        const unsigned gen = old / nloc;
        if (old + 1u == (gen + 1u) * nloc) {
            __builtin_amdgcn_fence(__ATOMIC_RELEASE, "agent");
            asm volatile("s_waitcnt vmcnt(0)" ::: "memory");
            const unsigned og = xb_add(&bar[XB_TOP], 1u);
            const unsigned tg = og / nx;
            if (og + 1u == (tg + 1u) * nx) xb_add(&bar[XB_TOPGEN], 1u);
            else XB_SPIN(xb_ld(&bar[XB_TOPGEN]) == tg, bar);
            __builtin_amdgcn_fence(__ATOMIC_ACQUIRE, "agent");
            xb_add(&bar[XB_XGEN(b.x)], 1u);
            asm volatile("s_waitcnt vmcnt(0)" ::: "memory");
        } else {
            XB_SPIN(xb_ld(&bar[XB_XGEN(b.x)]) == gen, bar);
            __builtin_amdgcn_fence(__ATOMIC_ACQUIRE, "agent");
            asm volatile("s_waitcnt vmcnt(0)" ::: "memory");
        }
    }
    __syncthreads();
}

struct Frame {
    LAS unsigned char* lds;
    gu32* ctl;
    int wave, G, vcu;
};

__device__ __forceinline__ void transpose_item(const float* W, int N, int k0, int n0, bf16_t* dst, int K, LAS float* scr, int lane) {
    f32x4 v[8];
#pragma unroll
    for (int it = 0; it < 8; ++it) v[it] = *(const GAS f32x4*)(W + (size_t)(k0 + it * 8 + (lane >> 3)) * N + n0 + 4 * (lane & 7));
#pragma unroll
    for (int it = 0; it < 8; ++it) { LAS float* s = scr + (it * 8 + (lane >> 3)) * 33 + 4 * (lane & 7); s[0] = v[it].x; s[1] = v[it].y; s[2] = v[it].z; s[3] = v[it].w; }
    LDS_WAIT(); asm volatile("" ::: "memory");
    const int c = lane & 7;
#pragma unroll
    for (int j = 0; j < 4; ++j) { const int n = (lane >> 3) + 8 * j; const LAS float* s = scr + (8 * c) * 33 + n;
        u32x4 o; o.x = pk2(s[0 * 33], s[1 * 33]); o.y = pk2(s[2 * 33], s[3 * 33]); o.z = pk2(s[4 * 33], s[5 * 33]); o.w = pk2(s[6 * 33], s[7 * 33]);
        *(GAS u32x4*)(dst + (size_t)n * K + k0 + 8 * c) = o; }
    LDS_WAIT(); asm volatile("" ::: "memory");
}

struct Args { const float* in[19]; float* out; unsigned char* ws; int ph_lo, ph_hi; };

namespace att {
constexpr int SLOT = 8192, NSL = 5;
constexpr int L_K = 0, L_V = NSL * SLOT, L_WS = 2 * NSL * SLOT, L_BIAS = L_WS + 8 * 256, L_OST = L_BIAS + 1024, L_END = L_OST + 8 * 4096;
__device__ __forceinline__ int crow(int r, int hi) { return (r & 3) + 8 * (r >> 2) + 4 * hi; }
__device__ __forceinline__ s16x4 vtr(const LAS char* p) { typedef short v4i16_t __attribute__((ext_vector_type(4))); return __builtin_bit_cast(s16x4, __builtin_amdgcn_ds_read_tr16_b64_v4i16((LAS v4i16_t*)p)); }

template <bool FIRST>
__device__ __forceinline__ void tile_step(const LAS char* lds, int slot, int s, int lane, int r32, int hi, int qin, const bf16x8 (&qr)[4], const LAS float* tb, LAS float* wsf,
                                          float& m_run, float& l_run, f32x16 (&o)[2], f32x16& negm) {
    constexpr float THR = 8.0f;
    const LAS char* kp = lds + L_K + slot + hi * 1024 + r32 * 16;
    f32x16 p0, p1;
#pragma unroll
    for (int d0 = 0; d0 < 4; ++d0) {
        const bf16x8 b0 = *(const LAS bf16x8*)(kp + d0 * 2048), b1 = *(const LAS bf16x8*)(kp + d0 * 2048 + 512);
        p0 = __builtin_amdgcn_mfma_f32_32x32x16_bf16(b0, qr[d0], d0 == 0 ? negm : p0, 0, 0, 0); p1 = __builtin_amdgcn_mfma_f32_32x32x16_bf16(b1, qr[d0], d0 == 0 ? negm : p1, 0, 0, 0); }
    if (s >= 6) { const int ib = qin + 64 * (8 - s) + 63 - 4 * hi;
#pragma unroll
        for (int r = 0; r < 16; ++r) { const int off = (r & 3) + 8 * (r >> 2); p0[r] += tb[ib - off]; p1[r] += tb[ib - off - 32]; } }
    float mx = __builtin_fmaxf(__builtin_fmaxf(p0[0], p0[1]), p1[0]), my = __builtin_fmaxf(__builtin_fmaxf(p0[2], p0[3]), p1[1]);
    mx = __builtin_fmaxf(__builtin_fmaxf(mx, p1[2]), p1[3]);
#pragma unroll
    for (int r = 4; r < 16; r += 4) { mx = __builtin_fmaxf(__builtin_fmaxf(mx, p0[r]), p0[r + 1]); my = __builtin_fmaxf(__builtin_fmaxf(my, p0[r + 2]), p0[r + 3]);
                                      mx = __builtin_fmaxf(__builtin_fmaxf(mx, p1[r]), p1[r + 1]); my = __builtin_fmaxf(__builtin_fmaxf(my, p1[r + 2]), p1[r + 3]); }
    mx = fmaxf(mx, my); mx = fmaxf(mx, __shfl_xor(mx, 32));
    if constexpr (FIRST) {
        m_run = mx;
#pragma unroll
        for (int r = 0; r < 16; ++r) { p0[r] -= mx; p1[r] -= mx; negm[r] = -mx; }
    } else if (__any(mx > THR)) {
        const float d = mx > THR ? mx : 0.f, f = __builtin_amdgcn_exp2f(-d);
        m_run += d; l_run *= f;
#pragma unroll
        for (int r = 0; r < 16; ++r) { p0[r] -= d; p1[r] -= d; negm[r] = -m_run; }
        if (hi == 0) wsf[r32] = f;
        LDS_WAIT();
#pragma unroll
        for (int r = 0; r < 16; ++r) { const float g = wsf[crow(r, hi)]; o[0][r] *= g; o[1][r] *= g; }
    }
    float rs = 0.f, rs2 = 0.f;
#pragma unroll
    for (int r = 0; r < 16; ++r) { p0[r] = __builtin_amdgcn_exp2f(p0[r]); p1[r] = __builtin_amdgcn_exp2f(p1[r]); rs += p0[r]; rs2 += p1[r]; }
    l_run += rs + rs2;
    u32x4 pw[4];
#pragma unroll
    for (int q = 0; q < 4; ++q) { pw[0][q] = cvt_pk_bf16(p0[2 * q], p0[2 * q + 1]); pw[1][q] = cvt_pk_bf16(p0[8 + 2 * q], p0[8 + 2 * q + 1]);
                                  pw[2][q] = cvt_pk_bf16(p1[2 * q], p1[2 * q + 1]); pw[3][q] = cvt_pk_bf16(p1[8 + 2 * q], p1[8 + 2 * q + 1]); }
    const unsigned vb = (unsigned)(uintptr_t)(lds + L_V + slot + ((lane >> 4) & 1) * 32 + (lane & 3) * 8 + (4 * hi + ((lane & 15) >> 2)) * 64);
#pragma unroll
    for (int d0 = 0; d0 < 2; ++d0) { s16x4 lo[4], hh[4];
#pragma unroll
        for (int ks = 0; ks < 4; ++ks) {
            asm volatile("ds_read_b64_tr_b16 %0, %1 offset:%c2" : "=&v"(lo[ks]) : "v"(vb), "i"(d0 * 4096 + ks * 1024) : "memory");
            asm volatile("ds_read_b64_tr_b16 %0, %1 offset:%c2" : "=&v"(hh[ks]) : "v"(vb), "i"(d0 * 4096 + ks * 1024 + 512) : "memory"); }
        asm volatile("s_waitcnt lgkmcnt(0)" ::: "memory"); __builtin_amdgcn_sched_barrier(0);
#pragma unroll
        for (int ks = 0; ks < 4; ++ks) { const bf16x8 vf = (bf16x8){lo[ks][0], lo[ks][1], lo[ks][2], lo[ks][3], hh[ks][0], hh[ks][1], hh[ks][2], hh[ks][3]};
            o[d0] = __builtin_amdgcn_mfma_f32_32x32x16_bf16(__builtin_bit_cast(bf16x8, pw[ks]), vf, o[d0], 0, 0, 0); } }
}

template <bool EDGE>
__device__ __forceinline__ void unit(const Frame& F, int b, int h, int cg, const bf16_t* Q, const bf16_t* Kb, const bf16_t* Vb, bf16_t* MIX, const float* relb) {
    LAS char* lds = (LAS char*)F.lds;
    const int wid = F.wave, lane = lane_id(), tid = wid * 64 + lane, r32 = lane & 31, hi = lane >> 5;
    const int wp = wid >> 1, half = wid & 1;
    const int c = 4 * cg + wp;
    const long rowbase = (long)b * SEQ;
    LAS float* wsf = (LAS float*)(lds + L_WS) + wid * 64;
    LAS float* tb = (LAS float*)(lds + L_BIAS);
    if (tid < 256) { const int i = tid < NREL ? tid : NREL - 1; tb[tid] = (relb[h * NREL + i] - relb[h * NREL + NREL - 1]) * LOG2E; }
    const bf16_t* Qw = Q + (rowbase + c * 64 + half * 32 + r32) * DA + h * HD;
    bf16x8 qr[4];
#pragma unroll
    for (int d0 = 0; d0 < 4; ++d0) qr[d0] = *(const GAS bf16x8*)(Qw + d0 * 16 + hi * 8);
    const int kc0 = 4 * cg - 8;
    const int krow = tid & 63, kch = tid >> 6;
    const int vrow = tid >> 3, vch = tid & 7;
    const bf16_t* ksrc = Kb + (rowbase + krow) * DA + h * HD + kch * 8;
    const bf16_t* vsrc = Vb + (rowbase + vrow) * DA + h * HD + vch * 8;
    const int kdst = L_K + kch * 1024 + krow * 16, vdst = L_V + (vch >> 2) * 4096 + vrow * 64 + (vch & 3) * 16;
#pragma unroll
    for (int j = 0; j < 4; ++j) { const int kc = kc0 + j;
        if (!EDGE || kc >= 0) { const u32x4 kv = *(const GAS u32x4*)(ksrc + (long)kc * 64 * DA); const u32x4 vv = *(const GAS u32x4*)(vsrc + (long)kc * 64 * DA);
            *(LAS u32x4*)(lds + kdst + j * SLOT) = kv; *(LAS u32x4*)(lds + vdst + j * SLOT) = vv; } }
    float m_run = 0.f, l_run = 0.f; f32x16 o[2]; o[0] = f32x16{}; o[1] = f32x16{}; f32x16 negm = f32x16{};
    const int qin = half * 32 + r32;
    if constexpr (!EDGE) {
        __syncthreads();
        { u32x4 kv = *(const GAS u32x4*)(ksrc + (long)(kc0 + 4) * 64 * DA), vv = *(const GAS u32x4*)(vsrc + (long)(kc0 + 4) * 64 * DA);
          tile_step<true>(lds, (wp % NSL) * SLOT, 0, lane, r32, hi, qin, qr, tb, wsf, m_run, l_run, o, negm);
          *(LAS u32x4*)(lds + kdst + 4 * SLOT) = kv; *(LAS u32x4*)(lds + vdst + 4 * SLOT) = vv; }
#pragma unroll 1
        for (int s = 1; s < 9; ++s) {
            __syncthreads();
            const int jn = s + 4; const bool ldn = jn < 12;
            u32x4 kv = (u32x4){0u, 0u, 0u, 0u}, vv = (u32x4){0u, 0u, 0u, 0u};
            if (ldn) { kv = *(const GAS u32x4*)(ksrc + (long)(kc0 + jn) * 64 * DA); vv = *(const GAS u32x4*)(vsrc + (long)(kc0 + jn) * 64 * DA); }
            tile_step<false>(lds, ((wp + s) % NSL) * SLOT, s, lane, r32, hi, qin, qr, tb, wsf, m_run, l_run, o, negm);
            if (ldn) { const int sl = (jn % NSL) * SLOT; *(LAS u32x4*)(lds + kdst + sl) = kv; *(LAS u32x4*)(lds + vdst + sl) = vv; }
        }
    } else {
        bool first = true;
#pragma unroll 1
        for (int s = 0; s < 9; ++s) {
            __syncthreads();
            const int jn = s + 4, kcn = kc0 + jn; const bool ldn = (jn < 12) && (kcn >= 0);
            u32x4 kv = (u32x4){0u, 0u, 0u, 0u}, vv = (u32x4){0u, 0u, 0u, 0u};
            if (ldn) { kv = *(const GAS u32x4*)(ksrc + (long)kcn * 64 * DA); vv = *(const GAS u32x4*)(vsrc + (long)kcn * 64 * DA); }
            const int j = wp + s, kc = kc0 + j;
            if (kc >= 0) { if (first) { tile_step<true>(lds, (j % NSL) * SLOT, s, lane, r32, hi, qin, qr, tb, wsf, m_run, l_run, o, negm); first = false; }
                           else tile_step<false>(lds, (j % NSL) * SLOT, s, lane, r32, hi, qin, qr, tb, wsf, m_run, l_run, o, negm); }
            if (ldn) { const int sl = (jn % NSL) * SLOT; *(LAS u32x4*)(lds + kdst + sl) = kv; *(LAS u32x4*)(lds + vdst + sl) = vv; }
        }
    }
    l_run += __shfl_xor(l_run, 32);
    if (hi == 0) wsf[32 + r32] = l_run;
    LDS_WAIT();
    LAS bf16_t* stg = (LAS bf16_t*)(lds + L_OST) + wid * 2048;
#pragma unroll
    for (int r = 0; r < 16; ++r) { const int orow = crow(r, hi); const float rl = __builtin_amdgcn_rcpf(wsf[32 + orow]);
#pragma unroll
        for (int d0 = 0; d0 < 2; ++d0) stg[orow * 64 + d0 * 32 + r32] = (bf16_t)f2bf(o[d0][r] * rl); }
    LDS_WAIT();
    bf16_t* Ow = MIX + (rowbase + c * 64 + half * 32) * D + h * HD;
#pragma unroll
    for (int i = 0; i < 4; ++i) { const int row = i * 8 + (lane >> 3), ch = lane & 7; const u32x4 v = *(const LAS u32x4*)(stg + row * 64 + ch * 8); *(GAS u32x4*)(Ow + (long)row * D + ch * 8) = v; }
    __syncthreads();
}
}

namespace cv {
constexpr int TT = 32, UR = TT + CW - 1;
constexpr int L_U = 0, L_Y = UR * DC * 2  , L_END = L_Y + TT * DC * 4;
__device__ __forceinline__ void unit(const Frame& F, int b, int tt, const bf16_t* Ab, const bf16_t* Gb, bf16_t* MIX, const float* dw_w, const float* dw_b, const float* ln_g, const float* ln_b) {
    LAS char* lds = (LAS char*)F.lds;
    const int wid = F.wave, lane = lane_id(), tid = wid * 64 + lane;
    const int t0 = tt * TT; const long rowbase = (long)b * SEQ;
    for (int idx = tid; idx < UR * 64; idx += 512) { const int r = idx >> 6, c8 = idx & 63; const int tok = t0 - (CW - 1) + r;
        u32x4 w = (u32x4){0u, 0u, 0u, 0u};
        if (tok >= 0) { const u32x4 av = *(const GAS u32x4*)(Ab + (rowbase + tok) * DC + c8 * 8), gv = *(const GAS u32x4*)(Gb + (rowbase + tok) * DC + c8 * 8);
#pragma unroll
            for (int q = 0; q < 4; ++q) { const float u0 = bf_lo(av[q]) * fsigmoid(bf_lo(gv[q])), u1 = bf_hi(av[q]) * fsigmoid(bf_hi(gv[q])); w[q] = cvt_pk_bf16(u0, u1); } }
        *(LAS u32x4*)(lds + L_U + r * (DC * 2) + c8 * 16) = w; }
    __syncthreads();
    { const int cp = tid & 255, th = tid >> 8;
      f32x2 w[CW];
#pragma unroll
      for (int j = 0; j < CW; ++j) w[j] = *(const GAS f32x2*)(dw_w + j * DC + 2 * cp);
      const f32x2 bias = *(const GAS f32x2*)(dw_b + 2 * cp);
#pragma unroll 1
      for (int blk = 0; blk < 2; ++blk) { const int tbk = th * 16 + blk * 8;
          f32x2 acc[8];
#pragma unroll
          for (int k = 0; k < 8; ++k) acc[k] = bias;
#pragma unroll
          for (int i = 0; i < 8 + CW - 1; ++i) { const unsigned uw = *(const LAS unsigned*)(lds + L_U + (tbk + i) * (DC * 2) + cp * 4); const f32x2 uv = (f32x2){bf_lo(uw), bf_hi(uw)};
#pragma unroll
              for (int k = 0; k < 8; ++k) { const int j = i - k; if (j >= 0 && j < CW) acc[k] += uv * w[j]; } }
#pragma unroll
          for (int k = 0; k < 8; ++k) *(LAS f32x2*)(lds + L_Y + (tbk + k) * (DC * 4) + cp * 8) = acc[k]; } }
    __syncthreads();
    { const f32x4 g0 = *(const GAS f32x4*)(ln_g + 8 * lane), g1 = *(const GAS f32x4*)(ln_g + 8 * lane + 4), b0 = *(const GAS f32x4*)(ln_b + 8 * lane), b1 = *(const GAS f32x4*)(ln_b + 8 * lane + 4);
#pragma unroll
      for (int q = 0; q < 4; ++q) { const int t = wid * 4 + q;
          f32x4 y0 = *(const LAS f32x4*)(lds + L_Y + t * (DC * 4) + lane * 32), y1 = *(const LAS f32x4*)(lds + L_Y + t * (DC * 4) + lane * 32 + 16);
          const float mean = wave_sum((y0.x + y0.y) + (y0.z + y0.w) + (y1.x + y1.y) + (y1.z + y1.w)) * (1.f / DC);
          y0 = y0 - mean; y1 = y1 - mean;
          const float var = wave_sum((y0.x * y0.x + y0.y * y0.y) + (y0.z * y0.z + y0.w * y0.w) + (y1.x * y1.x + y1.y * y1.y) + (y1.z * y1.z + y1.w * y1.w)) * (1.f / DC);
          const float rstd = 1.0f / sqrtf(var + LN_EPS);
          y0 = y0 * rstd * g0 + b0; y1 = y1 * rstd * g1 + b1;
          float z[8] = {y0.x, y0.y, y0.z, y0.w, y1.x, y1.y, y1.z, y1.w};
#pragma unroll
          for (int i = 0; i < 8; ++i) z[i] = z[i] * fsigmoid(z[i]);
          u32x4 w; w.x = cvt_pk_bf16(z[0], z[1]); w.y = cvt_pk_bf16(z[2], z[3]); w.z = cvt_pk_bf16(z[4], z[5]); w.w = cvt_pk_bf16(z[6], z[7]);
          *(GAS u32x4*)(MIX + (rowbase + t0 + t) * D + DA + 8 * lane) = w; } }
    __syncthreads();
}
}

__global__ void __launch_bounds__(NWAVES * 64, 2) hymba_fwd(Args args) {
    extern __shared__ __attribute__((aligned(16))) unsigned char lds_raw[];
    Frame F;
    F.lds = (LAS unsigned char*)lds_raw;
    F.wave = __builtin_amdgcn_readfirstlane(threadIdx.x >> 6);
    F.G = gridDim.x; { const int bx = blockIdx.x; F.vcu = (F.G % 8 == 0) ? (bx % 8) * (F.G / 8) + bx / 8 : bx; }
    unsigned char* ws = args.ws;
    F.ctl = (gu32*)(ws + WS_CTL);
    volatile LAS unsigned* MISC = (volatile LAS unsigned*)(F.lds + LDSCTL_OFF);
    for (int u = threadIdx.x; u < (LDS_BYTES - LDSCTL_OFF) / 4; u += NWAVES * 64) ((LAS unsigned*)(F.lds + LDSCTL_OFF))[u] = 0u;
    __syncthreads();
    const int lo = args.ph_lo, hi = args.ph_hi;
    const bool multi = (hi - lo) > 1;
    XcdBarrier bar; bar.bar = (unsigned*)(F.ctl + CW_BAR); bar.x = 0; bar.st = nullptr;
    if (multi) bar = xcd_barrier_post((unsigned*)(F.ctl + CW_BAR), MISC + 8);
#define IN(k) (lo <= (k) && (k) < hi)
#define BOTH(k) (IN(k) && IN((k) + 1))
#define GRID_BAR() xcd_barrier(bar)

    const float* x = args.in[0];
    bf16_t* Win_t = (bf16_t*)(ws + WS_WIN); bf16_t* Wout_t = (bf16_t*)(ws + WS_WOUT); unsigned char* Wgu8 = ws + WS_WGU; unsigned char* Wd8 = ws + WS_WD;
    bf16_t* X1 = (bf16_t*)(ws + WS_X1); bf16_t* XN = (bf16_t*)(ws + WS_XN);
    bf16_t* Qb = (bf16_t*)(ws + WS_Q); bf16_t* Kb = (bf16_t*)(ws + WS_K); bf16_t* Vb = (bf16_t*)(ws + WS_V); bf16_t* Ab = (bf16_t*)(ws + WS_A); bf16_t* Gb = (bf16_t*)(ws + WS_G);
    bf16_t* MIX = (bf16_t*)(ws + WS_MIX); unsigned char* HID8 = ws + WS_HID; unsigned char* T8 = ws + WS_XN; unsigned char* OB = ws + WS_O;
    u32x2* LIST = (u32x2*)(ws + WS_LIST); float* TOPW = (float*)(ws + WS_TOPW); bf16_t* RWB = (bf16_t*)(ws + WS_RWT);
    const int gw = F.vcu * NWAVES + F.wave, NGW = F.G * NWAVES;

    if (IN(0)) {
        const int lane = lane_id(), tid = F.wave * 64 + lane;
        LAS float* scr = (LAS float*)(F.lds + F.wave * 16896);
        constexpr int I_IN = (D / 64) * (NIN / 32), I_OUT = (D / 64) * (D / 32), I_EXP = (D / 64) * (D / 32);
        for (int it = gw; it < I_IN + I_OUT; it += NGW) {
            int r = it;
            if (r < I_IN) { const int kb = r / (NIN / 32), nb = r % (NIN / 32); transpose_item(args.in[2], NIN, kb * 64, nb * 32, Win_t + (size_t)(nb * 32) * D, D, scr, lane); continue; } r -= I_IN;
            const int kb = r / (D / 32), nb = r % (D / 32); transpose_item(args.in[8], D, kb * 64, nb * 32, Wout_t + (size_t)(nb * 32) * D, D, scr, lane);
        }
        { const GAS f32x4* gp = (const GAS f32x4*)args.in[1] + lane; f32x4 g[4];
#pragma unroll
          for (int j = 0; j < 4; ++j) g[j] = gp[64 * j];
          for (int m = gw; m < T; m += 2 * NGW) { const int m2 = m + NGW;
              const GAS f32x4* xr = (const GAS f32x4*)(x + (size_t)m * D) + lane; const GAS f32x4* xr2 = (const GAS f32x4*)(x + (size_t)(m2 < T ? m2 : m) * D) + lane; f32x4 v[4], v2[4]; float s = 0.f, s2 = 0.f;
#pragma unroll
              for (int j = 0; j < 4; ++j) { v[j] = __builtin_nontemporal_load(xr + 64 * j); v2[j] = __builtin_nontemporal_load(xr2 + 64 * j); }
#pragma unroll
              for (int j = 0; j < 4; ++j) { s += (v[j].x * v[j].x + v[j].y * v[j].y) + (v[j].z * v[j].z + v[j].w * v[j].w); s2 += (v2[j].x * v2[j].x + v2[j].y * v2[j].y) + (v2[j].z * v2[j].z + v2[j].w * v2[j].w); }
              const float r = 1.0f / sqrtf(wave_sum(s) * (1.f / D) + RMS_EPS), r2 = 1.0f / sqrtf(wave_sum(s2) * (1.f / D) + RMS_EPS);
              GAS u32x2* o8 = (GAS u32x2*)(XN + (size_t)m * D) + lane;
#pragma unroll
              for (int j = 0; j < 4; ++j) { const f32x4 y = v[j] * r * g[j]; o8[64 * j] = (u32x2){pk2(y.x, y.y), pk2(y.z, y.w)}; }
              if (m2 < T) { GAS u32x2* o82 = (GAS u32x2*)(XN + (size_t)m2 * D) + lane;
#pragma unroll
                  for (int j = 0; j < 4; ++j) { const f32x4 y = v2[j] * r2 * g[j]; o82[64 * j] = (u32x2){pk2(y.x, y.y), pk2(y.z, y.w)}; } } } }
        for (int i = blockIdx.x * 512 + tid; i < NE * D; i += F.G * 512) { const int e = i / D, k = i % D; const float v = args.in[10][k * NE + e] * args.in[9][k];
            const unsigned h = f2bf(v); RWB[i] = (bf16_t)h; RWB[NE * D + i] = (bf16_t)f2bf(v - __uint_as_float(h << 16)); }
        if (BOTH(0)) GRID_BAR();
    }

    if (IN(1)) {
        const int xg = (int)(blockIdx.x % 8), jb = (int)(blockIdx.x / 8), half = F.G / 16;
        if (jb < half) {
            pg8::DenseOrder S; S.init(T, NIN, F.G / 2, xg + 8 * jb, Win_t);
            pg8::EpiSplit E{Qb, (size_t)(WS_K - WS_Q) / 2, QSCALE};
            pg8::gemm_phase<pg8::EpiSplit, pg8::DenseOrder, true, 2>(F.lds, (const char*)XN, D, S, E);
        } else {
            const int cgw = (xg * half + (jb - half)) * NWAVES + F.wave, CNGW = (F.G / 2) * NWAVES;
        { constexpr int NIT = NE * 3 * 8 * 32;
          LAS unsigned* tile = (LAS unsigned*)(F.lds + F.wave * 4352); const int lane = lane_id();
          f32x4 v[16], w[16];
          auto src_of = [&](int r) -> const float* { const int em = r >> 8, ri = r & 255, e = em / 3, mat = em % 3, kb = ri >> 5, nb = ri & 31;
              const float* base = (mat == 0 ? args.in[12] : mat == 1 ? args.in[14] : args.in[16]) + (size_t)e * D * D;
              return base + (size_t)(kb * 128 + (lane >> 3)) * D + nb * 32 + 4 * (lane & 7); };
          int it = cgw;
          if (it < NIT) { const float* sp = src_of(it);
#pragma unroll
              for (int q = 0; q < 16; ++q) v[q] = __builtin_nontemporal_load((const GAS f32x4*)(sp + (size_t)q * 8 * D)); }
#pragma unroll 1
          for (; it < NIT; it += CNGW) {
              const int nx = it + CNGW;
              if (nx < NIT) { const float* sp = src_of(nx);
#pragma unroll
                  for (int q = 0; q < 16; ++q) w[q] = __builtin_nontemporal_load((const GAS f32x4*)(sp + (size_t)q * 8 * D)); }
              const int em = it >> 8, ri = it & 255, e = em / 3, mat = em % 3, kb = ri >> 5, nb = ri & 31, n0 = nb * 32, k0 = kb * 128;
              unsigned char* dst = (mat == 2) ? Wd8 + ((size_t)e * D + n0) * D : Wgu8 + ((size_t)e * 2048 + (size_t)(n0 >> 7) * 256 + (n0 & 127) + (mat == 1 ? 128 : 0)) * D;
#pragma unroll
              for (int q = 0; q < 16; ++q) tile[(lane & 7) * 132 + q * 8 + (lane >> 3)] = pk4_fp8(v[q].x * SC_W, v[q].y * SC_W, v[q].z * SC_W, v[q].w * SC_W);
              LDS_WAIT(); asm volatile("" ::: "memory");
              const int nq = lane >> 3, c = lane & 7;
              u32x4 r[4];
#pragma unroll
              for (int i = 0; i < 4; ++i) r[i] = *(const LAS u32x4*)(tile + nq * 132 + 16 * c + 4 * i);
              LDS_WAIT(); asm volatile("" ::: "memory");
              u32x4 o[4];
#pragma unroll
              for (int i = 0; i < 4; ++i) {
                  const unsigned x01 = __builtin_amdgcn_perm(r[i].y, r[i].x, 0x05010400u), y01 = __builtin_amdgcn_perm(r[i].y, r[i].x, 0x07030602u);
                  const unsigned x23 = __builtin_amdgcn_perm(r[i].w, r[i].z, 0x05010400u), y23 = __builtin_amdgcn_perm(r[i].w, r[i].z, 0x07030602u);
                  o[0][i] = __builtin_amdgcn_perm(x23, x01, 0x05040100u); o[1][i] = __builtin_amdgcn_perm(x23, x01, 0x07060302u);
                  o[2][i] = __builtin_amdgcn_perm(y23, y01, 0x05040100u); o[3][i] = __builtin_amdgcn_perm(y23, y01, 0x07060302u); }
#pragma unroll
              for (int j = 0; j < 4; ++j) __builtin_nontemporal_store(o[j], (GAS u32x4*)(dst + (size_t)(4 * nq + j) * D + k0 + 16 * c));
#pragma unroll
              for (int q = 0; q < 16; ++q) v[q] = w[q];
          } }
        }
        if (BOTH(1)) GRID_BAR();
    }

    if (IN(2)) {
        for (int u = blockIdx.x; u < 2 * NH * 32; u += F.G) { const int cg = u & 31, h = (u >> 5) & 7, b = u >> 8;
            if (cg < 2) att::unit<true>(F, b, h, cg, Qb, Kb, Vb, MIX, args.in[7]); else att::unit<false>(F, b, h, cg, Qb, Kb, Vb, MIX, args.in[7]); }
        for (int u = blockIdx.x; u < T / cv::TT; u += F.G) { const int b = u / (SEQ / cv::TT), tt = u % (SEQ / cv::TT);
            cv::unit(F, b, tt, Ab, Gb, MIX, args.in[3], args.in[4], args.in[5], args.in[6]); }
        if (BOTH(2)) GRID_BAR();
    }

    if (IN(3)) {
        pg8::DenseOrder S; S.init(T, D, F.G, (int)blockIdx.x, Wout_t);
        pg8::EpiRes E{x, X1, T8, args.in[9]};
        pg8::gemm_phase<pg8::EpiRes, pg8::DenseOrder, false, 2>(F.lds, (const char*)MIX, D, S, E);
        if (BOTH(3)) {
            const int tid = F.wave * 64 + lane_id();
            for (int i = tid; i < 8192; i += 512) { const int row = i >> 7, ch = i & 127; const u32x4 v = ((const GAS u32x4*)RWB)[i];
                *(LAS u32x4*)(F.lds + row * 2048 + (((ch & ~15) | ((ch ^ row) & 15)) * 16)) = v; }
            GRID_BAR(); }
    }

    if (IN(4)) {
        const int lane = lane_id(), tid = F.wave * 64 + lane, fr = lane & 15, fq = lane >> 4;
        LAS unsigned char* rwl = F.lds;
        LAS int* hist = (LAS int*)(F.lds + XTRA_OFF);
        LAS int* baseE = hist + 32;
        LAS int* selE = baseE + 32;
        LAS int* selP = selE + 256;
        LAS float* selR = (LAS float*)(selP + 256);
        LAS float* part = selR + 64;
        const int w4 = F.wave & 3, kh = F.wave >> 2;
        const float rb0 = args.in[11][fr], rb1 = args.in[11][16 + fr];
        bool filled = false;
#pragma unroll 1
        for (int tb = blockIdx.x * 4; tb < T / 16; tb += F.G * 4) {
            const int task = tb + w4;
            const bf16_t* xrow = X1 + (size_t)(task * 16 + fr) * D + kh * 512 + 8 * fq;
            u32x4 xv[16];
#pragma unroll
            for (int ks = 0; ks < 16; ++ks) xv[ks] = *(const GAS u32x4*)(xrow + 32 * ks);
            if (!filled && !BOTH(3)) {
                for (int i = tid; i < 8192; i += 512) { const int row = i >> 7, ch = i & 127; const u32x4 v = ((const GAS u32x4*)RWB)[i];
                    *(LAS u32x4*)(rwl + row * 2048 + (((ch & ~15) | ((ch ^ row) & 15)) * 16)) = v; } }
            filled = true;
            if (tid < 32) hist[tid] = 0;
            __syncthreads();
            f32x4 acc0 = (f32x4){0.f, 0.f, 0.f, 0.f}, acc1 = acc0; float ss = 0.f;
#pragma unroll
            for (int ks = 0; ks < 16; ++ks) {
                const u32x4 hi = xv[ks];
                { const float a0 = bf_lo(hi.x), a1 = bf_hi(hi.x), a2 = bf_lo(hi.y), a3 = bf_hi(hi.y), a4 = bf_lo(hi.z), a5 = bf_hi(hi.z), a6 = bf_lo(hi.w), a7 = bf_hi(hi.w);
                  ss += (a0 * a0 + a1 * a1) + (a2 * a2 + a3 * a3) + (a4 * a4 + a5 * a5) + (a6 * a6 + a7 * a7); }
                const bf16x8 ah = __builtin_bit_cast(bf16x8, hi);
                const int ch = kh * 64 + 4 * ks + fq;
                const int o0 = fr * 2048 + (((ch & ~15) | ((ch ^ fr) & 15)) * 16), o1 = o0 + 16 * 2048;
                const bf16x8 bh0 = *(const LAS bf16x8*)(rwl + o0), bl0 = *(const LAS bf16x8*)(rwl + 65536 + o0), bh1 = *(const LAS bf16x8*)(rwl + o1), bl1 = *(const LAS bf16x8*)(rwl + 65536 + o1);
                acc0 = __builtin_amdgcn_mfma_f32_16x16x32_bf16(ah, bh0, acc0, 0, 0, 0); acc1 = __builtin_amdgcn_mfma_f32_16x16x32_bf16(ah, bh1, acc1, 0, 0, 0);
                acc0 = __builtin_amdgcn_mfma_f32_16x16x32_bf16(ah, bl0, acc0, 0, 0, 0); acc1 = __builtin_amdgcn_mfma_f32_16x16x32_bf16(ah, bl1, acc1, 0, 0, 0);
            }
            ss += __shfl_xor(ss, 16); ss += __shfl_xor(ss, 32);
            if (kh == 1) { LAS float* pp = part + w4 * 576 + lane;
#pragma unroll
                for (int q = 0; q < 4; ++q) { pp[64 * q] = acc0[q]; pp[64 * (4 + q)] = acc1[q]; }
                pp[64 * 8] = ss; }
            __syncthreads();
            if (kh == 0) { const LAS float* pp = part + w4 * 576 + lane;
#pragma unroll
                for (int q = 0; q < 4; ++q) { acc0[q] += pp[64 * q]; acc1[q] += pp[64 * (4 + q)]; }
                ss += pp[64 * 8];
                const float rrow = 1.0f / sqrtf(ss * (1.f / D) + RMS_EPS);
                float c0[4], c1[4], rt[4], tv[4][4]; int te[4][4];
#pragma unroll
                for (int q = 0; q < 4; ++q) { rt[q] = __shfl(rrow, 4 * fq + q); c0[q] = acc0[q] * rt[q] + rb0; c1[q] = acc1[q] * rt[q] + rb1; }
#pragma unroll
                for (int k = 0; k < 4; ++k) { float v[4]; int e[4];
#pragma unroll
                    for (int q = 0; q < 4; ++q) { v[q] = c0[q]; e[q] = fr; if (c1[q] > c0[q]) { v[q] = c1[q]; e[q] = 16 + fr; } }
#define RT_STEP(CTRL) _Pragma("unroll") for (int q = 0; q < 4; ++q) { const float v2 = __builtin_bit_cast(float, __builtin_amdgcn_update_dpp(0, __builtin_bit_cast(int, v[q]), CTRL, 0xf, 0xf, false)); \
                        const int e2 = __builtin_amdgcn_update_dpp(0, e[q], CTRL, 0xf, 0xf, false); if (v2 > v[q] || (v2 == v[q] && e2 < e[q])) { v[q] = v2; e[q] = e2; } }
                    RT_STEP(0x128) RT_STEP(0x124) RT_STEP(0x122) RT_STEP(0x121)
#undef RT_STEP
#pragma unroll
                    for (int q = 0; q < 4; ++q) { tv[q][k] = v[q]; te[q][k] = e[q]; if (e[q] == fr) c0[q] = -INFINITY; if (e[q] == 16 + fr) c1[q] = -INFINITY; } }
#pragma unroll
                for (int q = 0; q < 4; ++q) {
                    const float e1 = __expf(tv[q][1] - tv[q][0]), e2 = __expf(tv[q][2] - tv[q][0]), e3 = __expf(tv[q][3] - tv[q][0]); const float inv = 1.0f / (1.0f + e1 + e2 + e3);
                    const int tl = w4 * 16 + 4 * fq + q, tok = task * 16 + 4 * fq + q;
                    if (fr == 0) { *(GAS f32x4*)(TOPW + (size_t)tok * 4) = (f32x4){inv, e1 * inv, e2 * inv, e3 * inv}; selR[tl] = rt[q]; }
                    if (fr < 4) { const int em = fr == 0 ? te[q][0] : fr == 1 ? te[q][1] : fr == 2 ? te[q][2] : te[q][3];
                        selE[tl * 4 + fr] = em; selP[tl * 4 + fr] = __hip_atomic_fetch_add(&hist[em], 1, __ATOMIC_RELAXED, __HIP_MEMORY_SCOPE_WORKGROUP); }
                } }
            __syncthreads();
            if (tid < 32) baseE[tid] = (int)__hip_atomic_fetch_add(F.ctl + CW_CNT + 64 * tid, (unsigned)hist[tid], RLX_AGENT);
            __syncthreads();
            if (tid < 256) { const int e = selE[tid]; LIST[(size_t)e * LCAP + baseE[e] + selP[tid]] = (u32x2){(unsigned)((tb * 16 + (tid >> 2)) * 4 + (tid & 3)), __float_as_uint(selR[tid >> 2])}; }
            __syncthreads();
        }
        if (BOTH(4)) GRID_BAR();
    }

    LAS int* tstart = (LAS int*)(F.lds + XTRA_OFF + 14336);
    LAS int* ecnt = tstart + 64;
    LAS i32x4* ulist = (LAS i32x4*)(tstart + 128);
    if (IN(5) || IN(6)) {
        const int tid = F.wave * 64 + lane_id();
        __syncthreads();
        if (tid < 32) ecnt[tid] = (int)__hip_atomic_load(F.ctl + CW_CNT + 64 * tid, RLX_AGENT);
        __syncthreads();
        if (tid == 0) { int s = 0; for (int e = 0; e < NE; ++e) { tstart[e] = s; s += (ecnt[e] + 255) >> 8; } tstart[NE] = s; }
        __syncthreads();
        if (tid < 64) {
            const int which = tid >> 5, i = tid & 31, npn = which ? 4 : 8, nper = F.G / 8, xg = (int)(blockIdx.x % 8), j = (int)(blockIdx.x / 8);
            const int R = (nper / npn) * (i * 8 + xg) + j / npn, Rtot = tstart[NE];
            int e = 0; for (int q = 1; q < NE; ++q) e += (tstart[q] <= R) ? 1 : 0;
            i32x4 u = (i32x4){0, 0, 0, 0};
            if (R < Rtot) { const int pm = R - tstart[e], rem = ecnt[e] - pm * 256; u = (i32x4){e, pm, j % npn, rem < 256 ? rem : 256}; }
            ulist[which * 32 + i] = u; }
        __syncthreads();
    }

    if (IN(5)) {
        pg8::MoeOrder S{ulist, LIST, (const char*)Wgu8, 8, 2048, 2, args.in[13], args.in[15], 128};
        pg8::EpiGU E{HID8};
        pg8::gemm_phase<pg8::EpiGU, pg8::MoeOrder, true, 1>(F.lds, (const char*)T8, D, S, E);
        if (BOTH(5)) GRID_BAR();
    }

    if (IN(6)) {
        pg8::MoeOrder S{ulist + 32, LIST, (const char*)Wd8, 4, 1024, 0, args.in[17], args.in[17], 256};
        pg8::EpiDown E{OB};
        pg8::gemm_phase<pg8::EpiDown, pg8::MoeOrder, true, 1>(F.lds, (const char*)HID8, D, S, E);
        if (BOTH(6)) GRID_BAR();
    }

    if (IN(7)) {
        const int lane = lane_id();
        const GAS f32x4* gp = (const GAS f32x4*)args.in[18] + lane; f32x4 g[4];
#pragma unroll
        for (int j = 0; j < 4; ++j) g[j] = gp[64 * j];
        unsigned bad = __hip_atomic_load(F.ctl + CW_BAR + XB_TMO, RLX_AGENT);
        for (int m = gw; m < T; m += NGW) {
            const GAS u32x2* xr = (const GAS u32x2*)(X1 + (size_t)m * D) + lane; f32x4 v[4];
#pragma unroll
            for (int j = 0; j < 4; ++j) { const u32x2 w = __builtin_nontemporal_load(xr + 64 * j); v[j] = (f32x4){bf_lo(w.x), bf_hi(w.x), bf_lo(w.y), bf_hi(w.y)}; }
            const f32x4 tw = *(const GAS f32x4*)(TOPW + (size_t)m * 4);
#pragma unroll
            for (int k = 0; k < 4; ++k) { const GAS unsigned* orow = (const GAS unsigned*)(OB + ((size_t)m * 4 + k) * D) + lane; const float wk = tw[k] * (1.0f / SC_O);
#pragma unroll
                for (int j = 0; j < 4; ++j) { const unsigned w = __builtin_nontemporal_load(orow + 64 * j); const f32x2 lo = __builtin_amdgcn_cvt_pk_f32_fp8((int)w, false), hi = __builtin_amdgcn_cvt_pk_f32_fp8((int)w, true);
                    v[j].x += wk * lo.x; v[j].y += wk * lo.y; v[j].z += wk * hi.x; v[j].w += wk * hi.y; } }
            float s = 0.f;
#pragma unroll
            for (int j = 0; j < 4; ++j) s += (v[j].x * v[j].x + v[j].y * v[j].y) + (v[j].z * v[j].z + v[j].w * v[j].w);
            float r = 1.0f / sqrtf(wave_sum(s) * (1.f / D) + RMS_EPS);
            if (bad) r = __builtin_nanf("");
            GAS f32x4* o = (GAS f32x4*)(args.out + (size_t)m * D) + lane;
#pragma unroll
            for (int j = 0; j < 4; ++j) __builtin_nontemporal_store(v[j] * r * g[j], o + 64 * j);
        }
    }
#undef IN
#undef BOTH
#undef GRID_BAR
}

#ifndef MK_N_LAUNCHES
#define MK_N_LAUNCHES 1
#endif
extern "C" void kernel_launch(void* const* d_in, const int* in_sizes, int n_in, void* d_out, int out_size, void* d_ws, size_t ws_size, hipStream_t stream) {
    static int grid = 0;
    if (grid == 0) {
        if (n_in != 19 || in_sizes[0] != T * D || out_size != T * D || ws_size < WS_END) { fprintf(stderr, "kernel_launch: unexpected shapes (n_in %d, in0 %d, out %d, ws %zu); nothing launched\n", n_in, n_in > 0 ? in_sizes[0] : -1, out_size, ws_size); grid = -1; return; }
        int dev = 0, cus = 0, per_cu = 0;
        if (hipGetDevice(&dev) != hipSuccess || hipDeviceGetAttribute(&cus, hipDeviceAttributeMultiprocessorCount, dev) != hipSuccess) { fprintf(stderr, "kernel_launch: device query failed\n"); grid = -1; return; }
        if (hipFuncSetAttribute((const void*)hymba_fwd, hipFuncAttributeMaxDynamicSharedMemorySize, LDS_BYTES) != hipSuccess) { fprintf(stderr, "kernel_launch: hipFuncSetAttribute failed\n"); grid = -1; return; }
        if (hipOccupancyMaxActiveBlocksPerMultiprocessor(&per_cu, (const void*)hymba_fwd, NWAVES * 64, LDS_BYTES) != hipSuccess || per_cu < 1) fprintf(stderr, "kernel_launch: note: occupancy query reports %d workgroups per CU\n", per_cu);
        (void)hipGetLastError();
        grid = (cus / 64) * 64; if (grid > 256) grid = 256;
        if (grid < 64) { fprintf(stderr, "kernel_launch: %d CUs: unsupported\n", cus); grid = -1; return; }
    }
    if (grid < 0) return;
    if (hipMemsetAsync((char*)d_ws + WS_CTL, 0, CTL_ZERO_BYTES, stream) != hipSuccess) { fprintf(stderr, "kernel_launch: memset failed\n"); return; }
    Args a{};
    for (int i = 0; i < 19; ++i) a.in[i] = (const float*)d_in[i];
    a.out = (float*)d_out; a.ws = (unsigned char*)d_ws;
    constexpr int NPH = 8;
    if (MK_N_LAUNCHES == 1) { a.ph_lo = 0; a.ph_hi = NPH; hipLaunchKernelGGL(hymba_fwd, dim3(grid), dim3(NWAVES * 64), LDS_BYTES, stream, a); }
    else for (int p = 0; p < NPH; ++p) { a.ph_lo = p; a.ph_hi = p + 1; hipLaunchKernelGGL(hymba_fwd, dim3(grid), dim3(NWAVES * 64), LDS_BYTES, stream, a); }
    const hipError_t le = hipPeekAtLastError();
    if (le != hipSuccess) fprintf(stderr, "kernel_launch: launch failed: %s\n", hipGetErrorName(le));
}
```

```cpp
#include <hip/hip_runtime.h>
#include <cstdio>
#include <cstdint>

#define GAS __attribute__((address_space(1)))
#define LAS __attribute__((address_space(3)))
typedef unsigned short bf16_t;
typedef short bf16x8 __attribute__((ext_vector_type(8)));
typedef short s16x4 __attribute__((ext_vector_type(4)));
typedef float f32x2 __attribute__((ext_vector_type(2)));
typedef float f32x4 __attribute__((ext_vector_type(4)));
typedef float f32x16 __attribute__((ext_vector_type(16)));
typedef unsigned u32x2 __attribute__((ext_vector_type(2)));
typedef unsigned u32x4 __attribute__((ext_vector_type(4)));
typedef int i32x4 __attribute__((ext_vector_type(4)));
typedef int i32x8 __attribute__((ext_vector_type(8)));
typedef GAS unsigned gu32;
#define RLX_AGENT __ATOMIC_RELAXED, __HIP_MEMORY_SCOPE_AGENT
#define LDS_WAIT() asm volatile("s_waitcnt lgkmcnt(0)" ::: "memory")
#define VM_WAIT() asm volatile("s_waitcnt vmcnt(0)" ::: "memory")

constexpr int T = 16384, SEQ = 8192, D = 1024, NIN = 2560, DA = 512, NH = 8, HD = 64, DC = 512, CW = 31;
constexpr int NE = 32, TOPK = 4, NP = T * TOPK, LCAP = 16384, NREL = 192;
constexpr float RMS_EPS = 1e-5f, LN_EPS = 1e-5f, LOG2E = 1.4426950408889634f;
constexpr float QSCALE = 0.125f * LOG2E;
constexpr float SC_T = 16.0f, SC_W = 256.0f, SC_H = 4.0f, SC_O = 32.0f;

constexpr size_t MiB = 1u << 20;
constexpr size_t WS_CTL = 0, CTL_ZERO_BYTES = 64 * 1024;
constexpr size_t WS_WIN = 1 * MiB, WS_WOUT = 6 * MiB, WS_WGU = 8 * MiB, WS_WD = 136 * MiB, WS_X1 = 200 * MiB, WS_XN = 264 * MiB;
constexpr size_t WS_Q = 296 * MiB, WS_K = 312 * MiB, WS_V = 328 * MiB, WS_A = 344 * MiB, WS_G = 360 * MiB, WS_MIX = 376 * MiB;
constexpr size_t WS_HID = 296 * MiB;
constexpr size_t WS_O = WS_WGU;
constexpr size_t WS_LIST = 424 * MiB, WS_TOPW = 428 * MiB, WS_RWT = 429 * MiB, WS_END = 430 * MiB;
constexpr int CW_TMO = 0, CW_BAR = 4096, CW_CNT = 8192;

constexpr int RING_BYTES = 131072, XTRA_OFF = RING_BYTES, LDS_BYTES = 147456, LDSCTL_OFF = LDS_BYTES - 512;
constexpr int NWAVES = 8;

__device__ __forceinline__ unsigned f2bf(float f) { unsigned u = __builtin_bit_cast(unsigned, f); return (u + 0x7fffu + ((u >> 16) & 1u)) >> 16; }
__device__ __forceinline__ unsigned pk2(float lo, float hi) { return f2bf(lo) | (f2bf(hi) << 16); }
__device__ __forceinline__ unsigned cvt_pk_bf16(float lo, float hi) { unsigned r; asm volatile("v_cvt_pk_bf16_f32 %0, %1, %2" : "=v"(r) : "v"(lo), "v"(hi)); return r; }
__device__ __forceinline__ float clamp448(float v) { return fminf(fmaxf(v, -448.0f), 448.0f); }
__device__ __forceinline__ unsigned pk4_fp8(float a, float b, float c, float d) {
    int r = __builtin_amdgcn_cvt_pk_fp8_f32(clamp448(a), clamp448(b), 0, false);
    r = __builtin_amdgcn_cvt_pk_fp8_f32(clamp448(c), clamp448(d), r, true);
    return (unsigned)r;
}
__device__ __forceinline__ unsigned pk4_fp8_nc(float a, float b, float c, float d) {
    int r = __builtin_amdgcn_cvt_pk_fp8_f32(a, b, 0, false);
    r = __builtin_amdgcn_cvt_pk_fp8_f32(c, d, r, true);
    return (unsigned)r;
}
__device__ __forceinline__ float bf_lo(unsigned w) { return __uint_as_float(w << 16); }
__device__ __forceinline__ float bf_hi(unsigned w) { return __uint_as_float(w & 0xffff0000u); }
__device__ __forceinline__ float fsigmoid(float z) { return __builtin_amdgcn_rcpf(1.0f + __builtin_amdgcn_exp2f(-z * LOG2E)); }
__device__ __forceinline__ int lane_id() { int l; asm volatile("v_mbcnt_lo_u32_b32 %0, -1, 0\n\tv_mbcnt_hi_u32_b32 %0, -1, %0" : "=v"(l)); return l; }
__device__ __forceinline__ float wave_sum(float v) {
#define WS_DPP(x, ctrl) __builtin_bit_cast(float, __builtin_amdgcn_update_dpp(0, __builtin_bit_cast(int, (x)), (ctrl), 0xf, 0xf, false))
    v += WS_DPP(v, 0xB1);
    v += WS_DPP(v, 0x4E);
    v += WS_DPP(v, 0x124);
    v += WS_DPP(v, 0x128);
#undef WS_DPP
    const float r0 = __builtin_bit_cast(float, __builtin_amdgcn_readlane(__builtin_bit_cast(int, v), 0)), r1 = __builtin_bit_cast(float, __builtin_amdgcn_readlane(__builtin_bit_cast(int, v), 16));
    const float r2 = __builtin_bit_cast(float, __builtin_amdgcn_readlane(__builtin_bit_cast(int, v), 32)), r3 = __builtin_bit_cast(float, __builtin_amdgcn_readlane(__builtin_bit_cast(int, v), 48));
    return (r0 + r1) + (r2 + r3);
}

namespace pg8 {
constexpr int BM = 256, BK = 64, HALF = 128, HTB = HALF * BK * 2, STAGE_BYTES = 8 * HTB;
__device__ __forceinline__ int lds_byte(int r, int c) { const int st = (r >> 4) * 2 + (c >> 5), rr = r & 15, cc = c & 31, ob = rr * 64 + cc * 2; return st * 1024 + (ob ^ (((ob >> 9) & 1) << 5)); }
__device__ __forceinline__ void stage_rc(int b, int& R, int& C) { const int st = b / 1024, sb = b % 1024, swz = sb ^ (((sb >> 9) & 1) << 5); R = (st >> 1) * 16 + swz / 64; C = (st & 1) * 32 + (swz % 64) / 2; }
__device__ __forceinline__ int perm32(int rho) { const int n = rho >> 4, i = rho & 15; return 8 * (i >> 2) + 4 * n + (i & 3); }

struct Unit { int pm, pn, e, nv; };
template <int N> __device__ __forceinline__ void wait_vm() { asm volatile("s_waitcnt vmcnt(%0)" :: "n"(N) : "memory"); }
template <int NFRESH, int NSTEADY> __device__ __forceinline__ void wait_vm_sel(int fresh) {
    asm volatile("s_cmp_eq_u32 %0, 0\n\ts_cbranch_scc1 .Lwvs_a_%=\n\ts_waitcnt vmcnt(%1)\n\ts_branch .Lwvs_b_%=\n.Lwvs_a_%=:\n\ts_waitcnt vmcnt(%2)\n.Lwvs_b_%=:" :: "s"(__builtin_amdgcn_readfirstlane(fresh)), "n"(NFRESH), "n"(NSTEADY) : "scc", "memory"); }

template <class Epi, class Sched, bool ALIGN_EPI, int ESZ>
__device__ __forceinline__ void gemm_phase(LAS unsigned char* lds, const char* Abase, const int K, const Sched& S, const Epi& E) {
    const int wid = __builtin_amdgcn_readfirstlane(threadIdx.x >> 6), lane = lane_id(), tid = wid * 64 + lane, wr = wid >> 2, wc = wid & 3, fr = lane & 15, fq = lane >> 4;
    const int RB = K * ESZ, nt = RB / 128;
    unsigned voffB[2];
#pragma unroll
    for (int i = 0; i < 2; ++i) { int R, C; stage_rc(tid * 16 + i * 8192, R, C); const int Rb = Epi::PERM ? ((R & ~31) + perm32(R & 31)) : R; voffB[i] = (unsigned)(Rb * RB + 2 * C); }
    const size_t kstep = (size_t)(BK * 2);
    const size_t hstep = (size_t)HALF * RB;
    const unsigned ldsw = (unsigned)wid * 1024u;
    const int aoff = lds_byte(wr * 64 + fr, fq * 8), boff = lds_byte(wc * 32 + fr, fq * 8);
#define PG8_SA(b, h) (((b) * 2 + (h)) * HTB)
#define PG8_SB(b, h) ((4 + (b) * 2 + (h)) * HTB)
#define PG8_STAGE(bufoff, gbase, voff) do { _Pragma("unroll") for (int _i = 0; _i < 2; ++_i) \
        __builtin_amdgcn_global_load_lds((const unsigned*)((const char*)(gbase) + (voff)[_i]), (LAS unsigned*)(lds + (bufoff) + ldsw + _i * 8192), 16, 0, 0); } while (0)
#define PG8_LD16(off) (*(const LAS i32x4*)(lds + (off)))
#define PG8_LDA(dst, b, h) do { _Pragma("unroll") for (int m = 0; m < 4; ++m) { const i32x4 _x = PG8_LD16(PG8_SA(b, h) + aoff + m * 2048), _y = PG8_LD16(PG8_SA(b, h) + aoff + m * 2048 + 1024); dst[m] = __builtin_shufflevector(_x, _y, 0, 1, 2, 3, 4, 5, 6, 7); } } while (0)
#define PG8_LDB(dst, b, h) do { _Pragma("unroll") for (int n = 0; n < 2; ++n) { const i32x4 _x = PG8_LD16(PG8_SB(b, h) + boff + n * 2048), _y = PG8_LD16(PG8_SB(b, h) + boff + n * 2048 + 1024); dst[n] = __builtin_shufflevector(_x, _y, 0, 1, 2, 3, 4, 5, 6, 7); } } while (0)
#define PG8_MMA(ai, bj, At, Bt) do { __builtin_amdgcn_s_setprio(1); _Pragma("unroll") for (int m = 0; m < 4; ++m) _Pragma("unroll") for (int n = 0; n < 2; ++n) _Pragma("unroll") for (int k = 0; k < 2; ++k) \
        acc[ai][bj][m][n] = __builtin_amdgcn_mfma_f32_16x16x32_bf16(PG8_HALF(Bt[n], k), PG8_HALF(At[m], k), acc[ai][bj][m][n], 0, 0, 0); __builtin_amdgcn_s_setprio(0); } while (0)
#define PG8_HALF(v, k) __builtin_bit_cast(bf16x8, (k) == 0 ? __builtin_shufflevector((v), (v), 0, 1, 2, 3) : __builtin_shufflevector((v), (v), 4, 5, 6, 7))
#define PG8_MMA8(ai, bj, At, Bt) do { __builtin_amdgcn_s_setprio(1); _Pragma("unroll") for (int m = 0; m < 4; ++m) _Pragma("unroll") for (int n = 0; n < 2; ++n) \
        acc[ai][bj][m][n] = __builtin_amdgcn_mfma_scale_f32_16x16x128_f8f6f4(Bt[n], At[m], acc[ai][bj][m][n], 0, 0, 0, 0, 0, 0);     __builtin_amdgcn_s_setprio(0); } while (0)
#define PG8_MM(ai, bj, At, Bt) do { if constexpr (ESZ == 2) PG8_MMA(ai, bj, At, Bt); else PG8_MMA8(ai, bj, At, Bt); } while (0)
#define PG8_WAIT_V(n) asm volatile("s_waitcnt vmcnt(" #n ")" ::: "memory")
#define PG8_WAIT_L(n) asm volatile("s_waitcnt lgkmcnt(" #n ")" ::: "memory")
#define PG8_BAR __builtin_amdgcn_s_barrier()
#define PG8_SCHED __builtin_amdgcn_sched_barrier(0)
    Unit cur, nxt; int ui = 0;
    if (!S.next(0, cur)) return;
    f32x4 acc[2][2][4][2];
#pragma unroll
    for (int a = 0; a < 2; ++a)
#pragma unroll
        for (int b = 0; b < 2; ++b)
#pragma unroll
            for (int m = 0; m < 4; ++m)
#pragma unroll
                for (int n = 0; n < 2; ++n) acc[a][b][m][n] = (f32x4){0.f, 0.f, 0.f, 0.f};
    i32x8 At[4], B0[2], B1[2];
    unsigned vA0[2], vA1[2];
    LAS u32x4* const vslot = (LAS u32x4*)(lds + STAGE_BYTES) + tid;
    LAS u32x2* const rowtab = (LAS u32x2*)(lds + STAGE_BYTES + 8192);
    LAS f32x4* const biastab = (LAS f32x4*)(lds + STAGE_BYTES + 8192 + 4096);
    if constexpr (Sched::GATHER) {
        if (tid < 256) rowtab[tid] = *S.entry_ptr(cur, tid);
        else if (tid < 320) biastab[tid - 256] = *(const f32x4*)S.bias_ptr(cur, tid - 256);
        __syncthreads();
        S.a_off_tab(rowtab, cur.nv, tid, RB, vA0, vA1);
    } else S.a_off(cur, tid, RB, vA0, vA1);
    const char* cB = S.b_ptr(cur, RB);
    const char* cA = Abase;
    PG8_STAGE(PG8_SB(0, 0), cB, voffB); PG8_STAGE(PG8_SB(0, 1), cB + hstep, voffB); PG8_STAGE(PG8_SA(0, 0), cA, vA0); PG8_STAGE(PG8_SA(0, 1), cA, vA1);
    if (wr == 1) PG8_BAR;
    PG8_WAIT_V(2); PG8_BAR;
    PG8_STAGE(PG8_SB(1, 0), cB + kstep, voffB); PG8_STAGE(PG8_SA(1, 0), cA + kstep, vA0); PG8_STAGE(PG8_SB(1, 1), cB + hstep + kstep, voffB);
    PG8_WAIT_V(6); PG8_BAR;
    for (;;) {
        const bool has_next = S.next(ui + 1, nxt);
        const char* nB = cB;
        const int par = ui & 1;
        if constexpr (Sched::GATHER) {
            if (has_next) nB = S.b_ptr(nxt, RB);
            else *vslot = (u32x4){vA0[0], vA0[1], vA1[0], vA1[1]};
        } else {
            unsigned n0[2] = {vA0[0], vA0[1]}, n1[2] = {vA1[0], vA1[1]};
            if (has_next) { S.a_off(nxt, tid, RB, n0, n1); nB = S.b_ptr(nxt, RB); }
            *vslot = (u32x4){n0[0], n0[1], n1[0], n1[1]};
        }
#pragma clang loop unroll(disable)
        for (int t = 0; t < nt; t += 2) {
            const bool last = (t == nt - 2);
            const int fresh = ((ui > 0) && (t == 0)) ? 1 : 0;
            if constexpr (Sched::GATHER) {
                if (has_next && t == 2) { const int l2 = lane_id();
                    if (wid < 2) __builtin_amdgcn_global_load_lds((const unsigned*)((const char*)S.entry_ptr(nxt, 0) + (wid * 64 + l2) * 16), (LAS unsigned*)((LAS char*)(rowtab + (par ^ 1) * 256) + wid * 1024), 16, 0, 0);
                    if (wid == 4) __builtin_amdgcn_global_load_lds((const unsigned*)S.bias_ptr(nxt, l2), (LAS unsigned*)(biastab + (par ^ 1) * 64), 16, 0, 0); }
                if (has_next && t == 4) { unsigned n0[2], n1[2]; const int t2 = wid * 64 + lane_id(); S.a_off_tab_nowait(rowtab + (par ^ 1) * 256, nxt.nv, t2, RB, n0, n1); ((LAS u32x4*)(lds + STAGE_BYTES))[t2] = (u32x4){n0[0], n0[1], n1[0], n1[1]}; }
            }
            const char* a1 = cA + (size_t)(t + 1) * kstep;
            const char* a2 = last ? cA : cA + (size_t)(t + 2) * kstep; const char* b2 = last ? nB : cB + (size_t)(t + 2) * kstep;
            const char* a3 = a2 + kstep; const char* b3 = b2 + kstep;
            PG8_LDB(B0, 0, 0); PG8_LDB(B1, 0, 1); PG8_SCHED; PG8_LDA(At, 0, 0); PG8_STAGE(PG8_SA(1, 1), a1, vA1);
            if (last) { const u32x4 nv = *vslot; vA0[0] = nv.x; vA0[1] = nv.y; vA1[0] = nv.z; vA1[1] = nv.w; }
            wait_vm_sel<8 + Epi::NSTORE, 8>(fresh); PG8_WAIT_L(0); PG8_BAR; PG8_MM(0, 0, At, B0); PG8_MM(0, 1, At, B1); PG8_BAR; PG8_SCHED;
            PG8_LDA(At, 0, 1); PG8_STAGE(PG8_SB(0, 0), b2, voffB); PG8_STAGE(PG8_SB(0, 1), b2 + hstep, voffB); PG8_STAGE(PG8_SA(0, 0), a2, vA0);
            wait_vm_sel<8 + Epi::NSTORE, 8>(fresh); PG8_WAIT_L(0); PG8_BAR; PG8_MM(1, 0, At, B0); PG8_MM(1, 1, At, B1); PG8_BAR; PG8_SCHED;
            PG8_LDB(B0, 1, 0); PG8_LDB(B1, 1, 1); PG8_SCHED; PG8_LDA(At, 1, 0); PG8_STAGE(PG8_SA(0, 1), a2, vA1);
            PG8_WAIT_V(8); PG8_WAIT_L(0); PG8_BAR; PG8_MM(0, 0, At, B0); PG8_MM(0, 1, At, B1); PG8_BAR; PG8_SCHED;
            PG8_LDA(At, 1, 1); PG8_STAGE(PG8_SB(1, 0), b3, voffB); PG8_STAGE(PG8_SB(1, 1), b3 + hstep, voffB); PG8_STAGE(PG8_SA(1, 0), a3, vA0);
            PG8_WAIT_V(8); PG8_WAIT_L(0); PG8_BAR; PG8_MM(1, 0, At, B0); PG8_MM(1, 1, At, B1); PG8_BAR; PG8_SCHED;
        }
        if constexpr (ALIGN_EPI) { if (wr == 0) PG8_BAR; }
        if constexpr (Sched::GATHER) { int zofs; asm volatile("s_mov_b32 %0, 0" : "=s"(zofs));
            E(acc, cur, wr, wc, fr, fq, rowtab + par * 256 + zofs, biastab + par * 64 + zofs); } else E(acc, cur, wr, wc, fr, fq);
        if (!has_next) break;
#pragma unroll
        for (int a = 0; a < 2; ++a)
#pragma unroll
            for (int b = 0; b < 2; ++b)
#pragma unroll
                for (int m = 0; m < 4; ++m)
#pragma unroll
                    for (int n = 0; n < 2; ++n) acc[a][b][m][n] = (f32x4){0.f, 0.f, 0.f, 0.f};
        cur = nxt; cB = nB; ++ui;
        if constexpr (ALIGN_EPI) { if (wr == 1) PG8_BAR; }
    }
    PG8_WAIT_V(0);
    if constexpr (!ALIGN_EPI) { if (wr == 0) PG8_BAR; }
    PG8_BAR;
#undef PG8_SA
#undef PG8_SB
#undef PG8_STAGE
#undef PG8_LDA
#undef PG8_LDB
#undef PG8_MMA
#undef PG8_MMA8
#undef PG8_MM
#undef PG8_HALF
#undef PG8_LD16
#undef PG8_WAIT_V
#undef PG8_WAIT_L
#undef PG8_BAR
#undef PG8_SCHED
}

struct DenseOrder {
    static constexpr bool GATHER = false;
    int nM, nN, nwg, G, c; const char* Bt;
    __device__ __forceinline__ void init(int M, int N, int G_, int c_, const void* Bt_) { nM = M / BM; nN = N / BM; nwg = nM * nN; G = G_; c = c_; Bt = (const char*)Bt_; }
    __device__ __forceinline__ bool next(int i, Unit& u) const {
        const long L = (long)i * G + c; if (L >= nwg) return false;
        int wgid = (int)L; { const int q = nwg / 8, r = nwg % 8, xcd = wgid % 8, off = wgid / 8; wgid = (xcd < r ? xcd * (q + 1) : r * (q + 1) + (xcd - r) * q) + off; }
        const int nig = 8 * nN, gid = wgid / nig, fm = gid * 8, gsz = (nM - fm) < 8 ? (nM - fm) : 8;
        u.pm = fm + ((wgid % nig) % gsz); u.pn = (wgid % nig) / gsz; u.e = 0; u.nv = 256; return true;
    }
    __device__ __forceinline__ const char* b_ptr(const Unit& u, int RB) const { return Bt + (size_t)u.pn * (256 * (size_t)RB); }
    __device__ __forceinline__ void a_off(const Unit& u, int tid, int RB, unsigned (&v0)[2], unsigned (&v1)[2]) const {
#pragma unroll
        for (int i = 0; i < 2; ++i) { int R, C; stage_rc(tid * 16 + i * 8192, R, C); v0[i] = (unsigned)((u.pm * 256 + R) * RB + 2 * C); v1[i] = (unsigned)((u.pm * 256 + 128 + R) * RB + 2 * C); }
    }
};
struct MoeOrder {
    static constexpr bool GATHER = true;
    const LAS i32x4* ul;
    const u32x2* list;
    const char* Bt; int npn, nrowsB, shiftA;
    const float* bias0; const float* bias1; int bcols;
    __device__ __forceinline__ bool next(int i, Unit& u) const {
        if (i >= 32) return false;
        const i32x4 v = ul[i];
        u.e = __builtin_amdgcn_readfirstlane(v.x); u.pm = __builtin_amdgcn_readfirstlane(v.y); u.pn = __builtin_amdgcn_readfirstlane(v.z); u.nv = __builtin_amdgcn_readfirstlane(v.w);
        return u.nv > 0;
    }
    __device__ __forceinline__ const char* b_ptr(const Unit& u, int RB) const { return Bt + ((size_t)u.e * nrowsB + (size_t)u.pn * 256) * (size_t)RB; }
    __device__ __forceinline__ const u32x2* entry_ptr(const Unit& u, int t) const { return list + (size_t)u.e * LCAP + u.pm * 256 + t; }
    __device__ __forceinline__ const float* bias_ptr(const Unit& u, int i) const {
        return (bcols == 128) ? ((i < 32 ? bias0 : bias1) + (size_t)u.e * D + u.pn * 128 + 4 * (i & 31)) : (bias0 + (size_t)u.e * D + u.pn * 256 + 4 * i); }
    __device__ __forceinline__ void a_off_tab(const LAS u32x2* rt, int nv, int tid, int RB, unsigned (&v0)[2], unsigned (&v1)[2]) const {
#pragma unroll
        for (int i = 0; i < 2; ++i) { int R, C; stage_rc(tid * 16 + i * 8192, R, C);
            const int p0 = (int)rt[R < nv ? R : 0].x >> shiftA, p1 = (int)rt[(128 + R) < nv ? (128 + R) : 0].x >> shiftA;
            v0[i] = (unsigned)(p0 * RB + 2 * C); v1[i] = (unsigned)(p1 * RB + 2 * C); }
    }
    __device__ __forceinline__ void a_off_tab_nowait(const LAS u32x2* rt, int nv, int tid, int RB, unsigned (&v0)[2], unsigned (&v1)[2]) const {
        unsigned pr[4]; int Cc[2];
#pragma unroll
        for (int i = 0; i < 2; ++i) { int R, C; stage_rc(tid * 16 + i * 8192, R, C); Cc[i] = C;
            const unsigned a0 = (unsigned)(uintptr_t)(rt + (R < nv ? R : 0)), a1 = (unsigned)(uintptr_t)(rt + ((128 + R) < nv ? (128 + R) : 0));
            asm volatile("ds_read_b32 %0, %1" : "=v"(pr[2 * i]) : "v"(a0) : "memory"); asm volatile("ds_read_b32 %0, %1" : "=v"(pr[2 * i + 1]) : "v"(a1) : "memory"); }
        asm volatile("s_waitcnt lgkmcnt(0)" : "+v"(pr[0]), "+v"(pr[1]), "+v"(pr[2]), "+v"(pr[3]) :: "memory");
#pragma unroll
        for (int i = 0; i < 2; ++i) { v0[i] = (unsigned)(((int)pr[2 * i] >> shiftA) * RB + 2 * Cc[i]); v1[i] = (unsigned)(((int)pr[2 * i + 1] >> shiftA) * RB + 2 * Cc[i]); }
    }
};

struct EpiSplit {
    static constexpr bool PERM = true; static constexpr int NSTORE = 16;
    bf16_t* O; size_t split_stride; float scale0;
    __device__ __forceinline__ void operator()(const f32x4 (&acc)[2][2][4][2], const Unit& u, int wr, int wc, int fr, int fq) const {
        const int row0 = u.pm * BM + wr * 64 + fr; int colt = u.pn * BM; const int t = colt / 512; bf16_t* base = O + (size_t)t * split_stride; colt -= t * 512;
        const float sc = (t == 0) ? scale0 : 1.f;
        const int col0 = colt + wc * 32 + 8 * fq;
#pragma unroll
        for (int ai = 0; ai < 2; ++ai)
#pragma unroll
            for (int m = 0; m < 4; ++m) { bf16_t* rowp = base + (size_t)(row0 + ai * HALF + m * 16) * 512 + col0;
#pragma unroll
                for (int bj = 0; bj < 2; ++bj) { const f32x4 v0 = acc[ai][bj][m][0] * sc, v1 = acc[ai][bj][m][1] * sc;
                    u32x4 w; w.x = cvt_pk_bf16(v0[0], v0[1]); w.y = cvt_pk_bf16(v0[2], v0[3]); w.z = cvt_pk_bf16(v1[0], v1[1]); w.w = cvt_pk_bf16(v1[2], v1[3]);
                    *(u32x4*)(rowp + bj * HALF) = w; } }
    }
};
struct EpiRes {
    static constexpr bool PERM = true; static constexpr int NSTORE = 0;
    const float* base; bf16_t* out; unsigned char* t8; const float* gain;
    __device__ __forceinline__ void operator()(const f32x4 (&acc)[2][2][4][2], const Unit& u, int wr, int wc, int fr, int fq) const {
        const int row0 = u.pm * BM + wr * 64 + fr, col0 = u.pn * BM + wc * 32 + 8 * fq;
        f32x4 gv[2][2];
#pragma unroll
        for (int bj = 0; bj < 2; ++bj)
#pragma unroll
            for (int n = 0; n < 2; ++n) gv[bj][n] = *(const f32x4*)(gain + col0 + bj * HALF + 4 * n) * SC_T;
#pragma unroll
        for (int ai = 0; ai < 2; ++ai)
#pragma unroll
            for (int m = 0; m < 4; ++m) { const size_t off = (size_t)(row0 + ai * HALF + m * 16) * D + col0;
#pragma unroll
                for (int bj = 0; bj < 2; ++bj) { const f32x4 v0 = __builtin_nontemporal_load((const f32x4*)(base + off + bj * HALF)) + acc[ai][bj][m][0], v1 = __builtin_nontemporal_load((const f32x4*)(base + off + bj * HALF + 4)) + acc[ai][bj][m][1];
                    *(u32x4*)(out + off + bj * HALF) = (u32x4){cvt_pk_bf16(v0[0], v0[1]), cvt_pk_bf16(v0[2], v0[3]), cvt_pk_bf16(v1[0], v1[1]), cvt_pk_bf16(v1[2], v1[3])};
                    const f32x4 s0 = v0 * gv[bj][0], s1 = v1 * gv[bj][1];
                    *(u32x2*)(t8 + off + bj * HALF) = (u32x2){pk4_fp8(s0[0], s0[1], s0[2], s0[3]), pk4_fp8(s1[0], s1[1], s1[2], s1[3])}; } }
    }
};
struct EpiGU {
    static constexpr bool PERM = true; static constexpr int NSTORE = 8;
    unsigned char* hid;
    __device__ __forceinline__ void operator()(const f32x4 (&acc)[2][2][4][2], const Unit& u, int wr, int wc, int fr, int fq, const LAS u32x2* rt, const LAS f32x4* bt) const {
        const int hc = u.pn * 128 + wc * 32 + 8 * fq;
        const f32x4 g0 = bt[8 * wc + 2 * fq], g1 = bt[8 * wc + 2 * fq + 1], u0 = bt[32 + 8 * wc + 2 * fq], u1 = bt[32 + 8 * wc + 2 * fq + 1];
        constexpr float inv = 1.0f / (SC_T * SC_W);
#pragma unroll
        for (int ai = 0; ai < 2; ++ai)
#pragma unroll
            for (int m = 0; m < 4; ++m) { const int r = ai * HALF + wr * 64 + m * 16 + fr;
                const u32x2 en = rt[r]; const float rs = __uint_as_float(en.y) * inv;
                f32x2 h[4];
#pragma unroll
                for (int n = 0; n < 2; ++n)
#pragma unroll
                    for (int x = 0; x < 2; ++x) { const f32x4 ga = acc[ai][0][m][n], ua = acc[ai][1][m][n], gb = n ? g1 : g0, ub = n ? u1 : u0;
                        f32x2 g = (f32x2){ga[2 * x], ga[2 * x + 1]} * rs + (f32x2){gb[2 * x], gb[2 * x + 1]}, up = (f32x2){ua[2 * x], ua[2 * x + 1]} * rs + (f32x2){ub[2 * x], ub[2 * x + 1]};
                        g.x = fminf(g.x, 7.0f); g.y = fminf(g.y, 7.0f); up.x = __builtin_amdgcn_fmed3f(up.x, -7.0f, 7.0f); up.y = __builtin_amdgcn_fmed3f(up.y, -7.0f, 7.0f);
                        const f32x2 z = g * (-1.702f * LOG2E); f32x2 t; t.x = __builtin_amdgcn_exp2f(z.x); t.y = __builtin_amdgcn_exp2f(z.y); t = t + 1.0f;
                        f32x2 sg; sg.x = __builtin_amdgcn_rcpf(t.x); sg.y = __builtin_amdgcn_rcpf(t.y);
                        h[n * 2 + x] = (up * SC_H + SC_H) * (g * sg); }
                u32x2 w; w.x = pk4_fp8_nc(h[0].x, h[0].y, h[1].x, h[1].y); w.y = pk4_fp8_nc(h[2].x, h[2].y, h[3].x, h[3].y);
                *(u32x2*)(hid + (size_t)(r < u.nv ? en.x : (unsigned)NP) * D + hc) = w; }
    }
};
struct EpiDown {
    static constexpr bool PERM = true; static constexpr int NSTORE = 16;
    unsigned char* o;
    __device__ __forceinline__ void operator()(const f32x4 (&acc)[2][2][4][2], const Unit& u, int wr, int wc, int fr, int fq, const LAS u32x2* rt, const LAS f32x4* bt) const {
        constexpr float inv = SC_O / (SC_H * SC_W);
        const int c0 = u.pn * BM + wc * 32 + 8 * fq;
        f32x4 bv[2][2];
#pragma unroll
        for (int bj = 0; bj < 2; ++bj)
#pragma unroll
            for (int n = 0; n < 2; ++n) bv[bj][n] = bt[bj * 32 + wc * 8 + 2 * fq + n] * SC_O;
#pragma unroll
        for (int ai = 0; ai < 2; ++ai)
#pragma unroll
            for (int m = 0; m < 4; ++m) { const int r = ai * HALF + wr * 64 + m * 16 + fr;
                const unsigned p = (r < u.nv) ? rt[r].x : (unsigned)NP; unsigned char* rowp = o + (size_t)p * D + c0;
#pragma unroll
                for (int bj = 0; bj < 2; ++bj) { const f32x4 v0 = acc[ai][bj][m][0] * inv + bv[bj][0], v1 = acc[ai][bj][m][1] * inv + bv[bj][1];
                    *(u32x2*)(rowp + bj * HALF) = (u32x2){pk4_fp8(v0[0], v0[1], v0[2], v0[3]), pk4_fp8(v1[0], v1[1], v1[2], v1[3])}; } }
    }
};
}

#define XB_TMO      128
#define XB_XCNT(j)  (256  + 64 * (j))
#define XB_XSUB(j)  (1280 + 64 * (j))
#define XB_XGEN(j)  (2304 + 64 * (j))
#define XB_TOP      3328
#define XB_TOPGEN   3392
#define XCD_BAR_WORDS 3456
#define XB_SPIN_CAP (1u << 18)
__device__ __forceinline__ unsigned xb_ld(unsigned* p)              { return __hip_atomic_load(p, __ATOMIC_RELAXED, __HIP_MEMORY_SCOPE_AGENT); }
__device__ __forceinline__ unsigned xb_add(unsigned* p, unsigned v) { return __hip_atomic_fetch_add(p, v, __ATOMIC_RELAXED, __HIP_MEMORY_SCOPE_AGENT); }
__device__ __forceinline__ unsigned xb_xcc_id() { return (unsigned)__builtin_amdgcn_s_getreg((3 << 11) | 20) & 0xFu; }
#define XB_SPIN(cond, bar) do { unsigned _sp = 0; while (cond) { __builtin_amdgcn_s_sleep(1); \
    if ((++_sp & 255u) == 0u) { if (xb_ld(&(bar)[XB_TMO])) break; if (_sp > XB_SPIN_CAP) { atomicAdd(&(bar)[XB_TMO], 1u); break; } } } } while (0)
struct XcdBarrier { unsigned* bar; unsigned x; volatile LAS unsigned* st; };
__device__ __forceinline__ XcdBarrier xcd_barrier_post(unsigned* bar, volatile LAS unsigned* st) {
    XcdBarrier b; b.bar = bar; b.x = xb_xcc_id(); b.st = st;
    if (threadIdx.x == 0) (void)xb_add(&bar[XB_XCNT(b.x)], 1u);
    return b;
}
__device__ __forceinline__ void xcd_barrier_complete(unsigned* bar, unsigned x, unsigned& nloc, unsigned& nx) {
    const unsigned G = gridDim.x * gridDim.y * gridDim.z;
    unsigned sum, cnt, mine, sp = 0u;
    for (;;) {
        sum = 0u; cnt = 0u; mine = 0u;
#pragma unroll
        for (unsigned j = 0; j < 16; ++j) { const unsigned c = xb_ld(&bar[XB_XCNT(j)]); sum += c; cnt += (c > 0u) ? 1u : 0u; mine = (j == x) ? c : mine; }
        if (sum == G) break;
        __builtin_amdgcn_s_sleep(1);
        if ((++sp & 255u) == 0u) { if (xb_ld(&bar[XB_TMO])) break; if (sp > XB_SPIN_CAP) { atomicAdd(&bar[XB_TMO], 1u); break; } }
    }
    nloc = mine > 0u ? mine : 1u; nx = cnt > 0u ? cnt : 1u;
}
__device__ __forceinline__ void xcd_barrier(const XcdBarrier& b) {
    asm volatile("s_waitcnt vmcnt(0)" ::: "memory");
    __syncthreads();
    if (threadIdx.x == 0) {
        unsigned* bar = b.bar;
        __builtin_amdgcn_s_waitcnt(0);
        unsigned nloc = b.st[0], nx = b.st[1];
        if (nloc == 0u) { xcd_barrier_complete(bar, b.x, nloc, nx); b.st[0] = nloc; b.st[1] = nx; }
        const unsigned old = xb_add(&bar[XB_XSUB(b.x)], 1u);
        const unsigned gen = old / nloc;
        if (old + 1u == (gen + 1u) * nloc) {
            __builtin_amdgcn_fence(__ATOMIC_RELEASE, "agent");
            asm volatile("s_waitcnt vmcnt(0)" ::: "memory");
            const unsigned og = xb_add(&bar[XB_TOP], 1u);
            const unsigned tg = og / nx;
            if (og + 1u == (tg + 1u) * nx) xb_add(&bar[XB_TOPGEN], 1u);
            else XB_SPIN(xb_ld(&bar[XB_TOPGEN]) == tg, bar);
            __builtin_amdgcn_fence(__ATOMIC_ACQUIRE, "agent");
            xb_add(&bar[XB_XGEN(b.x)], 1u);
            asm volatile("s_waitcnt vmcnt(0)" ::: "memory");
        } else {
            XB_SPIN(xb_ld(&bar[XB_XGEN(b.x)]) == gen, bar);
            __builtin_amdgcn_fence(__ATOMIC_ACQUIRE, "agent");
            asm volatile("s_waitcnt vmcnt(0)" ::: "memory");
        }
    }
    __syncthreads();
}

struct Frame {
    LAS unsigned char* lds;
    gu32* ctl;
    int wave, G, vcu;
};

__device__ __forceinline__ void transpose_item(const float* W, int N, int k0, int n0, bf16_t* dst, int K, LAS float* scr, int lane) {
    f32x4 v[8];
#pragma unroll
    for (int it = 0; it < 8; ++it) v[it] = *(const GAS f32x4*)(W + (size_t)(k0 + it * 8 + (lane >> 3)) * N + n0 + 4 * (lane & 7));
#pragma unroll
    for (int it = 0; it < 8; ++it) { LAS float* s = scr + (it * 8 + (lane >> 3)) * 33 + 4 * (lane & 7); s[0] = v[it].x; s[1] = v[it].y; s[2] = v[it].z; s[3] = v[it].w; }
    LDS_WAIT(); asm volatile("" ::: "memory");
    const int c = lane & 7;
#pragma unroll
    for (int j = 0; j < 4; ++j) { const int n = (lane >> 3) + 8 * j; const LAS float* s = scr + (8 * c) * 33 + n;
        u32x4 o; o.x = pk2(s[0 * 33], s[1 * 33]); o.y = pk2(s[2 * 33], s[3 * 33]); o.z = pk2(s[4 * 33], s[5 * 33]); o.w = pk2(s[6 * 33], s[7 * 33]);
        *(GAS u32x4*)(dst + (size_t)n * K + k0 + 8 * c) = o; }
    LDS_WAIT(); asm volatile("" ::: "memory");
}

struct Args { const float* in[19]; float* out; unsigned char* ws; int ph_lo, ph_hi; };

namespace att {
constexpr int SLOT = 8192, NSL = 5;
constexpr int L_K = 0, L_V = NSL * SLOT, L_WS = 2 * NSL * SLOT, L_BIAS = L_WS + 8 * 256, L_OST = L_BIAS + 1024, L_END = L_OST + 8 * 4096;
__device__ __forceinline__ int crow(int r, int hi) { return (r & 3) + 8 * (r >> 2) + 4 * hi; }
__device__ __forceinline__ s16x4 vtr(const LAS char* p) { typedef short v4i16_t __attribute__((ext_vector_type(4))); return __builtin_bit_cast(s16x4, __builtin_amdgcn_ds_read_tr16_b64_v4i16((LAS v4i16_t*)p)); }

template <bool FIRST>
__device__ __forceinline__ void tile_step(const LAS char* lds, int slot, int s, int lane, int r32, int hi, int qin, const bf16x8 (&qr)[4], const LAS float* tb, LAS float* wsf,
                                          float& m_run, float& l_run, f32x16 (&o)[2], f32x16& negm) {
    constexpr float THR = 8.0f;
    const LAS char* kp = lds + L_K + slot + hi * 1024 + r32 * 16;
    f32x16 p0, p1;
#pragma unroll
    for (int d0 = 0; d0 < 4; ++d0) {
        const bf16x8 b0 = *(const LAS bf16x8*)(kp + d0 * 2048), b1 = *(const LAS bf16x8*)(kp + d0 * 2048 + 512);
        p0 = __builtin_amdgcn_mfma_f32_32x32x16_bf16(b0, qr[d0], d0 == 0 ? negm : p0, 0, 0, 0); p1 = __builtin_amdgcn_mfma_f32_32x32x16_bf16(b1, qr[d0], d0 == 0 ? negm : p1, 0, 0, 0); }
    if (s >= 6) { const int ib = qin + 64 * (8 - s) + 63 - 4 * hi;
#pragma unroll
        for (int r = 0; r < 16; ++r) { const int off = (r & 3) + 8 * (r >> 2); p0[r] += tb[ib - off]; p1[r] += tb[ib - off - 32]; } }
    float mx = __builtin_fmaxf(__builtin_fmaxf(p0[0], p0[1]), p1[0]), my = __builtin_fmaxf(__builtin_fmaxf(p0[2], p0[3]), p1[1]);
    mx = __builtin_fmaxf(__builtin_fmaxf(mx, p1[2]), p1[3]);
#pragma unroll
    for (int r = 4; r < 16; r += 4) { mx = __builtin_fmaxf(__builtin_fmaxf(mx, p0[r]), p0[r + 1]); my = __builtin_fmaxf(__builtin_fmaxf(my, p0[r + 2]), p0[r + 3]);
                                      mx = __builtin_fmaxf(__builtin_fmaxf(mx, p1[r]), p1[r + 1]); my = __builtin_fmaxf(__builtin_fmaxf(my, p1[r + 2]), p1[r + 3]); }
    mx = fmaxf(mx, my); mx = fmaxf(mx, __shfl_xor(mx, 32));
    if constexpr (FIRST) {
        m_run = mx;
#pragma unroll
        for (int r = 0; r < 16; ++r) { p0[r] -= mx; p1[r] -= mx; negm[r] = -mx; }
    } else if (__any(mx > THR)) {
        const float d = mx > THR ? mx : 0.f, f = __builtin_amdgcn_exp2f(-d);
        m_run += d; l_run *= f;
#pragma unroll
        for (int r = 0; r < 16; ++r) { p0[r] -= d; p1[r] -= d; negm[r] = -m_run; }
        if (hi == 0) wsf[r32] = f;
        LDS_WAIT();
#pragma unroll
        for (int r = 0; r < 16; ++r) { const float g = wsf[crow(r, hi)]; o[0][r] *= g; o[1][r] *= g; }
    }
    float rs = 0.f, rs2 = 0.f;
#pragma unroll
    for (int r = 0; r < 16; ++r) { p0[r] = __builtin_amdgcn_exp2f(p0[r]); p1[r] = __builtin_amdgcn_exp2f(p1[r]); rs += p0[r]; rs2 += p1[r]; }
    l_run += rs + rs2;
    u32x4 pw[4];
#pragma unroll
    for (int q = 0; q < 4; ++q) { pw[0][q] = cvt_pk_bf16(p0[2 * q], p0[2 * q + 1]); pw[1][q] = cvt_pk_bf16(p0[8 + 2 * q], p0[8 + 2 * q + 1]);
                                  pw[2][q] = cvt_pk_bf16(p1[2 * q], p1[2 * q + 1]); pw[3][q] = cvt_pk_bf16(p1[8 + 2 * q], p1[8 + 2 * q + 1]); }
    const unsigned vb = (unsigned)(uintptr_t)(lds + L_V + slot + ((lane >> 4) & 1) * 32 + (lane & 3) * 8 + (4 * hi + ((lane & 15) >> 2)) * 64);
#pragma unroll
    for (int d0 = 0; d0 < 2; ++d0) { s16x4 lo[4], hh[4];
#pragma unroll
        for (int ks = 0; ks < 4; ++ks) {
            asm volatile("ds_read_b64_tr_b16 %0, %1 offset:%c2" : "=&v"(lo[ks]) : "v"(vb), "i"(d0 * 4096 + ks * 1024) : "memory");
            asm volatile("ds_read_b64_tr_b16 %0, %1 offset:%c2" : "=&v"(hh[ks]) : "v"(vb), "i"(d0 * 4096 + ks * 1024 + 512) : "memory"); }
        asm volatile("s_waitcnt lgkmcnt(0)" ::: "memory"); __builtin_amdgcn_sched_barrier(0);
#pragma unroll
        for (int ks = 0; ks < 4; ++ks) { const bf16x8 vf = (bf16x8){lo[ks][0], lo[ks][1], lo[ks][2], lo[ks][3], hh[ks][0], hh[ks][1], hh[ks][2], hh[ks][3]};
            o[d0] = __builtin_amdgcn_mfma_f32_32x32x16_bf16(__builtin_bit_cast(bf16x8, pw[ks]), vf, o[d0], 0, 0, 0); } }
}

template <bool EDGE>
__device__ __forceinline__ void unit(const Frame& F, int b, int h, int cg, const bf16_t* Q, const bf16_t* Kb, const bf16_t* Vb, bf16_t* MIX, const float* relb) {
    LAS char* lds = (LAS char*)F.lds;
    const int wid = F.wave, lane = lane_id(), tid = wid * 64 + lane, r32 = lane & 31, hi = lane >> 5;
    const int wp = wid >> 1, half = wid & 1;
    const int c = 4 * cg + wp;
    const long rowbase = (long)b * SEQ;
    LAS float* wsf = (LAS float*)(lds + L_WS) + wid * 64;
    LAS float* tb = (LAS float*)(lds + L_BIAS);
    if (tid < 256) { const int i = tid < NREL ? tid : NREL - 1; tb[tid] = (relb[h * NREL + i] - relb[h * NREL + NREL - 1]) * LOG2E; }
    const bf16_t* Qw = Q + (rowbase + c * 64 + half * 32 + r32) * DA + h * HD;
    bf16x8 qr[4];
#pragma unroll
    for (int d0 = 0; d0 < 4; ++d0) qr[d0] = *(const GAS bf16x8*)(Qw + d0 * 16 + hi * 8);
    const int kc0 = 4 * cg - 8;
    const int krow = tid & 63, kch = tid >> 6;
    const int vrow = tid >> 3, vch = tid & 7;
    const bf16_t* ksrc = Kb + (rowbase + krow) * DA + h * HD + kch * 8;
    const bf16_t* vsrc = Vb + (rowbase + vrow) * DA + h * HD + vch * 8;
    const int kdst = L_K + kch * 1024 + krow * 16, vdst = L_V + (vch >> 2) * 4096 + vrow * 64 + (vch & 3) * 16;
#pragma unroll
    for (int j = 0; j < 4; ++j) { const int kc = kc0 + j;
        if (!EDGE || kc >= 0) { const u32x4 kv = *(const GAS u32x4*)(ksrc + (long)kc * 64 * DA); const u32x4 vv = *(const GAS u32x4*)(vsrc + (long)kc * 64 * DA);
            *(LAS u32x4*)(lds + kdst + j * SLOT) = kv; *(LAS u32x4*)(lds + vdst + j * SLOT) = vv; } }
    float m_run = 0.f, l_run = 0.f; f32x16 o[2]; o[0] = f32x16{}; o[1] = f32x16{}; f32x16 negm = f32x16{};
    const int qin = half * 32 + r32;
    if constexpr (!EDGE) {
        __syncthreads();
        { u32x4 kv = *(const GAS u32x4*)(ksrc + (long)(kc0 + 4) * 64 * DA), vv = *(const GAS u32x4*)(vsrc + (long)(kc0 + 4) * 64 * DA);
          tile_step<true>(lds, (wp % NSL) * SLOT, 0, lane, r32, hi, qin, qr, tb, wsf, m_run, l_run, o, negm);
          *(LAS u32x4*)(lds + kdst + 4 * SLOT) = kv; *(LAS u32x4*)(lds + vdst + 4 * SLOT) = vv; }
#pragma unroll 1
        for (int s = 1; s < 9; ++s) {
            __syncthreads();
            const int jn = s + 4; const bool ldn = jn < 12;
            u32x4 kv = (u32x4){0u, 0u, 0u, 0u}, vv = (u32x4){0u, 0u, 0u, 0u};
            if (ldn) { kv = *(const GAS u32x4*)(ksrc + (long)(kc0 + jn) * 64 * DA); vv = *(const GAS u32x4*)(vsrc + (long)(kc0 + jn) * 64 * DA); }
            tile_step<false>(lds, ((wp + s) % NSL) * SLOT, s, lane, r32, hi, qin, qr, tb, wsf, m_run, l_run, o, negm);
            if (ldn) { const int sl = (jn % NSL) * SLOT; *(LAS u32x4*)(lds + kdst + sl) = kv; *(LAS u32x4*)(lds + vdst + sl) = vv; }
        }
    } else {
        bool first = true;
#pragma unroll 1
        for (int s = 0; s < 9; ++s) {
            __syncthreads();
            const int jn = s + 4, kcn = kc0 + jn; const bool ldn = (jn < 12) && (kcn >= 0);
            u32x4 kv = (u32x4){0u, 0u, 0u, 0u}, vv = (u32x4){0u, 0u, 0u, 0u};
            if (ldn) { kv = *(const GAS u32x4*)(ksrc + (long)kcn * 64 * DA); vv = *(const GAS u32x4*)(vsrc + (long)kcn * 64 * DA); }
            const int j = wp + s, kc = kc0 + j;
            if (kc >= 0) { if (first) { tile_step<true>(lds, (j % NSL) * SLOT, s, lane, r32, hi, qin, qr, tb, wsf, m_run, l_run, o, negm); first = false; }
                           else tile_step<false>(lds, (j % NSL) * SLOT, s, lane, r32, hi, qin, qr, tb, wsf, m_run, l_run, o, negm); }
            if (ldn) { const int sl = (jn % NSL) * SLOT; *(LAS u32x4*)(lds + kdst + sl) = kv; *(LAS u32x4*)(lds + vdst + sl) = vv; }
        }
    }
    l_run += __shfl_xor(l_run, 32);
    if (hi == 0) wsf[32 + r32] = l_run;
    LDS_WAIT();
    LAS bf16_t* stg = (LAS bf16_t*)(lds + L_OST) + wid * 2048;
#pragma unroll
    for (int r = 0; r < 16; ++r) { const int orow = crow(r, hi); const float rl = __builtin_amdgcn_rcpf(wsf[32 + orow]);
#pragma unroll
        for (int d0 = 0; d0 < 2; ++d0) stg[orow * 64 + d0 * 32 + r32] = (bf16_t)f2bf(o[d0][r] * rl); }
    LDS_WAIT();
    bf16_t* Ow = MIX + (rowbase + c * 64 + half * 32) * D + h * HD;
#pragma unroll
    for (int i = 0; i < 4; ++i) { const int row = i * 8 + (lane >> 3), ch = lane & 7; const u32x4 v = *(const LAS u32x4*)(stg + row * 64 + ch * 8); *(GAS u32x4*)(Ow + (long)row * D + ch * 8) = v; }
    __syncthreads();
}
}

namespace cv {
constexpr int TT = 32, UR = TT + CW - 1;
constexpr int L_U = 0, L_Y = UR * DC * 2  , L_END = L_Y + TT * DC * 4;
__device__ __forceinline__ void unit(const Frame& F, int b, int tt, const bf16_t* Ab, const bf16_t* Gb, bf16_t* MIX, const float* dw_w, const float* dw_b, const float* ln_g, const float* ln_b) {
    LAS char* lds = (LAS char*)F.lds;
    const int wid = F.wave, lane = lane_id(), tid = wid * 64 + lane;
    const int t0 = tt * TT; const long rowbase = (long)b * SEQ;
    for (int idx = tid; idx < UR * 64; idx += 512) { const int r = idx >> 6, c8 = idx & 63; const int tok = t0 - (CW - 1) + r;
        u32x4 w = (u32x4){0u, 0u, 0u, 0u};
        if (tok >= 0) { const u32x4 av = *(const GAS u32x4*)(Ab + (rowbase + tok) * DC + c8 * 8), gv = *(const GAS u32x4*)(Gb + (rowbase + tok) * DC + c8 * 8);
#pragma unroll
            for (int q = 0; q < 4; ++q) { const float u0 = bf_lo(av[q]) * fsigmoid(bf_lo(gv[q])), u1 = bf_hi(av[q]) * fsigmoid(bf_hi(gv[q])); w[q] = cvt_pk_bf16(u0, u1); } }
        *(LAS u32x4*)(lds + L_U + r * (DC * 2) + c8 * 16) = w; }
    __syncthreads();
    { const int cp = tid & 255, th = tid >> 8;
      f32x2 w[CW];
#pragma unroll
      for (int j = 0; j < CW; ++j) w[j] = *(const GAS f32x2*)(dw_w + j * DC + 2 * cp);
      const f32x2 bias = *(const GAS f32x2*)(dw_b + 2 * cp);
#pragma unroll 1
      for (int blk = 0; blk < 2; ++blk) { const int tbk = th * 16 + blk * 8;
          f32x2 acc[8];
#pragma unroll
          for (int k = 0; k < 8; ++k) acc[k] = bias;
#pragma unroll
          for (int i = 0; i < 8 + CW - 1; ++i) { const unsigned uw = *(const LAS unsigned*)(lds + L_U + (tbk + i) * (DC * 2) + cp * 4); const f32x2 uv = (f32x2){bf_lo(uw), bf_hi(uw)};
#pragma unroll
              for (int k = 0; k < 8; ++k) { const int j = i - k; if (j >= 0 && j < CW) acc[k] += uv * w[j]; } }
#pragma unroll
          for (int k = 0; k < 8; ++k) *(LAS f32x2*)(lds + L_Y + (tbk + k) * (DC * 4) + cp * 8) = acc[k]; } }
    __syncthreads();
    { const f32x4 g0 = *(const GAS f32x4*)(ln_g + 8 * lane), g1 = *(const GAS f32x4*)(ln_g + 8 * lane + 4), b0 = *(const GAS f32x4*)(ln_b + 8 * lane), b1 = *(const GAS f32x4*)(ln_b + 8 * lane + 4);
#pragma unroll
      for (int q = 0; q < 4; ++q) { const int t = wid * 4 + q;
          f32x4 y0 = *(const LAS f32x4*)(lds + L_Y + t * (DC * 4) + lane * 32), y1 = *(const LAS f32x4*)(lds + L_Y + t * (DC * 4) + lane * 32 + 16);
          const float mean = wave_sum((y0.x + y0.y) + (y0.z + y0.w) + (y1.x + y1.y) + (y1.z + y1.w)) * (1.f / DC);
          y0 = y0 - mean; y1 = y1 - mean;
          const float var = wave_sum((y0.x * y0.x + y0.y * y0.y) + (y0.z * y0.z + y0.w * y0.w) + (y1.x * y1.x + y1.y * y1.y) + (y1.z * y1.z + y1.w * y1.w)) * (1.f / DC);
          const float rstd = 1.0f / sqrtf(var + LN_EPS);
          y0 = y0 * rstd * g0 + b0; y1 = y1 * rstd * g1 + b1;
          float z[8] = {y0.x, y0.y, y0.z, y0.w, y1.x, y1.y, y1.z, y1.w};
#pragma unroll
          for (int i = 0; i < 8; ++i) z[i] = z[i] * fsigmoid(z[i]);
          u32x4 w; w.x = cvt_pk_bf16(z[0], z[1]); w.y = cvt_pk_bf16(z[2], z[3]); w.z = cvt_pk_bf16(z[4], z[5]); w.w = cvt_pk_bf16(z[6], z[7]);
          *(GAS u32x4*)(MIX + (rowbase + t0 + t) * D + DA + 8 * lane) = w; } }
    __syncthreads();
}
}

__global__ void __launch_bounds__(NWAVES * 64, 2) hymba_fwd(Args args) {
    extern __shared__ __attribute__((aligned(16))) unsigned char lds_raw[];
    Frame F;
    F.lds = (LAS unsigned char*)lds_raw;
    F.wave = __builtin_amdgcn_readfirstlane(threadIdx.x >> 6);
    F.G = gridDim.x; { const int bx = blockIdx.x; F.vcu = (F.G % 8 == 0) ? (bx % 8) * (F.G / 8) + bx / 8 : bx; }
    unsigned char* ws = args.ws;
    F.ctl = (gu32*)(ws + WS_CTL);
    volatile LAS unsigned* MISC = (volatile LAS unsigned*)(F.lds + LDSCTL_OFF);
    for (int u = threadIdx.x; u < (LDS_BYTES - LDSCTL_OFF) / 4; u += NWAVES * 64) ((LAS unsigned*)(F.lds + LDSCTL_OFF))[u] = 0u;
    __syncthreads();
    const int lo = args.ph_lo, hi = args.ph_hi;
    const bool multi = (hi - lo) > 1;
    XcdBarrier bar; bar.bar = (unsigned*)(F.ctl + CW_BAR); bar.x = 0; bar.st = nullptr;
    if (multi) bar = xcd_barrier_post((unsigned*)(F.ctl + CW_BAR), MISC + 8);
#define IN(k) (lo <= (k) && (k) < hi)
#define BOTH(k) (IN(k) && IN((k) + 1))
#define GRID_BAR() xcd_barrier(bar)

    const float* x = args.in[0];
    bf16_t* Win_t = (bf16_t*)(ws + WS_WIN); bf16_t* Wout_t = (bf16_t*)(ws + WS_WOUT); unsigned char* Wgu8 = ws + WS_WGU; unsigned char* Wd8 = ws + WS_WD;
    bf16_t* X1 = (bf16_t*)(ws + WS_X1); bf16_t* XN = (bf16_t*)(ws + WS_XN);
    bf16_t* Qb = (bf16_t*)(ws + WS_Q); bf16_t* Kb = (bf16_t*)(ws + WS_K); bf16_t* Vb = (bf16_t*)(ws + WS_V); bf16_t* Ab = (bf16_t*)(ws + WS_A); bf16_t* Gb = (bf16_t*)(ws + WS_G);
    bf16_t* MIX = (bf16_t*)(ws + WS_MIX); unsigned char* HID8 = ws + WS_HID; unsigned char* T8 = ws + WS_XN; unsigned char* OB = ws + WS_O;
    u32x2* LIST = (u32x2*)(ws + WS_LIST); float* TOPW = (float*)(ws + WS_TOPW); bf16_t* RWB = (bf16_t*)(ws + WS_RWT);
    const int gw = F.vcu * NWAVES + F.wave, NGW = F.G * NWAVES;

    if (IN(0)) {
        const int lane = lane_id(), tid = F.wave * 64 + lane;
        LAS float* scr = (LAS float*)(F.lds + F.wave * 16896);
        constexpr int I_IN = (D / 64) * (NIN / 32), I_OUT = (D / 64) * (D / 32), I_EXP = (D / 64) * (D / 32);
        for (int it = gw; it < I_IN + I_OUT; it += NGW) {
            int r = it;
            if (r < I_IN) { const int kb = r / (NIN / 32), nb = r % (NIN / 32); transpose_item(args.in[2], NIN, kb * 64, nb * 32, Win_t + (size_t)(nb * 32) * D, D, scr, lane); continue; } r -= I_IN;
            const int kb = r / (D / 32), nb = r % (D / 32); transpose_item(args.in[8], D, kb * 64, nb * 32, Wout_t + (size_t)(nb * 32) * D, D, scr, lane);
        }
        { const GAS f32x4* gp = (const GAS f32x4*)args.in[1] + lane; f32x4 g[4];
#pragma unroll
          for (int j = 0; j < 4; ++j) g[j] = gp[64 * j];
          for (int m = gw; m < T; m += 2 * NGW) { const int m2 = m + NGW;
              const GAS f32x4* xr = (const GAS f32x4*)(x + (size_t)m * D) + lane; const GAS f32x4* xr2 = (const GAS f32x4*)(x + (size_t)(m2 < T ? m2 : m) * D) + lane; f32x4 v[4], v2[4]; float s = 0.f, s2 = 0.f;
#pragma unroll
              for (int j = 0; j < 4; ++j) { v[j] = __builtin_nontemporal_load(xr + 64 * j); v2[j] = __builtin_nontemporal_load(xr2 + 64 * j); }
#pragma unroll
              for (int j = 0; j < 4; ++j) { s += (v[j].x * v[j].x + v[j].y * v[j].y) + (v[j].z * v[j].z + v[j].w * v[j].w); s2 += (v2[j].x * v2[j].x + v2[j].y * v2[j].y) + (v2[j].z * v2[j].z + v2[j].w * v2[j].w); }
              const float r = 1.0f / sqrtf(wave_sum(s) * (1.f / D) + RMS_EPS), r2 = 1.0f / sqrtf(wave_sum(s2) * (1.f / D) + RMS_EPS);
              GAS u32x2* o8 = (GAS u32x2*)(XN + (size_t)m * D) + lane;
#pragma unroll
              for (int j = 0; j < 4; ++j) { const f32x4 y = v[j] * r * g[j]; o8[64 * j] = (u32x2){pk2(y.x, y.y), pk2(y.z, y.w)}; }
              if (m2 < T) { GAS u32x2* o82 = (GAS u32x2*)(XN + (size_t)m2 * D) + lane;
#pragma unroll
                  for (int j = 0; j < 4; ++j) { const f32x4 y = v2[j] * r2 * g[j]; o82[64 * j] = (u32x2){pk2(y.x, y.y), pk2(y.z, y.w)}; } } } }
        for (int i = blockIdx.x * 512 + tid; i < NE * D; i += F.G * 512) { const int e = i / D, k = i % D; const float v = args.in[10][k * NE + e] * args.in[9][k];
            const unsigned h = f2bf(v); RWB[i] = (bf16_t)h; RWB[NE * D + i] = (bf16_t)f2bf(v - __uint_as_float(h << 16)); }
        if (BOTH(0)) GRID_BAR();
    }

    if (IN(1)) {
        const int xg = (int)(blockIdx.x % 8), jb = (int)(blockIdx.x / 8), half = F.G / 16;
        if (jb < half) {
            pg8::DenseOrder S; S.init(T, NIN, F.G / 2, xg + 8 * jb, Win_t);
            pg8::EpiSplit E{Qb, (size_t)(WS_K - WS_Q) / 2, QSCALE};
            pg8::gemm_phase<pg8::EpiSplit, pg8::DenseOrder, true, 2>(F.lds, (const char*)XN, D, S, E);
        } else {
            const int cgw = (xg * half + (jb - half)) * NWAVES + F.wave, CNGW = (F.G / 2) * NWAVES;
        { constexpr int NIT = NE * 3 * 8 * 32;
          LAS unsigned* tile = (LAS unsigned*)(F.lds + F.wave * 4352); const int lane = lane_id();
          f32x4 v[16], w[16];
          auto src_of = [&](int r) -> const float* { const int em = r >> 8, ri = r & 255, e = em / 3, mat = em % 3, kb = ri >> 5, nb = ri & 31;
              const float* base = (mat == 0 ? args.in[12] : mat == 1 ? args.in[14] : args.in[16]) + (size_t)e * D * D;
              return base + (size_t)(kb * 128 + (lane >> 3)) * D + nb * 32 + 4 * (lane & 7); };
          int it = cgw;
          if (it < NIT) { const float* sp = src_of(it);
#pragma unroll
              for (int q = 0; q < 16; ++q) v[q] = __builtin_nontemporal_load((const GAS f32x4*)(sp + (size_t)q * 8 * D)); }
#pragma unroll 1
          for (; it < NIT; it += CNGW) {
              const int nx = it + CNGW;
              if (nx < NIT) { const float* sp = src_of(nx);
#pragma unroll
                  for (int q = 0; q < 16; ++q) w[q] = __builtin_nontemporal_load((const GAS f32x4*)(sp + (size_t)q * 8 * D)); }
              const int em = it >> 8, ri = it & 255, e = em / 3, mat = em % 3, kb = ri >> 5, nb = ri & 31, n0 = nb * 32, k0 = kb * 128;
              unsigned char* dst = (mat == 2) ? Wd8 + ((size_t)e * D + n0) * D : Wgu8 + ((size_t)e * 2048 + (size_t)(n0 >> 7) * 256 + (n0 & 127) + (mat == 1 ? 128 : 0)) * D;
#pragma unroll
              for (int q = 0; q < 16; ++q) tile[(lane & 7) * 132 + q * 8 + (lane >> 3)] = pk4_fp8(v[q].x * SC_W, v[q].y * SC_W, v[q].z * SC_W, v[q].w * SC_W);
              LDS_WAIT(); asm volatile("" ::: "memory");
              const int nq = lane >> 3, c = lane & 7;
              u32x4 r[4];
#pragma unroll
              for (int i = 0; i < 4; ++i) r[i] = *(const LAS u32x4*)(tile + nq * 132 + 16 * c + 4 * i);
              LDS_WAIT(); asm volatile("" ::: "memory");
              u32x4 o[4];
#pragma unroll
              for (int i = 0; i < 4; ++i) {
                  const unsigned x01 = __builtin_amdgcn_perm(r[i].y, r[i].x, 0x05010400u), y01 = __builtin_amdgcn_perm(r[i].y, r[i].x, 0x07030602u);
                  const unsigned x23 = __builtin_amdgcn_perm(r[i].w, r[i].z, 0x05010400u), y23 = __builtin_amdgcn_perm(r[i].w, r[i].z, 0x07030602u);
                  o[0][i] = __builtin_amdgcn_perm(x23, x01, 0x05040100u); o[1][i] = __builtin_amdgcn_perm(x23, x01, 0x07060302u);
                  o[2][i] = __builtin_amdgcn_perm(y23, y01, 0x05040100u); o[3][i] = __builtin_amdgcn_perm(y23, y01, 0x07060302u); }
#pragma unroll
              for (int j = 0; j < 4; ++j) *(GAS u32x4*)(dst + (size_t)(4 * nq + j) * D + k0 + 16 * c) = o[j];
#pragma unroll
              for (int q = 0; q < 16; ++q) v[q] = w[q];
          } }
        }
        if (BOTH(1)) GRID_BAR();
    }

    if (IN(2)) {
        for (int u = blockIdx.x; u < 2 * NH * 32; u += F.G) { const int cg = u & 31, h = (u >> 5) & 7, b = u >> 8;
            if (cg < 2) att::unit<true>(F, b, h, cg, Qb, Kb, Vb, MIX, args.in[7]); else att::unit<false>(F, b, h, cg, Qb, Kb, Vb, MIX, args.in[7]); }
        for (int u = blockIdx.x; u < T / cv::TT; u += F.G) { const int b = u / (SEQ / cv::TT), tt = u % (SEQ / cv::TT);
            cv::unit(F, b, tt, Ab, Gb, MIX, args.in[3], args.in[4], args.in[5], args.in[6]); }
        if (BOTH(2)) GRID_BAR();
    }

    if (IN(3)) {
        pg8::DenseOrder S; S.init(T, D, F.G, (int)blockIdx.x, Wout_t);
        pg8::EpiRes E{x, X1, T8, args.in[9]};
        pg8::gemm_phase<pg8::EpiRes, pg8::DenseOrder, false, 2>(F.lds, (const char*)MIX, D, S, E);
        if (BOTH(3)) {
            const int tid = F.wave * 64 + lane_id();
            for (int i = tid; i < 8192; i += 512) { const int row = i >> 7, ch = i & 127; const u32x4 v = ((const GAS u32x4*)RWB)[i];
                *(LAS u32x4*)(F.lds + row * 2048 + (((ch & ~15) | ((ch ^ row) & 15)) * 16)) = v; }
            GRID_BAR(); }
    }

    if (IN(4)) {
        const int lane = lane_id(), tid = F.wave * 64 + lane, fr = lane & 15, fq = lane >> 4;
        LAS unsigned char* rwl = F.lds;
        LAS int* hist = (LAS int*)(F.lds + XTRA_OFF);
        LAS int* baseE = hist + 32;
        LAS int* selE = baseE + 32;
        LAS int* selP = selE + 256;
        LAS float* selR = (LAS float*)(selP + 256);
        LAS float* part = selR + 64;
        const int w4 = F.wave & 3, kh = F.wave >> 2;
        const float rb0 = args.in[11][fr], rb1 = args.in[11][16 + fr];
        bool filled = false;
#pragma unroll 1
        for (int tb = blockIdx.x * 4; tb < T / 16; tb += F.G * 4) {
            const int task = tb + w4;
            const bf16_t* xrow = X1 + (size_t)(task * 16 + fr) * D + kh * 512 + 8 * fq;
            u32x4 xv[16];
#pragma unroll
            for (int ks = 0; ks < 16; ++ks) xv[ks] = *(const GAS u32x4*)(xrow + 32 * ks);
            if (!filled && !BOTH(3)) {
                for (int i = tid; i < 8192; i += 512) { const int row = i >> 7, ch = i & 127; const u32x4 v = ((const GAS u32x4*)RWB)[i];
                    *(LAS u32x4*)(rwl + row * 2048 + (((ch & ~15) | ((ch ^ row) & 15)) * 16)) = v; } }
            filled = true;
            if (tid < 32) hist[tid] = 0;
            __syncthreads();
            f32x4 acc0 = (f32x4){0.f, 0.f, 0.f, 0.f}, acc1 = acc0; float ss = 0.f;
#pragma unroll
            for (int ks = 0; ks < 16; ++ks) {
                const u32x4 hi = xv[ks];
                { const float a0 = bf_lo(hi.x), a1 = bf_hi(hi.x), a2 = bf_lo(hi.y), a3 = bf_hi(hi.y), a4 = bf_lo(hi.z), a5 = bf_hi(hi.z), a6 = bf_lo(hi.w), a7 = bf_hi(hi.w);
                  ss += (a0 * a0 + a1 * a1) + (a2 * a2 + a3 * a3) + (a4 * a4 + a5 * a5) + (a6 * a6 + a7 * a7); }
                const bf16x8 ah = __builtin_bit_cast(bf16x8, hi);
                const int ch = kh * 64 + 4 * ks + fq;
                const int o0 = fr * 2048 + (((ch & ~15) | ((ch ^ fr) & 15)) * 16), o1 = o0 + 16 * 2048;
                const bf16x8 bh0 = *(const LAS bf16x8*)(rwl + o0), bl0 = *(const LAS bf16x8*)(rwl + 65536 + o0), bh1 = *(const LAS bf16x8*)(rwl + o1), bl1 = *(const LAS bf16x8*)(rwl + 65536 + o1);
                acc0 = __builtin_amdgcn_mfma_f32_16x16x32_bf16(ah, bh0, acc0, 0, 0, 0); acc1 = __builtin_amdgcn_mfma_f32_16x16x32_bf16(ah, bh1, acc1, 0, 0, 0);
                acc0 = __builtin_amdgcn_mfma_f32_16x16x32_bf16(ah, bl0, acc0, 0, 0, 0); acc1 = __builtin_amdgcn_mfma_f32_16x16x32_bf16(ah, bl1, acc1, 0, 0, 0);
            }
            ss += __shfl_xor(ss, 16); ss += __shfl_xor(ss, 32);
            if (kh == 1) { LAS float* pp = part + w4 * 576 + lane;
#pragma unroll
                for (int q = 0; q < 4; ++q) { pp[64 * q] = acc0[q]; pp[64 * (4 + q)] = acc1[q]; }
                pp[64 * 8] = ss; }
            __syncthreads();
            if (kh == 0) { const LAS float* pp = part + w4 * 576 + lane;
#pragma unroll
                for (int q = 0; q < 4; ++q) { acc0[q] += pp[64 * q]; acc1[q] += pp[64 * (4 + q)]; }
                ss += pp[64 * 8];
                const float rrow = 1.0f / sqrtf(ss * (1.f / D) + RMS_EPS);
                float c0[4], c1[4], rt[4], tv[4][4]; int te[4][4];
#pragma unroll
                for (int q = 0; q < 4; ++q) { rt[q] = __shfl(rrow, 4 * fq + q); c0[q] = acc0[q] * rt[q] + rb0; c1[q] = acc1[q] * rt[q] + rb1; }
#pragma unroll
                for (int k = 0; k < 4; ++k) { float v[4]; int e[4];
#pragma unroll
                    for (int q = 0; q < 4; ++q) { v[q] = c0[q]; e[q] = fr; if (c1[q] > c0[q]) { v[q] = c1[q]; e[q] = 16 + fr; } }
#define RT_STEP(CTRL) _Pragma("unroll") for (int q = 0; q < 4; ++q) { const float v2 = __builtin_bit_cast(float, __builtin_amdgcn_update_dpp(0, __builtin_bit_cast(int, v[q]), CTRL, 0xf, 0xf, false)); \
                        const int e2 = __builtin_amdgcn_update_dpp(0, e[q], CTRL, 0xf, 0xf, false); if (v2 > v[q] || (v2 == v[q] && e2 < e[q])) { v[q] = v2; e[q] = e2; } }
                    RT_STEP(0x128) RT_STEP(0x124) RT_STEP(0x122) RT_STEP(0x121)
#undef RT_STEP
#pragma unroll
                    for (int q = 0; q < 4; ++q) { tv[q][k] = v[q]; te[q][k] = e[q]; if (e[q] == fr) c0[q] = -INFINITY; if (e[q] == 16 + fr) c1[q] = -INFINITY; } }
#pragma unroll
                for (int q = 0; q < 4; ++q) {
                    const float e1 = __expf(tv[q][1] - tv[q][0]), e2 = __expf(tv[q][2] - tv[q][0]), e3 = __expf(tv[q][3] - tv[q][0]); const float inv = 1.0f / (1.0f + e1 + e2 + e3);
                    const int tl = w4 * 16 + 4 * fq + q, tok = task * 16 + 4 * fq + q;
                    if (fr == 0) { *(GAS f32x4*)(TOPW + (size_t)tok * 4) = (f32x4){inv, e1 * inv, e2 * inv, e3 * inv}; selR[tl] = rt[q]; }
                    if (fr < 4) { const int em = fr == 0 ? te[q][0] : fr == 1 ? te[q][1] : fr == 2 ? te[q][2] : te[q][3];
                        selE[tl * 4 + fr] = em; selP[tl * 4 + fr] = __hip_atomic_fetch_add(&hist[em], 1, __ATOMIC_RELAXED, __HIP_MEMORY_SCOPE_WORKGROUP); }
                } }
            __syncthreads();
            if (tid < 32) baseE[tid] = (int)__hip_atomic_fetch_add(F.ctl + CW_CNT + 64 * tid, (unsigned)hist[tid], RLX_AGENT);
            __syncthreads();
            if (tid < 256) { const int e = selE[tid]; LIST[(size_t)e * LCAP + baseE[e] + selP[tid]] = (u32x2){(unsigned)((tb * 16 + (tid >> 2)) * 4 + (tid & 3)), __float_as_uint(selR[tid >> 2])}; }
            __syncthreads();
        }
        if (BOTH(4)) GRID_BAR();
    }

    LAS int* tstart = (LAS int*)(F.lds + XTRA_OFF + 14336);
    LAS int* ecnt = tstart + 64;
    LAS i32x4* ulist = (LAS i32x4*)(tstart + 128);
    if (IN(5) || IN(6)) {
        const int tid = F.wave * 64 + lane_id();
        __syncthreads();
        if (tid < 32) ecnt[tid] = (int)__hip_atomic_load(F.ctl + CW_CNT + 64 * tid, RLX_AGENT);
        __syncthreads();
        if (tid == 0) { int s = 0; for (int e = 0; e < NE; ++e) { tstart[e] = s; s += (ecnt[e] + 255) >> 8; } tstart[NE] = s; }
        __syncthreads();
        if (tid < 64) {
            const int which = tid >> 5, i = tid & 31, npn = which ? 4 : 8, nper = F.G / 8, xg = (int)(blockIdx.x % 8), j = (int)(blockIdx.x / 8);
            const int R = (nper / npn) * (i * 8 + xg) + j / npn, Rtot = tstart[NE];
            int e = 0; for (int q = 1; q < NE; ++q) e += (tstart[q] <= R) ? 1 : 0;
            i32x4 u = (i32x4){0, 0, 0, 0};
            if (R < Rtot) { const int pm = R - tstart[e], rem = ecnt[e] - pm * 256; u = (i32x4){e, pm, j % npn, rem < 256 ? rem : 256}; }
            ulist[which * 32 + i] = u; }
        __syncthreads();
    }

    if (IN(5)) {
        pg8::MoeOrder S{ulist, LIST, (const char*)Wgu8, 8, 2048, 2, args.in[13], args.in[15], 128};
        pg8::EpiGU E{HID8};
        pg8::gemm_phase<pg8::EpiGU, pg8::MoeOrder, true, 1>(F.lds, (const char*)T8, D, S, E);
        if (BOTH(5)) GRID_BAR();
    }

    if (IN(6)) {
        pg8::MoeOrder S{ulist + 32, LIST, (const char*)Wd8, 4, 1024, 0, args.in[17], args.in[17], 256};
        pg8::EpiDown E{OB};
        pg8::gemm_phase<pg8::EpiDown, pg8::MoeOrder, true, 1>(F.lds, (const char*)HID8, D, S, E);
        if (BOTH(6)) GRID_BAR();
    }

    if (IN(7)) {
        const int lane = lane_id();
        const GAS f32x4* gp = (const GAS f32x4*)args.in[18] + lane; f32x4 g[4];
#pragma unroll
        for (int j = 0; j < 4; ++j) g[j] = gp[64 * j];
        unsigned bad = __hip_atomic_load(F.ctl + CW_BAR + XB_TMO, RLX_AGENT);
        for (int m = gw; m < T; m += NGW) {
            const GAS u32x2* xr = (const GAS u32x2*)(X1 + (size_t)m * D) + lane; f32x4 v[4];
#pragma unroll
            for (int j = 0; j < 4; ++j) { const u32x2 w = __builtin_nontemporal_load(xr + 64 * j); v[j] = (f32x4){bf_lo(w.x), bf_hi(w.x), bf_lo(w.y), bf_hi(w.y)}; }
            const f32x4 tw = *(const GAS f32x4*)(TOPW + (size_t)m * 4);
#pragma unroll
            for (int k = 0; k < 4; ++k) { const GAS unsigned* orow = (const GAS unsigned*)(OB + ((size_t)m * 4 + k) * D) + lane; const float wk = tw[k] * (1.0f / SC_O);
#pragma unroll
                for (int j = 0; j < 4; ++j) { const unsigned w = __builtin_nontemporal_load(orow + 64 * j); const f32x2 lo = __builtin_amdgcn_cvt_pk_f32_fp8((int)w, false), hi = __builtin_amdgcn_cvt_pk_f32_fp8((int)w, true);
                    v[j].x += wk * lo.x; v[j].y += wk * lo.y; v[j].z += wk * hi.x; v[j].w += wk * hi.y; } }
            float s = 0.f;
#pragma unroll
            for (int j = 0; j < 4; ++j) s += (v[j].x * v[j].x + v[j].y * v[j].y) + (v[j].z * v[j].z + v[j].w * v[j].w);
            float r = 1.0f / sqrtf(wave_sum(s) * (1.f / D) + RMS_EPS);
            if (bad) r = __builtin_nanf("");
            GAS f32x4* o = (GAS f32x4*)(args.out + (size_t)m * D) + lane;
#pragma unroll
            for (int j = 0; j < 4; ++j) __builtin_nontemporal_store(v[j] * r * g[j], o + 64 * j);
        }
    }
#undef IN
#undef BOTH
#undef GRID_BAR
}

#ifndef MK_N_LAUNCHES
#define MK_N_LAUNCHES 1
#endif
extern "C" void kernel_launch(void* const* d_in, const int* in_sizes, int n_in, void* d_out, int out_size, void* d_ws, size_t ws_size, hipStream_t stream) {
    static int grid = 0;
    if (grid == 0) {
        if (n_in != 19 || in_sizes[0] != T * D || out_size != T * D || ws_size < WS_END) { fprintf(stderr, "kernel_launch: unexpected shapes (n_in %d, in0 %d, out %d, ws %zu); nothing launched\n", n_in, n_in > 0 ? in_sizes[0] : -1, out_size, ws_size); grid = -1; return; }
        int dev = 0, cus = 0, per_cu = 0;
        if (hipGetDevice(&dev) != hipSuccess || hipDeviceGetAttribute(&cus, hipDeviceAttributeMultiprocessorCount, dev) != hipSuccess) { fprintf(stderr, "kernel_launch: device query failed\n"); grid = -1; return; }
        if (hipFuncSetAttribute((const void*)hymba_fwd, hipFuncAttributeMaxDynamicSharedMemorySize, LDS_BYTES) != hipSuccess) { fprintf(stderr, "kernel_launch: hipFuncSetAttribute failed\n"); grid = -1; return; }
        if (hipOccupancyMaxActiveBlocksPerMultiprocessor(&per_cu, (const void*)hymba_fwd, NWAVES * 64, LDS_BYTES) != hipSuccess || per_cu < 1) fprintf(stderr, "kernel_launch: note: occupancy query reports %d workgroups per CU\n", per_cu);
        (void)hipGetLastError();
        grid = (cus / 64) * 64; if (grid > 256) grid = 256;
        if (grid < 64) { fprintf(stderr, "kernel_launch: %d CUs: unsupported\n", cus); grid = -1; return; }
    }
    if (grid < 0) return;
    if (hipMemsetAsync((char*)d_ws + WS_CTL, 0, CTL_ZERO_BYTES, stream) != hipSuccess) { fprintf(stderr, "kernel_launch: memset failed\n"); return; }
    Args a{};
    for (int i = 0; i < 19; ++i) a.in[i] = (const float*)d_in[i];
    a.out = (float*)d_out; a.ws = (unsigned char*)d_ws;
    constexpr int NPH = 8;
    if (MK_N_LAUNCHES == 1) { a.ph_lo = 0; a.ph_hi = NPH; hipLaunchKernelGGL(hymba_fwd, dim3(grid), dim3(NWAVES * 64), LDS_BYTES, stream, a); }
    else for (int p = 0; p < NPH; ++p) { a.ph_lo = p; a.ph_hi = p + 1; hipLaunchKernelGGL(hymba_fwd, dim3(grid), dim3(NWAVES * 64), LDS_BYTES, stream, a); }
    const hipError_t le = hipPeekAtLastError();
    if (le != hipSuccess) fprintf(stderr, "kernel_launch: launch failed: %s\n", hipGetErrorName(le));
}
```

```cpp
#include <hip/hip_runtime.h>
#include <cstdio>
#include <cstdint>

#define GAS __attribute__((address_space(1)))
#define LAS __attribute__((address_space(3)))
typedef unsigned short bf16_t;
typedef short bf16x8 __attribute__((ext_vector_type(8)));
typedef short s16x4 __attribute__((ext_vector_type(4)));
typedef float f32x2 __attribute__((ext_vector_type(2)));
typedef float f32x4 __attribute__((ext_vector_type(4)));
typedef float f32x16 __attribute__((ext_vector_type(16)));
typedef unsigned u32x2 __attribute__((ext_vector_type(2)));
typedef unsigned u32x4 __attribute__((ext_vector_type(4)));
typedef int i32x4 __attribute__((ext_vector_type(4)));
typedef int i32x8 __attribute__((ext_vector_type(8)));
typedef GAS unsigned gu32;
#define RLX_AGENT __ATOMIC_RELAXED, __HIP_MEMORY_SCOPE_AGENT
#define LDS_WAIT() asm volatile("s_waitcnt lgkmcnt(0)" ::: "memory")
#define VM_WAIT() asm volatile("s_waitcnt vmcnt(0)" ::: "memory")

constexpr int T = 16384, SEQ = 8192, D = 1024, NIN = 2560, DA = 512, NH = 8, HD = 64, DC = 512, CW = 31;
constexpr int NE = 32, TOPK = 4, NP = T * TOPK, LCAP = 16384, NREL = 192;
constexpr float RMS_EPS = 1e-5f, LN_EPS = 1e-5f, LOG2E = 1.4426950408889634f;
constexpr float QSCALE = 0.125f * LOG2E;
constexpr float SC_T = 16.0f, SC_W = 256.0f, SC_H = 4.0f, SC_O = 32.0f;

constexpr size_t MiB = 1u << 20;
constexpr size_t WS_CTL = 0, CTL_ZERO_BYTES = 64 * 1024;
constexpr size_t WS_WIN = 1 * MiB, WS_WOUT = 6 * MiB, WS_WGU = 8 * MiB, WS_WD = 136 * MiB, WS_X1 = 200 * MiB, WS_XN = 264 * MiB;
constexpr size_t WS_Q = 296 * MiB, WS_K = 312 * MiB, WS_V = 328 * MiB, WS_A = 344 * MiB, WS_G = 360 * MiB, WS_MIX = 376 * MiB;
constexpr size_t WS_HID = 296 * MiB;
constexpr size_t WS_O = WS_WGU;
constexpr size_t WS_LIST = 424 * MiB, WS_TOPW = 428 * MiB, WS_RWT = 429 * MiB, WS_END = 430 * MiB;
constexpr int CW_TMO = 0, CW_BAR = 4096, CW_CNT = 8192;

constexpr int RING_BYTES = 131072, XTRA_OFF = RING_BYTES, LDS_BYTES = 147456, LDSCTL_OFF = LDS_BYTES - 512;
constexpr int NWAVES = 8;

__device__ __forceinline__ unsigned f2bf(float f) { unsigned u = __builtin_bit_cast(unsigned, f); return (u + 0x7fffu + ((u >> 16) & 1u)) >> 16; }
__device__ __forceinline__ unsigned pk2(float lo, float hi) { return f2bf(lo) | (f2bf(hi) << 16); }
__device__ __forceinline__ unsigned cvt_pk_bf16(float lo, float hi) { unsigned r; asm volatile("v_cvt_pk_bf16_f32 %0, %1, %2" : "=v"(r) : "v"(lo), "v"(hi)); return r; }
__device__ __forceinline__ float clamp448(float v) { return fminf(fmaxf(v, -448.0f), 448.0f); }
__device__ __forceinline__ unsigned pk4_fp8(float a, float b, float c, float d) {
    int r = __builtin_amdgcn_cvt_pk_fp8_f32(clamp448(a), clamp448(b), 0, false);
    r = __builtin_amdgcn_cvt_pk_fp8_f32(clamp448(c), clamp448(d), r, true);
    return (unsigned)r;
}
__device__ __forceinline__ unsigned pk4_fp8_nc(float a, float b, float c, float d) {
    int r = __builtin_amdgcn_cvt_pk_fp8_f32(a, b, 0, false);
    r = __builtin_amdgcn_cvt_pk_fp8_f32(c, d, r, true);
    return (unsigned)r;
}
__device__ __forceinline__ float bf_lo(unsigned w) { return __uint_as_float(w << 16); }
__device__ __forceinline__ float bf_hi(unsigned w) { return __uint_as_float(w & 0xffff0000u); }
__device__ __forceinline__ float fsigmoid(float z) { return __builtin_amdgcn_rcpf(1.0f + __builtin_amdgcn_exp2f(-z * LOG2E)); }
__device__ __forceinline__ int lane_id() { int l; asm volatile("v_mbcnt_lo_u32_b32 %0, -1, 0\n\tv_mbcnt_hi_u32_b32 %0, -1, %0" : "=v"(l)); return l; }
__device__ __forceinline__ float wave_sum(float v) {
#define WS_DPP(x, ctrl) __builtin_bit_cast(float, __builtin_amdgcn_update_dpp(0, __builtin_bit_cast(int, (x)), (ctrl), 0xf, 0xf, false))
    v += WS_DPP(v, 0xB1);
    v += WS_DPP(v, 0x4E);
    v += WS_DPP(v, 0x124);
    v += WS_DPP(v, 0x128);
#undef WS_DPP
    const float r0 = __builtin_bit_cast(float, __builtin_amdgcn_readlane(__builtin_bit_cast(int, v), 0)), r1 = __builtin_bit_cast(float, __builtin_amdgcn_readlane(__builtin_bit_cast(int, v), 16));
    const float r2 = __builtin_bit_cast(float, __builtin_amdgcn_readlane(__builtin_bit_cast(int, v), 32)), r3 = __builtin_bit_cast(float, __builtin_amdgcn_readlane(__builtin_bit_cast(int, v), 48));
    return (r0 + r1) + (r2 + r3);
}

namespace pg8 {
constexpr int BM = 256, BK = 64, HALF = 128, HTB = HALF * BK * 2, STAGE_BYTES = 8 * HTB;
__device__ __forceinline__ int lds_byte(int r, int c) { const int st = (r >> 4) * 2 + (c >> 5), rr = r & 15, cc = c & 31, ob = rr * 64 + cc * 2; return st * 1024 + (ob ^ (((ob >> 9) & 1) << 5)); }
__device__ __forceinline__ void stage_rc(int b, int& R, int& C) { const int st = b / 1024, sb = b % 1024, swz = sb ^ (((sb >> 9) & 1) << 5); R = (st >> 1) * 16 + swz / 64; C = (st & 1) * 32 + (swz % 64) / 2; }
__device__ __forceinline__ int perm32(int rho) { const int n = rho >> 4, i = rho & 15; return 8 * (i >> 2) + 4 * n + (i & 3); }

struct Unit { int pm, pn, e, nv; };
template <int N> __device__ __forceinline__ void wait_vm() { asm volatile("s_waitcnt vmcnt(%0)" :: "n"(N) : "memory"); }
template <int NFRESH, int NSTEADY> __device__ __forceinline__ void wait_vm_sel(int fresh) {
    asm volatile("s_cmp_eq_u32 %0, 0\n\ts_cbranch_scc1 .Lwvs_a_%=\n\ts_waitcnt vmcnt(%1)\n\ts_branch .Lwvs_b_%=\n.Lwvs_a_%=:\n\ts_waitcnt vmcnt(%2)\n.Lwvs_b_%=:" :: "s"(__builtin_amdgcn_readfirstlane(fresh)), "n"(NFRESH), "n"(NSTEADY) : "scc", "memory"); }

template <class Epi, class Sched, bool ALIGN_EPI, int ESZ>
__device__ __forceinline__ void gemm_phase(LAS unsigned char* lds, const char* Abase, const int K, const Sched& S, const Epi& E) {
    const int wid = __builtin_amdgcn_readfirstlane(threadIdx.x >> 6), lane = lane_id(), tid = wid * 64 + lane, wr = wid >> 2, wc = wid & 3, fr = lane & 15, fq = lane >> 4;
    const int RB = K * ESZ, nt = RB / 128;
    unsigned voffB[2];
#pragma unroll
    for (int i = 0; i < 2; ++i) { int R, C; stage_rc(tid * 16 + i * 8192, R, C); const int Rb = Epi::PERM ? ((R & ~31) + perm32(R & 31)) : R; voffB[i] = (unsigned)(Rb * RB + 2 * C); }
    const size_t kstep = (size_t)(BK * 2);
    const size_t hstep = (size_t)HALF * RB;
    const unsigned ldsw = (unsigned)wid * 1024u;
    const int aoff = lds_byte(wr * 64 + fr, fq * 8), boff = lds_byte(wc * 32 + fr, fq * 8);
#define PG8_SA(b, h) (((b) * 2 + (h)) * HTB)
#define PG8_SB(b, h) ((4 + (b) * 2 + (h)) * HTB)
#define PG8_STAGE(bufoff, gbase, voff) do { _Pragma("unroll") for (int _i = 0; _i < 2; ++_i) \
        __builtin_amdgcn_global_load_lds((const unsigned*)((const char*)(gbase) + (voff)[_i]), (LAS unsigned*)(lds + (bufoff) + ldsw + _i * 8192), 16, 0, 0); } while (0)
#define PG8_LD16(off) (*(const LAS i32x4*)(lds + (off)))
#define PG8_LDA(dst, b, h) do { _Pragma("unroll") for (int m = 0; m < 4; ++m) { const i32x4 _x = PG8_LD16(PG8_SA(b, h) + aoff + m * 2048), _y = PG8_LD16(PG8_SA(b, h) + aoff + m * 2048 + 1024); dst[m] = __builtin_shufflevector(_x, _y, 0, 1, 2, 3, 4, 5, 6, 7); } } while (0)
#define PG8_LDB(dst, b, h) do { _Pragma("unroll") for (int n = 0; n < 2; ++n) { const i32x4 _x = PG8_LD16(PG8_SB(b, h) + boff + n * 2048), _y = PG8_LD16(PG8_SB(b, h) + boff + n * 2048 + 1024); dst[n] = __builtin_shufflevector(_x, _y, 0, 1, 2, 3, 4, 5, 6, 7); } } while (0)
#define PG8_MMA(ai, bj, At, Bt) do { __builtin_amdgcn_s_setprio(1); _Pragma("unroll") for (int m = 0; m < 4; ++m) _Pragma("unroll") for (int n = 0; n < 2; ++n) _Pragma("unroll") for (int k = 0; k < 2; ++k) \
        acc[ai][bj][m][n] = __builtin_amdgcn_mfma_f32_16x16x32_bf16(PG8_HALF(Bt[n], k), PG8_HALF(At[m], k), acc[ai][bj][m][n], 0, 0, 0); __builtin_amdgcn_s_setprio(0); } while (0)
#define PG8_HALF(v, k) __builtin_bit_cast(bf16x8, (k) == 0 ? __builtin_shufflevector((v), (v), 0, 1, 2, 3) : __builtin_shufflevector((v), (v), 4, 5, 6, 7))
#define PG8_MMA8(ai, bj, At, Bt) do { __builtin_amdgcn_s_setprio(1); _Pragma("unroll") for (int m = 0; m < 4; ++m) _Pragma("unroll") for (int n = 0; n < 2; ++n) \
        acc[ai][bj][m][n] = __builtin_amdgcn_mfma_scale_f32_16x16x128_f8f6f4(Bt[n], At[m], acc[ai][bj][m][n], 0, 0, 0, 0, 0, 0);     __builtin_amdgcn_s_setprio(0); } while (0)
#define PG8_MM(ai, bj, At, Bt) do { if constexpr (ESZ == 2) PG8_MMA(ai, bj, At, Bt); else PG8_MMA8(ai, bj, At, Bt); } while (0)
#define PG8_WAIT_V(n) asm volatile("s_waitcnt vmcnt(" #n ")" ::: "memory")
#define PG8_WAIT_L(n) asm volatile("s_waitcnt lgkmcnt(" #n ")" ::: "memory")
#define PG8_BAR __builtin_amdgcn_s_barrier()
#define PG8_SCHED __builtin_amdgcn_sched_barrier(0)
    Unit cur, nxt; int ui = 0;
    if (!S.next(0, cur)) return;
    f32x4 acc[2][2][4][2];
#pragma unroll
    for (int a = 0; a < 2; ++a)
#pragma unroll
        for (int b = 0; b < 2; ++b)
#pragma unroll
            for (int m = 0; m < 4; ++m)
#pragma unroll
                for (int n = 0; n < 2; ++n) acc[a][b][m][n] = (f32x4){0.f, 0.f, 0.f, 0.f};
    i32x8 At[4], B0[2], B1[2];
    unsigned vA0[2], vA1[2];
    LAS u32x4* const vslot = (LAS u32x4*)(lds + STAGE_BYTES) + tid;
    LAS u32x2* const rowtab = (LAS u32x2*)(lds + STAGE_BYTES + 8192);
    LAS f32x4* const biastab = (LAS f32x4*)(lds + STAGE_BYTES + 8192 + 4096);
    if constexpr (Sched::GATHER) {
        if (tid < 256) rowtab[tid] = *S.entry_ptr(cur, tid);
        else if (tid < 320) biastab[tid - 256] = *(const f32x4*)S.bias_ptr(cur, tid - 256);
        __syncthreads();
        S.a_off_tab(rowtab, cur.nv, tid, RB, vA0, vA1);
    } else S.a_off(cur, tid, RB, vA0, vA1);
    const char* cB = S.b_ptr(cur, RB);
    const char* cA = Abase;
    PG8_STAGE(PG8_SB(0, 0), cB, voffB); PG8_STAGE(PG8_SB(0, 1), cB + hstep, voffB); PG8_STAGE(PG8_SA(0, 0), cA, vA0); PG8_STAGE(PG8_SA(0, 1), cA, vA1);
    if (wr == 1) PG8_BAR;
    PG8_WAIT_V(2); PG8_BAR;
    PG8_STAGE(PG8_SB(1, 0), cB + kstep, voffB); PG8_STAGE(PG8_SA(1, 0), cA + kstep, vA0); PG8_STAGE(PG8_SB(1, 1), cB + hstep + kstep, voffB);
    PG8_WAIT_V(6); PG8_BAR;
    for (;;) {
        const bool has_next = S.next(ui + 1, nxt);
        const char* nB = cB;
        const int par = ui & 1;
        if constexpr (Sched::GATHER) {
            if (has_next) nB = S.b_ptr(nxt, RB);
            else *vslot = (u32x4){vA0[0], vA0[1], vA1[0], vA1[1]};
        } else {
            unsigned n0[2] = {vA0[0], vA0[1]}, n1[2] = {vA1[0], vA1[1]};
            if (has_next) { S.a_off(nxt, tid, RB, n0, n1); nB = S.b_ptr(nxt, RB); }
            *vslot = (u32x4){n0[0], n0[1], n1[0], n1[1]};
        }
#pragma clang loop unroll(disable)
        for (int t = 0; t < nt; t += 2) {
            const bool last = (t == nt - 2);
            const int fresh = ((ui > 0) && (t == 0)) ? 1 : 0;
            if constexpr (Sched::GATHER) {
                if (has_next && t == 2) { const int l2 = lane_id();
                    if (wid < 2) __builtin_amdgcn_global_load_lds((const unsigned*)((const char*)S.entry_ptr(nxt, 0) + (wid * 64 + l2) * 16), (LAS unsigned*)((LAS char*)(rowtab + (par ^ 1) * 256) + wid * 1024), 16, 0, 0);
                    if (wid == 4) __builtin_amdgcn_global_load_lds((const unsigned*)S.bias_ptr(nxt, l2), (LAS unsigned*)(biastab + (par ^ 1) * 64), 16, 0, 0); }
                if (has_next && t == 4) { unsigned n0[2], n1[2]; const int t2 = wid * 64 + lane_id(); S.a_off_tab_nowait(rowtab + (par ^ 1) * 256, nxt.nv, t2, RB, n0, n1); ((LAS u32x4*)(lds + STAGE_BYTES))[t2] = (u32x4){n0[0], n0[1], n1[0], n1[1]}; }
            }
            const char* a1 = cA + (size_t)(t + 1) * kstep;
            const char* a2 = last ? cA : cA + (size_t)(t + 2) * kstep; const char* b2 = last ? nB : cB + (size_t)(t + 2) * kstep;
            const char* a3 = a2 + kstep; const char* b3 = b2 + kstep;
            PG8_LDB(B0, 0, 0); PG8_LDB(B1, 0, 1); PG8_SCHED; PG8_LDA(At, 0, 0); PG8_STAGE(PG8_SA(1, 1), a1, vA1);
            if (last) { const u32x4 nv = *vslot; vA0[0] = nv.x; vA0[1] = nv.y; vA1[0] = nv.z; vA1[1] = nv.w; }
            wait_vm_sel<8 + Epi::NSTORE, 8>(fresh); PG8_WAIT_L(0); PG8_BAR; PG8_MM(0, 0, At, B0); PG8_MM(0, 1, At, B1); PG8_BAR; PG8_SCHED;
            PG8_LDA(At, 0, 1); PG8_STAGE(PG8_SB(0, 0), b2, voffB); PG8_STAGE(PG8_SB(0, 1), b2 + hstep, voffB); PG8_STAGE(PG8_SA(0, 0), a2, vA0);
            wait_vm_sel<8 + Epi::NSTORE, 8>(fresh); PG8_WAIT_L(0); PG8_BAR; PG8_MM(1, 0, At, B0); PG8_MM(1, 1, At, B1); PG8_BAR; PG8_SCHED;
            PG8_LDB(B0, 1, 0); PG8_LDB(B1, 1, 1); PG8_SCHED; PG8_LDA(At, 1, 0); PG8_STAGE(PG8_SA(0, 1), a2, vA1);
            PG8_WAIT_V(8); PG8_WAIT_L(0); PG8_BAR; PG8_MM(0, 0, At, B0); PG8_MM(0, 1, At, B1); PG8_BAR; PG8_SCHED;
            PG8_LDA(At, 1, 1); PG8_STAGE(PG8_SB(1, 0), b3, voffB); PG8_STAGE(PG8_SB(1, 1), b3 + hstep, voffB); PG8_STAGE(PG8_SA(1, 0), a3, vA0);
            PG8_WAIT_V(8); PG8_WAIT_L(0); PG8_BAR; PG8_MM(1, 0, At, B0); PG8_MM(1, 1, At, B1); PG8_BAR; PG8_SCHED;
        }
        if constexpr (ALIGN_EPI) { if (wr == 0) PG8_BAR; }
        if constexpr (Sched::GATHER) { int zofs; asm volatile("s_mov_b32 %0, 0" : "=s"(zofs));
            E(acc, cur, wr, wc, fr, fq, rowtab + par * 256 + zofs, biastab + par * 64 + zofs); } else E(acc, cur, wr, wc, fr, fq);
        if (!has_next) break;
#pragma unroll
        for (int a = 0; a < 2; ++a)
#pragma unroll
            for (int b = 0; b < 2; ++b)
#pragma unroll
                for (int m = 0; m < 4; ++m)
#pragma unroll
                    for (int n = 0; n < 2; ++n) acc[a][b][m][n] = (f32x4){0.f, 0.f, 0.f, 0.f};
        cur = nxt; cB = nB; ++ui;
        if constexpr (ALIGN_EPI) { if (wr == 1) PG8_BAR; }
    }
    PG8_WAIT_V(0);
    if constexpr (!ALIGN_EPI) { if (wr == 0) PG8_BAR; }
    PG8_BAR;
#undef PG8_SA
#undef PG8_SB
#undef PG8_STAGE
#undef PG8_LDA
#undef PG8_LDB
#undef PG8_MMA
#undef PG8_MMA8
#undef PG8_MM
#undef PG8_HALF
#undef PG8_LD16
#undef PG8_WAIT_V
#undef PG8_WAIT_L
#undef PG8_BAR
#undef PG8_SCHED
}

struct DenseOrder {
    static constexpr bool GATHER = false;
    int nM, nN, nwg, G, c; const char* Bt;
    __device__ __forceinline__ void init(int M, int N, int G_, int c_, const void* Bt_) { nM = M / BM; nN = N / BM; nwg = nM * nN; G = G_; c = c_; Bt = (const char*)Bt_; }
    __device__ __forceinline__ bool next(int i, Unit& u) const {
        const long L = (long)i * G + c; if (L >= nwg) return false;
        int wgid = (int)L; { const int q = nwg / 8, r = nwg % 8, xcd = wgid % 8, off = wgid / 8; wgid = (xcd < r ? xcd * (q + 1) : r * (q + 1) + (xcd - r) * q) + off; }
        const int nig = 8 * nN, gid = wgid / nig, fm = gid * 8, gsz = (nM - fm) < 8 ? (nM - fm) : 8;
        u.pm = fm + ((wgid % nig) % gsz); u.pn = (wgid % nig) / gsz; u.e = 0; u.nv = 256; return true;
    }
    __device__ __forceinline__ const char* b_ptr(const Unit& u, int RB) const { return Bt + (size_t)u.pn * (256 * (size_t)RB); }
    __device__ __forceinline__ void a_off(const Unit& u, int tid, int RB, unsigned (&v0)[2], unsigned (&v1)[2]) const {
#pragma unroll
        for (int i = 0; i < 2; ++i) { int R, C; stage_rc(tid * 16 + i * 8192, R, C); v0[i] = (unsigned)((u.pm * 256 + R) * RB + 2 * C); v1[i] = (unsigned)((u.pm * 256 + 128 + R) * RB + 2 * C); }
    }
};
struct MoeOrder {
    static constexpr bool GATHER = true;
    const LAS i32x4* ul;
    const u32x2* list;
    const char* Bt; int npn, nrowsB, shiftA;
    const float* bias0; const float* bias1; int bcols;
    __device__ __forceinline__ bool next(int i, Unit& u) const {
        if (i >= 32) return false;
        const i32x4 v = ul[i];
        u.e = __builtin_amdgcn_readfirstlane(v.x); u.pm = __builtin_amdgcn_readfirstlane(v.y); u.pn = __builtin_amdgcn_readfirstlane(v.z); u.nv = __builtin_amdgcn_readfirstlane(v.w);
        return u.nv > 0;
    }
    __device__ __forceinline__ const char* b_ptr(const Unit& u, int RB) const { return Bt + ((size_t)u.e * nrowsB + (size_t)u.pn * 256) * (size_t)RB; }
    __device__ __forceinline__ const u32x2* entry_ptr(const Unit& u, int t) const { return list + (size_t)u.e * LCAP + u.pm * 256 + t; }
    __device__ __forceinline__ const float* bias_ptr(const Unit& u, int i) const {
        return (bcols == 128) ? ((i < 32 ? bias0 : bias1) + (size_t)u.e * D + u.pn * 128 + 4 * (i & 31)) : (bias0 + (size_t)u.e * D + u.pn * 256 + 4 * i); }
    __device__ __forceinline__ void a_off_tab(const LAS u32x2* rt, int nv, int tid, int RB, unsigned (&v0)[2], unsigned (&v1)[2]) const {
#pragma unroll
        for (int i = 0; i < 2; ++i) { int R, C; stage_rc(tid * 16 + i * 8192, R, C);
            const int p0 = (int)rt[R < nv ? R : 0].x >> shiftA, p1 = (int)rt[(128 + R) < nv ? (128 + R) : 0].x >> shiftA;
            v0[i] = (unsigned)(p0 * RB + 2 * C); v1[i] = (unsigned)(p1 * RB + 2 * C); }
    }
    __device__ __forceinline__ void a_off_tab_nowait(const LAS u32x2* rt, int nv, int tid, int RB, unsigned (&v0)[2], unsigned (&v1)[2]) const {
        unsigned pr[4]; int Cc[2];
#pragma unroll
        for (int i = 0; i < 2; ++i) { int R, C; stage_rc(tid * 16 + i * 8192, R, C); Cc[i] = C;
            const unsigned a0 = (unsigned)(uintptr_t)(rt + (R < nv ? R : 0)), a1 = (unsigned)(uintptr_t)(rt + ((128 + R) < nv ? (128 + R) : 0));
            asm volatile("ds_read_b32 %0, %1" : "=v"(pr[2 * i]) : "v"(a0) : "memory"); asm volatile("ds_read_b32 %0, %1" : "=v"(pr[2 * i + 1]) : "v"(a1) : "memory"); }
        asm volatile("s_waitcnt lgkmcnt(0)" : "+v"(pr[0]), "+v"(pr[1]), "+v"(pr[2]), "+v"(pr[3]) :: "memory");
#pragma unroll
        for (int i = 0; i < 2; ++i) { v0[i] = (unsigned)(((int)pr[2 * i] >> shiftA) * RB + 2 * Cc[i]); v1[i] = (unsigned)(((int)pr[2 * i + 1] >> shiftA) * RB + 2 * Cc[i]); }
    }
};

struct EpiSplit {
    static constexpr bool PERM = true; static constexpr int NSTORE = 16;
    bf16_t* O; size_t split_stride; float scale0;
    __device__ __forceinline__ void operator()(const f32x4 (&acc)[2][2][4][2], const Unit& u, int wr, int wc, int fr, int fq) const {
        const int row0 = u.pm * BM + wr * 64 + fr; int colt = u.pn * BM; const int t = colt / 512; bf16_t* base = O + (size_t)t * split_stride; colt -= t * 512;
        const float sc = (t == 0) ? scale0 : 1.f;
        const int col0 = colt + wc * 32 + 8 * fq;
#pragma unroll
        for (int ai = 0; ai < 2; ++ai)
#pragma unroll
            for (int m = 0; m < 4; ++m) { bf16_t* rowp = base + (size_t)(row0 + ai * HALF + m * 16) * 512 + col0;
#pragma unroll
                for (int bj = 0; bj < 2; ++bj) { const f32x4 v0 = acc[ai][bj][m][0] * sc, v1 = acc[ai][bj][m][1] * sc;
                    u32x4 w; w.x = cvt_pk_bf16(v0[0], v0[1]); w.y = cvt_pk_bf16(v0[2], v0[3]); w.z = cvt_pk_bf16(v1[0], v1[1]); w.w = cvt_pk_bf16(v1[2], v1[3]);
                    *(u32x4*)(rowp + bj * HALF) = w; } }
    }
};
struct EpiRes {
    static constexpr bool PERM = true; static constexpr int NSTORE = 0;
    const float* base; bf16_t* out; unsigned char* t8; const float* gain;
    __device__ __forceinline__ void operator()(const f32x4 (&acc)[2][2][4][2], const Unit& u, int wr, int wc, int fr, int fq) const {
        const int row0 = u.pm * BM + wr * 64 + fr, col0 = u.pn * BM + wc * 32 + 8 * fq;
        f32x4 gv[2][2];
#pragma unroll
        for (int bj = 0; bj < 2; ++bj)
#pragma unroll
            for (int n = 0; n < 2; ++n) gv[bj][n] = *(const f32x4*)(gain + col0 + bj * HALF + 4 * n) * SC_T;
#pragma unroll
        for (int ai = 0; ai < 2; ++ai)
#pragma unroll
            for (int m = 0; m < 4; ++m) { const size_t off = (size_t)(row0 + ai * HALF + m * 16) * D + col0;
#pragma unroll
                for (int bj = 0; bj < 2; ++bj) { const f32x4 v0 = __builtin_nontemporal_load((const f32x4*)(base + off + bj * HALF)) + acc[ai][bj][m][0], v1 = __builtin_nontemporal_load((const f32x4*)(base + off + bj * HALF + 4)) + acc[ai][bj][m][1];
                    *(u32x4*)(out + off + bj * HALF) = (u32x4){cvt_pk_bf16(v0[0], v0[1]), cvt_pk_bf16(v0[2], v0[3]), cvt_pk_bf16(v1[0], v1[1]), cvt_pk_bf16(v1[2], v1[3])};
                    const f32x4 s0 = v0 * gv[bj][0], s1 = v1 * gv[bj][1];
                    *(u32x2*)(t8 + off + bj * HALF) = (u32x2){pk4_fp8(s0[0], s0[1], s0[2], s0[3]), pk4_fp8(s1[0], s1[1], s1[2], s1[3])}; } }
    }
};
struct EpiGU {
    static constexpr bool PERM = true; static constexpr int NSTORE = 8;
    unsigned char* hid;
    __device__ __forceinline__ void operator()(const f32x4 (&acc)[2][2][4][2], const Unit& u, int wr, int wc, int fr, int fq, const LAS u32x2* rt, const LAS f32x4* bt) const {
        const int hc = u.pn * 128 + wc * 32 + 8 * fq;
        const f32x4 g0 = bt[8 * wc + 2 * fq], g1 = bt[8 * wc + 2 * fq + 1], u0 = bt[32 + 8 * wc + 2 * fq], u1 = bt[32 + 8 * wc + 2 * fq + 1];
        constexpr float inv = 1.0f / (SC_T * SC_W);
#pragma unroll
        for (int ai = 0; ai < 2; ++ai)
#pragma unroll
            for (int m = 0; m < 4; ++m) { const int r = ai * HALF + wr * 64 + m * 16 + fr;
                const u32x2 en = rt[r]; const float rs = __uint_as_float(en.y) * inv;
                f32x2 h[4];
#pragma unroll
                for (int n = 0; n < 2; ++n)
#pragma unroll
                    for (int x = 0; x < 2; ++x) { const f32x4 ga = acc[ai][0][m][n], ua = acc[ai][1][m][n], gb = n ? g1 : g0, ub = n ? u1 : u0;
                        f32x2 g = (f32x2){ga[2 * x], ga[2 * x + 1]} * rs + (f32x2){gb[2 * x], gb[2 * x + 1]}, up = (f32x2){ua[2 * x], ua[2 * x + 1]} * rs + (f32x2){ub[2 * x], ub[2 * x + 1]};
                        g.x = fminf(g.x, 7.0f); g.y = fminf(g.y, 7.0f); up.x = __builtin_amdgcn_fmed3f(up.x, -7.0f, 7.0f); up.y = __builtin_amdgcn_fmed3f(up.y, -7.0f, 7.0f);
                        const f32x2 z = g * (-1.702f * LOG2E); f32x2 t; t.x = __builtin_amdgcn_exp2f(z.x); t.y = __builtin_amdgcn_exp2f(z.y); t = t + 1.0f;
                        f32x2 sg; sg.x = __builtin_amdgcn_rcpf(t.x); sg.y = __builtin_amdgcn_rcpf(t.y);
                        h[n * 2 + x] = (up * SC_H + SC_H) * (g * sg); }
                u32x2 w; w.x = pk4_fp8_nc(h[0].x, h[0].y, h[1].x, h[1].y); w.y = pk4_fp8_nc(h[2].x, h[2].y, h[3].x, h[3].y);
                *(u32x2*)(hid + (size_t)(r < u.nv ? en.x : (unsigned)NP) * D + hc) = w; }
    }
};
struct EpiDown {
    static constexpr bool PERM = true; static constexpr int NSTORE = 16;
    unsigned char* o;
    __device__ __forceinline__ void operator()(const f32x4 (&acc)[2][2][4][2], const Unit& u, int wr, int wc, int fr, int fq, const LAS u32x2* rt, const LAS f32x4* bt) const {
        constexpr float inv = SC_O / (SC_H * SC_W);
        const int c0 = u.pn * BM + wc * 32 + 8 * fq;
        f32x4 bv[2][2];
#pragma unroll
        for (int bj = 0; bj < 2; ++bj)
#pragma unroll
            for (int n = 0; n < 2; ++n) bv[bj][n] = bt[bj * 32 + wc * 8 + 2 * fq + n] * SC_O;
#pragma unroll
        for (int ai = 0; ai < 2; ++ai)
#pragma unroll
            for (int m = 0; m < 4; ++m) { const int r = ai * HALF + wr * 64 + m * 16 + fr;
                const unsigned p = (r < u.nv) ? rt[r].x : (unsigned)NP; unsigned char* rowp = o + (size_t)p * D + c0;
#pragma unroll
                for (int bj = 0; bj < 2; ++bj) { const f32x4 v0 = acc[ai][bj][m][0] * inv + bv[bj][0], v1 = acc[ai][bj][m][1] * inv + bv[bj][1];
                    *(u32x2*)(rowp + bj * HALF) = (u32x2){pk4_fp8(v0[0], v0[1], v0[2], v0[3]), pk4_fp8(v1[0], v1[1], v1[2], v1[3])}; } }
    }
};
}

#define XB_TMO      128
#define XB_XCNT(j)  (256  + 64 * (j))
#define XB_XSUB(j)  (1280 + 64 * (j))
#define XB_XGEN(j)  (2304 + 64 * (j))
#define XB_TOP      3328
#define XB_TOPGEN   3392
#define XCD_BAR_WORDS 3456
#define XB_SPIN_CAP (1u << 18)
__device__ __forceinline__ unsigned xb_ld(unsigned* p)              { return __hip_atomic_load(p, __ATOMIC_RELAXED, __HIP_MEMORY_SCOPE_AGENT); }
__device__ __forceinline__ unsigned xb_add(unsigned* p, unsigned v) { return __hip_atomic_fetch_add(p, v, __ATOMIC_RELAXED, __HIP_MEMORY_SCOPE_AGENT); }
__device__ __forceinline__ unsigned xb_xcc_id() { return (unsigned)__builtin_amdgcn_s_getreg((3 << 11) | 20) & 0xFu; }
#define XB_SPIN(cond, bar) do { unsigned _sp = 0; while (cond) { __builtin_amdgcn_s_sleep(1); \
    if ((++_sp & 255u) == 0u) { if (xb_ld(&(bar)[XB_TMO])) break; if (_sp > XB_SPIN_CAP) { atomicAdd(&(bar)[XB_TMO], 1u); break; } } } } while (0)
struct XcdBarrier { unsigned* bar; unsigned x; volatile LAS unsigned* st; };
__device__ __forceinline__ XcdBarrier xcd_barrier_post(unsigned* bar, volatile LAS unsigned* st) {
    XcdBarrier b; b.bar = bar; b.x = xb_xcc_id(); b.st = st;
    if (threadIdx.x == 0) (void)xb_add(&bar[XB_XCNT(b.x)], 1u);
    return b;
}
__device__ __forceinline__ void xcd_barrier_complete(unsigned* bar, unsigned x, unsigned& nloc, unsigned& nx) {
    const unsigned G = gridDim.x * gridDim.y * gridDim.z;
    unsigned sum, cnt, mine, sp = 0u;
    for (;;) {
        sum = 0u; cnt = 0u; mine = 0u;
#pragma unroll
        for (unsigned j = 0; j < 16; ++j) { const unsigned c = xb_ld(&bar[XB_XCNT(j)]); sum += c; cnt += (c > 0u) ? 1u : 0u; mine = (j == x) ? c : mine; }
        if (sum == G) break;
        __builtin_amdgcn_s_sleep(1);
        if ((++sp & 255u) == 0u) { if (xb_ld(&bar[XB_TMO])) break; if (sp > XB_SPIN_CAP) { atomicAdd(&bar[XB_TMO], 1u); break; } }
    }
    nloc = mine > 0u ? mine : 1u; nx = cnt > 0u ? cnt : 1u;
}
__device__ __forceinline__ void xcd_barrier(const XcdBarrier& b) {
    asm volatile("s_waitcnt vmcnt(0)" ::: "memory");
    __syncthreads();
    if (threadIdx.x == 0) {
        unsigned* bar = b.bar;
        __builtin_amdgcn_s_waitcnt(0);
        unsigned nloc = b.st[0], nx = b.st[1];
        if (nloc == 0u) { xcd_barrier_complete(bar, b.x, nloc, nx); b.st[0] = nloc; b.st[1] = nx; }
        const unsigned old = xb_add(&bar[XB_XSUB(b.x)], 1u);
        const unsigned gen = old / nloc;
        if (old + 1u == (gen + 1u) * nloc) {
            __builtin_amdgcn_fence(__ATOMIC_RELEASE, "agent");
            asm volatile("s_waitcnt vmcnt(0)" ::: "memory");
            const unsigned og = xb_add(&bar[XB_TOP], 1u);
            const unsigned tg = og / nx;
            if (og + 1u == (tg + 1u) * nx) xb_add(&bar[XB_TOPGEN], 1u);
            else XB_SPIN(xb_ld(&bar[XB_TOPGEN]) == tg, bar);
            __builtin_amdgcn_fence(__ATOMIC_ACQUIRE, "agent");
            xb_add(&bar[XB_XGEN(b.x)], 1u);
            asm volatile("s_waitcnt vmcnt(0)" ::: "memory");
        } else {
            XB_SPIN(xb_ld(&bar[XB_XGEN(b.x)]) == gen, bar);
            __builtin_amdgcn_fence(__ATOMIC_ACQUIRE, "agent");
            asm volatile("s_waitcnt vmcnt(0)" ::: "memory");
        }
    }
    __syncthreads();
}

struct Frame {
    LAS unsigned char* lds;
    gu32* ctl;
    int wave, G, vcu;
};

__device__ __forceinline__ void transpose_item(const float* W, int N, int k0, int n0, bf16_t* dst, int K, LAS float* scr, int lane) {
    f32x4 v[8];
#pragma unroll
    for (int it = 0; it < 8; ++it) v[it] = *(const GAS f32x4*)(W + (size_t)(k0 + it * 8 + (lane >> 3)) * N + n0 + 4 * (lane & 7));
#pragma unroll
    for (int it = 0; it < 8; ++it) { LAS float* s = scr + (it * 8 + (lane >> 3)) * 33 + 4 * (lane & 7); s[0] = v[it].x; s[1] = v[it].y; s[2] = v[it].z; s[3] = v[it].w; }
    LDS_WAIT(); asm volatile("" ::: "memory");
    const int c = lane & 7;
#pragma unroll
    for (int j = 0; j < 4; ++j) { const int n = (lane >> 3) + 8 * j; const LAS float* s = scr + (8 * c) * 33 + n;
        u32x4 o; o.x = pk2(s[0 * 33], s[1 * 33]); o.y = pk2(s[2 * 33], s[3 * 33]); o.z = pk2(s[4 * 33], s[5 * 33]); o.w = pk2(s[6 * 33], s[7 * 33]);
        *(GAS u32x4*)(dst + (size_t)n * K + k0 + 8 * c) = o; }
    LDS_WAIT(); asm volatile("" ::: "memory");
}

struct Args { const float* in[19]; float* out; unsigned char* ws; int ph_lo, ph_hi; };

namespace att {
constexpr int SLOT = 8192, NSL = 5;
constexpr int L_K = 0, L_V = NSL * SLOT, L_WS = 2 * NSL * SLOT, L_BIAS = L_WS + 8 * 256, L_OST = L_BIAS + 1024, L_END = L_OST + 8 * 4096;
__device__ __forceinline__ int crow(int r, int hi) { return (r & 3) + 8 * (r >> 2) + 4 * hi; }
__device__ __forceinline__ s16x4 vtr(const LAS char* p) { typedef short v4i16_t __attribute__((ext_vector_type(4))); return __builtin_bit_cast(s16x4, __builtin_amdgcn_ds_read_tr16_b64_v4i16((LAS v4i16_t*)p)); }

template <bool FIRST>
__device__ __forceinline__ void tile_step(const LAS char* lds, int slot, int s, int lane, int r32, int hi, int qin, const bf16x8 (&qr)[4], const LAS float* tb, LAS float* wsf,
                                          float& m_run, float& l_run, f32x16 (&o)[2], f32x16& negm) {
    constexpr float THR = 8.0f;
    const LAS char* kp = lds + L_K + slot + hi * 1024 + r32 * 16;
    f32x16 p0, p1;
#pragma unroll
    for (int d0 = 0; d0 < 4; ++d0) {
        const bf16x8 b0 = *(const LAS bf16x8*)(kp + d0 * 2048), b1 = *(const LAS bf16x8*)(kp + d0 * 2048 + 512);
        p0 = __builtin_amdgcn_mfma_f32_32x32x16_bf16(b0, qr[d0], d0 == 0 ? negm : p0, 0, 0, 0); p1 = __builtin_amdgcn_mfma_f32_32x32x16_bf16(b1, qr[d0], d0 == 0 ? negm : p1, 0, 0, 0); }
    if (s >= 6) { const int ib = qin + 64 * (8 - s) + 63 - 4 * hi;
#pragma unroll
        for (int r = 0; r < 16; ++r) { const int off = (r & 3) + 8 * (r >> 2); p0[r] += tb[ib - off]; p1[r] += tb[ib - off - 32]; } }
    float mx = __builtin_fmaxf(__builtin_fmaxf(p0[0], p0[1]), p1[0]), my = __builtin_fmaxf(__builtin_fmaxf(p0[2], p0[3]), p1[1]);
    mx = __builtin_fmaxf(__builtin_fmaxf(mx, p1[2]), p1[3]);
#pragma unroll
    for (int r = 4; r < 16; r += 4) { mx = __builtin_fmaxf(__builtin_fmaxf(mx, p0[r]), p0[r + 1]); my = __builtin_fmaxf(__builtin_fmaxf(my, p0[r + 2]), p0[r + 3]);
                                      mx = __builtin_fmaxf(__builtin_fmaxf(mx, p1[r]), p1[r + 1]); my = __builtin_fmaxf(__builtin_fmaxf(my, p1[r + 2]), p1[r + 3]); }
    mx = fmaxf(mx, my); mx = fmaxf(mx, __shfl_xor(mx, 32));
    if constexpr (FIRST) {
        m_run = mx;
#pragma unroll
        for (int r = 0; r < 16; ++r) { p0[r] -= mx; p1[r] -= mx; negm[r] = -mx; }
    } else if (__any(mx > THR)) {
        const float d = mx > THR ? mx : 0.f, f = __builtin_amdgcn_exp2f(-d);
        m_run += d; l_run *= f;
#pragma unroll
        for (int r = 0; r < 16; ++r) { p0[r] -= d; p1[r] -= d; negm[r] = -m_run; }
        if (hi == 0) wsf[r32] = f;
        LDS_WAIT();
#pragma unroll
        for (int r = 0; r < 16; ++r) { const float g = wsf[crow(r, hi)]; o[0][r] *= g; o[1][r] *= g; }
    }
    float rs = 0.f, rs2 = 0.f;
#pragma unroll
    for (int r = 0; r < 16; ++r) { p0[r] = __builtin_amdgcn_exp2f(p0[r]); p1[r] = __builtin_amdgcn_exp2f(p1[r]); rs += p0[r]; rs2 += p1[r]; }
    l_run += rs + rs2;
    u32x4 pw[4];
#pragma unroll
    for (int q = 0; q < 4; ++q) { pw[0][q] = cvt_pk_bf16(p0[2 * q], p0[2 * q + 1]); pw[1][q] = cvt_pk_bf16(p0[8 + 2 * q], p0[8 + 2 * q + 1]);
                                  pw[2][q] = cvt_pk_bf16(p1[2 * q], p1[2 * q + 1]); pw[3][q] = cvt_pk_bf16(p1[8 + 2 * q], p1[8 + 2 * q + 1]); }
    const unsigned vb = (unsigned)(uintptr_t)(lds + L_V + slot + ((lane >> 4) & 1) * 32 + (lane & 3) * 8 + (4 * hi + ((lane & 15) >> 2)) * 64);
#pragma unroll
    for (int d0 = 0; d0 < 2; ++d0) { s16x4 lo[4], hh[4];
#pragma unroll
        for (int ks = 0; ks < 4; ++ks) {
            asm volatile("ds_read_b64_tr_b16 %0, %1 offset:%c2" : "=&v"(lo[ks]) : "v"(vb), "i"(d0 * 4096 + ks * 1024) : "memory");
            asm volatile("ds_read_b64_tr_b16 %0, %1 offset:%c2" : "=&v"(hh[ks]) : "v"(vb), "i"(d0 * 4096 + ks * 1024 + 512) : "memory"); }
        asm volatile("s_waitcnt lgkmcnt(0)" ::: "memory"); __builtin_amdgcn_sched_barrier(0);
#pragma unroll
        for (int ks = 0; ks < 4; ++ks) { const bf16x8 vf = (bf16x8){lo[ks][0], lo[ks][1], lo[ks][2], lo[ks][3], hh[ks][0], hh[ks][1], hh[ks][2], hh[ks][3]};
            o[d0] = __builtin_amdgcn_mfma_f32_32x32x16_bf16(__builtin_bit_cast(bf16x8, pw[ks]), vf, o[d0], 0, 0, 0); } }
}

template <bool EDGE>
__device__ __forceinline__ void unit(const Frame& F, int b, int h, int cg, const bf16_t* Q, const bf16_t* Kb, const bf16_t* Vb, bf16_t* MIX, const float* relb) {
    LAS char* lds = (LAS char*)F.lds;
    const int wid = F.wave, lane = lane_id(), tid = wid * 64 + lane, r32 = lane & 31, hi = lane >> 5;
    const int wp = wid >> 1, half = wid & 1;
    const int c = 4 * cg + wp;
    const long rowbase = (long)b * SEQ;
    LAS float* wsf = (LAS float*)(lds + L_WS) + wid * 64;
    LAS float* tb = (LAS float*)(lds + L_BIAS);
    if (tid < 256) { const int i = tid < NREL ? tid : NREL - 1; tb[tid] = (relb[h * NREL + i] - relb[h * NREL + NREL - 1]) * LOG2E; }
    const bf16_t* Qw = Q + (rowbase + c * 64 + half * 32 + r32) * DA + h * HD;
    bf16x8 qr[4];
#pragma unroll
    for (int d0 = 0; d0 < 4; ++d0) qr[d0] = *(const GAS bf16x8*)(Qw + d0 * 16 + hi * 8);
    const int kc0 = 4 * cg - 8;
    const int krow = tid & 63, kch = tid >> 6;
    const int vrow = tid >> 3, vch = tid & 7;
    const bf16_t* ksrc = Kb + (rowbase + krow) * DA + h * HD + kch * 8;
    const bf16_t* vsrc = Vb + (rowbase + vrow) * DA + h * HD + vch * 8;
    const int kdst = L_K + kch * 1024 + krow * 16, vdst = L_V + (vch >> 2) * 4096 + vrow * 64 + (vch & 3) * 16;
#pragma unroll
    for (int j = 0; j < 4; ++j) { const int kc = kc0 + j;
        if (!EDGE || kc >= 0) { const u32x4 kv = *(const GAS u32x4*)(ksrc + (long)kc * 64 * DA); const u32x4 vv = *(const GAS u32x4*)(vsrc + (long)kc * 64 * DA);
            *(LAS u32x4*)(lds + kdst + j * SLOT) = kv; *(LAS u32x4*)(lds + vdst + j * SLOT) = vv; } }
    float m_run = 0.f, l_run = 0.f; f32x16 o[2]; o[0] = f32x16{}; o[1] = f32x16{}; f32x16 negm = f32x16{};
    const int qin = half * 32 + r32;
    if constexpr (!EDGE) {
        __syncthreads();
        { u32x4 kv = *(const GAS u32x4*)(ksrc + (long)(kc0 + 4) * 64 * DA), vv = *(const GAS u32x4*)(vsrc + (long)(kc0 + 4) * 64 * DA);
          tile_step<true>(lds, (wp % NSL) * SLOT, 0, lane, r32, hi, qin, qr, tb, wsf, m_run, l_run, o, negm);
          *(LAS u32x4*)(lds + kdst + 4 * SLOT) = kv; *(LAS u32x4*)(lds + vdst + 4 * SLOT) = vv; }
#pragma unroll 1
        for (int s = 1; s < 9; ++s) {
            __syncthreads();
            const int jn = s + 4; const bool ldn = jn < 12;
            u32x4 kv = (u32x4){0u, 0u, 0u, 0u}, vv = (u32x4){0u, 0u, 0u, 0u};
            if (ldn) { kv = *(const GAS u32x4*)(ksrc + (long)(kc0 + jn) * 64 * DA); vv = *(const GAS u32x4*)(vsrc + (long)(kc0 + jn) * 64 * DA); }
            tile_step<false>(lds, ((wp + s) % NSL) * SLOT, s, lane, r32, hi, qin, qr, tb, wsf, m_run, l_run, o, negm);
            if (ldn) { const int sl = (jn % NSL) * SLOT; *(LAS u32x4*)(lds + kdst + sl) = kv; *(LAS u32x4*)(lds + vdst + sl) = vv; }
        }
    } else {
        bool first = true;
#pragma unroll 1
        for (int s = 0; s < 9; ++s) {
            __syncthreads();
            const int jn = s + 4, kcn = kc0 + jn; const bool ldn = (jn < 12) && (kcn >= 0);
            u32x4 kv = (u32x4){0u, 0u, 0u, 0u}, vv = (u32x4){0u, 0u, 0u, 0u};
            if (ldn) { kv = *(const GAS u32x4*)(ksrc + (long)kcn * 64 * DA); vv = *(const GAS u32x4*)(vsrc + (long)kcn * 64 * DA); }
            const int j = wp + s, kc = kc0 + j;
            if (kc >= 0) { if (first) { tile_step<true>(lds, (j % NSL) * SLOT, s, lane, r32, hi, qin, qr, tb, wsf, m_run, l_run, o, negm); first = false; }
                           else tile_step<false>(lds, (j % NSL) * SLOT, s, lane, r32, hi, qin, qr, tb, wsf, m_run, l_run, o, negm); }
            if (ldn) { const int sl = (jn % NSL) * SLOT; *(LAS u32x4*)(lds + kdst + sl) = kv; *(LAS u32x4*)(lds + vdst + sl) = vv; }
        }
    }
    l_run += __shfl_xor(l_run, 32);
    if (hi == 0) wsf[32 + r32] = l_run;
    LDS_WAIT();
    LAS bf16_t* stg = (LAS bf16_t*)(lds + L_OST) + wid * 2048;
#pragma unroll
    for (int r = 0; r < 16; ++r) { const int orow = crow(r, hi); const float rl = __builtin_amdgcn_rcpf(wsf[32 + orow]);
#pragma unroll
        for (int d0 = 0; d0 < 2; ++d0) stg[orow * 64 + d0 * 32 + r32] = (bf16_t)f2bf(o[d0][r] * rl); }
    LDS_WAIT();
    bf16_t* Ow = MIX + (rowbase + c * 64 + half * 32) * D + h * HD;
#pragma unroll
    for (int i = 0; i < 4; ++i) { const int row = i * 8 + (lane >> 3), ch = lane & 7; const u32x4 v = *(const LAS u32x4*)(stg + row * 64 + ch * 8); *(GAS u32x4*)(Ow + (long)row * D + ch * 8) = v; }
    __syncthreads();
}
}

namespace cv {
constexpr int TT = 32, UR = TT + CW - 1;
constexpr int L_U = 0, L_Y = UR * DC * 2  , L_END = L_Y + TT * DC * 4;
__device__ __forceinline__ void unit(const Frame& F, int b, int tt, const bf16_t* Ab, const bf16_t* Gb, bf16_t* MIX, const float* dw_w, const float* dw_b, const float* ln_g, const float* ln_b) {
    LAS char* lds = (LAS char*)F.lds;
    const int wid = F.wave, lane = lane_id(), tid = wid * 64 + lane;
    const int t0 = tt * TT; const long rowbase = (long)b * SEQ;
    for (int idx = tid; idx < UR * 64; idx += 512) { const int r = idx >> 6, c8 = idx & 63; const int tok = t0 - (CW - 1) + r;
        u32x4 w = (u32x4){0u, 0u, 0u, 0u};
        if (tok >= 0) { const u32x4 av = *(const GAS u32x4*)(Ab + (rowbase + tok) * DC + c8 * 8), gv = *(const GAS u32x4*)(Gb + (rowbase + tok) * DC + c8 * 8);
#pragma unroll
            for (int q = 0; q < 4; ++q) { const float u0 = bf_lo(av[q]) * fsigmoid(bf_lo(gv[q])), u1 = bf_hi(av[q]) * fsigmoid(bf_hi(gv[q])); w[q] = cvt_pk_bf16(u0, u1); } }
        *(LAS u32x4*)(lds + L_U + r * (DC * 2) + c8 * 16) = w; }
    __syncthreads();
    { const int cp = tid & 255, th = tid >> 8;
      f32x2 w[CW];
#pragma unroll
      for (int j = 0; j < CW; ++j) w[j] = *(const GAS f32x2*)(dw_w + j * DC + 2 * cp);
      const f32x2 bias = *(const GAS f32x2*)(dw_b + 2 * cp);
#pragma unroll 1
      for (int blk = 0; blk < 2; ++blk) { const int tbk = th * 16 + blk * 8;
          f32x2 acc[8];
#pragma unroll
          for (int k = 0; k < 8; ++k) acc[k] = bias;
#pragma unroll
          for (int i = 0; i < 8 + CW - 1; ++i) { const unsigned uw = *(const LAS unsigned*)(lds + L_U + (tbk + i) * (DC * 2) + cp * 4); const f32x2 uv = (f32x2){bf_lo(uw), bf_hi(uw)};
#pragma unroll
              for (int k = 0; k < 8; ++k) { const int j = i - k; if (j >= 0 && j < CW) acc[k] += uv * w[j]; } }
#pragma unroll
          for (int k = 0; k < 8; ++k) *(LAS f32x2*)(lds + L_Y + (tbk + k) * (DC * 4) + cp * 8) = acc[k]; } }
    __syncthreads();
    { const f32x4 g0 = *(const GAS f32x4*)(ln_g + 8 * lane), g1 = *(const GAS f32x4*)(ln_g + 8 * lane + 4), b0 = *(const GAS f32x4*)(ln_b + 8 * lane), b1 = *(const GAS f32x4*)(ln_b + 8 * lane + 4);
#pragma unroll
      for (int q = 0; q < 4; ++q) { const int t = wid * 4 + q;
          f32x4 y0 = *(const LAS f32x4*)(lds + L_Y + t * (DC * 4) + lane * 32), y1 = *(const LAS f32x4*)(lds + L_Y + t * (DC * 4) + lane * 32 + 16);
          const float mean = wave_sum((y0.x + y0.y) + (y0.z + y0.w) + (y1.x + y1.y) + (y1.z + y1.w)) * (1.f / DC);
          y0 = y0 - mean; y1 = y1 - mean;
          const float var = wave_sum((y0.x * y0.x + y0.y * y0.y) + (y0.z * y0.z + y0.w * y0.w) + (y1.x * y1.x + y1.y * y1.y) + (y1.z * y1.z + y1.w * y1.w)) * (1.f / DC);
          const float rstd = 1.0f / sqrtf(var + LN_EPS);
          y0 = y0 * rstd * g0 + b0; y1 = y1 * rstd * g1 + b1;
          float z[8] = {y0.x, y0.y, y0.z, y0.w, y1.x, y1.y, y1.z, y1.w};
#pragma unroll
          for (int i = 0; i < 8; ++i) z[i] = z[i] * fsigmoid(z[i]);
          u32x4 w; w.x = cvt_pk_bf16(z[0], z[1]); w.y = cvt_pk_bf16(z[2], z[3]); w.z = cvt_pk_bf16(z[4], z[5]); w.w = cvt_pk_bf16(z[6], z[7]);
          *(GAS u32x4*)(MIX + (rowbase + t0 + t) * D + DA + 8 * lane) = w; } }
    __syncthreads();
}
}

__global__ void __launch_bounds__(NWAVES * 64, 2) hymba_fwd(Args args) {
    extern __shared__ __attribute__((aligned(16))) unsigned char lds_raw[];
    Frame F;
    F.lds = (LAS unsigned char*)lds_raw;
    F.wave = __builtin_amdgcn_readfirstlane(threadIdx.x >> 6);
    F.G = gridDim.x; { const int bx = blockIdx.x; F.vcu = (F.G % 8 == 0) ? (bx % 8) * (F.G / 8) + bx / 8 : bx; }
    unsigned char* ws = args.ws;
    F.ctl = (gu32*)(ws + WS_CTL);
    volatile LAS unsigned* MISC = (volatile LAS unsigned*)(F.lds + LDSCTL_OFF);
    for (int u = threadIdx.x; u < (LDS_BYTES - LDSCTL_OFF) / 4; u += NWAVES * 64) ((LAS unsigned*)(F.lds + LDSCTL_OFF))[u] = 0u;
    __syncthreads();
    const int lo = args.ph_lo, hi = args.ph_hi;
    const bool multi = (hi - lo) > 1;
    XcdBarrier bar; bar.bar = (unsigned*)(F.ctl + CW_BAR); bar.x = 0; bar.st = nullptr;
    if (multi) bar = xcd_barrier_post((unsigned*)(F.ctl + CW_BAR), MISC + 8);
#define IN(k) (lo <= (k) && (k) < hi)
#define BOTH(k) (IN(k) && IN((k) + 1))
#define GRID_BAR() xcd_barrier(bar)

    const float* x = args.in[0];
    bf16_t* Win_t = (bf16_t*)(ws + WS_WIN); bf16_t* Wout_t = (bf16_t*)(ws + WS_WOUT); unsigned char* Wgu8 = ws + WS_WGU; unsigned char* Wd8 = ws + WS_WD;
    bf16_t* X1 = (bf16_t*)(ws + WS_X1); bf16_t* XN = (bf16_t*)(ws + WS_XN);
    bf16_t* Qb = (bf16_t*)(ws + WS_Q); bf16_t* Kb = (bf16_t*)(ws + WS_K); bf16_t* Vb = (bf16_t*)(ws + WS_V); bf16_t* Ab = (bf16_t*)(ws + WS_A); bf16_t* Gb = (bf16_t*)(ws + WS_G);
    bf16_t* MIX = (bf16_t*)(ws + WS_MIX); unsigned char* HID8 = ws + WS_HID; unsigned char* T8 = ws + WS_XN; unsigned char* OB = ws + WS_O;
    u32x2* LIST = (u32x2*)(ws + WS_LIST); float* TOPW = (float*)(ws + WS_TOPW); bf16_t* RWB = (bf16_t*)(ws + WS_RWT);
    const int gw = F.vcu * NWAVES + F.wave, NGW = F.G * NWAVES;

    if (IN(0)) {
        const int lane = lane_id(), tid = F.wave * 64 + lane;
        LAS float* scr = (LAS float*)(F.lds + F.wave * 16896);
        constexpr int I_IN = (D / 64) * (NIN / 32), I_OUT = (D / 64) * (D / 32), I_EXP = (D / 64) * (D / 32);
        for (int it = gw; it < I_IN + I_OUT; it += NGW) {
            int r = it;
            if (r < I_IN) { const int kb = r / (NIN / 32), nb = r % (NIN / 32); transpose_item(args.in[2], NIN, kb * 64, nb * 32, Win_t + (size_t)(nb * 32) * D, D, scr, lane); continue; } r -= I_IN;
            const int kb = r / (D / 32), nb = r % (D / 32); transpose_item(args.in[8], D, kb * 64, nb * 32, Wout_t + (size_t)(nb * 32) * D, D, scr, lane);
        }
        { const GAS f32x4* gp = (const GAS f32x4*)args.in[1] + lane; f32x4 g[4];
#pragma unroll
          for (int j = 0; j < 4; ++j) g[j] = gp[64 * j];
          for (int m = gw; m < T; m += 2 * NGW) { const int m2 = m + NGW;
              const GAS f32x4* xr = (const GAS f32x4*)(x + (size_t)m * D) + lane; const GAS f32x4* xr2 = (const GAS f32x4*)(x + (size_t)(m2 < T ? m2 : m) * D) + lane; f32x4 v[4], v2[4]; float s = 0.f, s2 = 0.f;
#pragma unroll
              for (int j = 0; j < 4; ++j) { v[j] = __builtin_nontemporal_load(xr + 64 * j); v2[j] = __builtin_nontemporal_load(xr2 + 64 * j); }
#pragma unroll
              for (int j = 0; j < 4; ++j) { s += (v[j].x * v[j].x + v[j].y * v[j].y) + (v[j].z * v[j].z + v[j].w * v[j].w); s2 += (v2[j].x * v2[j].x + v2[j].y * v2[j].y) + (v2[j].z * v2[j].z + v2[j].w * v2[j].w); }
              const float r = 1.0f / sqrtf(wave_sum(s) * (1.f / D) + RMS_EPS), r2 = 1.0f / sqrtf(wave_sum(s2) * (1.f / D) + RMS_EPS);
              GAS u32x2* o8 = (GAS u32x2*)(XN + (size_t)m * D) + lane;
#pragma unroll
              for (int j = 0; j < 4; ++j) { const f32x4 y = v[j] * r * g[j]; o8[64 * j] = (u32x2){pk2(y.x, y.y), pk2(y.z, y.w)}; }
              if (m2 < T) { GAS u32x2* o82 = (GAS u32x2*)(XN + (size_t)m2 * D) + lane;
#pragma unroll
                  for (int j = 0; j < 4; ++j) { const f32x4 y = v2[j] * r2 * g[j]; o82[64 * j] = (u32x2){pk2(y.x, y.y), pk2(y.z, y.w)}; } } } }
        for (int i = blockIdx.x * 512 + tid; i < NE * D; i += F.G * 512) { const int e = i / D, k = i % D; const float v = args.in[10][k * NE + e] * args.in[9][k];
            const unsigned h = f2bf(v); RWB[i] = (bf16_t)h; RWB[NE * D + i] = (bf16_t)f2bf(v - __uint_as_float(h << 16)); }
        if (BOTH(0)) GRID_BAR();
    }

    if (IN(1)) {
        const int xg = (int)(blockIdx.x % 8), jb = (int)(blockIdx.x / 8), half = F.G / 16;
        if (jb < half) {
            pg8::DenseOrder S; S.init(T, NIN, F.G / 2, xg + 8 * jb, Win_t);
            pg8::EpiSplit E{Qb, (size_t)(WS_K - WS_Q) / 2, QSCALE};
            pg8::gemm_phase<pg8::EpiSplit, pg8::DenseOrder, true, 2>(F.lds, (const char*)XN, D, S, E);
        } else {
            const int cgw = (xg * half + (jb - half)) * NWAVES + F.wave, CNGW = (F.G / 2) * NWAVES;
        { constexpr int NIT = NE * 3 * 8 * 32;
          LAS unsigned* tile = (LAS unsigned*)(F.lds + F.wave * 4352); const int lane = lane_id();
          f32x4 v[16], w[16];
          auto src_of = [&](int r) -> const float* { const int em = r >> 8, ri = r & 255, e = em / 3, mat = em % 3, kb = ri >> 5, nb = ri & 31;
              const float* base = (mat == 0 ? args.in[12] : mat == 1 ? args.in[14] : args.in[16]) + (size_t)e * D * D;
              return base + (size_t)(kb * 128 + (lane >> 3)) * D + nb * 32 + 4 * (lane & 7); };
          int it = cgw;
          if (it < NIT) { const float* sp = src_of(it);
#pragma unroll
              for (int q = 0; q < 16; ++q) v[q] = __builtin_nontemporal_load((const GAS f32x4*)(sp + (size_t)q * 8 * D)); }
#pragma unroll 1
          for (; it < NIT; it += CNGW) {
              const int nx = it + CNGW;
              if (nx < NIT) { const float* sp = src_of(nx);
#pragma unroll
                  for (int q = 0; q < 16; ++q) w[q] = __builtin_nontemporal_load((const GAS f32x4*)(sp + (size_t)q * 8 * D)); }
              const int em = it >> 8, ri = it & 255, e = em / 3, mat = em % 3, kb = ri >> 5, nb = ri & 31, n0 = nb * 32, k0 = kb * 128;
              unsigned char* dst = (mat == 2) ? Wd8 + ((size_t)e * D + n0) * D : Wgu8 + ((size_t)e * 2048 + (size_t)(n0 >> 7) * 256 + (n0 & 127) + (mat == 1 ? 128 : 0)) * D;
#pragma unroll
              for (int q = 0; q < 16; ++q) tile[(lane & 7) * 132 + q * 8 + (lane >> 3)] = pk4_fp8(v[q].x * SC_W, v[q].y * SC_W, v[q].z * SC_W, v[q].w * SC_W);
              LDS_WAIT(); asm volatile("" ::: "memory");
              const int nq = lane >> 3, c = lane & 7;
              u32x4 r[4];
#pragma unroll
              for (int i = 0; i < 4; ++i) r[i] = *(const LAS u32x4*)(tile + nq * 132 + 16 * c + 4 * i);
              LDS_WAIT(); asm volatile("" ::: "memory");
              u32x4 o[4];
#pragma unroll
              for (int i = 0; i < 4; ++i) {
                  const unsigned x01 = __builtin_amdgcn_perm(r[i].y, r[i].x, 0x05010400u), y01 = __builtin_amdgcn_perm(r[i].y, r[i].x, 0x07030602u);
                  const unsigned x23 = __builtin_amdgcn_perm(r[i].w, r[i].z, 0x05010400u), y23 = __builtin_amdgcn_perm(r[i].w, r[i].z, 0x07030602u);
                  o[0][i] = __builtin_amdgcn_perm(x23, x01, 0x05040100u); o[1][i] = __builtin_amdgcn_perm(x23, x01, 0x07060302u);
                  o[2][i] = __builtin_amdgcn_perm(y23, y01, 0x05040100u); o[3][i] = __builtin_amdgcn_perm(y23, y01, 0x07060302u); }
#pragma unroll
              for (int j = 0; j < 4; ++j) *(GAS u32x4*)(dst + (size_t)(4 * nq + j) * D + k0 + 16 * c) = o[j];
#pragma unroll
              for (int q = 0; q < 16; ++q) v[q] = w[q];
          } }
        }
        if (BOTH(1)) GRID_BAR();
    }

    if (IN(2)) {
        for (int u = F.vcu; u < 2 * NH * 32; u += F.G) { const int cg = u & 31, h = (u >> 5) & 7, b = u >> 8;
            if (cg < 2) att::unit<true>(F, b, h, cg, Qb, Kb, Vb, MIX, args.in[7]); else att::unit<false>(F, b, h, cg, Qb, Kb, Vb, MIX, args.in[7]); }
        for (int u = F.vcu; u < T / cv::TT; u += F.G) { const int b = u / (SEQ / cv::TT), tt = u % (SEQ / cv::TT);
            cv::unit(F, b, tt, Ab, Gb, MIX, args.in[3], args.in[4], args.in[5], args.in[6]); }
        if (BOTH(2)) GRID_BAR();
    }

    if (IN(3)) {
        pg8::DenseOrder S; S.init(T, D, F.G, (int)blockIdx.x, Wout_t);
        pg8::EpiRes E{x, X1, T8, args.in[9]};
        pg8::gemm_phase<pg8::EpiRes, pg8::DenseOrder, false, 2>(F.lds, (const char*)MIX, D, S, E);
        if (BOTH(3)) {
            const int tid = F.wave * 64 + lane_id();
            for (int i = tid; i < 8192; i += 512) { const int row = i >> 7, ch = i & 127; const u32x4 v = ((const GAS u32x4*)RWB)[i];
                *(LAS u32x4*)(F.lds + row * 2048 + (((ch & ~15) | ((ch ^ row) & 15)) * 16)) = v; }
            GRID_BAR(); }
    }

    if (IN(4)) {
        const int lane = lane_id(), tid = F.wave * 64 + lane, fr = lane & 15, fq = lane >> 4;
        LAS unsigned char* rwl = F.lds;
        LAS int* hist = (LAS int*)(F.lds + XTRA_OFF);
        LAS int* baseE = hist + 32;
        LAS int* selE = baseE + 32;
        LAS int* selP = selE + 256;
        LAS float* selR = (LAS float*)(selP + 256);
        LAS float* part = selR + 64;
        const int w4 = F.wave & 3, kh = F.wave >> 2;
        const float rb0 = args.in[11][fr], rb1 = args.in[11][16 + fr];
        bool filled = false;
#pragma unroll 1
        for (int tb = blockIdx.x * 4; tb < T / 16; tb += F.G * 4) {
            const int task = tb + w4;
            const bf16_t* xrow = X1 + (size_t)(task * 16 + fr) * D + kh * 512 + 8 * fq;
            u32x4 xv[16];
#pragma unroll
            for (int ks = 0; ks < 16; ++ks) xv[ks] = *(const GAS u32x4*)(xrow + 32 * ks);
            if (!filled && !BOTH(3)) {
                for (int i = tid; i < 8192; i += 512) { const int row = i >> 7, ch = i & 127; const u32x4 v = ((const GAS u32x4*)RWB)[i];
                    *(LAS u32x4*)(rwl + row * 2048 + (((ch & ~15) | ((ch ^ row) & 15)) * 16)) = v; } }
            filled = true;
            if (tid < 32) hist[tid] = 0;
            __syncthreads();
            f32x4 acc0 = (f32x4){0.f, 0.f, 0.f, 0.f}, acc1 = acc0; float ss = 0.f;
#pragma unroll
            for (int ks = 0; ks < 16; ++ks) {
                const u32x4 hi = xv[ks];
                { const float a0 = bf_lo(hi.x), a1 = bf_hi(hi.x), a2 = bf_lo(hi.y), a3 = bf_hi(hi.y), a4 = bf_lo(hi.z), a5 = bf_hi(hi.z), a6 = bf_lo(hi.w), a7 = bf_hi(hi.w);
                  ss += (a0 * a0 + a1 * a1) + (a2 * a2 + a3 * a3) + (a4 * a4 + a5 * a5) + (a6 * a6 + a7 * a7); }
                const bf16x8 ah = __builtin_bit_cast(bf16x8, hi);
                const int ch = kh * 64 + 4 * ks + fq;
                const int o0 = fr * 2048 + (((ch & ~15) | ((ch ^ fr) & 15)) * 16), o1 = o0 + 16 * 2048;
                const bf16x8 bh0 = *(const LAS bf16x8*)(rwl + o0), bl0 = *(const LAS bf16x8*)(rwl + 65536 + o0), bh1 = *(const LAS bf16x8*)(rwl + o1), bl1 = *(const LAS bf16x8*)(rwl + 65536 + o1);
                acc0 = __builtin_amdgcn_mfma_f32_16x16x32_bf16(ah, bh0, acc0, 0, 0, 0); acc1 = __builtin_amdgcn_mfma_f32_16x16x32_bf16(ah, bh1, acc1, 0, 0, 0);
                acc0 = __builtin_amdgcn_mfma_f32_16x16x32_bf16(ah, bl0, acc0, 0, 0, 0); acc1 = __builtin_amdgcn_mfma_f32_16x16x32_bf16(ah, bl1, acc1, 0, 0, 0);
            }
            ss += __shfl_xor(ss, 16); ss += __shfl_xor(ss, 32);
            if (kh == 1) { LAS float* pp = part + w4 * 576 + lane;
#pragma unroll
                for (int q = 0; q < 4; ++q) { pp[64 * q] = acc0[q]; pp[64 * (4 + q)] = acc1[q]; }
                pp[64 * 8] = ss; }
            __syncthreads();
            if (kh == 0) { const LAS float* pp = part + w4 * 576 + lane;
#pragma unroll
                for (int q = 0; q < 4; ++q) { acc0[q] += pp[64 * q]; acc1[q] += pp[64 * (4 + q)]; }
                ss += pp[64 * 8];
                const float rrow = 1.0f / sqrtf(ss * (1.f / D) + RMS_EPS);
                float c0[4], c1[4], rt[4], tv[4][4]; int te[4][4];
#pragma unroll
                for (int q = 0; q < 4; ++q) { rt[q] = __shfl(rrow, 4 * fq + q); c0[q] = acc0[q] * rt[q] + rb0; c1[q] = acc1[q] * rt[q] + rb1; }
#pragma unroll
                for (int k = 0; k < 4; ++k) { float v[4]; int e[4];
#pragma unroll
                    for (int q = 0; q < 4; ++q) { v[q] = c0[q]; e[q] = fr; if (c1[q] > c0[q]) { v[q] = c1[q]; e[q] = 16 + fr; } }
#define RT_STEP(CTRL) _Pragma("unroll") for (int q = 0; q < 4; ++q) { const float v2 = __builtin_bit_cast(float, __builtin_amdgcn_update_dpp(0, __builtin_bit_cast(int, v[q]), CTRL, 0xf, 0xf, false)); \
                        const int e2 = __builtin_amdgcn_update_dpp(0, e[q], CTRL, 0xf, 0xf, false); if (v2 > v[q] || (v2 == v[q] && e2 < e[q])) { v[q] = v2; e[q] = e2; } }
                    RT_STEP(0x128) RT_STEP(0x124) RT_STEP(0x122) RT_STEP(0x121)
#undef RT_STEP
#pragma unroll
                    for (int q = 0; q < 4; ++q) { tv[q][k] = v[q]; te[q][k] = e[q]; if (e[q] == fr) c0[q] = -INFINITY; if (e[q] == 16 + fr) c1[q] = -INFINITY; } }
#pragma unroll
                for (int q = 0; q < 4; ++q) {
                    const float e1 = __expf(tv[q][1] - tv[q][0]), e2 = __expf(tv[q][2] - tv[q][0]), e3 = __expf(tv[q][3] - tv[q][0]); const float inv = 1.0f / (1.0f + e1 + e2 + e3);
                    const int tl = w4 * 16 + 4 * fq + q, tok = task * 16 + 4 * fq + q;
                    if (fr == 0) { *(GAS f32x4*)(TOPW + (size_t)tok * 4) = (f32x4){inv, e1 * inv, e2 * inv, e3 * inv}; selR[tl] = rt[q]; }
                    if (fr < 4) { const int em = fr == 0 ? te[q][0] : fr == 1 ? te[q][1] : fr == 2 ? te[q][2] : te[q][3];
                        selE[tl * 4 + fr] = em; selP[tl * 4 + fr] = __hip_atomic_fetch_add(&hist[em], 1, __ATOMIC_RELAXED, __HIP_MEMORY_SCOPE_WORKGROUP); }
                } }
            __syncthreads();
            if (tid < 32) baseE[tid] = (int)__hip_atomic_fetch_add(F.ctl + CW_CNT + 64 * tid, (unsigned)hist[tid], RLX_AGENT);
            __syncthreads();
            if (tid < 256) { const int e = selE[tid]; LIST[(size_t)e * LCAP + baseE[e] + selP[tid]] = (u32x2){(unsigned)((tb * 16 + (tid >> 2)) * 4 + (tid & 3)), __float_as_uint(selR[tid >> 2])}; }
            __syncthreads();
        }
        if (BOTH(4)) GRID_BAR();
    }

    LAS int* tstart = (LAS int*)(F.lds + XTRA_OFF + 14336);
    LAS int* ecnt = tstart + 64;
    LAS i32x4* ulist = (LAS i32x4*)(tstart + 128);
    if (IN(5) || IN(6)) {
        const int tid = F.wave * 64 + lane_id();
        __syncthreads();
        if (tid < 32) ecnt[tid] = (int)__hip_atomic_load(F.ctl + CW_CNT + 64 * tid, RLX_AGENT);
        __syncthreads();
        if (tid == 0) { int s = 0; for (int e = 0; e < NE; ++e) { tstart[e] = s; s += (ecnt[e] + 255) >> 8; } tstart[NE] = s; }
        __syncthreads();
        if (tid < 64) {
            const int which = tid >> 5, i = tid & 31, npn = which ? 4 : 8, nper = F.G / 8, xg = (int)(blockIdx.x % 8), j = (int)(blockIdx.x / 8);
            const int R = (nper / npn) * (i * 8 + xg) + j / npn, Rtot = tstart[NE];
            int e = 0; for (int q = 1; q < NE; ++q) e += (tstart[q] <= R) ? 1 : 0;
            i32x4 u = (i32x4){0, 0, 0, 0};
            if (R < Rtot) { const int pm = R - tstart[e], rem = ecnt[e] - pm * 256; u = (i32x4){e, pm, j % npn, rem < 256 ? rem : 256}; }
            ulist[which * 32 + i] = u; }
        __syncthreads();
    }

    if (IN(5)) {
        pg8::MoeOrder S{ulist, LIST, (const char*)Wgu8, 8, 2048, 2, args.in[13], args.in[15], 128};
        pg8::EpiGU E{HID8};
        pg8::gemm_phase<pg8::EpiGU, pg8::MoeOrder, true, 1>(F.lds, (const char*)T8, D, S, E);
        if (BOTH(5)) GRID_BAR();
    }

    if (IN(6)) {
        pg8::MoeOrder S{ulist + 32, LIST, (const char*)Wd8, 4, 1024, 0, args.in[17], args.in[17], 256};
        pg8::EpiDown E{OB};
        pg8::gemm_phase<pg8::EpiDown, pg8::MoeOrder, true, 1>(F.lds, (const char*)HID8, D, S, E);
        if (BOTH(6)) GRID_BAR();
    }

    if (IN(7)) {
        const int lane = lane_id();
        const GAS f32x4* gp = (const GAS f32x4*)args.in[18] + lane; f32x4 g[4];
#pragma unroll
        for (int j = 0; j < 4; ++j) g[j] = gp[64 * j];
        unsigned bad = __hip_atomic_load(F.ctl + CW_BAR + XB_TMO, RLX_AGENT);
        for (int m = gw; m < T; m += NGW) {
            const GAS u32x2* xr = (const GAS u32x2*)(X1 + (size_t)m * D) + lane; f32x4 v[4];
#pragma unroll
            for (int j = 0; j < 4; ++j) { const u32x2 w = __builtin_nontemporal_load(xr + 64 * j); v[j] = (f32x4){bf_lo(w.x), bf_hi(w.x), bf_lo(w.y), bf_hi(w.y)}; }
            const f32x4 tw = *(const GAS f32x4*)(TOPW + (size_t)m * 4);
#pragma unroll
            for (int k = 0; k < 4; ++k) { const GAS unsigned* orow = (const GAS unsigned*)(OB + ((size_t)m * 4 + k) * D) + lane; const float wk = tw[k] * (1.0f / SC_O);
#pragma unroll
                for (int j = 0; j < 4; ++j) { const unsigned w = __builtin_nontemporal_load(orow + 64 * j); const f32x2 lo = __builtin_amdgcn_cvt_pk_f32_fp8((int)w, false), hi = __builtin_amdgcn_cvt_pk_f32_fp8((int)w, true);
                    v[j].x += wk * lo.x; v[j].y += wk * lo.y; v[j].z += wk * hi.x; v[j].w += wk * hi.y; } }
            float s = 0.f;
#pragma unroll
            for (int j = 0; j < 4; ++j) s += (v[j].x * v[j].x + v[j].y * v[j].y) + (v[j].z * v[j].z + v[j].w * v[j].w);
            float r = 1.0f / sqrtf(wave_sum(s) * (1.f / D) + RMS_EPS);
            if (bad) r = __builtin_nanf("");
            GAS f32x4* o = (GAS f32x4*)(args.out + (size_t)m * D) + lane;
#pragma unroll
            for (int j = 0; j < 4; ++j) __builtin_nontemporal_store(v[j] * r * g[j], o + 64 * j);
        }
    }
#undef IN
#undef BOTH
#undef GRID_BAR
}

#ifndef MK_N_LAUNCHES
#define MK_N_LAUNCHES 1
#endif
extern "C" void kernel_launch(void* const* d_in, const int* in_sizes, int n_in, void* d_out, int out_size, void* d_ws, size_t ws_size, hipStream_t stream) {
    static int grid = 0;
    if (grid == 0) {
        if (n_in != 19 || in_sizes[0] != T * D || out_size != T * D || ws_size < WS_END) { fprintf(stderr, "kernel_launch: unexpected shapes (n_in %d, in0 %d, out %d, ws %zu); nothing launched\n", n_in, n_in > 0 ? in_sizes[0] : -1, out_size, ws_size); grid = -1; return; }
        int dev = 0, cus = 0, per_cu = 0;
        if (hipGetDevice(&dev) != hipSuccess || hipDeviceGetAttribute(&cus, hipDeviceAttributeMultiprocessorCount, dev) != hipSuccess) { fprintf(stderr, "kernel_launch: device query failed\n"); grid = -1; return; }
        if (hipFuncSetAttribute((const void*)hymba_fwd, hipFuncAttributeMaxDynamicSharedMemorySize, LDS_BYTES) != hipSuccess) { fprintf(stderr, "kernel_launch: hipFuncSetAttribute failed\n"); grid = -1; return; }
        if (hipOccupancyMaxActiveBlocksPerMultiprocessor(&per_cu, (const void*)hymba_fwd, NWAVES * 64, LDS_BYTES) != hipSuccess || per_cu < 1) fprintf(stderr, "kernel_launch: note: occupancy query reports %d workgroups per CU\n", per_cu);
        (void)hipGetLastError();
        grid = (cus / 64) * 64; if (grid > 256) grid = 256;
        if (grid < 64) { fprintf(stderr, "kernel_launch: %d CUs: unsupported\n", cus); grid = -1; return; }
    }
    if (grid < 0) return;
    if (hipMemsetAsync((char*)d_ws + WS_CTL, 0, CTL_ZERO_BYTES, stream) != hipSuccess) { fprintf(stderr, "kernel_launch: memset failed\n"); return; }
    Args a{};
    for (int i = 0; i < 19; ++i) a.in[i] = (const float*)d_in[i];
    a.out = (float*)d_out; a.ws = (unsigned char*)d_ws;
    constexpr int NPH = 8;
    if (MK_N_LAUNCHES == 1) { a.ph_lo = 0; a.ph_hi = NPH; hipLaunchKernelGGL(hymba_fwd, dim3(grid), dim3(NWAVES * 64), LDS_BYTES, stream, a); }
    else for (int p = 0; p < NPH; ++p) { a.ph_lo = p; a.ph_hi = p + 1; hipLaunchKernelGGL(hymba_fwd, dim3(grid), dim3(NWAVES * 64), LDS_BYTES, stream, a); }
    const hipError_t le = hipPeekAtLastError();
    if (le != hipSuccess) fprintf(stderr, "kernel_launch: launch failed: %s\n", hipGetErrorName(le));
}
```

```cpp
#include <hip/hip_runtime.h>
#include <cstdio>
#include <cstdint>

#define GAS __attribute__((address_space(1)))
#define LAS __attribute__((address_space(3)))
typedef unsigned short bf16_t;
typedef short bf16x8 __attribute__((ext_vector_type(8)));
typedef short s16x4 __attribute__((ext_vector_type(4)));
typedef float f32x2 __attribute__((ext_vector_type(2)));
typedef float f32x4 __attribute__((ext_vector_type(4)));
typedef float f32x16 __attribute__((ext_vector_type(16)));
typedef unsigned u32x2 __attribute__((ext_vector_type(2)));
typedef unsigned u32x4 __attribute__((ext_vector_type(4)));
typedef int i32x4 __attribute__((ext_vector_type(4)));
typedef int i32x8 __attribute__((ext_vector_type(8)));
typedef GAS unsigned gu32;
#define RLX_AGENT __ATOMIC_RELAXED, __HIP_MEMORY_SCOPE_AGENT
#define LDS_WAIT() asm volatile("s_waitcnt lgkmcnt(0)" ::: "memory")
#define VM_WAIT() asm volatile("s_waitcnt vmcnt(0)" ::: "memory")

constexpr int T = 16384, SEQ = 8192, D = 1024, NIN = 2560, DA = 512, NH = 8, HD = 64, DC = 512, CW = 31;
constexpr int NE = 32, TOPK = 4, NP = T * TOPK, LCAP = 16384, NREL = 192;
constexpr float RMS_EPS = 1e-5f, LN_EPS = 1e-5f, LOG2E = 1.4426950408889634f;
constexpr float QSCALE = 0.125f * LOG2E;
constexpr float SC_T = 16.0f, SC_W = 256.0f, SC_H = 4.0f, SC_O = 32.0f;

constexpr size_t MiB = 1u << 20;
constexpr size_t WS_CTL = 0, CTL_ZERO_BYTES = 64 * 1024;
constexpr size_t WS_WIN = 1 * MiB, WS_WOUT = 6 * MiB, WS_WGU = 8 * MiB, WS_WD = 136 * MiB, WS_X1 = 200 * MiB, WS_XN = 264 * MiB;
constexpr size_t WS_Q = 296 * MiB, WS_K = 312 * MiB, WS_V = 328 * MiB, WS_A = 344 * MiB, WS_G = 360 * MiB, WS_MIX = 376 * MiB;
constexpr size_t WS_HID = 296 * MiB;
constexpr size_t WS_O = WS_WGU;
constexpr size_t WS_LIST = 424 * MiB, WS_TOPW = 428 * MiB, WS_RWT = 429 * MiB, WS_END = 430 * MiB;
constexpr int CW_TMO = 0, CW_BAR = 4096, CW_CNT = 8192;

constexpr int RING_BYTES = 131072, XTRA_OFF = RING_BYTES, LDS_BYTES = 147456, LDSCTL_OFF = LDS_BYTES - 512;
constexpr int NWAVES = 8;

__device__ __forceinline__ unsigned f2bf(float f) { unsigned u = __builtin_bit_cast(unsigned, f); return (u + 0x7fffu + ((u >> 16) & 1u)) >> 16; }
__device__ __forceinline__ unsigned pk2(float lo, float hi) { return f2bf(lo) | (f2bf(hi) << 16); }
__device__ __forceinline__ unsigned cvt_pk_bf16(float lo, float hi) { unsigned r; asm volatile("v_cvt_pk_bf16_f32 %0, %1, %2" : "=v"(r) : "v"(lo), "v"(hi)); return r; }
__device__ __forceinline__ float clamp448(float v) { return fminf(fmaxf(v, -448.0f), 448.0f); }
__device__ __forceinline__ unsigned pk4_fp8(float a, float b, float c, float d) {
    int r = __builtin_amdgcn_cvt_pk_fp8_f32(clamp448(a), clamp448(b), 0, false);
    r = __builtin_amdgcn_cvt_pk_fp8_f32(clamp448(c), clamp448(d), r, true);
    return (unsigned)r;
}
__device__ __forceinline__ unsigned pk4_fp8_nc(float a, float b, float c, float d) {
    int r = __builtin_amdgcn_cvt_pk_fp8_f32(a, b, 0, false);
    r = __builtin_amdgcn_cvt_pk_fp8_f32(c, d, r, true);
    return (unsigned)r;
}
__device__ __forceinline__ float bf_lo(unsigned w) { return __uint_as_float(w << 16); }
__device__ __forceinline__ float bf_hi(unsigned w) { return __uint_as_float(w & 0xffff0000u); }
__device__ __forceinline__ float fsigmoid(float z) { return __builtin_amdgcn_rcpf(1.0f + __builtin_amdgcn_exp2f(-z * LOG2E)); }
__device__ __forceinline__ int lane_id() { int l; asm volatile("v_mbcnt_lo_u32_b32 %0, -1, 0\n\tv_mbcnt_hi_u32_b32 %0, -1, %0" : "=v"(l)); return l; }
__device__ __forceinline__ float wave_sum(float v) {
#define WS_DPP(x, ctrl) __builtin_bit_cast(float, __builtin_amdgcn_update_dpp(0, __builtin_bit_cast(int, (x)), (ctrl), 0xf, 0xf, false))
    v += WS_DPP(v, 0xB1);
    v += WS_DPP(v, 0x4E);
    v += WS_DPP(v, 0x124);
    v += WS_DPP(v, 0x128);
#undef WS_DPP
    const float r0 = __builtin_bit_cast(float, __builtin_amdgcn_readlane(__builtin_bit_cast(int, v), 0)), r1 = __builtin_bit_cast(float, __builtin_amdgcn_readlane(__builtin_bit_cast(int, v), 16));
    const float r2 = __builtin_bit_cast(float, __builtin_amdgcn_readlane(__builtin_bit_cast(int, v), 32)), r3 = __builtin_bit_cast(float, __builtin_amdgcn_readlane(__builtin_bit_cast(int, v), 48));
    return (r0 + r1) + (r2 + r3);
}

namespace pg8 {
constexpr int BM = 256, BK = 64, HALF = 128, HTB = HALF * BK * 2, STAGE_BYTES = 8 * HTB;
__device__ __forceinline__ int lds_byte(int r, int c) { const int st = (r >> 4) * 2 + (c >> 5), rr = r & 15, cc = c & 31, ob = rr * 64 + cc * 2; return st * 1024 + (ob ^ (((ob >> 9) & 1) << 5)); }
__device__ __forceinline__ void stage_rc(int b, int& R, int& C) { const int st = b / 1024, sb = b % 1024, swz = sb ^ (((sb >> 9) & 1) << 5); R = (st >> 1) * 16 + swz / 64; C = (st & 1) * 32 + (swz % 64) / 2; }
__device__ __forceinline__ int perm32(int rho) { const int n = rho >> 4, i = rho & 15; return 8 * (i >> 2) + 4 * n + (i & 3); }

struct Unit { int pm, pn, e, nv; };
template <int N> __device__ __forceinline__ void wait_vm() { asm volatile("s_waitcnt vmcnt(%0)" :: "n"(N) : "memory"); }
template <int NFRESH, int NSTEADY> __device__ __forceinline__ void wait_vm_sel(int fresh) {
    asm volatile("s_cmp_eq_u32 %0, 0\n\ts_cbranch_scc1 .Lwvs_a_%=\n\ts_waitcnt vmcnt(%1)\n\ts_branch .Lwvs_b_%=\n.Lwvs_a_%=:\n\ts_waitcnt vmcnt(%2)\n.Lwvs_b_%=:" :: "s"(__builtin_amdgcn_readfirstlane(fresh)), "n"(NFRESH), "n"(NSTEADY) : "scc", "memory"); }

template <class Epi, class Sched, bool ALIGN_EPI, int ESZ>
__device__ __forceinline__ void gemm_phase(LAS unsigned char* lds, const char* Abase, const int K, const Sched& S, const Epi& E) {
    const int wid = __builtin_amdgcn_readfirstlane(threadIdx.x >> 6), lane = lane_id(), tid = wid * 64 + lane, wr = wid >> 2, wc = wid & 3, fr = lane & 15, fq = lane >> 4;
    const int RB = K * ESZ, nt = RB / 128;
    unsigned voffB[2];
#pragma unroll
    for (int i = 0; i < 2; ++i) { int R, C; stage_rc(tid * 16 + i * 8192, R, C); const int Rb = Epi::PERM ? ((R & ~31) + perm32(R & 31)) : R; voffB[i] = (unsigned)(Rb * RB + 2 * C); }
    const size_t kstep = (size_t)(BK * 2);
    const size_t hstep = (size_t)HALF * RB;
    const unsigned ldsw = (unsigned)wid * 1024u;
    const int aoff = lds_byte(wr * 64 + fr, fq * 8), boff = lds_byte(wc * 32 + fr, fq * 8);
#define PG8_SA(b, h) (((b) * 2 + (h)) * HTB)
#define PG8_SB(b, h) ((4 + (b) * 2 + (h)) * HTB)
#define PG8_STAGE(bufoff, gbase, voff) do { _Pragma("unroll") for (int _i = 0; _i < 2; ++_i) \
        __builtin_amdgcn_global_load_lds((const unsigned*)((const char*)(gbase) + (voff)[_i]), (LAS unsigned*)(lds + (bufoff) + ldsw + _i * 8192), 16, 0, 0); } while (0)
#define PG8_LD16(off) (*(const LAS i32x4*)(lds + (off)))
#define PG8_LDA(dst, b, h) do { _Pragma("unroll") for (int m = 0; m < 4; ++m) { const i32x4 _x = PG8_LD16(PG8_SA(b, h) + aoff + m * 2048), _y = PG8_LD16(PG8_SA(b, h) + aoff + m * 2048 + 1024); dst[m] = __builtin_shufflevector(_x, _y, 0, 1, 2, 3, 4, 5, 6, 7); } } while (0)
#define PG8_LDB(dst, b, h) do { _Pragma("unroll") for (int n = 0; n < 2; ++n) { const i32x4 _x = PG8_LD16(PG8_SB(b, h) + boff + n * 2048), _y = PG8_LD16(PG8_SB(b, h) + boff + n * 2048 + 1024); dst[n] = __builtin_shufflevector(_x, _y, 0, 1, 2, 3, 4, 5, 6, 7); } } while (0)
#define PG8_MMA(ai, bj, At, Bt) do { __builtin_amdgcn_s_setprio(1); _Pragma("unroll") for (int m = 0; m < 4; ++m) _Pragma("unroll") for (int n = 0; n < 2; ++n) _Pragma("unroll") for (int k = 0; k < 2; ++k) \
        acc[ai][bj][m][n] = __builtin_amdgcn_mfma_f32_16x16x32_bf16(PG8_HALF(Bt[n], k), PG8_HALF(At[m], k), acc[ai][bj][m][n], 0, 0, 0); __builtin_amdgcn_s_setprio(0); } while (0)
#define PG8_HALF(v, k) __builtin_bit_cast(bf16x8, (k) == 0 ? __builtin_shufflevector((v), (v), 0, 1, 2, 3) : __builtin_shufflevector((v), (v), 4, 5, 6, 7))
#define PG8_MMA8(ai, bj, At, Bt) do { __builtin_amdgcn_s_setprio(1); _Pragma("unroll") for (int m = 0; m < 4; ++m) _Pragma("unroll") for (int n = 0; n < 2; ++n) \
        acc[ai][bj][m][n] = __builtin_amdgcn_mfma_scale_f32_16x16x128_f8f6f4(Bt[n], At[m], acc[ai][bj][m][n], 0, 0, 0, 0, 0, 0);     __builtin_amdgcn_s_setprio(0); } while (0)
#define PG8_MM(ai, bj, At, Bt) do { if constexpr (ESZ == 2) PG8_MMA(ai, bj, At, Bt); else PG8_MMA8(ai, bj, At, Bt); } while (0)
#define PG8_WAIT_V(n) asm volatile("s_waitcnt vmcnt(" #n ")" ::: "memory")
#define PG8_WAIT_L(n) asm volatile("s_waitcnt lgkmcnt(" #n ")" ::: "memory")
#define PG8_BAR __builtin_amdgcn_s_barrier()
#define PG8_SCHED __builtin_amdgcn_sched_barrier(0)
    Unit cur, nxt; int ui = 0;
    if (!S.next(0, cur)) return;
    f32x4 acc[2][2][4][2];
#pragma unroll
    for (int a = 0; a < 2; ++a)
#pragma unroll
        for (int b = 0; b < 2; ++b)
#pragma unroll
            for (int m = 0; m < 4; ++m)
#pragma unroll
                for (int n = 0; n < 2; ++n) acc[a][b][m][n] = (f32x4){0.f, 0.f, 0.f, 0.f};
    i32x8 At[4], B0[2], B1[2];
    unsigned vA0[2], vA1[2];
    LAS u32x4* const vslot = (LAS u32x4*)(lds + STAGE_BYTES) + tid;
    LAS u32x2* const rowtab = (LAS u32x2*)(lds + STAGE_BYTES + 8192);
    LAS f32x4* const biastab = (LAS f32x4*)(lds + STAGE_BYTES + 8192 + 4096);
    if constexpr (Sched::GATHER) {
        if (tid < 256) rowtab[tid] = *S.entry_ptr(cur, tid);
        else if (tid < 320) biastab[tid - 256] = *(const f32x4*)S.bias_ptr(cur, tid - 256);
        __syncthreads();
        S.a_off_tab(rowtab, cur.nv, tid, RB, vA0, vA1);
    } else S.a_off(cur, tid, RB, vA0, vA1);
    const char* cB = S.b_ptr(cur, RB);
    const char* cA = Abase;
    PG8_STAGE(PG8_SB(0, 0), cB, voffB); PG8_STAGE(PG8_SB(0, 1), cB + hstep, voffB); PG8_STAGE(PG8_SA(0, 0), cA, vA0); PG8_STAGE(PG8_SA(0, 1), cA, vA1);
    if (wr == 1) PG8_BAR;
    PG8_WAIT_V(2); PG8_BAR;
    PG8_STAGE(PG8_SB(1, 0), cB + kstep, voffB); PG8_STAGE(PG8_SA(1, 0), cA + kstep, vA0); PG8_STAGE(PG8_SB(1, 1), cB + hstep + kstep, voffB);
    PG8_WAIT_V(6); PG8_BAR;
    for (;;) {
        const bool has_next = S.next(ui + 1, nxt);
        const char* nB = cB;
        const int par = ui & 1;
        if constexpr (Sched::GATHER) {
            if (has_next) nB = S.b_ptr(nxt, RB);
            else *vslot = (u32x4){vA0[0], vA0[1], vA1[0], vA1[1]};
        } else {
            unsigned n0[2] = {vA0[0], vA0[1]}, n1[2] = {vA1[0], vA1[1]};
            if (has_next) { S.a_off(nxt, tid, RB, n0, n1); nB = S.b_ptr(nxt, RB); }
            *vslot = (u32x4){n0[0], n0[1], n1[0], n1[1]};
        }
#pragma clang loop unroll(disable)
        for (int t = 0; t < nt; t += 2) {
            const bool last = (t == nt - 2);
            const int fresh = ((ui > 0) && (t == 0)) ? 1 : 0;
            if constexpr (Sched::GATHER) {
                if (has_next && t == 2) { const int l2 = lane_id();
                    if (wid < 2) __builtin_amdgcn_global_load_lds((const unsigned*)((const char*)S.entry_ptr(nxt, 0) + (wid * 64 + l2) * 16), (LAS unsigned*)((LAS char*)(rowtab + (par ^ 1) * 256) + wid * 1024), 16, 0, 0);
                    if (wid == 4) __builtin_amdgcn_global_load_lds((const unsigned*)S.bias_ptr(nxt, l2), (LAS unsigned*)(biastab + (par ^ 1) * 64), 16, 0, 0); }
                if (has_next && t == 4) { unsigned n0[2], n1[2]; const int t2 = wid * 64 + lane_id(); S.a_off_tab_nowait(rowtab + (par ^ 1) * 256, nxt.nv, t2, RB, n0, n1); ((LAS u32x4*)(lds + STAGE_BYTES))[t2] = (u32x4){n0[0], n0[1], n1[0], n1[1]}; }
            }
            const char* a1 = cA + (size_t)(t + 1) * kstep;
            const char* a2 = last ? cA : cA + (size_t)(t + 2) * kstep; const char* b2 = last ? nB : cB + (size_t)(t + 2) * kstep;
            const char* a3 = a2 + kstep; const char* b3 = b2 + kstep;
            PG8_LDB(B0, 0, 0); PG8_LDB(B1, 0, 1); PG8_SCHED; PG8_LDA(At, 0, 0); PG8_STAGE(PG8_SA(1, 1), a1, vA1);
            if (last) { const u32x4 nv = *vslot; vA0[0] = nv.x; vA0[1] = nv.y; vA1[0] = nv.z; vA1[1] = nv.w; }
            wait_vm_sel<8 + Epi::NSTORE, 8>(fresh); PG8_WAIT_L(0); PG8_BAR; PG8_MM(0, 0, At, B0); PG8_MM(0, 1, At, B1); PG8_BAR; PG8_SCHED;
            PG8_LDA(At, 0, 1); PG8_STAGE(PG8_SB(0, 0), b2, voffB); PG8_STAGE(PG8_SB(0, 1), b2 + hstep, voffB); PG8_STAGE(PG8_SA(0, 0), a2, vA0);
            wait_vm_sel<8 + Epi::NSTORE, 8>(fresh); PG8_WAIT_L(0); PG8_BAR; PG8_MM(1, 0, At, B0); PG8_MM(1, 1, At, B1); PG8_BAR; PG8_SCHED;
            PG8_LDB(B0, 1, 0); PG8_LDB(B1, 1, 1); PG8_SCHED; PG8_LDA(At, 1, 0); PG8_STAGE(PG8_SA(0, 1), a2, vA1);
            PG8_WAIT_V(8); PG8_WAIT_L(0); PG8_BAR; PG8_MM(0, 0, At, B0); PG8_MM(0, 1, At, B1); PG8_BAR; PG8_SCHED;
            PG8_LDA(At, 1, 1); PG8_STAGE(PG8_SB(1, 0), b3, voffB); PG8_STAGE(PG8_SB(1, 1), b3 + hstep, voffB); PG8_STAGE(PG8_SA(1, 0), a3, vA0);
            PG8_WAIT_V(8); PG8_WAIT_L(0); PG8_BAR; PG8_MM(1, 0, At, B0); PG8_MM(1, 1, At, B1); PG8_BAR; PG8_SCHED;
        }
        if constexpr (ALIGN_EPI) { if (wr == 0) PG8_BAR; }
        if constexpr (Sched::GATHER) { int zofs; asm volatile("s_mov_b32 %0, 0" : "=s"(zofs));
            E(acc, cur, wr, wc, fr, fq, rowtab + par * 256 + zofs, biastab + par * 64 + zofs); } else E(acc, cur, wr, wc, fr, fq);
        if (!has_next) break;
#pragma unroll
        for (int a = 0; a < 2; ++a)
#pragma unroll
            for (int b = 0; b < 2; ++b)
#pragma unroll
                for (int m = 0; m < 4; ++m)
#pragma unroll
                    for (int n = 0; n < 2; ++n) acc[a][b][m][n] = (f32x4){0.f, 0.f, 0.f, 0.f};
        cur = nxt; cB = nB; ++ui;
        if constexpr (ALIGN_EPI) { if (wr == 1) PG8_BAR; }
    }
    PG8_WAIT_V(0);
    if constexpr (!ALIGN_EPI) { if (wr == 0) PG8_BAR; }
    PG8_BAR;
#undef PG8_SA
#undef PG8_SB
#undef PG8_STAGE
#undef PG8_LDA
#undef PG8_LDB
#undef PG8_MMA
#undef PG8_MMA8
#undef PG8_MM
#undef PG8_HALF
#undef PG8_LD16
#undef PG8_WAIT_V
#undef PG8_WAIT_L
#undef PG8_BAR
#undef PG8_SCHED
}

struct DenseOrder {
    static constexpr bool GATHER = false;
    int nM, nN, nwg, G, c; const char* Bt;
    __device__ __forceinline__ void init(int M, int N, int G_, int c_, const void* Bt_) { nM = M / BM; nN = N / BM; nwg = nM * nN; G = G_; c = c_; Bt = (const char*)Bt_; }
    __device__ __forceinline__ bool next(int i, Unit& u) const {
        const long L = (long)i * G + c; if (L >= nwg) return false;
        int wgid = (int)L; { const int q = nwg / 8, r = nwg % 8, xcd = wgid % 8, off = wgid / 8; wgid = (xcd < r ? xcd * (q + 1) : r * (q + 1) + (xcd - r) * q) + off; }
        const int nig = 8 * nN, gid = wgid / nig, fm = gid * 8, gsz = (nM - fm) < 8 ? (nM - fm) : 8;
        u.pm = fm + ((wgid % nig) % gsz); u.pn = (wgid % nig) / gsz; u.e = 0; u.nv = 256; return true;
    }
    __device__ __forceinline__ const char* b_ptr(const Unit& u, int RB) const { return Bt + (size_t)u.pn * (256 * (size_t)RB); }
    __device__ __forceinline__ void a_off(const Unit& u, int tid, int RB, unsigned (&v0)[2], unsigned (&v1)[2]) const {
#pragma unroll
        for (int i = 0; i < 2; ++i) { int R, C; stage_rc(tid * 16 + i * 8192, R, C); v0[i] = (unsigned)((u.pm * 256 + R) * RB + 2 * C); v1[i] = (unsigned)((u.pm * 256 + 128 + R) * RB + 2 * C); }
    }
};
struct MoeOrder {
    static constexpr bool GATHER = true;
    const LAS i32x4* ul;
    const u32x2* list;
    const char* Bt; int npn, nrowsB, shiftA;
    const float* bias0; const float* bias1; int bcols;
    __device__ __forceinline__ bool next(int i, Unit& u) const {
        if (i >= 32) return false;
        const i32x4 v = ul[i];
        u.e = __builtin_amdgcn_readfirstlane(v.x); u.pm = __builtin_amdgcn_readfirstlane(v.y); u.pn = __builtin_amdgcn_readfirstlane(v.z); u.nv = __builtin_amdgcn_readfirstlane(v.w);
        return u.nv > 0;
    }
    __device__ __forceinline__ const char* b_ptr(const Unit& u, int RB) const { return Bt + ((size_t)u.e * nrowsB + (size_t)u.pn * 256) * (size_t)RB; }
    __device__ __forceinline__ const u32x2* entry_ptr(const Unit& u, int t) const { return list + (size_t)u.e * LCAP + u.pm * 256 + t; }
    __device__ __forceinline__ const float* bias_ptr(const Unit& u, int i) const {
        return (bcols == 128) ? ((i < 32 ? bias0 : bias1) + (size_t)u.e * D + u.pn * 128 + 4 * (i & 31)) : (bias0 + (size_t)u.e * D + u.pn * 256 + 4 * i); }
    __device__ __forceinline__ void a_off_tab(const LAS u32x2* rt, int nv, int tid, int RB, unsigned (&v0)[2], unsigned (&v1)[2]) const {
#pragma unroll
        for (int i = 0; i < 2; ++i) { int R, C; stage_rc(tid * 16 + i * 8192, R, C);
            const int p0 = (int)rt[R < nv ? R : 0].x >> shiftA, p1 = (int)rt[(128 + R) < nv ? (128 + R) : 0].x >> shiftA;
            v0[i] = (unsigned)(p0 * RB + 2 * C); v1[i] = (unsigned)(p1 * RB + 2 * C); }
    }
    __device__ __forceinline__ void a_off_tab_nowait(const LAS u32x2* rt, int nv, int tid, int RB, unsigned (&v0)[2], unsigned (&v1)[2]) const {
        unsigned pr[4]; int Cc[2];
#pragma unroll
        for (int i = 0; i < 2; ++i) { int R, C; stage_rc(tid * 16 + i * 8192, R, C); Cc[i] = C;
            const unsigned a0 = (unsigned)(uintptr_t)(rt + (R < nv ? R : 0)), a1 = (unsigned)(uintptr_t)(rt + ((128 + R) < nv ? (128 + R) : 0));
            asm volatile("ds_read_b32 %0, %1" : "=v"(pr[2 * i]) : "v"(a0) : "memory"); asm volatile("ds_read_b32 %0, %1" : "=v"(pr[2 * i + 1]) : "v"(a1) : "memory"); }
        asm volatile("s_waitcnt lgkmcnt(0)" : "+v"(pr[0]), "+v"(pr[1]), "+v"(pr[2]), "+v"(pr[3]) :: "memory");
#pragma unroll
        for (int i = 0; i < 2; ++i) { v0[i] = (unsigned)(((int)pr[2 * i] >> shiftA) * RB + 2 * Cc[i]); v1[i] = (unsigned)(((int)pr[2 * i + 1] >> shiftA) * RB + 2 * Cc[i]); }
    }
};

struct EpiSplit {
    static constexpr bool PERM = true; static constexpr int NSTORE = 16;
    bf16_t* O; size_t split_stride; float scale0;
    __device__ __forceinline__ void operator()(const f32x4 (&acc)[2][2][4][2], const Unit& u, int wr, int wc, int fr, int fq) const {
        const int row0 = u.pm * BM + wr * 64 + fr; int colt = u.pn * BM; const int t = colt / 512; bf16_t* base = O + (size_t)t * split_stride; colt -= t * 512;
        const float sc = (t == 0) ? scale0 : 1.f;
        const int col0 = colt + wc * 32 + 8 * fq;
#pragma unroll
        for (int ai = 0; ai < 2; ++ai)
#pragma unroll
            for (int m = 0; m < 4; ++m) { bf16_t* rowp = base + (size_t)(row0 + ai * HALF + m * 16) * 512 + col0;
#pragma unroll
                for (int bj = 0; bj < 2; ++bj) { const f32x4 v0 = acc[ai][bj][m][0] * sc, v1 = acc[ai][bj][m][1] * sc;
                    u32x4 w; w.x = cvt_pk_bf16(v0[0], v0[1]); w.y = cvt_pk_bf16(v0[2], v0[3]); w.z = cvt_pk_bf16(v1[0], v1[1]); w.w = cvt_pk_bf16(v1[2], v1[3]);
                    *(u32x4*)(rowp + bj * HALF) = w; } }
    }
};
struct EpiRes {
    static constexpr bool PERM = true; static constexpr int NSTORE = 0;
    const float* base; bf16_t* out; unsigned char* t8; const float* gain;
    __device__ __forceinline__ void operator()(const f32x4 (&acc)[2][2][4][2], const Unit& u, int wr, int wc, int fr, int fq) const {
        const int row0 = u.pm * BM + wr * 64 + fr, col0 = u.pn * BM + wc * 32 + 8 * fq;
        f32x4 gv[2][2];
#pragma unroll
        for (int bj = 0; bj < 2; ++bj)
#pragma unroll
            for (int n = 0; n < 2; ++n) gv[bj][n] = *(const f32x4*)(gain + col0 + bj * HALF + 4 * n) * SC_T;
#pragma unroll
        for (int ai = 0; ai < 2; ++ai)
#pragma unroll
            for (int m = 0; m < 4; ++m) { const size_t off = (size_t)(row0 + ai * HALF + m * 16) * D + col0;
#pragma unroll
                for (int bj = 0; bj < 2; ++bj) { const f32x4 v0 = __builtin_nontemporal_load((const f32x4*)(base + off + bj * HALF)) + acc[ai][bj][m][0], v1 = __builtin_nontemporal_load((const f32x4*)(base + off + bj * HALF + 4)) + acc[ai][bj][m][1];
                    *(u32x4*)(out + off + bj * HALF) = (u32x4){cvt_pk_bf16(v0[0], v0[1]), cvt_pk_bf16(v0[2], v0[3]), cvt_pk_bf16(v1[0], v1[1]), cvt_pk_bf16(v1[2], v1[3])};
                    const f32x4 s0 = v0 * gv[bj][0], s1 = v1 * gv[bj][1];
                    *(u32x2*)(t8 + off + bj * HALF) = (u32x2){pk4_fp8(s0[0], s0[1], s0[2], s0[3]), pk4_fp8(s1[0], s1[1], s1[2], s1[3])}; } }
    }
};
struct EpiGU {
    static constexpr bool PERM = true; static constexpr int NSTORE = 8;
    unsigned char* hid;
    __device__ __forceinline__ void operator()(const f32x4 (&acc)[2][2][4][2], const Unit& u, int wr, int wc, int fr, int fq, const LAS u32x2* rt, const LAS f32x4* bt) const {
        const int hc = u.pn * 128 + wc * 32 + 8 * fq;
        const f32x4 g0 = bt[8 * wc + 2 * fq], g1 = bt[8 * wc + 2 * fq + 1], u0 = bt[32 + 8 * wc + 2 * fq], u1 = bt[32 + 8 * wc + 2 * fq + 1];
        constexpr float inv = 1.0f / (SC_T * SC_W);
#pragma unroll
        for (int ai = 0; ai < 2; ++ai)
#pragma unroll
            for (int m = 0; m < 4; ++m) { const int r = ai * HALF + wr * 64 + m * 16 + fr;
                const u32x2 en = rt[r]; const float rs = __uint_as_float(en.y) * inv;
                f32x2 h[4];
#pragma unroll
                for (int n = 0; n < 2; ++n)
#pragma unroll
                    for (int x = 0; x < 2; ++x) { const f32x4 ga = acc[ai][0][m][n], ua = acc[ai][1][m][n], gb = n ? g1 : g0, ub = n ? u1 : u0;
                        f32x2 g = (f32x2){ga[2 * x], ga[2 * x + 1]} * rs + (f32x2){gb[2 * x], gb[2 * x + 1]}, up = (f32x2){ua[2 * x], ua[2 * x + 1]} * rs + (f32x2){ub[2 * x], ub[2 * x + 1]};
                        g.x = fminf(g.x, 7.0f); g.y = fminf(g.y, 7.0f); up.x = __builtin_amdgcn_fmed3f(up.x, -7.0f, 7.0f); up.y = __builtin_amdgcn_fmed3f(up.y, -7.0f, 7.0f);
                        const f32x2 z = g * (-1.702f * LOG2E); f32x2 t; t.x = __builtin_amdgcn_exp2f(z.x); t.y = __builtin_amdgcn_exp2f(z.y); t = t + 1.0f;
                        f32x2 sg; sg.x = __builtin_amdgcn_rcpf(t.x); sg.y = __builtin_amdgcn_rcpf(t.y);
                        h[n * 2 + x] = (up * SC_H + SC_H) * (g * sg); }
                u32x2 w; w.x = pk4_fp8_nc(h[0].x, h[0].y, h[1].x, h[1].y); w.y = pk4_fp8_nc(h[2].x, h[2].y, h[3].x, h[3].y);
                *(u32x2*)(hid + (size_t)(r < u.nv ? en.x : (unsigned)NP) * D + hc) = w; }
    }
};
struct EpiDown {
    static constexpr bool PERM = true; static constexpr int NSTORE = 16;
    unsigned char* o;
    __device__ __forceinline__ void operator()(const f32x4 (&acc)[2][2][4][2], const Unit& u, int wr, int wc, int fr, int fq, const LAS u32x2* rt, const LAS f32x4* bt) const {
        constexpr float inv = SC_O / (SC_H * SC_W);
        const int c0 = u.pn * BM + wc * 32 + 8 * fq;
        f32x4 bv[2][2];
#pragma unroll
        for (int bj = 0; bj < 2; ++bj)
#pragma unroll
            for (int n = 0; n < 2; ++n) bv[bj][n] = bt[bj * 32 + wc * 8 + 2 * fq + n] * SC_O;
#pragma unroll
        for (int ai = 0; ai < 2; ++ai)
#pragma unroll
            for (int m = 0; m < 4; ++m) { const int r = ai * HALF + wr * 64 + m * 16 + fr;
                const unsigned p = (r < u.nv) ? rt[r].x : (unsigned)NP; unsigned char* rowp = o + (size_t)p * D + c0;
#pragma unroll
                for (int bj = 0; bj < 2; ++bj) { const f32x4 v0 = acc[ai][bj][m][0] * inv + bv[bj][0], v1 = acc[ai][bj][m][1] * inv + bv[bj][1];
                    *(u32x2*)(rowp + bj * HALF) = (u32x2){pk4_fp8(v0[0], v0[1], v0[2], v0[3]), pk4_fp8(v1[0], v1[1], v1[2], v1[3])}; } }
    }
};
}

#define XB_TMO      128
#define XB_XCNT(j)  (256  + 64 * (j))
#define XB_XSUB(j)  (1280 + 64 * (j))
#define XB_XGEN(j)  (2304 + 64 * (j))
#define XB_TOP      3328
#define XB_TOPGEN   3392
#define XCD_BAR_WORDS 3456
#define XB_SPIN_CAP (1u << 18)
__device__ __forceinline__ unsigned xb_ld(unsigned* p)              { return __hip_atomic_load(p, __ATOMIC_RELAXED, __HIP_MEMORY_SCOPE_AGENT); }
__device__ __forceinline__ unsigned xb_add(unsigned* p, unsigned v) { return __hip_atomic_fetch_add(p, v, __ATOMIC_RELAXED, __HIP_MEMORY_SCOPE_AGENT); }
__device__ __forceinline__ unsigned xb_xcc_id() { return (unsigned)__builtin_amdgcn_s_getreg((3 << 11) | 20) & 0xFu; }
#define XB_SPIN(cond, bar) do { unsigned _sp = 0; while (cond) { __builtin_amdgcn_s_sleep(1); \
    if ((++_sp & 255u) == 0u) { if (xb_ld(&(bar)[XB_TMO])) break; if (_sp > XB_SPIN_CAP) { atomicAdd(&(bar)[XB_TMO], 1u); break; } } } } while (0)
struct XcdBarrier { unsigned* bar; unsigned x; volatile LAS unsigned* st; };
__device__ __forceinline__ XcdBarrier xcd_barrier_post(unsigned* bar, volatile LAS unsigned* st) {
    XcdBarrier b; b.bar = bar; b.x = xb_xcc_id(); b.st = st;
    if (threadIdx.x == 0) (void)xb_add(&bar[XB_XCNT(b.x)], 1u);
    return b;
}
__device__ __forceinline__ void xcd_barrier_complete(unsigned* bar, unsigned x, unsigned& nloc, unsigned& nx) {
    const unsigned G = gridDim.x * gridDim.y * gridDim.z;
    unsigned sum, cnt, mine, sp = 0u;
    for (;;) {
        sum = 0u; cnt = 0u; mine = 0u;
#pragma unroll
        for (unsigned j = 0; j < 16; ++j) { const unsigned c = xb_ld(&bar[XB_XCNT(j)]); sum += c; cnt += (c > 0u) ? 1u : 0u; mine = (j == x) ? c : mine; }
        if (sum == G) break;
        __builtin_amdgcn_s_sleep(1);
        if ((++sp & 255u) == 0u) { if (xb_ld(&bar[XB_TMO])) break; if (sp > XB_SPIN_CAP) { atomicAdd(&bar[XB_TMO], 1u); break; } }
    }
    nloc = mine > 0u ? mine : 1u; nx = cnt > 0u ? cnt : 1u;
}
__device__ __forceinline__ void xcd_barrier(const XcdBarrier& b) {
    asm volatile("s_waitcnt vmcnt(0)" ::: "memory");
    __syncthreads();
    if (threadIdx.x == 0) {
        unsigned* bar = b.bar;
        __builtin_amdgcn_s_waitcnt(0);
        unsigned nloc = b.st[0], nx = b.st[1];
        if (nloc == 0u) { xcd_barrier_complete(bar, b.x, nloc, nx); b.st[0] = nloc; b.st[1] = nx; }
        const unsigned old = xb_add(&bar[XB_XSUB(b.x)], 1u);
        const unsigned gen = old / nloc;
        if (old + 1u == (gen + 1u) * nloc) {
            __builtin_amdgcn_fence(__ATOMIC_RELEASE, "agent");
            asm volatile("s_waitcnt vmcnt(0)" ::: "memory");
            const unsigned og = xb_add(&bar[XB_TOP], 1u);
            const unsigned tg = og / nx;
            if (og + 1u == (tg + 1u) * nx) xb_add(&bar[XB_TOPGEN], 1u);
            else XB_SPIN(xb_ld(&bar[XB_TOPGEN]) == tg, bar);
            __builtin_amdgcn_fence(__ATOMIC_ACQUIRE, "agent");
            xb_add(&bar[XB_XGEN(b.x)], 1u);
            asm volatile("s_waitcnt vmcnt(0)" ::: "memory");
        } else {
            XB_SPIN(xb_ld(&bar[XB_XGEN(b.x)]) == gen, bar);
            __builtin_amdgcn_fence(__ATOMIC_ACQUIRE, "agent");
            asm volatile("s_waitcnt vmcnt(0)" ::: "memory");
        }
    }
    __syncthreads();
}

struct Frame {
    LAS unsigned char* lds;
    gu32* ctl;
    int wave, G, vcu;
};

__device__ __forceinline__ void transpose_item(const float* W, int N, int k0, int n0, bf16_t* dst, int K, LAS float* scr, int lane) {
    f32x4 v[8];
#pragma unroll
    for (int it = 0; it < 8; ++it) v[it] = *(const GAS f32x4*)(W + (size_t)(k0 + it * 8 + (lane >> 3)) * N + n0 + 4 * (lane & 7));
#pragma unroll
    for (int it = 0; it < 8; ++it) { LAS float* s = scr + (it * 8 + (lane >> 3)) * 33 + 4 * (lane & 7); s[0] = v[it].x; s[1] = v[it].y; s[2] = v[it].z; s[3] = v[it].w; }
    LDS_WAIT(); asm volatile("" ::: "memory");
    const int c = lane & 7;
#pragma unroll
    for (int j = 0; j < 4; ++j) { const int n = (lane >> 3) + 8 * j; const LAS float* s = scr + (8 * c) * 33 + n;
        u32x4 o; o.x = pk2(s[0 * 33], s[1 * 33]); o.y = pk2(s[2 * 33], s[3 * 33]); o.z = pk2(s[4 * 33], s[5 * 33]); o.w = pk2(s[6 * 33], s[7 * 33]);
        *(GAS u32x4*)(dst + (size_t)n * K + k0 + 8 * c) = o; }
    LDS_WAIT(); asm volatile("" ::: "memory");
}

struct Args { const float* in[19]; float* out; unsigned char* ws; int ph_lo, ph_hi; };

namespace att {
constexpr int SLOT = 8192, NSL = 5;
constexpr int L_K = 0, L_V = NSL * SLOT, L_WS = 2 * NSL * SLOT, L_BIAS = L_WS + 8 * 256, L_OST = L_BIAS + 1024, L_END = L_OST + 8 * 4096;
__device__ __forceinline__ int crow(int r, int hi) { return (r & 3) + 8 * (r >> 2) + 4 * hi; }
__device__ __forceinline__ s16x4 vtr(const LAS char* p) { typedef short v4i16_t __attribute__((ext_vector_type(4))); return __builtin_bit_cast(s16x4, __builtin_amdgcn_ds_read_tr16_b64_v4i16((LAS v4i16_t*)p)); }

template <bool FIRST>
__device__ __forceinline__ void tile_step(const LAS char* lds, int slot, int s, int lane, int r32, int hi, int qin, const bf16x8 (&qr)[4], const LAS float* tb, LAS float* wsf,
                                          float& m_run, float& l_run, f32x16 (&o)[2], f32x16& negm) {
    constexpr float THR = 8.0f;
    const LAS char* kp = lds + L_K + slot + hi * 1024 + r32 * 16;
    f32x16 p0, p1;
#pragma unroll
    for (int d0 = 0; d0 < 4; ++d0) {
        const bf16x8 b0 = *(const LAS bf16x8*)(kp + d0 * 2048), b1 = *(const LAS bf16x8*)(kp + d0 * 2048 + 512);
        p0 = __builtin_amdgcn_mfma_f32_32x32x16_bf16(b0, qr[d0], d0 == 0 ? negm : p0, 0, 0, 0); p1 = __builtin_amdgcn_mfma_f32_32x32x16_bf16(b1, qr[d0], d0 == 0 ? negm : p1, 0, 0, 0); }
    if (s >= 6) { const int ib = qin + 64 * (8 - s) + 63 - 4 * hi;
#pragma unroll
        for (int r = 0; r < 16; ++r) { const int off = (r & 3) + 8 * (r >> 2); p0[r] += tb[ib - off]; p1[r] += tb[ib - off - 32]; } }
    float mx = __builtin_fmaxf(__builtin_fmaxf(p0[0], p0[1]), p1[0]), my = __builtin_fmaxf(__builtin_fmaxf(p0[2], p0[3]), p1[1]);
    mx = __builtin_fmaxf(__builtin_fmaxf(mx, p1[2]), p1[3]);
#pragma unroll
    for (int r = 4; r < 16; r += 4) { mx = __builtin_fmaxf(__builtin_fmaxf(mx, p0[r]), p0[r + 1]); my = __builtin_fmaxf(__builtin_fmaxf(my, p0[r + 2]), p0[r + 3]);
                                      mx = __builtin_fmaxf(__builtin_fmaxf(mx, p1[r]), p1[r + 1]); my = __builtin_fmaxf(__builtin_fmaxf(my, p1[r + 2]), p1[r + 3]); }
    mx = fmaxf(mx, my); mx = fmaxf(mx, __shfl_xor(mx, 32));
    if constexpr (FIRST) {
        m_run = mx;
#pragma unroll
        for (int r = 0; r < 16; ++r) { p0[r] -= mx; p1[r] -= mx; negm[r] = -mx; }
    } else if (__any(mx > THR)) {
        const float d = mx > THR ? mx : 0.f, f = __builtin_amdgcn_exp2f(-d);
        m_run += d; l_run *= f;
#pragma unroll
        for (int r = 0; r < 16; ++r) { p0[r] -= d; p1[r] -= d; negm[r] = -m_run; }
        if (hi == 0) wsf[r32] = f;
        LDS_WAIT();
#pragma unroll
        for (int r = 0; r < 16; ++r) { const float g = wsf[crow(r, hi)]; o[0][r] *= g; o[1][r] *= g; }
    }
    float rs = 0.f, rs2 = 0.f;
#pragma unroll
    for (int r = 0; r < 16; ++r) { p0[r] = __builtin_amdgcn_exp2f(p0[r]); p1[r] = __builtin_amdgcn_exp2f(p1[r]); rs += p0[r]; rs2 += p1[r]; }
    l_run += rs + rs2;
    u32x4 pw[4];
#pragma unroll
    for (int q = 0; q < 4; ++q) { pw[0][q] = cvt_pk_bf16(p0[2 * q], p0[2 * q + 1]); pw[1][q] = cvt_pk_bf16(p0[8 + 2 * q], p0[8 + 2 * q + 1]);
                                  pw[2][q] = cvt_pk_bf16(p1[2 * q], p1[2 * q + 1]); pw[3][q] = cvt_pk_bf16(p1[8 + 2 * q], p1[8 + 2 * q + 1]); }
    const unsigned vb = (unsigned)(uintptr_t)(lds + L_V + slot + ((lane >> 4) & 1) * 32 + (lane & 3) * 8 + (4 * hi + ((lane & 15) >> 2)) * 64);
#pragma unroll
    for (int d0 = 0; d0 < 2; ++d0) { s16x4 lo[4], hh[4];
#pragma unroll
        for (int ks = 0; ks < 4; ++ks) {
            asm volatile("ds_read_b64_tr_b16 %0, %1 offset:%c2" : "=&v"(lo[ks]) : "v"(vb), "i"(d0 * 4096 + ks * 1024) : "memory");
            asm volatile("ds_read_b64_tr_b16 %0, %1 offset:%c2" : "=&v"(hh[ks]) : "v"(vb), "i"(d0 * 4096 + ks * 1024 + 512) : "memory"); }
        asm volatile("s_waitcnt lgkmcnt(0)" ::: "memory"); __builtin_amdgcn_sched_barrier(0);
#pragma unroll
        for (int ks = 0; ks < 4; ++ks) { const bf16x8 vf = (bf16x8){lo[ks][0], lo[ks][1], lo[ks][2], lo[ks][3], hh[ks][0], hh[ks][1], hh[ks][2], hh[ks][3]};
            o[d0] = __builtin_amdgcn_mfma_f32_32x32x16_bf16(__builtin_bit_cast(bf16x8, pw[ks]), vf, o[d0], 0, 0, 0); } }
}

template <bool EDGE>
__device__ __forceinline__ void unit(const Frame& F, int b, int h, int cg, const bf16_t* Q, const bf16_t* Kb, const bf16_t* Vb, bf16_t* MIX, const float* relb) {
    LAS char* lds = (LAS char*)F.lds;
    const int wid = F.wave, lane = lane_id(), tid = wid * 64 + lane, r32 = lane & 31, hi = lane >> 5;
    const int wp = wid >> 1, half = wid & 1;
    const int c = 4 * cg + wp;
    const long rowbase = (long)b * SEQ;
    LAS float* wsf = (LAS float*)(lds + L_WS) + wid * 64;
    LAS float* tb = (LAS float*)(lds + L_BIAS);
    if (tid < 256) { const int i = tid < NREL ? tid : NREL - 1; tb[tid] = (relb[h * NREL + i] - relb[h * NREL + NREL - 1]) * LOG2E; }
    const bf16_t* Qw = Q + (rowbase + c * 64 + half * 32 + r32) * DA + h * HD;
    bf16x8 qr[4];
#pragma unroll
    for (int d0 = 0; d0 < 4; ++d0) qr[d0] = *(const GAS bf16x8*)(Qw + d0 * 16 + hi * 8);
    const int kc0 = 4 * cg - 8;
    const int krow = tid & 63, kch = tid >> 6;
    const int vrow = tid >> 3, vch = tid & 7;
    const bf16_t* ksrc = Kb + (rowbase + krow) * DA + h * HD + kch * 8;
    const bf16_t* vsrc = Vb + (rowbase + vrow) * DA + h * HD + vch * 8;
    const int kdst = L_K + kch * 1024 + krow * 16, vdst = L_V + (vch >> 2) * 4096 + vrow * 64 + (vch & 3) * 16;
#pragma unroll
    for (int j = 0; j < 4; ++j) { const int kc = kc0 + j;
        if (!EDGE || kc >= 0) { const u32x4 kv = *(const GAS u32x4*)(ksrc + (long)kc * 64 * DA); const u32x4 vv = *(const GAS u32x4*)(vsrc + (long)kc * 64 * DA);
            *(LAS u32x4*)(lds + kdst + j * SLOT) = kv; *(LAS u32x4*)(lds + vdst + j * SLOT) = vv; } }
    float m_run = 0.f, l_run = 0.f; f32x16 o[2]; o[0] = f32x16{}; o[1] = f32x16{}; f32x16 negm = f32x16{};
    const int qin = half * 32 + r32;
    if constexpr (!EDGE) {
        __syncthreads();
        { u32x4 kv = *(const GAS u32x4*)(ksrc + (long)(kc0 + 4) * 64 * DA), vv = *(const GAS u32x4*)(vsrc + (long)(kc0 + 4) * 64 * DA);
          tile_step<true>(lds, (wp % NSL) * SLOT, 0, lane, r32, hi, qin, qr, tb, wsf, m_run, l_run, o, negm);
          *(LAS u32x4*)(lds + kdst + 4 * SLOT) = kv; *(LAS u32x4*)(lds + vdst + 4 * SLOT) = vv; }
#pragma unroll 1
        for (int s = 1; s < 9; ++s) {
            __syncthreads();
            const int jn = s + 4; const bool ldn = jn < 12;
            u32x4 kv = (u32x4){0u, 0u, 0u, 0u}, vv = (u32x4){0u, 0u, 0u, 0u};
            if (ldn) { kv = *(const GAS u32x4*)(ksrc + (long)(kc0 + jn) * 64 * DA); vv = *(const GAS u32x4*)(vsrc + (long)(kc0 + jn) * 64 * DA); }
            tile_step<false>(lds, ((wp + s) % NSL) * SLOT, s, lane, r32, hi, qin, qr, tb, wsf, m_run, l_run, o, negm);
            if (ldn) { const int sl = (jn % NSL) * SLOT; *(LAS u32x4*)(lds + kdst + sl) = kv; *(LAS u32x4*)(lds + vdst + sl) = vv; }
        }
    } else {
        bool first = true;
#pragma unroll 1
        for (int s = 0; s < 9; ++s) {
            __syncthreads();
            const int jn = s + 4, kcn = kc0 + jn; const bool ldn = (jn < 12) && (kcn >= 0);
            u32x4 kv = (u32x4){0u, 0u, 0u, 0u}, vv = (u32x4){0u, 0u, 0u, 0u};
            if (ldn) { kv = *(const GAS u32x4*)(ksrc + (long)kcn * 64 * DA); vv = *(const GAS u32x4*)(vsrc + (long)kcn * 64 * DA); }
            const int j = wp + s, kc = kc0 + j;
            if (kc >= 0) { if (first) { tile_step<true>(lds, (j % NSL) * SLOT, s, lane, r32, hi, qin, qr, tb, wsf, m_run, l_run, o, negm); first = false; }
                           else tile_step<false>(lds, (j % NSL) * SLOT, s, lane, r32, hi, qin, qr, tb, wsf, m_run, l_run, o, negm); }
            if (ldn) { const int sl = (jn % NSL) * SLOT; *(LAS u32x4*)(lds + kdst + sl) = kv; *(LAS u32x4*)(lds + vdst + sl) = vv; }
        }
    }
    l_run += __shfl_xor(l_run, 32);
    if (hi == 0) wsf[32 + r32] = l_run;
    LDS_WAIT();
    LAS bf16_t* stg = (LAS bf16_t*)(lds + L_OST) + wid * 2048;
#pragma unroll
    for (int r = 0; r < 16; ++r) { const int orow = crow(r, hi); const float rl = __builtin_amdgcn_rcpf(wsf[32 + orow]);
#pragma unroll
        for (int d0 = 0; d0 < 2; ++d0) stg[orow * 64 + d0 * 32 + r32] = (bf16_t)f2bf(o[d0][r] * rl); }
    LDS_WAIT();
    bf16_t* Ow = MIX + (rowbase + c * 64 + half * 32) * D + h * HD;
#pragma unroll
    for (int i = 0; i < 4; ++i) { const int row = i * 8 + (lane >> 3), ch = lane & 7; const u32x4 v = *(const LAS u32x4*)(stg + row * 64 + ch * 8); *(GAS u32x4*)(Ow + (long)row * D + ch * 8) = v; }
    __syncthreads();
}
}

namespace cv {
constexpr int TT = 32, UR = TT + CW - 1;
constexpr int L_U = 0, L_Y = UR * DC * 2  , L_END = L_Y + TT * DC * 4;
__device__ __forceinline__ void unit(const Frame& F, int b, int tt, const bf16_t* Ab, const bf16_t* Gb, bf16_t* MIX, const float* dw_w, const float* dw_b, const float* ln_g, const float* ln_b) {
    LAS char* lds = (LAS char*)F.lds;
    const int wid = F.wave, lane = lane_id(), tid = wid * 64 + lane;
    const int t0 = tt * TT; const long rowbase = (long)b * SEQ;
    for (int idx = tid; idx < UR * 64; idx += 512) { const int r = idx >> 6, c8 = idx & 63; const int tok = t0 - (CW - 1) + r;
        u32x4 w = (u32x4){0u, 0u, 0u, 0u};
        if (tok >= 0) { const u32x4 av = *(const GAS u32x4*)(Ab + (rowbase + tok) * DC + c8 * 8), gv = *(const GAS u32x4*)(Gb + (rowbase + tok) * DC + c8 * 8);
#pragma unroll
            for (int q = 0; q < 4; ++q) { const float u0 = bf_lo(av[q]) * fsigmoid(bf_lo(gv[q])), u1 = bf_hi(av[q]) * fsigmoid(bf_hi(gv[q])); w[q] = cvt_pk_bf16(u0, u1); } }
        *(LAS u32x4*)(lds + L_U + r * (DC * 2) + c8 * 16) = w; }
    __syncthreads();
    { const int cp = tid & 255, th = tid >> 8;
      f32x2 w[CW];
#pragma unroll
      for (int j = 0; j < CW; ++j) w[j] = *(const GAS f32x2*)(dw_w + j * DC + 2 * cp);
      const f32x2 bias = *(const GAS f32x2*)(dw_b + 2 * cp);
#pragma unroll 1
      for (int blk = 0; blk < 2; ++blk) { const int tbk = th * 16 + blk * 8;
          f32x2 acc[8];
#pragma unroll
          for (int k = 0; k < 8; ++k) acc[k] = bias;
#pragma unroll
          for (int i = 0; i < 8 + CW - 1; ++i) { const unsigned uw = *(const LAS unsigned*)(lds + L_U + (tbk + i) * (DC * 2) + cp * 4); const f32x2 uv = (f32x2){bf_lo(uw), bf_hi(uw)};
#pragma unroll
              for (int k = 0; k < 8; ++k) { const int j = i - k; if (j >= 0 && j < CW) acc[k] += uv * w[j]; } }
#pragma unroll
          for (int k = 0; k < 8; ++k) *(LAS f32x2*)(lds + L_Y + (tbk + k) * (DC * 4) + cp * 8) = acc[k]; } }
    __syncthreads();
    { const f32x4 g0 = *(const GAS f32x4*)(ln_g + 8 * lane), g1 = *(const GAS f32x4*)(ln_g + 8 * lane + 4), b0 = *(const GAS f32x4*)(ln_b + 8 * lane), b1 = *(const GAS f32x4*)(ln_b + 8 * lane + 4);
#pragma unroll
      for (int q = 0; q < 4; ++q) { const int t = wid * 4 + q;
          f32x4 y0 = *(const LAS f32x4*)(lds + L_Y + t * (DC * 4) + lane * 32), y1 = *(const LAS f32x4*)(lds + L_Y + t * (DC * 4) + lane * 32 + 16);
          const float mean = wave_sum((y0.x + y0.y) + (y0.z + y0.w) + (y1.x + y1.y) + (y1.z + y1.w)) * (1.f / DC);
          y0 = y0 - mean; y1 = y1 - mean;
          const float var = wave_sum((y0.x * y0.x + y0.y * y0.y) + (y0.z * y0.z + y0.w * y0.w) + (y1.x * y1.x + y1.y * y1.y) + (y1.z * y1.z + y1.w * y1.w)) * (1.f / DC);
          const float rstd = 1.0f / sqrtf(var + LN_EPS);
          y0 = y0 * rstd * g0 + b0; y1 = y1 * rstd * g1 + b1;
          float z[8] = {y0.x, y0.y, y0.z, y0.w, y1.x, y1.y, y1.z, y1.w};
#pragma unroll
          for (int i = 0; i < 8; ++i) z[i] = z[i] * fsigmoid(z[i]);
          u32x4 w; w.x = cvt_pk_bf16(z[0], z[1]); w.y = cvt_pk_bf16(z[2], z[3]); w.z = cvt_pk_bf16(z[4], z[5]); w.w = cvt_pk_bf16(z[6], z[7]);
          *(GAS u32x4*)(MIX + (rowbase + t0 + t) * D + DA + 8 * lane) = w; } }
    __syncthreads();
}
}

__global__ void __launch_bounds__(NWAVES * 64, 2) hymba_fwd(Args args) {
    extern __shared__ __attribute__((aligned(16))) unsigned char lds_raw[];
    Frame F;
    F.lds = (LAS unsigned char*)lds_raw;
    F.wave = __builtin_amdgcn_readfirstlane(threadIdx.x >> 6);
    F.G = gridDim.x; { const int bx = blockIdx.x; F.vcu = (F.G % 8 == 0) ? (bx % 8) * (F.G / 8) + bx / 8 : bx; }
    unsigned char* ws = args.ws;
    F.ctl = (gu32*)(ws + WS_CTL);
    volatile LAS unsigned* MISC = (volatile LAS unsigned*)(F.lds + LDSCTL_OFF);
    for (int u = threadIdx.x; u < (LDS_BYTES - LDSCTL_OFF) / 4; u += NWAVES * 64) ((LAS unsigned*)(F.lds + LDSCTL_OFF))[u] = 0u;
    __syncthreads();
    const int lo = args.ph_lo, hi = args.ph_hi;
    const bool multi = (hi - lo) > 1;
    XcdBarrier bar; bar.bar = (unsigned*)(F.ctl + CW_BAR); bar.x = 0; bar.st = nullptr;
    if (multi) bar = xcd_barrier_post((unsigned*)(F.ctl + CW_BAR), MISC + 8);
#define IN(k) (lo <= (k) && (k) < hi)
#define BOTH(k) (IN(k) && IN((k) + 1))
#define GRID_BAR() xcd_barrier(bar)

    const float* x = args.in[0];
    bf16_t* Win_t = (bf16_t*)(ws + WS_WIN); bf16_t* Wout_t = (bf16_t*)(ws + WS_WOUT); unsigned char* Wgu8 = ws + WS_WGU; unsigned char* Wd8 = ws + WS_WD;
    bf16_t* X1 = (bf16_t*)(ws + WS_X1); bf16_t* XN = (bf16_t*)(ws + WS_XN);
    bf16_t* Qb = (bf16_t*)(ws + WS_Q); bf16_t* Kb = (bf16_t*)(ws + WS_K); bf16_t* Vb = (bf16_t*)(ws + WS_V); bf16_t* Ab = (bf16_t*)(ws + WS_A); bf16_t* Gb = (bf16_t*)(ws + WS_G);
    bf16_t* MIX = (bf16_t*)(ws + WS_MIX); unsigned char* HID8 = ws + WS_HID; unsigned char* T8 = ws + WS_XN; unsigned char* OB = ws + WS_O;
    u32x2* LIST = (u32x2*)(ws + WS_LIST); float* TOPW = (float*)(ws + WS_TOPW); bf16_t* RWB = (bf16_t*)(ws + WS_RWT);
    const int gw = F.vcu * NWAVES + F.wave, NGW = F.G * NWAVES;

    if (IN(0)) {
        const int lane = lane_id(), tid = F.wave * 64 + lane;
        LAS float* scr = (LAS float*)(F.lds + F.wave * 16896);
        constexpr int I_IN = (D / 64) * (NIN / 32), I_OUT = (D / 64) * (D / 32), I_EXP = (D / 64) * (D / 32);
        for (int it = gw; it < I_IN + I_OUT; it += NGW) {
            int r = it;
            if (r < I_IN) { const int kb = r / (NIN / 32), nb = r % (NIN / 32); transpose_item(args.in[2], NIN, kb * 64, nb * 32, Win_t + (size_t)(nb * 32) * D, D, scr, lane); continue; } r -= I_IN;
            const int kb = r / (D / 32), nb = r % (D / 32); transpose_item(args.in[8], D, kb * 64, nb * 32, Wout_t + (size_t)(nb * 32) * D, D, scr, lane);
        }
        { const GAS f32x4* gp = (const GAS f32x4*)args.in[1] + lane; f32x4 g[4];
#pragma unroll
          for (int j = 0; j < 4; ++j) g[j] = gp[64 * j];
          for (int m = gw; m < T; m += 2 * NGW) { const int m2 = m + NGW;
              const GAS f32x4* xr = (const GAS f32x4*)(x + (size_t)m * D) + lane; const GAS f32x4* xr2 = (const GAS f32x4*)(x + (size_t)(m2 < T ? m2 : m) * D) + lane; f32x4 v[4], v2[4]; float s = 0.f, s2 = 0.f;
#pragma unroll
              for (int j = 0; j < 4; ++j) { v[j] = __builtin_nontemporal_load(xr + 64 * j); v2[j] = __builtin_nontemporal_load(xr2 + 64 * j); }
#pragma unroll
              for (int j = 0; j < 4; ++j) { s += (v[j].x * v[j].x + v[j].y * v[j].y) + (v[j].z * v[j].z + v[j].w * v[j].w); s2 += (v2[j].x * v2[j].x + v2[j].y * v2[j].y) + (v2[j].z * v2[j].z + v2[j].w * v2[j].w); }
              const float r = 1.0f / sqrtf(wave_sum(s) * (1.f / D) + RMS_EPS), r2 = 1.0f / sqrtf(wave_sum(s2) * (1.f / D) + RMS_EPS);
              GAS u32x2* o8 = (GAS u32x2*)(XN + (size_t)m * D) + lane;
#pragma unroll
              for (int j = 0; j < 4; ++j) { const f32x4 y = v[j] * r * g[j]; o8[64 * j] = (u32x2){pk2(y.x, y.y), pk2(y.z, y.w)}; }
              if (m2 < T) { GAS u32x2* o82 = (GAS u32x2*)(XN + (size_t)m2 * D) + lane;
#pragma unroll
                  for (int j = 0; j < 4; ++j) { const f32x4 y = v2[j] * r2 * g[j]; o82[64 * j] = (u32x2){pk2(y.x, y.y), pk2(y.z, y.w)}; } } } }
        for (int i = blockIdx.x * 512 + tid; i < NE * D; i += F.G * 512) { const int e = i / D, k = i % D; const float v = args.in[10][k * NE + e] * args.in[9][k];
            const unsigned h = f2bf(v); RWB[i] = (bf16_t)h; RWB[NE * D + i] = (bf16_t)f2bf(v - __uint_as_float(h << 16)); }
        if (BOTH(0)) GRID_BAR();
    }

    if (IN(1)) {
        const int xg = (int)(blockIdx.x % 8), jb = (int)(blockIdx.x / 8), half = F.G / 16;
        if (jb < half) {
            pg8::DenseOrder S; S.init(T, NIN, F.G / 2, xg + 8 * jb, Win_t);
            pg8::EpiSplit E{Qb, (size_t)(WS_K - WS_Q) / 2, QSCALE};
            pg8::gemm_phase<pg8::EpiSplit, pg8::DenseOrder, true, 2>(F.lds, (const char*)XN, D, S, E);
        } else {
            const int cgw = (xg * half + (jb - half)) * NWAVES + F.wave, CNGW = (F.G / 2) * NWAVES;
        { constexpr int NIT = NE * 3 * 8 * 32;
          LAS unsigned* tile = (LAS unsigned*)(F.lds + F.wave * 4352); const int lane = lane_id();
          f32x4 v[16], w[16];
          auto src_of = [&](int r) -> const float* { const int em = r >> 8, ri = r & 255, e = em / 3, mat = em % 3, kb = ri >> 5, nb = ri & 31;
              const float* base = (mat == 0 ? args.in[12] : mat == 1 ? args.in[14] : args.in[16]) + (size_t)e * D * D;
              return base + (size_t)(kb * 128 + (lane >> 3)) * D + nb * 32 + 4 * (lane & 7); };
          int it = cgw;
          if (it < NIT) { const float* sp = src_of(it);
#pragma unroll
              for (int q = 0; q < 16; ++q) v[q] = __builtin_nontemporal_load((const GAS f32x4*)(sp + (size_t)q * 8 * D)); }
#pragma unroll 1
          for (; it < NIT; it += CNGW) {
              const int nx = it + CNGW;
              if (nx < NIT) { const float* sp = src_of(nx);
#pragma unroll
                  for (int q = 0; q < 16; ++q) w[q] = __builtin_nontemporal_load((const GAS f32x4*)(sp + (size_t)q * 8 * D)); }
              const int em = it >> 8, ri = it & 255, e = em / 3, mat = em % 3, kb = ri >> 5, nb = ri & 31, n0 = nb * 32, k0 = kb * 128;
              unsigned char* dst = (mat == 2) ? Wd8 + ((size_t)e * D + n0) * D : Wgu8 + ((size_t)e * 2048 + (size_t)(n0 >> 7) * 256 + (n0 & 127) + (mat == 1 ? 128 : 0)) * D;
#pragma unroll
              for (int q = 0; q < 16; ++q) tile[(lane & 7) * 132 + q * 8 + (lane >> 3)] = pk4_fp8(v[q].x * SC_W, v[q].y * SC_W, v[q].z * SC_W, v[q].w * SC_W);
              LDS_WAIT(); asm volatile("" ::: "memory");
              const int nq = lane >> 3, c = lane & 7;
              u32x4 r[4];
#pragma unroll
              for (int i = 0; i < 4; ++i) r[i] = *(const LAS u32x4*)(tile + nq * 132 + 16 * c + 4 * i);
              LDS_WAIT(); asm volatile("" ::: "memory");
              u32x4 o[4];
#pragma unroll
              for (int i = 0; i < 4; ++i) {
                  const unsigned x01 = __builtin_amdgcn_perm(r[i].y, r[i].x, 0x05010400u), y01 = __builtin_amdgcn_perm(r[i].y, r[i].x, 0x07030602u);
                  const unsigned x23 = __builtin_amdgcn_perm(r[i].w, r[i].z, 0x05010400u), y23 = __builtin_amdgcn_perm(r[i].w, r[i].z, 0x07030602u);
                  o[0][i] = __builtin_amdgcn_perm(x23, x01, 0x05040100u); o[1][i] = __builtin_amdgcn_perm(x23, x01, 0x07060302u);
                  o[2][i] = __builtin_amdgcn_perm(y23, y01, 0x05040100u); o[3][i] = __builtin_amdgcn_perm(y23, y01, 0x07060302u); }
#pragma unroll
              for (int j = 0; j < 4; ++j) *(GAS u32x4*)(dst + (size_t)(4 * nq + j) * D + k0 + 16 * c) = o[j];
#pragma unroll
              for (int q = 0; q < 16; ++q) v[q] = w[q];
          } }
        }
        if (BOTH(1)) GRID_BAR();
    }

    if (IN(2)) {
        if (F.G == 256) {
            const int xg = (int)(blockIdx.x % 8), j = (int)(blockIdx.x / 8);
            for (int i = 0; i < 2; ++i) { const int h = 4 * i + (j >> 3), pm = 8 * xg + (j & 7), b = pm >> 5, cg = pm & 31;
                if (cg < 2) att::unit<true>(F, b, h, cg, Qb, Kb, Vb, MIX, args.in[7]); else att::unit<false>(F, b, h, cg, Qb, Kb, Vb, MIX, args.in[7]); }
            for (int i = 0; i < 2; ++i) { const int loc = j + 32 * i, tg = (8 * xg + (loc >> 3)) * 8 + (loc & 7), b = tg / (SEQ / cv::TT), tt = tg % (SEQ / cv::TT);
                cv::unit(F, b, tt, Ab, Gb, MIX, args.in[3], args.in[4], args.in[5], args.in[6]); }
        } else {
        for (int u = F.vcu; u < 2 * NH * 32; u += F.G) { const int cg = u & 31, h = (u >> 5) & 7, b = u >> 8;
            if (cg < 2) att::unit<true>(F, b, h, cg, Qb, Kb, Vb, MIX, args.in[7]); else att::unit<false>(F, b, h, cg, Qb, Kb, Vb, MIX, args.in[7]); }
        for (int u = F.vcu; u < T / cv::TT; u += F.G) { const int b = u / (SEQ / cv::TT), tt = u % (SEQ / cv::TT);
            cv::unit(F, b, tt, Ab, Gb, MIX, args.in[3], args.in[4], args.in[5], args.in[6]); }
        }
        if (BOTH(2)) GRID_BAR();
    }

    if (IN(3)) {
        pg8::DenseOrder S; S.init(T, D, F.G, (int)blockIdx.x, Wout_t);
        pg8::EpiRes E{x, X1, T8, args.in[9]};
        pg8::gemm_phase<pg8::EpiRes, pg8::DenseOrder, false, 2>(F.lds, (const char*)MIX, D, S, E);
        if (BOTH(3)) {
            const int tid = F.wave * 64 + lane_id();
            for (int i = tid; i < 8192; i += 512) { const int row = i >> 7, ch = i & 127; const u32x4 v = ((const GAS u32x4*)RWB)[i];
                *(LAS u32x4*)(F.lds + row * 2048 + (((ch & ~15) | ((ch ^ row) & 15)) * 16)) = v; }
            GRID_BAR(); }
    }

    if (IN(4)) {
        const int lane = lane_id(), tid = F.wave * 64 + lane, fr = lane & 15, fq = lane >> 4;
        LAS unsigned char* rwl = F.lds;
        LAS int* hist = (LAS int*)(F.lds + XTRA_OFF);
        LAS int* baseE = hist + 32;
        LAS int* selE = baseE + 32;
        LAS int* selP = selE + 256;
        LAS float* selR = (LAS float*)(selP + 256);
        LAS float* part = selR + 64;
        const int w4 = F.wave & 3, kh = F.wave >> 2;
        const float rb0 = args.in[11][fr], rb1 = args.in[11][16 + fr];
        bool filled = false;
#pragma unroll 1
        for (int tb = F.vcu * 4; tb < T / 16; tb += F.G * 4) {
            const int task = tb + w4;
            const bf16_t* xrow = X1 + (size_t)(task * 16 + fr) * D + kh * 512 + 8 * fq;
            u32x4 xv[16];
#pragma unroll
            for (int ks = 0; ks < 16; ++ks) xv[ks] = *(const GAS u32x4*)(xrow + 32 * ks);
            if (!filled && !BOTH(3)) {
                for (int i = tid; i < 8192; i += 512) { const int row = i >> 7, ch = i & 127; const u32x4 v = ((const GAS u32x4*)RWB)[i];
                    *(LAS u32x4*)(rwl + row * 2048 + (((ch & ~15) | ((ch ^ row) & 15)) * 16)) = v; } }
            filled = true;
            if (tid < 32) hist[tid] = 0;
            __syncthreads();
            f32x4 acc0 = (f32x4){0.f, 0.f, 0.f, 0.f}, acc1 = acc0; float ss = 0.f;
#pragma unroll
            for (int ks = 0; ks < 16; ++ks) {
                const u32x4 hi = xv[ks];
                { const float a0 = bf_lo(hi.x), a1 = bf_hi(hi.x), a2 = bf_lo(hi.y), a3 = bf_hi(hi.y), a4 = bf_lo(hi.z), a5 = bf_hi(hi.z), a6 = bf_lo(hi.w), a7 = bf_hi(hi.w);
                  ss += (a0 * a0 + a1 * a1) + (a2 * a2 + a3 * a3) + (a4 * a4 + a5 * a5) + (a6 * a6 + a7 * a7); }
                const bf16x8 ah = __builtin_bit_cast(bf16x8, hi);
                const int ch = kh * 64 + 4 * ks + fq;
                const int o0 = fr * 2048 + (((ch & ~15) | ((ch ^ fr) & 15)) * 16), o1 = o0 + 16 * 2048;
                const bf16x8 bh0 = *(const LAS bf16x8*)(rwl + o0), bl0 = *(const LAS bf16x8*)(rwl + 65536 + o0), bh1 = *(const LAS bf16x8*)(rwl + o1), bl1 = *(const LAS bf16x8*)(rwl + 65536 + o1);
                acc0 = __builtin_amdgcn_mfma_f32_16x16x32_bf16(ah, bh0, acc0, 0, 0, 0); acc1 = __builtin_amdgcn_mfma_f32_16x16x32_bf16(ah, bh1, acc1, 0, 0, 0);
                acc0 = __builtin_amdgcn_mfma_f32_16x16x32_bf16(ah, bl0, acc0, 0, 0, 0); acc1 = __builtin_amdgcn_mfma_f32_16x16x32_bf16(ah, bl1, acc1, 0, 0, 0);
            }
            ss += __shfl_xor(ss, 16); ss += __shfl_xor(ss, 32);
            if (kh == 1) { LAS float* pp = part + w4 * 576 + lane;
#pragma unroll
                for (int q = 0; q < 4; ++q) { pp[64 * q] = acc0[q]; pp[64 * (4 + q)] = acc1[q]; }
                pp[64 * 8] = ss; }
            __syncthreads();
            if (kh == 0) { const LAS float* pp = part + w4 * 576 + lane;
#pragma unroll
                for (int q = 0; q < 4; ++q) { acc0[q] += pp[64 * q]; acc1[q] += pp[64 * (4 + q)]; }
                ss += pp[64 * 8];
                const float rrow = 1.0f / sqrtf(ss * (1.f / D) + RMS_EPS);
                float c0[4], c1[4], rt[4], tv[4][4]; int te[4][4];
#pragma unroll
                for (int q = 0; q < 4; ++q) { rt[q] = __shfl(rrow, 4 * fq + q); c0[q] = acc0[q] * rt[q] + rb0; c1[q] = acc1[q] * rt[q] + rb1; }
#pragma unroll
                for (int k = 0; k < 4; ++k) { float v[4]; int e[4];
#pragma unroll
                    for (int q = 0; q < 4; ++q) { v[q] = c0[q]; e[q] = fr; if (c1[q] > c0[q]) { v[q] = c1[q]; e[q] = 16 + fr; } }
#define RT_STEP(CTRL) _Pragma("unroll") for (int q = 0; q < 4; ++q) { const float v2 = __builtin_bit_cast(float, __builtin_amdgcn_update_dpp(0, __builtin_bit_cast(int, v[q]), CTRL, 0xf, 0xf, false)); \
                        const int e2 = __builtin_amdgcn_update_dpp(0, e[q], CTRL, 0xf, 0xf, false); if (v2 > v[q] || (v2 == v[q] && e2 < e[q])) { v[q] = v2; e[q] = e2; } }
                    RT_STEP(0x128) RT_STEP(0x124) RT_STEP(0x122) RT_STEP(0x121)
#undef RT_STEP
#pragma unroll
                    for (int q = 0; q < 4; ++q) { tv[q][k] = v[q]; te[q][k] = e[q]; if (e[q] == fr) c0[q] = -INFINITY; if (e[q] == 16 + fr) c1[q] = -INFINITY; } }
#pragma unroll
                for (int q = 0; q < 4; ++q) {
                    const float e1 = __expf(tv[q][1] - tv[q][0]), e2 = __expf(tv[q][2] - tv[q][0]), e3 = __expf(tv[q][3] - tv[q][0]); const float inv = 1.0f / (1.0f + e1 + e2 + e3);
                    const int tl = w4 * 16 + 4 * fq + q, tok = task * 16 + 4 * fq + q;
                    if (fr == 0) { *(GAS f32x4*)(TOPW + (size_t)tok * 4) = (f32x4){inv, e1 * inv, e2 * inv, e3 * inv}; selR[tl] = rt[q]; }
                    if (fr < 4) { const int em = fr == 0 ? te[q][0] : fr == 1 ? te[q][1] : fr == 2 ? te[q][2] : te[q][3];
                        selE[tl * 4 + fr] = em; selP[tl * 4 + fr] = __hip_atomic_fetch_add(&hist[em], 1, __ATOMIC_RELAXED, __HIP_MEMORY_SCOPE_WORKGROUP); }
                } }
            __syncthreads();
            if (tid < 32) baseE[tid] = (int)__hip_atomic_fetch_add(F.ctl + CW_CNT + 64 * tid, (unsigned)hist[tid], RLX_AGENT);
            __syncthreads();
            if (tid < 256) { const int e = selE[tid]; LIST[(size_t)e * LCAP + baseE[e] + selP[tid]] = (u32x2){(unsigned)((tb * 16 + (tid >> 2)) * 4 + (tid & 3)), __float_as_uint(selR[tid >> 2])}; }
            __syncthreads();
        }
        if (BOTH(4)) GRID_BAR();
    }

    LAS int* tstart = (LAS int*)(F.lds + XTRA_OFF + 14336);
    LAS int* ecnt = tstart + 64;
    LAS i32x4* ulist = (LAS i32x4*)(tstart + 128);
    if (IN(5) || IN(6)) {
        const int tid = F.wave * 64 + lane_id();
        __syncthreads();
        if (tid < 32) ecnt[tid] = (int)__hip_atomic_load(F.ctl + CW_CNT + 64 * tid, RLX_AGENT);
        __syncthreads();
        if (tid == 0) { int s = 0; for (int e = 0; e < NE; ++e) { tstart[e] = s; s += (ecnt[e] + 255) >> 8; } tstart[NE] = s; }
        __syncthreads();
        if (tid < 64) {
            const int which = tid >> 5, i = tid & 31, npn = which ? 4 : 8, nper = F.G / 8, xg = (int)(blockIdx.x % 8), j = (int)(blockIdx.x / 8);
            const int R = (nper / npn) * (i * 8 + xg) + j / npn, Rtot = tstart[NE];
            int e = 0; for (int q = 1; q < NE; ++q) e += (tstart[q] <= R) ? 1 : 0;
            i32x4 u = (i32x4){0, 0, 0, 0};
            if (R < Rtot) { const int pm = R - tstart[e], rem = ecnt[e] - pm * 256; u = (i32x4){e, pm, j % npn, rem < 256 ? rem : 256}; }
            ulist[which * 32 + i] = u; }
        __syncthreads();
    }

    if (IN(5)) {
        pg8::MoeOrder S{ulist, LIST, (const char*)Wgu8, 8, 2048, 2, args.in[13], args.in[15], 128};
        pg8::EpiGU E{HID8};
        pg8::gemm_phase<pg8::EpiGU, pg8::MoeOrder, true, 1>(F.lds, (const char*)T8, D, S, E);
        if (BOTH(5)) GRID_BAR();
    }

    if (IN(6)) {
        pg8::MoeOrder S{ulist + 32, LIST, (const char*)Wd8, 4, 1024, 0, args.in[17], args.in[17], 256};
        pg8::EpiDown E{OB};
        pg8::gemm_phase<pg8::EpiDown, pg8::MoeOrder, true, 1>(F.lds, (const char*)HID8, D, S, E);
        if (BOTH(6)) GRID_BAR();
    }

    if (IN(7)) {
        const int lane = lane_id();
        const GAS f32x4* gp = (const GAS f32x4*)args.in[18] + lane; f32x4 g[4];
#pragma unroll
        for (int j = 0; j < 4; ++j) g[j] = gp[64 * j];
        unsigned bad = __hip_atomic_load(F.ctl + CW_BAR + XB_TMO, RLX_AGENT);
        for (int m = gw; m < T; m += NGW) {
            const GAS u32x2* xr = (const GAS u32x2*)(X1 + (size_t)m * D) + lane; f32x4 v[4];
#pragma unroll
            for (int j = 0; j < 4; ++j) { const u32x2 w = __builtin_nontemporal_load(xr + 64 * j); v[j] = (f32x4){bf_lo(w.x), bf_hi(w.x), bf_lo(w.y), bf_hi(w.y)}; }
            const f32x4 tw = *(const GAS f32x4*)(TOPW + (size_t)m * 4);
#pragma unroll
            for (int k = 0; k < 4; ++k) { const GAS unsigned* orow = (const GAS unsigned*)(OB + ((size_t)m * 4 + k) * D) + lane; const float wk = tw[k] * (1.0f / SC_O);
#pragma unroll
                for (int j = 0; j < 4; ++j) { const unsigned w = __builtin_nontemporal_load(orow + 64 * j); const f32x2 lo = __builtin_amdgcn_cvt_pk_f32_fp8((int)w, false), hi = __builtin_amdgcn_cvt_pk_f32_fp8((int)w, true);
                    v[j].x += wk * lo.x; v[j].y += wk * lo.y; v[j].z += wk * hi.x; v[j].w += wk * hi.y; } }
            float s = 0.f;
#pragma unroll
            for (int j = 0; j < 4; ++j) s += (v[j].x * v[j].x + v[j].y * v[j].y) + (v[j].z * v[j].z + v[j].w * v[j].w);
            float r = 1.0f / sqrtf(wave_sum(s) * (1.f / D) + RMS_EPS);
            if (bad) r = __builtin_nanf("");
            GAS f32x4* o = (GAS f32x4*)(args.out + (size_t)m * D) + lane;
#pragma unroll
            for (int j = 0; j < 4; ++j) __builtin_nontemporal_store(v[j] * r * g[j], o + 64 * j);
        }
    }
#undef IN
#undef BOTH
#undef GRID_BAR
}

#ifndef MK_N_LAUNCHES
#define MK_N_LAUNCHES 1
#endif
extern "C" void kernel_launch(void* const* d_in, const int* in_sizes, int n_in, void* d_out, int out_size, void* d_ws, size_t ws_size, hipStream_t stream) {
    static int grid = 0;
    if (grid == 0) {
        if (n_in != 19 || in_sizes[0] != T * D || out_size != T * D || ws_size < WS_END) { fprintf(stderr, "kernel_launch: unexpected shapes (n_in %d, in0 %d, out %d, ws %zu); nothing launched\n", n_in, n_in > 0 ? in_sizes[0] : -1, out_size, ws_size); grid = -1; return; }
        int dev = 0, cus = 0, per_cu = 0;
        if (hipGetDevice(&dev) != hipSuccess || hipDeviceGetAttribute(&cus, hipDeviceAttributeMultiprocessorCount, dev) != hipSuccess) { fprintf(stderr, "kernel_launch: device query failed\n"); grid = -1; return; }
        if (hipFuncSetAttribute((const void*)hymba_fwd, hipFuncAttributeMaxDynamicSharedMemorySize, LDS_BYTES) != hipSuccess) { fprintf(stderr, "kernel_launch: hipFuncSetAttribute failed\n"); grid = -1; return; }
        if (hipOccupancyMaxActiveBlocksPerMultiprocessor(&per_cu, (const void*)hymba_fwd, NWAVES * 64, LDS_BYTES) != hipSuccess || per_cu < 1) fprintf(stderr, "kernel_launch: note: occupancy query reports %d workgroups per CU\n", per_cu);
        (void)hipGetLastError();
        grid = (cus / 64) * 64; if (grid > 256) grid = 256;
        if (grid < 64) { fprintf(stderr, "kernel_launch: %d CUs: unsupported\n", cus); grid = -1; return; }
    }
    if (grid < 0) return;
    if (hipMemsetAsync((char*)d_ws + WS_CTL, 0, CTL_ZERO_BYTES, stream) != hipSuccess) { fprintf(stderr, "kernel_launch: memset failed\n"); return; }
    Args a{};
    for (int i = 0; i < 19; ++i) a.in[i] = (const float*)d_in[i];
    a.out = (float*)d_out; a.ws = (unsigned char*)d_ws;
    constexpr int NPH = 8;
    if (MK_N_LAUNCHES == 1) { a.ph_lo = 0; a.ph_hi = NPH; hipLaunchKernelGGL(hymba_fwd, dim3(grid), dim3(NWAVES * 64), LDS_BYTES, stream, a); }
    else for (int p = 0; p < NPH; ++p) { a.ph_lo = p; a.ph_hi = p + 1; hipLaunchKernelGGL(hymba_fwd, dim3(grid), dim3(NWAVES * 64), LDS_BYTES, stream, a); }
    const hipError_t le = hipPeekAtLastError();
    if (le != hipSuccess) fprintf(stderr, "kernel_launch: launch failed: %s\n", hipGetErrorName(le));
}
```

```cpp
#include <hip/hip_runtime.h>
#include <cstdio>
#include <cstdint>

#define GAS __attribute__((address_space(1)))
#define LAS __attribute__((address_space(3)))
typedef unsigned short bf16_t;
typedef short bf16x8 __attribute__((ext_vector_type(8)));
typedef short s16x4 __attribute__((ext_vector_type(4)));
typedef float f32x2 __attribute__((ext_vector_type(2)));
typedef float f32x4 __attribute__((ext_vector_type(4)));
typedef float f32x16 __attribute__((ext_vector_type(16)));
typedef unsigned u32x2 __attribute__((ext_vector_type(2)));
typedef unsigned u32x4 __attribute__((ext_vector_type(4)));
typedef int i32x4 __attribute__((ext_vector_type(4)));
typedef int i32x8 __attribute__((ext_vector_type(8)));
typedef GAS unsigned gu32;
#define RLX_AGENT __ATOMIC_RELAXED, __HIP_MEMORY_SCOPE_AGENT
#define LDS_WAIT() asm volatile("s_waitcnt lgkmcnt(0)" ::: "memory")
#define VM_WAIT() asm volatile("s_waitcnt vmcnt(0)" ::: "memory")

constexpr int T = 16384, SEQ = 8192, D = 1024, NIN = 2560, DA = 512, NH = 8, HD = 64, DC = 512, CW = 31;
constexpr int NE = 32, TOPK = 4, NP = T * TOPK, LCAP = 16384, NREL = 192;
constexpr float RMS_EPS = 1e-5f, LN_EPS = 1e-5f, LOG2E = 1.4426950408889634f;
constexpr float QSCALE = 0.125f * LOG2E;
constexpr float SC_T = 16.0f, SC_W = 256.0f, SC_H = 4.0f, SC_O = 32.0f;

constexpr size_t MiB = 1u << 20;
constexpr size_t WS_CTL = 0, CTL_ZERO_BYTES = 64 * 1024;
constexpr size_t WS_WIN = 1 * MiB, WS_WOUT = 6 * MiB, WS_WGU = 8 * MiB, WS_WD = 136 * MiB, WS_X1 = 200 * MiB, WS_XN = 264 * MiB;
constexpr size_t WS_Q = 296 * MiB, WS_K = 312 * MiB, WS_V = 328 * MiB, WS_A = 344 * MiB, WS_G = 360 * MiB, WS_MIX = 376 * MiB;
constexpr size_t WS_HID = 296 * MiB;
constexpr size_t WS_O = WS_WGU;
constexpr size_t WS_LIST = 424 * MiB, WS_TOPW = 428 * MiB, WS_RWT = 429 * MiB, WS_XCH = 430 * MiB, WS_END = 440 * MiB;
constexpr int CW_TMO = 0, CW_BAR = 4096, CW_CNT = 8192;

constexpr int RING_BYTES = 131072, XTRA_OFF = RING_BYTES, LDS_BYTES = 147456, LDSCTL_OFF = LDS_BYTES - 512;
constexpr int NWAVES = 8;

__device__ __forceinline__ unsigned f2bf(float f) { unsigned u = __builtin_bit_cast(unsigned, f); return (u + 0x7fffu + ((u >> 16) & 1u)) >> 16; }
__device__ __forceinline__ unsigned pk2(float lo, float hi) { return f2bf(lo) | (f2bf(hi) << 16); }
__device__ __forceinline__ unsigned cvt_pk_bf16(float lo, float hi) { unsigned r; asm volatile("v_cvt_pk_bf16_f32 %0, %1, %2" : "=v"(r) : "v"(lo), "v"(hi)); return r; }
__device__ __forceinline__ float clamp448(float v) { return fminf(fmaxf(v, -448.0f), 448.0f); }
__device__ __forceinline__ unsigned pk4_fp8(float a, float b, float c, float d) {
    int r = __builtin_amdgcn_cvt_pk_fp8_f32(clamp448(a), clamp448(b), 0, false);
    r = __builtin_amdgcn_cvt_pk_fp8_f32(clamp448(c), clamp448(d), r, true);
    return (unsigned)r;
}
__device__ __forceinline__ unsigned pk4_fp8_nc(float a, float b, float c, float d) {
    int r = __builtin_amdgcn_cvt_pk_fp8_f32(a, b, 0, false);
    r = __builtin_amdgcn_cvt_pk_fp8_f32(c, d, r, true);
    return (unsigned)r;
}
__device__ __forceinline__ float bf_lo(unsigned w) { return __uint_as_float(w << 16); }
__device__ __forceinline__ float bf_hi(unsigned w) { return __uint_as_float(w & 0xffff0000u); }
__device__ __forceinline__ float fsigmoid(float z) { return __builtin_amdgcn_rcpf(1.0f + __builtin_amdgcn_exp2f(-z * LOG2E)); }
__device__ __forceinline__ int lane_id() { int l; asm volatile("v_mbcnt_lo_u32_b32 %0, -1, 0\n\tv_mbcnt_hi_u32_b32 %0, -1, %0" : "=v"(l)); return l; }
__device__ __forceinline__ float wave_sum(float v) {
#define WS_DPP(x, ctrl) __builtin_bit_cast(float, __builtin_amdgcn_update_dpp(0, __builtin_bit_cast(int, (x)), (ctrl), 0xf, 0xf, false))
    v += WS_DPP(v, 0xB1);
    v += WS_DPP(v, 0x4E);
    v += WS_DPP(v, 0x124);
    v += WS_DPP(v, 0x128);
#undef WS_DPP
    const float r0 = __builtin_bit_cast(float, __builtin_amdgcn_readlane(__builtin_bit_cast(int, v), 0)), r1 = __builtin_bit_cast(float, __builtin_amdgcn_readlane(__builtin_bit_cast(int, v), 16));
    const float r2 = __builtin_bit_cast(float, __builtin_amdgcn_readlane(__builtin_bit_cast(int, v), 32)), r3 = __builtin_bit_cast(float, __builtin_amdgcn_readlane(__builtin_bit_cast(int, v), 48));
    return (r0 + r1) + (r2 + r3);
}

namespace pg8 {
constexpr int BM = 256, BK = 64, HALF = 128, HTB = HALF * BK * 2, STAGE_BYTES = 8 * HTB;
__device__ __forceinline__ int lds_byte(int r, int c) { const int st = (r >> 4) * 2 + (c >> 5), rr = r & 15, cc = c & 31, ob = rr * 64 + cc * 2; return st * 1024 + (ob ^ (((ob >> 9) & 1) << 5)); }
__device__ __forceinline__ void stage_rc(int b, int& R, int& C) { const int st = b / 1024, sb = b % 1024, swz = sb ^ (((sb >> 9) & 1) << 5); R = (st >> 1) * 16 + swz / 64; C = (st & 1) * 32 + (swz % 64) / 2; }
__device__ __forceinline__ int perm32(int rho) { const int n = rho >> 4, i = rho & 15; return 8 * (i >> 2) + 4 * n + (i & 3); }

struct Unit { int pm, pn, e, nv; };
template <int N> __device__ __forceinline__ void wait_vm() { asm volatile("s_waitcnt vmcnt(%0)" :: "n"(N) : "memory"); }
template <int NFRESH, int NSTEADY> __device__ __forceinline__ void wait_vm_sel(int fresh) {
    asm volatile("s_cmp_eq_u32 %0, 0\n\ts_cbranch_scc1 .Lwvs_a_%=\n\ts_waitcnt vmcnt(%1)\n\ts_branch .Lwvs_b_%=\n.Lwvs_a_%=:\n\ts_waitcnt vmcnt(%2)\n.Lwvs_b_%=:" :: "s"(__builtin_amdgcn_readfirstlane(fresh)), "n"(NFRESH), "n"(NSTEADY) : "scc", "memory"); }

template <class Epi, class Sched, bool ALIGN_EPI, int ESZ>
__device__ __forceinline__ void gemm_phase(LAS unsigned char* lds, const char* Abase, const int K, const Sched& S, const Epi& E) {
    const int wid = __builtin_amdgcn_readfirstlane(threadIdx.x >> 6), lane = lane_id(), tid = wid * 64 + lane, wr = wid >> 2, wc = wid & 3, fr = lane & 15, fq = lane >> 4;
    const int RB = K * ESZ, nt = RB / 128;
    unsigned voffB[2];
#pragma unroll
    for (int i = 0; i < 2; ++i) { int R, C; stage_rc(tid * 16 + i * 8192, R, C); const int Rb = Epi::PERM ? ((R & ~31) + perm32(R & 31)) : R; voffB[i] = (unsigned)(Rb * RB + 2 * C); }
    const size_t kstep = (size_t)(BK * 2);
    const size_t hstep = (size_t)HALF * RB;
    const unsigned ldsw = (unsigned)wid * 1024u;
    const int aoff = lds_byte(wr * 64 + fr, fq * 8), boff = lds_byte(wc * 32 + fr, fq * 8);
#define PG8_SA(b, h) (((b) * 2 + (h)) * HTB)
#define PG8_SB(b, h) ((4 + (b) * 2 + (h)) * HTB)
#define PG8_STAGE(bufoff, gbase, voff) do { _Pragma("unroll") for (int _i = 0; _i < 2; ++_i) \
        __builtin_amdgcn_global_load_lds((const unsigned*)((const char*)(gbase) + (voff)[_i]), (LAS unsigned*)(lds + (bufoff) + ldsw + _i * 8192), 16, 0, 0); } while (0)
#define PG8_LD16(off) (*(const LAS i32x4*)(lds + (off)))
#define PG8_LDA(dst, b, h) do { _Pragma("unroll") for (int m = 0; m < 4; ++m) { const i32x4 _x = PG8_LD16(PG8_SA(b, h) + aoff + m * 2048), _y = PG8_LD16(PG8_SA(b, h) + aoff + m * 2048 + 1024); dst[m] = __builtin_shufflevector(_x, _y, 0, 1, 2, 3, 4, 5, 6, 7); } } while (0)
#define PG8_LDB(dst, b, h) do { _Pragma("unroll") for (int n = 0; n < 2; ++n) { const i32x4 _x = PG8_LD16(PG8_SB(b, h) + boff + n * 2048), _y = PG8_LD16(PG8_SB(b, h) + boff + n * 2048 + 1024); dst[n] = __builtin_shufflevector(_x, _y, 0, 1, 2, 3, 4, 5, 6, 7); } } while (0)
#define PG8_MMA(ai, bj, At, Bt) do { __builtin_amdgcn_s_setprio(1); _Pragma("unroll") for (int m = 0; m < 4; ++m) _Pragma("unroll") for (int n = 0; n < 2; ++n) _Pragma("unroll") for (int k = 0; k < 2; ++k) \
        acc[ai][bj][m][n] = __builtin_amdgcn_mfma_f32_16x16x32_bf16(PG8_HALF(Bt[n], k), PG8_HALF(At[m], k), acc[ai][bj][m][n], 0, 0, 0); __builtin_amdgcn_s_setprio(0); } while (0)
#define PG8_HALF(v, k) __builtin_bit_cast(bf16x8, (k) == 0 ? __builtin_shufflevector((v), (v), 0, 1, 2, 3) : __builtin_shufflevector((v), (v), 4, 5, 6, 7))
#define PG8_MMA8(ai, bj, At, Bt) do { __builtin_amdgcn_s_setprio(1); _Pragma("unroll") for (int m = 0; m < 4; ++m) _Pragma("unroll") for (int n = 0; n < 2; ++n) \
        acc[ai][bj][m][n] = __builtin_amdgcn_mfma_scale_f32_16x16x128_f8f6f4(Bt[n], At[m], acc[ai][bj][m][n], 0, 0, 0, 0, 0, 0);     __builtin_amdgcn_s_setprio(0); } while (0)
#define PG8_MM(ai, bj, At, Bt) do { if constexpr (ESZ == 2) PG8_MMA(ai, bj, At, Bt); else PG8_MMA8(ai, bj, At, Bt); } while (0)
#define PG8_WAIT_V(n) asm volatile("s_waitcnt vmcnt(" #n ")" ::: "memory")
#define PG8_WAIT_L(n) asm volatile("s_waitcnt lgkmcnt(" #n ")" ::: "memory")
#define PG8_BAR __builtin_amdgcn_s_barrier()
#define PG8_SCHED __builtin_amdgcn_sched_barrier(0)
    Unit cur, nxt; int ui = 0;
    if (!S.next(0, cur)) return;
    f32x4 acc[2][2][4][2];
#pragma unroll
    for (int a = 0; a < 2; ++a)
#pragma unroll
        for (int b = 0; b < 2; ++b)
#pragma unroll
            for (int m = 0; m < 4; ++m)
#pragma unroll
                for (int n = 0; n < 2; ++n) acc[a][b][m][n] = (f32x4){0.f, 0.f, 0.f, 0.f};
    i32x8 At[4], B0[2], B1[2];
    unsigned vA0[2], vA1[2];
    LAS u32x4* const vslot = (LAS u32x4*)(lds + STAGE_BYTES) + tid;
    LAS u32x2* const rowtab = (LAS u32x2*)(lds + STAGE_BYTES + 8192);
    LAS f32x4* const biastab = (LAS f32x4*)(lds + STAGE_BYTES + 8192 + 4096);
    if constexpr (Sched::GATHER) {
        if (tid < 256) rowtab[tid] = *S.entry_ptr(cur, tid);
        else if (tid < 320) biastab[tid - 256] = *(const f32x4*)S.bias_ptr(cur, tid - 256);
        __syncthreads();
        S.a_off_tab(rowtab, cur.nv, tid, RB, vA0, vA1);
    } else S.a_off(cur, tid, RB, vA0, vA1);
    const char* cB = S.b_ptr(cur, RB);
    const char* cA = Abase;
    PG8_STAGE(PG8_SB(0, 0), cB, voffB); PG8_STAGE(PG8_SB(0, 1), cB + hstep, voffB); PG8_STAGE(PG8_SA(0, 0), cA, vA0); PG8_STAGE(PG8_SA(0, 1), cA, vA1);
    if (wr == 1) PG8_BAR;
    PG8_WAIT_V(2); PG8_BAR;
    PG8_STAGE(PG8_SB(1, 0), cB + kstep, voffB); PG8_STAGE(PG8_SA(1, 0), cA + kstep, vA0); PG8_STAGE(PG8_SB(1, 1), cB + hstep + kstep, voffB);
    PG8_WAIT_V(6); PG8_BAR;
    for (;;) {
        const bool has_next = S.next(ui + 1, nxt);
        const char* nB = cB;
        const int par = ui & 1;
        if constexpr (Sched::GATHER) {
            if (has_next) nB = S.b_ptr(nxt, RB);
            else *vslot = (u32x4){vA0[0], vA0[1], vA1[0], vA1[1]};
        } else {
            unsigned n0[2] = {vA0[0], vA0[1]}, n1[2] = {vA1[0], vA1[1]};
            if (has_next) { S.a_off(nxt, tid, RB, n0, n1); nB = S.b_ptr(nxt, RB); }
            *vslot = (u32x4){n0[0], n0[1], n1[0], n1[1]};
        }
#pragma clang loop unroll(disable)
        for (int t = 0; t < nt; t += 2) {
            const bool last = (t == nt - 2);
            const int fresh = ((ui > 0) && (t == 0)) ? 1 : 0;
            if constexpr (Sched::GATHER) {
                if (has_next && t == 2) { const int l2 = lane_id();
                    if (wid < 2) __builtin_amdgcn_global_load_lds((const unsigned*)((const char*)S.entry_ptr(nxt, 0) + (wid * 64 + l2) * 16), (LAS unsigned*)((LAS char*)(rowtab + (par ^ 1) * 256) + wid * 1024), 16, 0, 0);
                    if (wid == 4) __builtin_amdgcn_global_load_lds((const unsigned*)S.bias_ptr(nxt, l2), (LAS unsigned*)(biastab + (par ^ 1) * 64), 16, 0, 0); }
                if (has_next && t == 4) { unsigned n0[2], n1[2]; const int t2 = wid * 64 + lane_id(); S.a_off_tab_nowait(rowtab + (par ^ 1) * 256, nxt.nv, t2, RB, n0, n1); ((LAS u32x4*)(lds + STAGE_BYTES))[t2] = (u32x4){n0[0], n0[1], n1[0], n1[1]}; }
            }
            const char* a1 = cA + (size_t)(t + 1) * kstep;
            const char* a2 = last ? cA : cA + (size_t)(t + 2) * kstep; const char* b2 = last ? nB : cB + (size_t)(t + 2) * kstep;
            const char* a3 = a2 + kstep; const char* b3 = b2 + kstep;
            PG8_LDB(B0, 0, 0); PG8_LDB(B1, 0, 1); PG8_SCHED; PG8_LDA(At, 0, 0); PG8_STAGE(PG8_SA(1, 1), a1, vA1);
            if (last) { const u32x4 nv = *vslot; vA0[0] = nv.x; vA0[1] = nv.y; vA1[0] = nv.z; vA1[1] = nv.w; }
            wait_vm_sel<8 + Epi::NSTORE, 8>(fresh); PG8_WAIT_L(0); PG8_BAR; PG8_MM(0, 0, At, B0); PG8_MM(0, 1, At, B1); PG8_BAR; PG8_SCHED;
            PG8_LDA(At, 0, 1); PG8_STAGE(PG8_SB(0, 0), b2, voffB); PG8_STAGE(PG8_SB(0, 1), b2 + hstep, voffB); PG8_STAGE(PG8_SA(0, 0), a2, vA0);
            wait_vm_sel<8 + Epi::NSTORE, 8>(fresh); PG8_WAIT_L(0); PG8_BAR; PG8_MM(1, 0, At, B0); PG8_MM(1, 1, At, B1); PG8_BAR; PG8_SCHED;
            PG8_LDB(B0, 1, 0); PG8_LDB(B1, 1, 1); PG8_SCHED; PG8_LDA(At, 1, 0); PG8_STAGE(PG8_SA(0, 1), a2, vA1);
            PG8_WAIT_V(8); PG8_WAIT_L(0); PG8_BAR; PG8_MM(0, 0, At, B0); PG8_MM(0, 1, At, B1); PG8_BAR; PG8_SCHED;
            PG8_LDA(At, 1, 1); PG8_STAGE(PG8_SB(1, 0), b3, voffB); PG8_STAGE(PG8_SB(1, 1), b3 + hstep, voffB); PG8_STAGE(PG8_SA(1, 0), a3, vA0);
            PG8_WAIT_V(8); PG8_WAIT_L(0); PG8_BAR; PG8_MM(1, 0, At, B0); PG8_MM(1, 1, At, B1); PG8_BAR; PG8_SCHED;
        }
        if constexpr (ALIGN_EPI) { if (wr == 0) PG8_BAR; }
        if constexpr (Epi::AFTER_DRAIN) {   }
        else if constexpr (Sched::GATHER) { int zofs; asm volatile("s_mov_b32 %0, 0" : "=s"(zofs));
            E(acc, cur, wr, wc, fr, fq, rowtab + par * 256 + zofs, biastab + par * 64 + zofs); } else E(acc, cur, wr, wc, fr, fq);
        if (!has_next) break;
#pragma unroll
        for (int a = 0; a < 2; ++a)
#pragma unroll
            for (int b = 0; b < 2; ++b)
#pragma unroll
                for (int m = 0; m < 4; ++m)
#pragma unroll
                    for (int n = 0; n < 2; ++n) acc[a][b][m][n] = (f32x4){0.f, 0.f, 0.f, 0.f};
        cur = nxt; cB = nB; ++ui;
        if constexpr (ALIGN_EPI) { if (wr == 1) PG8_BAR; }
    }
    PG8_WAIT_V(0);
    if constexpr (!ALIGN_EPI) { if (wr == 0) PG8_BAR; }
    PG8_BAR;
    if constexpr (Epi::AFTER_DRAIN) E.fused(acc, cur, wr, wc, fr, fq, lds, wid, lane);
#undef PG8_SA
#undef PG8_SB
#undef PG8_STAGE
#undef PG8_LDA
#undef PG8_LDB
#undef PG8_MMA
#undef PG8_MMA8
#undef PG8_MM
#undef PG8_HALF
#undef PG8_LD16
#undef PG8_WAIT_V
#undef PG8_WAIT_L
#undef PG8_BAR
#undef PG8_SCHED
}

struct DenseOrder {
    static constexpr bool GATHER = false;
    int nM, nN, nwg, G, c; const char* Bt;
    __device__ __forceinline__ void init(int M, int N, int G_, int c_, const void* Bt_) { nM = M / BM; nN = N / BM; nwg = nM * nN; G = G_; c = c_; Bt = (const char*)Bt_; }
    __device__ __forceinline__ bool next(int i, Unit& u) const {
        const long L = (long)i * G + c; if (L >= nwg) return false;
        int wgid = (int)L; { const int q = nwg / 8, r = nwg % 8, xcd = wgid % 8, off = wgid / 8; wgid = (xcd < r ? xcd * (q + 1) : r * (q + 1) + (xcd - r) * q) + off; }
        const int nig = 8 * nN, gid = wgid / nig, fm = gid * 8, gsz = (nM - fm) < 8 ? (nM - fm) : 8;
        u.pm = fm + ((wgid % nig) % gsz); u.pn = (wgid % nig) / gsz; u.e = 0; u.nv = 256; return true;
    }
    __device__ __forceinline__ const char* b_ptr(const Unit& u, int RB) const { return Bt + (size_t)u.pn * (256 * (size_t)RB); }
    __device__ __forceinline__ void a_off(const Unit& u, int tid, int RB, unsigned (&v0)[2], unsigned (&v1)[2]) const {
#pragma unroll
        for (int i = 0; i < 2; ++i) { int R, C; stage_rc(tid * 16 + i * 8192, R, C); v0[i] = (unsigned)((u.pm * 256 + R) * RB + 2 * C); v1[i] = (unsigned)((u.pm * 256 + 128 + R) * RB + 2 * C); }
    }
};
struct MoeOrder {
    static constexpr bool GATHER = true;
    const LAS i32x4* ul;
    const u32x2* list;
    const char* Bt; int npn, nrowsB, shiftA;
    const float* bias0; const float* bias1; int bcols;
    __device__ __forceinline__ bool next(int i, Unit& u) const {
        if (i >= 32) return false;
        const i32x4 v = ul[i];
        u.e = __builtin_amdgcn_readfirstlane(v.x); u.pm = __builtin_amdgcn_readfirstlane(v.y); u.pn = __builtin_amdgcn_readfirstlane(v.z); u.nv = __builtin_amdgcn_readfirstlane(v.w);
        return u.nv > 0;
    }
    __device__ __forceinline__ const char* b_ptr(const Unit& u, int RB) const { return Bt + ((size_t)u.e * nrowsB + (size_t)u.pn * 256) * (size_t)RB; }
    __device__ __forceinline__ const u32x2* entry_ptr(const Unit& u, int t) const { return list + (size_t)u.e * LCAP + u.pm * 256 + t; }
    __device__ __forceinline__ const float* bias_ptr(const Unit& u, int i) const {
        return (bcols == 128) ? ((i < 32 ? bias0 : bias1) + (size_t)u.e * D + u.pn * 128 + 4 * (i & 31)) : (bias0 + (size_t)u.e * D + u.pn * 256 + 4 * i); }
    __device__ __forceinline__ void a_off_tab(const LAS u32x2* rt, int nv, int tid, int RB, unsigned (&v0)[2], unsigned (&v1)[2]) const {
#pragma unroll
        for (int i = 0; i < 2; ++i) { int R, C; stage_rc(tid * 16 + i * 8192, R, C);
            const int p0 = (int)rt[R < nv ? R : 0].x >> shiftA, p1 = (int)rt[(128 + R) < nv ? (128 + R) : 0].x >> shiftA;
            v0[i] = (unsigned)(p0 * RB + 2 * C); v1[i] = (unsigned)(p1 * RB + 2 * C); }
    }
    __device__ __forceinline__ void a_off_tab_nowait(const LAS u32x2* rt, int nv, int tid, int RB, unsigned (&v0)[2], unsigned (&v1)[2]) const {
        unsigned pr[4]; int Cc[2];
#pragma unroll
        for (int i = 0; i < 2; ++i) { int R, C; stage_rc(tid * 16 + i * 8192, R, C); Cc[i] = C;
            const unsigned a0 = (unsigned)(uintptr_t)(rt + (R < nv ? R : 0)), a1 = (unsigned)(uintptr_t)(rt + ((128 + R) < nv ? (128 + R) : 0));
            asm volatile("ds_read_b32 %0, %1" : "=v"(pr[2 * i]) : "v"(a0) : "memory"); asm volatile("ds_read_b32 %0, %1" : "=v"(pr[2 * i + 1]) : "v"(a1) : "memory"); }
        asm volatile("s_waitcnt lgkmcnt(0)" : "+v"(pr[0]), "+v"(pr[1]), "+v"(pr[2]), "+v"(pr[3]) :: "memory");
#pragma unroll
        for (int i = 0; i < 2; ++i) { v0[i] = (unsigned)(((int)pr[2 * i] >> shiftA) * RB + 2 * Cc[i]); v1[i] = (unsigned)(((int)pr[2 * i + 1] >> shiftA) * RB + 2 * Cc[i]); }
    }
};

struct EpiSplit {
    static constexpr bool PERM = true, AFTER_DRAIN = false; static constexpr int NSTORE = 16;
    bf16_t* O; size_t split_stride; float scale0;
    __device__ __forceinline__ void operator()(const f32x4 (&acc)[2][2][4][2], const Unit& u, int wr, int wc, int fr, int fq) const {
        const int row0 = u.pm * BM + wr * 64 + fr; int colt = u.pn * BM; const int t = colt / 512; bf16_t* base = O + (size_t)t * split_stride; colt -= t * 512;
        const float sc = (t == 0) ? scale0 : 1.f;
        const int col0 = colt + wc * 32 + 8 * fq;
#pragma unroll
        for (int ai = 0; ai < 2; ++ai)
#pragma unroll
            for (int m = 0; m < 4; ++m) { bf16_t* rowp = base + (size_t)(row0 + ai * HALF + m * 16) * 512 + col0;
#pragma unroll
                for (int bj = 0; bj < 2; ++bj) { const f32x4 v0 = acc[ai][bj][m][0] * sc, v1 = acc[ai][bj][m][1] * sc;
                    u32x4 w; w.x = cvt_pk_bf16(v0[0], v0[1]); w.y = cvt_pk_bf16(v0[2], v0[3]); w.z = cvt_pk_bf16(v1[0], v1[1]); w.w = cvt_pk_bf16(v1[2], v1[3]);
                    *(u32x4*)(rowp + bj * HALF) = w; } }
    }
};
struct EpiRes {
    static constexpr bool PERM = true, AFTER_DRAIN = false; static constexpr int NSTORE = 0;
    const float* base; bf16_t* out; unsigned char* t8; const float* gain;
    __device__ __forceinline__ void operator()(const f32x4 (&acc)[2][2][4][2], const Unit& u, int wr, int wc, int fr, int fq) const {
        const int row0 = u.pm * BM + wr * 64 + fr, col0 = u.pn * BM + wc * 32 + 8 * fq;
        f32x4 gv[2][2];
#pragma unroll
        for (int bj = 0; bj < 2; ++bj)
#pragma unroll
            for (int n = 0; n < 2; ++n) gv[bj][n] = *(const f32x4*)(gain + col0 + bj * HALF + 4 * n) * SC_T;
#pragma unroll
        for (int ai = 0; ai < 2; ++ai)
#pragma unroll
            for (int m = 0; m < 4; ++m) { const size_t off = (size_t)(row0 + ai * HALF + m * 16) * D + col0;
#pragma unroll
                for (int bj = 0; bj < 2; ++bj) { const f32x4 v0 = __builtin_nontemporal_load((const f32x4*)(base + off + bj * HALF)) + acc[ai][bj][m][0], v1 = __builtin_nontemporal_load((const f32x4*)(base + off + bj * HALF + 4)) + acc[ai][bj][m][1];
                    *(u32x4*)(out + off + bj * HALF) = (u32x4){cvt_pk_bf16(v0[0], v0[1]), cvt_pk_bf16(v0[2], v0[3]), cvt_pk_bf16(v1[0], v1[1]), cvt_pk_bf16(v1[2], v1[3])};
                    const f32x4 s0 = v0 * gv[bj][0], s1 = v1 * gv[bj][1];
                    *(u32x2*)(t8 + off + bj * HALF) = (u32x2){pk4_fp8(s0[0], s0[1], s0[2], s0[3]), pk4_fp8(s1[0], s1[1], s1[2], s1[3])}; } }
    }
};
struct EpiResRouter {
    static constexpr bool PERM = true, AFTER_DRAIN = true; static constexpr int NSTORE = 0;
    const float* base; bf16_t* out; unsigned char* t8; const float* gain; const bf16_t* rwb; float* xch;
    __device__ __forceinline__ void operator()(const f32x4 (&)[2][2][4][2], const Unit&, int, int, int, int) const {}
    __device__ __forceinline__ void fused(const f32x4 (&acc)[2][2][4][2], const Unit& u, int wr, int wc, int fr, int fq, LAS unsigned char* lds, int wid, int lane) const {
        const int row0 = u.pm * BM + wr * 64 + fr, col0 = u.pn * BM + wc * 32 + 8 * fq;
        LAS float* lp = (LAS float*)lds;
        LAS float* sp = (LAS float*)(lds + STAGE_BYTES);
        f32x4 gv[2][2]; bf16x8 bfr[2][2][2];
#pragma unroll
        for (int bj = 0; bj < 2; ++bj) {
#pragma unroll
            for (int n = 0; n < 2; ++n) gv[bj][n] = *(const f32x4*)(gain + col0 + bj * HALF + 4 * n) * SC_T;
#pragma unroll
            for (int nt = 0; nt < 2; ++nt)
#pragma unroll
                for (int hl = 0; hl < 2; ++hl) bfr[bj][nt][hl] = *(const bf16x8*)(rwb + (size_t)hl * NE * D + (size_t)(16 * nt + fr) * D + col0 + bj * HALF); }
#pragma unroll
        for (int ai = 0; ai < 2; ++ai)
#pragma unroll
            for (int m = 0; m < 4; ++m) { const size_t off = (size_t)(row0 + ai * HALF + m * 16) * D + col0; const int lrow = ai * HALF + wr * 64 + m * 16;
                f32x4 l0 = (f32x4){0.f, 0.f, 0.f, 0.f}, l1 = l0; float ss = 0.f;
#pragma unroll
                for (int bj = 0; bj < 2; ++bj) { const f32x4 v0 = __builtin_nontemporal_load((const f32x4*)(base + off + bj * HALF)) + acc[ai][bj][m][0], v1 = __builtin_nontemporal_load((const f32x4*)(base + off + bj * HALF + 4)) + acc[ai][bj][m][1];
                    const u32x4 hi = (u32x4){cvt_pk_bf16(v0[0], v0[1]), cvt_pk_bf16(v0[2], v0[3]), cvt_pk_bf16(v1[0], v1[1]), cvt_pk_bf16(v1[2], v1[3])};
                    *(u32x4*)(out + off + bj * HALF) = hi;
                    const f32x4 s0 = v0 * gv[bj][0], s1 = v1 * gv[bj][1];
                    *(u32x2*)(t8 + off + bj * HALF) = (u32x2){pk4_fp8(s0[0], s0[1], s0[2], s0[3]), pk4_fp8(s1[0], s1[1], s1[2], s1[3])};
                    ss += (v0[0] * v0[0] + v0[1] * v0[1]) + (v0[2] * v0[2] + v0[3] * v0[3]) + (v1[0] * v1[0] + v1[1] * v1[1]) + (v1[2] * v1[2] + v1[3] * v1[3]);
                    const bf16x8 ah = __builtin_bit_cast(bf16x8, hi);
                    l0 = __builtin_amdgcn_mfma_f32_16x16x32_bf16(ah, bfr[bj][0][0], l0, 0, 0, 0); l1 = __builtin_amdgcn_mfma_f32_16x16x32_bf16(ah, bfr[bj][1][0], l1, 0, 0, 0);
                    l0 = __builtin_amdgcn_mfma_f32_16x16x32_bf16(ah, bfr[bj][0][1], l0, 0, 0, 0); l1 = __builtin_amdgcn_mfma_f32_16x16x32_bf16(ah, bfr[bj][1][1], l1, 0, 0, 0); }
#pragma unroll
                for (int reg = 0; reg < 4; ++reg) { lp[(wc * 256 + lrow + 4 * fq + reg) * 32 + fr] = l0[reg]; lp[(wc * 256 + lrow + 4 * fq + reg) * 32 + 16 + fr] = l1[reg]; }
                ss += __shfl_xor(ss, 16); ss += __shfl_xor(ss, 32);
                if (fq == 0) sp[wc * 256 + lrow + fr] = ss; }
        __syncthreads();
        { const int tid = wid * 64 + lane, row = tid >> 1, h = tid & 1;
          float* dst = xch + ((size_t)(u.pm * 4 + u.pn) * 256 + row) * 36 + 16 * h;
#pragma unroll
          for (int e4 = 0; e4 < 4; ++e4) { f32x4 a = *(const LAS f32x4*)(lp + (0 * 256 + row) * 32 + 16 * h + 4 * e4);
#pragma unroll
              for (int w = 1; w < 4; ++w) a = a + *(const LAS f32x4*)(lp + (w * 256 + row) * 32 + 16 * h + 4 * e4);
              *(f32x4*)(dst + 4 * e4) = a; }
          if (h == 0) dst[32] = ((sp[row] + sp[256 + row]) + sp[512 + row]) + sp[768 + row]; }
    }
};
struct EpiGU {
    static constexpr bool PERM = true, AFTER_DRAIN = false; static constexpr int NSTORE = 8;
    unsigned char* hid;
    __device__ __forceinline__ void operator()(const f32x4 (&acc)[2][2][4][2], const Unit& u, int wr, int wc, int fr, int fq, const LAS u32x2* rt, const LAS f32x4* bt) const {
        const int hc = u.pn * 128 + wc * 32 + 8 * fq;
        const f32x4 g0 = bt[8 * wc + 2 * fq], g1 = bt[8 * wc + 2 * fq + 1], u0 = bt[32 + 8 * wc + 2 * fq], u1 = bt[32 + 8 * wc + 2 * fq + 1];
        constexpr float inv = 1.0f / (SC_T * SC_W);
#pragma unroll
        for (int ai = 0; ai < 2; ++ai)
#pragma unroll
            for (int m = 0; m < 4; ++m) { const int r = ai * HALF + wr * 64 + m * 16 + fr;
                const u32x2 en = rt[r]; const float rs = __uint_as_float(en.y) * inv;
                f32x2 h[4];
#pragma unroll
                for (int n = 0; n < 2; ++n)
#pragma unroll
                    for (int x = 0; x < 2; ++x) { const f32x4 ga = acc[ai][0][m][n], ua = acc[ai][1][m][n], gb = n ? g1 : g0, ub = n ? u1 : u0;
                        f32x2 g = (f32x2){ga[2 * x], ga[2 * x + 1]} * rs + (f32x2){gb[2 * x], gb[2 * x + 1]}, up = (f32x2){ua[2 * x], ua[2 * x + 1]} * rs + (f32x2){ub[2 * x], ub[2 * x + 1]};
                        g.x = fminf(g.x, 7.0f); g.y = fminf(g.y, 7.0f); up.x = __builtin_amdgcn_fmed3f(up.x, -7.0f, 7.0f); up.y = __builtin_amdgcn_fmed3f(up.y, -7.0f, 7.0f);
                        const f32x2 z = g * (-1.702f * LOG2E); f32x2 t; t.x = __builtin_amdgcn_exp2f(z.x); t.y = __builtin_amdgcn_exp2f(z.y); t = t + 1.0f;
                        f32x2 sg; sg.x = __builtin_amdgcn_rcpf(t.x); sg.y = __builtin_amdgcn_rcpf(t.y);
                        h[n * 2 + x] = (up * SC_H + SC_H) * (g * sg); }
                u32x2 w; w.x = pk4_fp8_nc(h[0].x, h[0].y, h[1].x, h[1].y); w.y = pk4_fp8_nc(h[2].x, h[2].y, h[3].x, h[3].y);
                *(u32x2*)(hid + (size_t)(r < u.nv ? en.x : (unsigned)NP) * D + hc) = w; }
    }
};
struct EpiDown {
    static constexpr bool PERM = true, AFTER_DRAIN = false; static constexpr int NSTORE = 16;
    unsigned char* o;
    __device__ __forceinline__ void operator()(const f32x4 (&acc)[2][2][4][2], const Unit& u, int wr, int wc, int fr, int fq, const LAS u32x2* rt, const LAS f32x4* bt) const {
        constexpr float inv = SC_O / (SC_H * SC_W);
        const int c0 = u.pn * BM + wc * 32 + 8 * fq;
        f32x4 bv[2][2];
#pragma unroll
        for (int bj = 0; bj < 2; ++bj)
#pragma unroll
            for (int n = 0; n < 2; ++n) bv[bj][n] = bt[bj * 32 + wc * 8 + 2 * fq + n] * SC_O;
#pragma unroll
        for (int ai = 0; ai < 2; ++ai)
#pragma unroll
            for (int m = 0; m < 4; ++m) { const int r = ai * HALF + wr * 64 + m * 16 + fr;
                const unsigned p = (r < u.nv) ? rt[r].x : (unsigned)NP; unsigned char* rowp = o + (size_t)p * D + c0;
#pragma unroll
                for (int bj = 0; bj < 2; ++bj) { const f32x4 v0 = acc[ai][bj][m][0] * inv + bv[bj][0], v1 = acc[ai][bj][m][1] * inv + bv[bj][1];
                    *(u32x2*)(rowp + bj * HALF) = (u32x2){pk4_fp8(v0[0], v0[1], v0[2], v0[3]), pk4_fp8(v1[0], v1[1], v1[2], v1[3])}; } }
    }
};
}

#define XB_TMO      128
#define XB_XCNT(j)  (256  + 64 * (j))
#define XB_XSUB(j)  (1280 + 64 * (j))
#define XB_XGEN(j)  (2304 + 64 * (j))
#define XB_TOP      3328
#define XB_TOPGEN   3392
#define XCD_BAR_WORDS 3456
#define XB_SPIN_CAP (1u << 18)
__device__ __forceinline__ unsigned xb_ld(unsigned* p)              { return __hip_atomic_load(p, __ATOMIC_RELAXED, __HIP_MEMORY_SCOPE_AGENT); }
__device__ __forceinline__ unsigned xb_add(unsigned* p, unsigned v) { return __hip_atomic_fetch_add(p, v, __ATOMIC_RELAXED, __HIP_MEMORY_SCOPE_AGENT); }
__device__ __forceinline__ unsigned xb_xcc_id() { return (unsigned)__builtin_amdgcn_s_getreg((3 << 11) | 20) & 0xFu; }
#define XB_SPIN(cond, bar) do { unsigned _sp = 0; while (cond) { __builtin_amdgcn_s_sleep(1); \
    if ((++_sp & 255u) == 0u) { if (xb_ld(&(bar)[XB_TMO])) break; if (_sp > XB_SPIN_CAP) { atomicAdd(&(bar)[XB_TMO], 1u); break; } } } } while (0)
struct XcdBarrier { unsigned* bar; unsigned x; volatile LAS unsigned* st; };
__device__ __forceinline__ XcdBarrier xcd_barrier_post(unsigned* bar, volatile LAS unsigned* st) {
    XcdBarrier b; b.bar = bar; b.x = xb_xcc_id(); b.st = st;
    if (threadIdx.x == 0) (void)xb_add(&bar[XB_XCNT(b.x)], 1u);
    return b;
}
__device__ __forceinline__ void xcd_barrier_complete(unsigned* bar, unsigned x, unsigned& nloc, unsigned& nx) {
    const unsigned G = gridDim.x * gridDim.y * gridDim.z;
    unsigned sum, cnt, mine, sp = 0u;
    for (;;) {
        sum = 0u; cnt = 0u; mine = 0u;
#pragma unroll
        for (unsigned j = 0; j < 16; ++j) { const unsigned c = xb_ld(&bar[XB_XCNT(j)]); sum += c; cnt += (c > 0u) ? 1u : 0u; mine = (j == x) ? c : mine; }
        if (sum == G) break;
        __builtin_amdgcn_s_sleep(1);
        if ((++sp & 255u) == 0u) { if (xb_ld(&bar[XB_TMO])) break; if (sp > XB_SPIN_CAP) { atomicAdd(&bar[XB_TMO], 1u); break; } }
    }
    nloc = mine > 0u ? mine : 1u; nx = cnt > 0u ? cnt : 1u;
}
__device__ __forceinline__ void xcd_barrier(const XcdBarrier& b) {
    asm volatile("s_waitcnt vmcnt(0)" ::: "memory");
    __syncthreads();
    if (threadIdx.x == 0) {
        unsigned* bar = b.bar;
        __builtin_amdgcn_s_waitcnt(0);
        unsigned nloc = b.st[0], nx = b.st[1];
        if (nloc == 0u) { xcd_barrier_complete(bar, b.x, nloc, nx); b.st[0] = nloc; b.st[1] = nx; }
        const unsigned old = xb_add(&bar[XB_XSUB(b.x)], 1u);
        const unsigned gen = old / nloc;
        if (old + 1u == (gen + 1u) * nloc) {
            __builtin_amdgcn_fence(__ATOMIC_RELEASE, "agent");
            asm volatile("s_waitcnt vmcnt(0)" ::: "memory");
            const unsigned og = xb_add(&bar[XB_TOP], 1u);
            const unsigned tg = og / nx;
            if (og + 1u == (tg + 1u) * nx) xb_add(&bar[XB_TOPGEN], 1u);
            else XB_SPIN(xb_ld(&bar[XB_TOPGEN]) == tg, bar);
            __builtin_amdgcn_fence(__ATOMIC_ACQUIRE, "agent");
            xb_add(&bar[XB_XGEN(b.x)], 1u);
            asm volatile("s_waitcnt vmcnt(0)" ::: "memory");
        } else {
            XB_SPIN(xb_ld(&bar[XB_XGEN(b.x)]) == gen, bar);
            __builtin_amdgcn_fence(__ATOMIC_ACQUIRE, "agent");
            asm volatile("s_waitcnt vmcnt(0)" ::: "memory");
        }
    }
    __syncthreads();
}

struct Frame {
    LAS unsigned char* lds;
    gu32* ctl;
    int wave, G, vcu;
};

__device__ __forceinline__ void transpose_item(const float* W, int N, int k0, int n0, bf16_t* dst, int K, LAS float* scr, int lane) {
    f32x4 v[8];
#pragma unroll
    for (int it = 0; it < 8; ++it) v[it] = *(const GAS f32x4*)(W + (size_t)(k0 + it * 8 + (lane >> 3)) * N + n0 + 4 * (lane & 7));
#pragma unroll
    for (int it = 0; it < 8; ++it) { LAS float* s = scr + (it * 8 + (lane >> 3)) * 33 + 4 * (lane & 7); s[0] = v[it].x; s[1] = v[it].y; s[2] = v[it].z; s[3] = v[it].w; }
    LDS_WAIT(); asm volatile("" ::: "memory");
    const int c = lane & 7;
#pragma unroll
    for (int j = 0; j < 4; ++j) { const int n = (lane >> 3) + 8 * j; const LAS float* s = scr + (8 * c) * 33 + n;
        u32x4 o; o.x = pk2(s[0 * 33], s[1 * 33]); o.y = pk2(s[2 * 33], s[3 * 33]); o.z = pk2(s[4 * 33], s[5 * 33]); o.w = pk2(s[6 * 33], s[7 * 33]);
        *(GAS u32x4*)(dst + (size_t)n * K + k0 + 8 * c) = o; }
    LDS_WAIT(); asm volatile("" ::: "memory");
}

struct Args { const float* in[19]; float* out; unsigned char* ws; int ph_lo, ph_hi; };

namespace att {
constexpr int SLOT = 8192, NSL = 5;
constexpr int L_K = 0, L_V = NSL * SLOT, L_WS = 2 * NSL * SLOT, L_BIAS = L_WS + 8 * 256, L_OST = L_BIAS + 1024, L_END = L_OST + 8 * 4096;
__device__ __forceinline__ int crow(int r, int hi) { return (r & 3) + 8 * (r >> 2) + 4 * hi; }
__device__ __forceinline__ s16x4 vtr(const LAS char* p) { typedef short v4i16_t __attribute__((ext_vector_type(4))); return __builtin_bit_cast(s16x4, __builtin_amdgcn_ds_read_tr16_b64_v4i16((LAS v4i16_t*)p)); }

template <bool FIRST>
__device__ __forceinline__ void tile_step(const LAS char* lds, int slot, int s, int lane, int r32, int hi, int qin, const bf16x8 (&qr)[4], const LAS float* tb, LAS float* wsf,
                                          float& m_run, float& l_run, f32x16 (&o)[2], f32x16& negm) {
    constexpr float THR = 8.0f;
    const LAS char* kp = lds + L_K + slot + hi * 1024 + r32 * 16;
    f32x16 p0, p1;
#pragma unroll
    for (int d0 = 0; d0 < 4; ++d0) {
        const bf16x8 b0 = *(const LAS bf16x8*)(kp + d0 * 2048), b1 = *(const LAS bf16x8*)(kp + d0 * 2048 + 512);
        p0 = __builtin_amdgcn_mfma_f32_32x32x16_bf16(b0, qr[d0], d0 == 0 ? negm : p0, 0, 0, 0); p1 = __builtin_amdgcn_mfma_f32_32x32x16_bf16(b1, qr[d0], d0 == 0 ? negm : p1, 0, 0, 0); }
    if (s >= 6) { const int ib = qin + 64 * (8 - s) + 63 - 4 * hi;
#pragma unroll
        for (int r = 0; r < 16; ++r) { const int off = (r & 3) + 8 * (r >> 2); p0[r] += tb[ib - off]; p1[r] += tb[ib - off - 32]; } }
    float mx = __builtin_fmaxf(__builtin_fmaxf(p0[0], p0[1]), p1[0]), my = __builtin_fmaxf(__builtin_fmaxf(p0[2], p0[3]), p1[1]);
    mx = __builtin_fmaxf(__builtin_fmaxf(mx, p1[2]), p1[3]);
#pragma unroll
    for (int r = 4; r < 16; r += 4) { mx = __builtin_fmaxf(__builtin_fmaxf(mx, p0[r]), p0[r + 1]); my = __builtin_fmaxf(__builtin_fmaxf(my, p0[r + 2]), p0[r + 3]);
                                      mx = __builtin_fmaxf(__builtin_fmaxf(mx, p1[r]), p1[r + 1]); my = __builtin_fmaxf(__builtin_fmaxf(my, p1[r + 2]), p1[r + 3]); }
    mx = fmaxf(mx, my); mx = fmaxf(mx, __shfl_xor(mx, 32));
    if constexpr (FIRST) {
        m_run = mx;
#pragma unroll
        for (int r = 0; r < 16; ++r) { p0[r] -= mx; p1[r] -= mx; negm[r] = -mx; }
    } else if (__any(mx > THR)) {
        const float d = mx > THR ? mx : 0.f, f = __builtin_amdgcn_exp2f(-d);
        m_run += d; l_run *= f;
#pragma unroll
        for (int r = 0; r < 16; ++r) { p0[r] -= d; p1[r] -= d; negm[r] = -m_run; }
        if (hi == 0) wsf[r32] = f;
        LDS_WAIT();
#pragma unroll
        for (int r = 0; r < 16; ++r) { const float g = wsf[crow(r, hi)]; o[0][r] *= g; o[1][r] *= g; }
    }
    float rs = 0.f, rs2 = 0.f;
#pragma unroll
    for (int r = 0; r < 16; ++r) { p0[r] = __builtin_amdgcn_exp2f(p0[r]); p1[r] = __builtin_amdgcn_exp2f(p1[r]); rs += p0[r]; rs2 += p1[r]; }
    l_run += rs + rs2;
    u32x4 pw[4];
#pragma unroll
    for (int q = 0; q < 4; ++q) { pw[0][q] = cvt_pk_bf16(p0[2 * q], p0[2 * q + 1]); pw[1][q] = cvt_pk_bf16(p0[8 + 2 * q], p0[8 + 2 * q + 1]);
                                  pw[2][q] = cvt_pk_bf16(p1[2 * q], p1[2 * q + 1]); pw[3][q] = cvt_pk_bf16(p1[8 + 2 * q], p1[8 + 2 * q + 1]); }
    const unsigned vb = (unsigned)(uintptr_t)(lds + L_V + slot + ((lane >> 4) & 1) * 32 + (lane & 3) * 8 + (4 * hi + ((lane & 15) >> 2)) * 64);
#pragma unroll
    for (int d0 = 0; d0 < 2; ++d0) { s16x4 lo[4], hh[4];
#pragma unroll
        for (int ks = 0; ks < 4; ++ks) {
            asm volatile("ds_read_b64_tr_b16 %0, %1 offset:%c2" : "=&v"(lo[ks]) : "v"(vb), "i"(d0 * 4096 + ks * 1024) : "memory");
            asm volatile("ds_read_b64_tr_b16 %0, %1 offset:%c2" : "=&v"(hh[ks]) : "v"(vb), "i"(d0 * 4096 + ks * 1024 + 512) : "memory"); }
        asm volatile("s_waitcnt lgkmcnt(0)" ::: "memory"); __builtin_amdgcn_sched_barrier(0);
#pragma unroll
        for (int ks = 0; ks < 4; ++ks) { const bf16x8 vf = (bf16x8){lo[ks][0], lo[ks][1], lo[ks][2], lo[ks][3], hh[ks][0], hh[ks][1], hh[ks][2], hh[ks][3]};
            o[d0] = __builtin_amdgcn_mfma_f32_32x32x16_bf16(__builtin_bit_cast(bf16x8, pw[ks]), vf, o[d0], 0, 0, 0); } }
}

template <bool EDGE>
__device__ __forceinline__ void unit(const Frame& F, int b, int h, int cg, const bf16_t* Q, const bf16_t* Kb, const bf16_t* Vb, bf16_t* MIX, const float* relb) {
    LAS char* lds = (LAS char*)F.lds;
    const int wid = F.wave, lane = lane_id(), tid = wid * 64 + lane, r32 = lane & 31, hi = lane >> 5;
    const int wp = wid >> 1, half = wid & 1;
    const int c = 4 * cg + wp;
    const long rowbase = (long)b * SEQ;
    LAS float* wsf = (LAS float*)(lds + L_WS) + wid * 64;
    LAS float* tb = (LAS float*)(lds + L_BIAS);
    if (tid < 256) { const int i = tid < NREL ? tid : NREL - 1; tb[tid] = (relb[h * NREL + i] - relb[h * NREL + NREL - 1]) * LOG2E; }
    const bf16_t* Qw = Q + (rowbase + c * 64 + half * 32 + r32) * DA + h * HD;
    bf16x8 qr[4];
#pragma unroll
    for (int d0 = 0; d0 < 4; ++d0) qr[d0] = *(const GAS bf16x8*)(Qw + d0 * 16 + hi * 8);
    const int kc0 = 4 * cg - 8;
    const int krow = tid & 63, kch = tid >> 6;
    const int vrow = tid >> 3, vch = tid & 7;
    const bf16_t* ksrc = Kb + (rowbase + krow) * DA + h * HD + kch * 8;
    const bf16_t* vsrc = Vb + (rowbase + vrow) * DA + h * HD + vch * 8;
    const int kdst = L_K + kch * 1024 + krow * 16, vdst = L_V + (vch >> 2) * 4096 + vrow * 64 + (vch & 3) * 16;
#pragma unroll
    for (int j = 0; j < 4; ++j) { const int kc = kc0 + j;
        if (!EDGE || kc >= 0) { const u32x4 kv = *(const GAS u32x4*)(ksrc + (long)kc * 64 * DA); const u32x4 vv = *(const GAS u32x4*)(vsrc + (long)kc * 64 * DA);
            *(LAS u32x4*)(lds + kdst + j * SLOT) = kv; *(LAS u32x4*)(lds + vdst + j * SLOT) = vv; } }
    float m_run = 0.f, l_run = 0.f; f32x16 o[2]; o[0] = f32x16{}; o[1] = f32x16{}; f32x16 negm = f32x16{};
    const int qin = half * 32 + r32;
    if constexpr (!EDGE) {
        __syncthreads();
        { u32x4 kv = *(const GAS u32x4*)(ksrc + (long)(kc0 + 4) * 64 * DA), vv = *(const GAS u32x4*)(vsrc + (long)(kc0 + 4) * 64 * DA);
          tile_step<true>(lds, (wp % NSL) * SLOT, 0, lane, r32, hi, qin, qr, tb, wsf, m_run, l_run, o, negm);
          *(LAS u32x4*)(lds + kdst + 4 * SLOT) = kv; *(LAS u32x4*)(lds + vdst + 4 * SLOT) = vv; }
#pragma unroll 1
        for (int s = 1; s < 9; ++s) {
            __syncthreads();
            const int jn = s + 4; const bool ldn = jn < 12;
            u32x4 kv = (u32x4){0u, 0u, 0u, 0u}, vv = (u32x4){0u, 0u, 0u, 0u};
            if (ldn) { kv = *(const GAS u32x4*)(ksrc + (long)(kc0 + jn) * 64 * DA); vv = *(const GAS u32x4*)(vsrc + (long)(kc0 + jn) * 64 * DA); }
            tile_step<false>(lds, ((wp + s) % NSL) * SLOT, s, lane, r32, hi, qin, qr, tb, wsf, m_run, l_run, o, negm);
            if (ldn) { const int sl = (jn % NSL) * SLOT; *(LAS u32x4*)(lds + kdst + sl) = kv; *(LAS u32x4*)(lds + vdst + sl) = vv; }
        }
    } else {
        bool first = true;
#pragma unroll 1
        for (int s = 0; s < 9; ++s) {
            __syncthreads();
            const int jn = s + 4, kcn = kc0 + jn; const bool ldn = (jn < 12) && (kcn >= 0);
            u32x4 kv = (u32x4){0u, 0u, 0u, 0u}, vv = (u32x4){0u, 0u, 0u, 0u};
            if (ldn) { kv = *(const GAS u32x4*)(ksrc + (long)kcn * 64 * DA); vv = *(const GAS u32x4*)(vsrc + (long)kcn * 64 * DA); }
            const int j = wp + s, kc = kc0 + j;
            if (kc >= 0) { if (first) { tile_step<true>(lds, (j % NSL) * SLOT, s, lane, r32, hi, qin, qr, tb, wsf, m_run, l_run, o, negm); first = false; }
                           else tile_step<false>(lds, (j % NSL) * SLOT, s, lane, r32, hi, qin, qr, tb, wsf, m_run, l_run, o, negm); }
            if (ldn) { const int sl = (jn % NSL) * SLOT; *(LAS u32x4*)(lds + kdst + sl) = kv; *(LAS u32x4*)(lds + vdst + sl) = vv; }
        }
    }
    l_run += __shfl_xor(l_run, 32);
    if (hi == 0) wsf[32 + r32] = l_run;
    LDS_WAIT();
    LAS bf16_t* stg = (LAS bf16_t*)(lds + L_OST) + wid * 2048;
#pragma unroll
    for (int r = 0; r < 16; ++r) { const int orow = crow(r, hi); const float rl = __builtin_amdgcn_rcpf(wsf[32 + orow]);
#pragma unroll
        for (int d0 = 0; d0 < 2; ++d0) stg[orow * 64 + d0 * 32 + r32] = (bf16_t)f2bf(o[d0][r] * rl); }
    LDS_WAIT();
    bf16_t* Ow = MIX + (rowbase + c * 64 + half * 32) * D + h * HD;
#pragma unroll
    for (int i = 0; i < 4; ++i) { const int row = i * 8 + (lane >> 3), ch = lane & 7; const u32x4 v = *(const LAS u32x4*)(stg + row * 64 + ch * 8); *(GAS u32x4*)(Ow + (long)row * D + ch * 8) = v; }
    __syncthreads();
}
}

namespace cv {
constexpr int TT = 32, UR = TT + CW - 1;
constexpr int L_U = 0, L_Y = UR * DC * 2  , L_END = L_Y + TT * DC * 4;
__device__ __forceinline__ void unit(const Frame& F, int b, int tt, const bf16_t* Ab, const bf16_t* Gb, bf16_t* MIX, const float* dw_w, const float* dw_b, const float* ln_g, const float* ln_b) {
    LAS char* lds = (LAS char*)F.lds;
    const int wid = F.wave, lane = lane_id(), tid = wid * 64 + lane;
    const int t0 = tt * TT; const long rowbase = (long)b * SEQ;
    for (int idx = tid; idx < UR * 64; idx += 512) { const int r = idx >> 6, c8 = idx & 63; const int tok = t0 - (CW - 1) + r;
        u32x4 w = (u32x4){0u, 0u, 0u, 0u};
        if (tok >= 0) { const u32x4 av = *(const GAS u32x4*)(Ab + (rowbase + tok) * DC + c8 * 8), gv = *(const GAS u32x4*)(Gb + (rowbase + tok) * DC + c8 * 8);
#pragma unroll
            for (int q = 0; q < 4; ++q) { const float u0 = bf_lo(av[q]) * fsigmoid(bf_lo(gv[q])), u1 = bf_hi(av[q]) * fsigmoid(bf_hi(gv[q])); w[q] = cvt_pk_bf16(u0, u1); } }
        *(LAS u32x4*)(lds + L_U + r * (DC * 2) + c8 * 16) = w; }
    __syncthreads();
    { const int cp = tid & 255, th = tid >> 8;
      f32x2 w[CW];
#pragma unroll
      for (int j = 0; j < CW; ++j) w[j] = *(const GAS f32x2*)(dw_w + j * DC + 2 * cp);
      const f32x2 bias = *(const GAS f32x2*)(dw_b + 2 * cp);
#pragma unroll 1
      for (int blk = 0; blk < 2; ++blk) { const int tbk = th * 16 + blk * 8;
          f32x2 acc[8];
#pragma unroll
          for (int k = 0; k < 8; ++k) acc[k] = bias;
#pragma unroll
          for (int i = 0; i < 8 + CW - 1; ++i) { const unsigned uw = *(const LAS unsigned*)(lds + L_U + (tbk + i) * (DC * 2) + cp * 4); const f32x2 uv = (f32x2){bf_lo(uw), bf_hi(uw)};
#pragma unroll
              for (int k = 0; k < 8; ++k) { const int j = i - k; if (j >= 0 && j < CW) acc[k] += uv * w[j]; } }
#pragma unroll
          for (int k = 0; k < 8; ++k) *(LAS f32x2*)(lds + L_Y + (tbk + k) * (DC * 4) + cp * 8) = acc[k]; } }
    __syncthreads();
    { const f32x4 g0 = *(const GAS f32x4*)(ln_g + 8 * lane), g1 = *(const GAS f32x4*)(ln_g + 8 * lane + 4), b0 = *(const GAS f32x4*)(ln_b + 8 * lane), b1 = *(const GAS f32x4*)(ln_b + 8 * lane + 4);
#pragma unroll
      for (int q = 0; q < 4; ++q) { const int t = wid * 4 + q;
          f32x4 y0 = *(const LAS f32x4*)(lds + L_Y + t * (DC * 4) + lane * 32), y1 = *(const LAS f32x4*)(lds + L_Y + t * (DC * 4) + lane * 32 + 16);
          const float mean = wave_sum((y0.x + y0.y) + (y0.z + y0.w) + (y1.x + y1.y) + (y1.z + y1.w)) * (1.f / DC);
          y0 = y0 - mean; y1 = y1 - mean;
          const float var = wave_sum((y0.x * y0.x + y0.y * y0.y) + (y0.z * y0.z + y0.w * y0.w) + (y1.x * y1.x + y1.y * y1.y) + (y1.z * y1.z + y1.w * y1.w)) * (1.f / DC);
          const float rstd = 1.0f / sqrtf(var + LN_EPS);
          y0 = y0 * rstd * g0 + b0; y1 = y1 * rstd * g1 + b1;
          float z[8] = {y0.x, y0.y, y0.z, y0.w, y1.x, y1.y, y1.z, y1.w};
#pragma unroll
          for (int i = 0; i < 8; ++i) z[i] = z[i] * fsigmoid(z[i]);
          u32x4 w; w.x = cvt_pk_bf16(z[0], z[1]); w.y = cvt_pk_bf16(z[2], z[3]); w.z = cvt_pk_bf16(z[4], z[5]); w.w = cvt_pk_bf16(z[6], z[7]);
          *(GAS u32x4*)(MIX + (rowbase + t0 + t) * D + DA + 8 * lane) = w; } }
    __syncthreads();
}
}

__global__ void __launch_bounds__(NWAVES * 64, 2) hymba_fwd(Args args) {
    extern __shared__ __attribute__((aligned(16))) unsigned char lds_raw[];
    Frame F;
    F.lds = (LAS unsigned char*)lds_raw;
    F.wave = __builtin_amdgcn_readfirstlane(threadIdx.x >> 6);
    F.G = gridDim.x; { const int bx = blockIdx.x; F.vcu = (F.G % 8 == 0) ? (bx % 8) * (F.G / 8) + bx / 8 : bx; }
    unsigned char* ws = args.ws;
    F.ctl = (gu32*)(ws + WS_CTL);
    volatile LAS unsigned* MISC = (volatile LAS unsigned*)(F.lds + LDSCTL_OFF);
    for (int u = threadIdx.x; u < (LDS_BYTES - LDSCTL_OFF) / 4; u += NWAVES * 64) ((LAS unsigned*)(F.lds + LDSCTL_OFF))[u] = 0u;
    __syncthreads();
    const int lo = args.ph_lo, hi = args.ph_hi;
    const bool multi = (hi - lo) > 1;
    XcdBarrier bar; bar.bar = (unsigned*)(F.ctl + CW_BAR); bar.x = 0; bar.st = nullptr;
    if (multi) bar = xcd_barrier_post((unsigned*)(F.ctl + CW_BAR), MISC + 8);
#define IN(k) (lo <= (k) && (k) < hi)
#define BOTH(k) (IN(k) && IN((k) + 1))
#define GRID_BAR() xcd_barrier(bar)

    const float* x = args.in[0];
    bf16_t* Win_t = (bf16_t*)(ws + WS_WIN); bf16_t* Wout_t = (bf16_t*)(ws + WS_WOUT); unsigned char* Wgu8 = ws + WS_WGU; unsigned char* Wd8 = ws + WS_WD;
    bf16_t* X1 = (bf16_t*)(ws + WS_X1); bf16_t* XN = (bf16_t*)(ws + WS_XN);
    bf16_t* Qb = (bf16_t*)(ws + WS_Q); bf16_t* Kb = (bf16_t*)(ws + WS_K); bf16_t* Vb = (bf16_t*)(ws + WS_V); bf16_t* Ab = (bf16_t*)(ws + WS_A); bf16_t* Gb = (bf16_t*)(ws + WS_G);
    bf16_t* MIX = (bf16_t*)(ws + WS_MIX); unsigned char* HID8 = ws + WS_HID; unsigned char* T8 = ws + WS_XN; unsigned char* OB = ws + WS_O;
    u32x2* LIST = (u32x2*)(ws + WS_LIST); float* XCH = (float*)(ws + WS_XCH);   float* TOPW = (float*)(ws + WS_TOPW); bf16_t* RWB = (bf16_t*)(ws + WS_RWT);
    const int gw = F.vcu * NWAVES + F.wave, NGW = F.G * NWAVES;

    if (IN(0)) {
        const int lane = lane_id(), tid = F.wave * 64 + lane;
        LAS float* scr = (LAS float*)(F.lds + F.wave * 16896);
        constexpr int I_IN = (D / 64) * (NIN / 32), I_OUT = (D / 64) * (D / 32), I_EXP = (D / 64) * (D / 32);
        for (int it = gw; it < I_IN + I_OUT; it += NGW) {
            int r = it;
            if (r < I_IN) { const int kb = r / (NIN / 32), nb = r % (NIN / 32); transpose_item(args.in[2], NIN, kb * 64, nb * 32, Win_t + (size_t)(nb * 32) * D, D, scr, lane); continue; } r -= I_IN;
            const int kb = r / (D / 32), nb = r % (D / 32); transpose_item(args.in[8], D, kb * 64, nb * 32, Wout_t + (size_t)(nb * 32) * D, D, scr, lane);
        }
        { const GAS f32x4* gp = (const GAS f32x4*)args.in[1] + lane; f32x4 g[4];
#pragma unroll
          for (int j = 0; j < 4; ++j) g[j] = gp[64 * j];
          for (int m = gw; m < T; m += 2 * NGW) { const int m2 = m + NGW;
              const GAS f32x4* xr = (const GAS f32x4*)(x + (size_t)m * D) + lane; const GAS f32x4* xr2 = (const GAS f32x4*)(x + (size_t)(m2 < T ? m2 : m) * D) + lane; f32x4 v[4], v2[4]; float s = 0.f, s2 = 0.f;
#pragma unroll
              for (int j = 0; j < 4; ++j) { v[j] = __builtin_nontemporal_load(xr + 64 * j); v2[j] = __builtin_nontemporal_load(xr2 + 64 * j); }
#pragma unroll
              for (int j = 0; j < 4; ++j) { s += (v[j].x * v[j].x + v[j].y * v[j].y) + (v[j].z * v[j].z + v[j].w * v[j].w); s2 += (v2[j].x * v2[j].x + v2[j].y * v2[j].y) + (v2[j].z * v2[j].z + v2[j].w * v2[j].w); }
              const float r = 1.0f / sqrtf(wave_sum(s) * (1.f / D) + RMS_EPS), r2 = 1.0f / sqrtf(wave_sum(s2) * (1.f / D) + RMS_EPS);
              GAS u32x2* o8 = (GAS u32x2*)(XN + (size_t)m * D) + lane;
#pragma unroll
              for (int j = 0; j < 4; ++j) { const f32x4 y = v[j] * r * g[j]; o8[64 * j] = (u32x2){pk2(y.x, y.y), pk2(y.z, y.w)}; }
              if (m2 < T) { GAS u32x2* o82 = (GAS u32x2*)(XN + (size_t)m2 * D) + lane;
#pragma unroll
                  for (int j = 0; j < 4; ++j) { const f32x4 y = v2[j] * r2 * g[j]; o82[64 * j] = (u32x2){pk2(y.x, y.y), pk2(y.z, y.w)}; } } } }
        for (int i = blockIdx.x * 512 + tid; i < NE * D; i += F.G * 512) { const int e = i / D, k = i % D; const float v = args.in[10][k * NE + e] * args.in[9][k];
            const unsigned h = f2bf(v); RWB[i] = (bf16_t)h; RWB[NE * D + i] = (bf16_t)f2bf(v - __uint_as_float(h << 16)); }
        if (BOTH(0)) GRID_BAR();
    }

    if (IN(1)) {
        const int xg = (int)(blockIdx.x % 8), jb = (int)(blockIdx.x / 8), half = F.G / 16;
        if (jb < half) {
            pg8::DenseOrder S; S.init(T, NIN, F.G / 2, xg + 8 * jb, Win_t);
            pg8::EpiSplit E{Qb, (size_t)(WS_K - WS_Q) / 2, QSCALE};
            pg8::gemm_phase<pg8::EpiSplit, pg8::DenseOrder, true, 2>(F.lds, (const char*)XN, D, S, E);
        } else {
            const int cgw = (xg * half + (jb - half)) * NWAVES + F.wave, CNGW = (F.G / 2) * NWAVES;
        { constexpr int NIT = NE * 3 * 8 * 32;
          LAS unsigned* tile = (LAS unsigned*)(F.lds + F.wave * 4352); const int lane = lane_id();
          f32x4 v[16], w[16];
          auto src_of = [&](int r) -> const float* { const int em = r >> 8, ri = r & 255, e = em / 3, mat = em % 3, kb = ri >> 5, nb = ri & 31;
              const float* base = (mat == 0 ? args.in[12] : mat == 1 ? args.in[14] : args.in[16]) + (size_t)e * D * D;
              return base + (size_t)(kb * 128 + (lane >> 3)) * D + nb * 32 + 4 * (lane & 7); };
          int it = cgw;
          if (it < NIT) { const float* sp = src_of(it);
#pragma unroll
              for (int q = 0; q < 16; ++q) v[q] = __builtin_nontemporal_load((const GAS f32x4*)(sp + (size_t)q * 8 * D)); }
#pragma unroll 1
          for (; it < NIT; it += CNGW) {
              const int nx = it + CNGW;
              if (nx < NIT) { const float* sp = src_of(nx);
#pragma unroll
                  for (int q = 0; q < 16; ++q) w[q] = __builtin_nontemporal_load((const GAS f32x4*)(sp + (size_t)q * 8 * D)); }
              const int em = it >> 8, ri = it & 255, e = em / 3, mat = em % 3, kb = ri >> 5, nb = ri & 31, n0 = nb * 32, k0 = kb * 128;
              unsigned char* dst = (mat == 2) ? Wd8 + ((size_t)e * D + n0) * D : Wgu8 + ((size_t)e * 2048 + (size_t)(n0 >> 7) * 256 + (n0 & 127) + (mat == 1 ? 128 : 0)) * D;
#pragma unroll
              for (int q = 0; q < 16; ++q) tile[(lane & 7) * 132 + q * 8 + (lane >> 3)] = pk4_fp8(v[q].x * SC_W, v[q].y * SC_W, v[q].z * SC_W, v[q].w * SC_W);
              LDS_WAIT(); asm volatile("" ::: "memory");
              const int nq = lane >> 3, c = lane & 7;
              u32x4 r[4];
#pragma unroll
              for (int i = 0; i < 4; ++i) r[i] = *(const LAS u32x4*)(tile + nq * 132 + 16 * c + 4 * i);
              LDS_WAIT(); asm volatile("" ::: "memory");
              u32x4 o[4];
#pragma unroll
              for (int i = 0; i < 4; ++i) {
                  const unsigned x01 = __builtin_amdgcn_perm(r[i].y, r[i].x, 0x05010400u), y01 = __builtin_amdgcn_perm(r[i].y, r[i].x, 0x07030602u);
                  const unsigned x23 = __builtin_amdgcn_perm(r[i].w, r[i].z, 0x05010400u), y23 = __builtin_amdgcn_perm(r[i].w, r[i].z, 0x07030602u);
                  o[0][i] = __builtin_amdgcn_perm(x23, x01, 0x05040100u); o[1][i] = __builtin_amdgcn_perm(x23, x01, 0x07060302u);
                  o[2][i] = __builtin_amdgcn_perm(y23, y01, 0x05040100u); o[3][i] = __builtin_amdgcn_perm(y23, y01, 0x07060302u); }
#pragma unroll
              for (int j = 0; j < 4; ++j) *(GAS u32x4*)(dst + (size_t)(4 * nq + j) * D + k0 + 16 * c) = o[j];
#pragma unroll
              for (int q = 0; q < 16; ++q) v[q] = w[q];
          } }
        }
        if (BOTH(1)) GRID_BAR();
    }

    if (IN(2)) {
        if (F.G == 256) {
            const int xg = (int)(blockIdx.x % 8), j = (int)(blockIdx.x / 8);
            for (int i = 0; i < 2; ++i) { const int h = 4 * i + (j >> 3), pm = 8 * xg + (j & 7), b = pm >> 5, cg = pm & 31;
                if (cg < 2) att::unit<true>(F, b, h, cg, Qb, Kb, Vb, MIX, args.in[7]); else att::unit<false>(F, b, h, cg, Qb, Kb, Vb, MIX, args.in[7]); }
            for (int i = 0; i < 2; ++i) { const int loc = j + 32 * i, tg = (8 * xg + (loc >> 3)) * 8 + (loc & 7), b = tg / (SEQ / cv::TT), tt = tg % (SEQ / cv::TT);
                cv::unit(F, b, tt, Ab, Gb, MIX, args.in[3], args.in[4], args.in[5], args.in[6]); }
        } else {
        for (int u = F.vcu; u < 2 * NH * 32; u += F.G) { const int cg = u & 31, h = (u >> 5) & 7, b = u >> 8;
            if (cg < 2) att::unit<true>(F, b, h, cg, Qb, Kb, Vb, MIX, args.in[7]); else att::unit<false>(F, b, h, cg, Qb, Kb, Vb, MIX, args.in[7]); }
        for (int u = F.vcu; u < T / cv::TT; u += F.G) { const int b = u / (SEQ / cv::TT), tt = u % (SEQ / cv::TT);
            cv::unit(F, b, tt, Ab, Gb, MIX, args.in[3], args.in[4], args.in[5], args.in[6]); }
        }
        if (BOTH(2)) GRID_BAR();
    }

    if (IN(3)) {
        pg8::DenseOrder S; S.init(T, D, F.G, (int)blockIdx.x, Wout_t);
        if (F.G == 256) {
            pg8::EpiResRouter E{x, X1, T8, args.in[9], RWB, XCH};
            pg8::gemm_phase<pg8::EpiResRouter, pg8::DenseOrder, false, 2>(F.lds, (const char*)MIX, D, S, E);
            if (BOTH(3)) GRID_BAR();
        } else {
        pg8::EpiRes E{x, X1, T8, args.in[9]};
        pg8::gemm_phase<pg8::EpiRes, pg8::DenseOrder, false, 2>(F.lds, (const char*)MIX, D, S, E);
        if (BOTH(3)) {
            const int tid = F.wave * 64 + lane_id();
            for (int i = tid; i < 8192; i += 512) { const int row = i >> 7, ch = i & 127; const u32x4 v = ((const GAS u32x4*)RWB)[i];
                *(LAS u32x4*)(F.lds + row * 2048 + (((ch & ~15) | ((ch ^ row) & 15)) * 16)) = v; }
            GRID_BAR(); }
        }
    }

    if (IN(4)) {
        const int lane = lane_id(), tid = F.wave * 64 + lane, fr = lane & 15, fq = lane >> 4;
        LAS unsigned char* rwl = F.lds;
        LAS int* hist = (LAS int*)(F.lds + XTRA_OFF);
        LAS int* baseE = hist + 32;
        LAS int* selE = baseE + 32;
        LAS int* selP = selE + 256;
        LAS float* selR = (LAS float*)(selP + 256);
        LAS float* part = selR + 64;
        const int w4 = F.wave & 3, kh = F.wave >> 2;
        const float rb0 = args.in[11][fr], rb1 = args.in[11][16 + fr];
        bool filled = false; const bool fusedr = (F.G == 256);
#pragma unroll 1
        for (int tb = F.vcu * 4; tb < T / 16; tb += F.G * 4) {
            const int task = tb + w4;
            f32x4 acc0 = (f32x4){0.f, 0.f, 0.f, 0.f}, acc1 = acc0; float ss = 0.f;
            if (fusedr) {
                if (tid < 32) hist[tid] = 0;
                __syncthreads();
                if (kh == 0) { const int pm = task >> 4, rb = (task & 15) * 16;
#pragma unroll
                    for (int pn = 0; pn < 4; ++pn) { const float* xp = XCH + ((size_t)(pm * 4 + pn) * 256 + rb) * 36;
#pragma unroll
                        for (int q = 0; q < 4; ++q) { acc0[q] += xp[(4 * fq + q) * 36 + fr]; acc1[q] += xp[(4 * fq + q) * 36 + 16 + fr]; }
                        ss += xp[fr * 36 + 32]; } }
            } else {
            const bf16_t* xrow = X1 + (size_t)(task * 16 + fr) * D + kh * 512 + 8 * fq;
            u32x4 xv[16];
#pragma unroll
            for (int ks = 0; ks < 16; ++ks) xv[ks] = *(const GAS u32x4*)(xrow + 32 * ks);
            if (!filled && !BOTH(3)) {
                for (int i = tid; i < 8192; i += 512) { const int row = i >> 7, ch = i & 127; const u32x4 v = ((const GAS u32x4*)RWB)[i];
                    *(LAS u32x4*)(rwl + row * 2048 + (((ch & ~15) | ((ch ^ row) & 15)) * 16)) = v; } }
            filled = true;
            if (tid < 32) hist[tid] = 0;
            __syncthreads();
#pragma unroll
            for (int ks = 0; ks < 16; ++ks) {
                const u32x4 hi = xv[ks];
                { const float a0 = bf_lo(hi.x), a1 = bf_hi(hi.x), a2 = bf_lo(hi.y), a3 = bf_hi(hi.y), a4 = bf_lo(hi.z), a5 = bf_hi(hi.z), a6 = bf_lo(hi.w), a7 = bf_hi(hi.w);
                  ss += (a0 * a0 + a1 * a1) + (a2 * a2 + a3 * a3) + (a4 * a4 + a5 * a5) + (a6 * a6 + a7 * a7); }
                const bf16x8 ah = __builtin_bit_cast(bf16x8, hi);
                const int ch = kh * 64 + 4 * ks + fq;
                const int o0 = fr * 2048 + (((ch & ~15) | ((ch ^ fr) & 15)) * 16), o1 = o0 + 16 * 2048;
                const bf16x8 bh0 = *(const LAS bf16x8*)(rwl + o0), bl0 = *(const LAS bf16x8*)(rwl + 65536 + o0), bh1 = *(const LAS bf16x8*)(rwl + o1), bl1 = *(const LAS bf16x8*)(rwl + 65536 + o1);
                acc0 = __builtin_amdgcn_mfma_f32_16x16x32_bf16(ah, bh0, acc0, 0, 0, 0); acc1 = __builtin_amdgcn_mfma_f32_16x16x32_bf16(ah, bh1, acc1, 0, 0, 0);
                acc0 = __builtin_amdgcn_mfma_f32_16x16x32_bf16(ah, bl0, acc0, 0, 0, 0); acc1 = __builtin_amdgcn_mfma_f32_16x16x32_bf16(ah, bl1, acc1, 0, 0, 0);
            }
            ss += __shfl_xor(ss, 16); ss += __shfl_xor(ss, 32);
            if (kh == 1) { LAS float* pp = part + w4 * 576 + lane;
#pragma unroll
                for (int q = 0; q < 4; ++q) { pp[64 * q] = acc0[q]; pp[64 * (4 + q)] = acc1[q]; }
                pp[64 * 8] = ss; }
            __syncthreads();
            if (kh == 0) { const LAS float* pp = part + w4 * 576 + lane;
#pragma unroll
                for (int q = 0; q < 4; ++q) { acc0[q] += pp[64 * q]; acc1[q] += pp[64 * (4 + q)]; }
                ss += pp[64 * 8]; }
            }
            if (kh == 0) {
                const float rrow = 1.0f / sqrtf(ss * (1.f / D) + RMS_EPS);
                float c0[4], c1[4], rt[4], tv[4][4]; int te[4][4];
#pragma unroll
                for (int q = 0; q < 4; ++q) { rt[q] = __shfl(rrow, 4 * fq + q); c0[q] = acc0[q] * rt[q] + rb0; c1[q] = acc1[q] * rt[q] + rb1; }
#pragma unroll
                for (int k = 0; k < 4; ++k) { float v[4]; int e[4];
#pragma unroll
                    for (int q = 0; q < 4; ++q) { v[q] = c0[q]; e[q] = fr; if (c1[q] > c0[q]) { v[q] = c1[q]; e[q] = 16 + fr; } }
#define RT_STEP(CTRL) _Pragma("unroll") for (int q = 0; q < 4; ++q) { const float v2 = __builtin_bit_cast(float, __builtin_amdgcn_update_dpp(0, __builtin_bit_cast(int, v[q]), CTRL, 0xf, 0xf, false)); \
                        const int e2 = __builtin_amdgcn_update_dpp(0, e[q], CTRL, 0xf, 0xf, false); if (v2 > v[q] || (v2 == v[q] && e2 < e[q])) { v[q] = v2; e[q] = e2; } }
                    RT_STEP(0x128) RT_STEP(0x124) RT_STEP(0x122) RT_STEP(0x121)
#undef RT_STEP
#pragma unroll
                    for (int q = 0; q < 4; ++q) { tv[q][k] = v[q]; te[q][k] = e[q]; if (e[q] == fr) c0[q] = -INFINITY; if (e[q] == 16 + fr) c1[q] = -INFINITY; } }
#pragma unroll
                for (int q = 0; q < 4; ++q) {
                    const float e1 = __expf(tv[q][1] - tv[q][0]), e2 = __expf(tv[q][2] - tv[q][0]), e3 = __expf(tv[q][3] - tv[q][0]); const float inv = 1.0f / (1.0f + e1 + e2 + e3);
                    const int tl = w4 * 16 + 4 * fq + q, tok = task * 16 + 4 * fq + q;
                    if (fr == 0) { *(GAS f32x4*)(TOPW + (size_t)tok * 4) = (f32x4){inv, e1 * inv, e2 * inv, e3 * inv}; selR[tl] = rt[q]; }
                    if (fr < 4) { const int em = fr == 0 ? te[q][0] : fr == 1 ? te[q][1] : fr == 2 ? te[q][2] : te[q][3];
                        selE[tl * 4 + fr] = em; selP[tl * 4 + fr] = __hip_atomic_fetch_add(&hist[em], 1, __ATOMIC_RELAXED, __HIP_MEMORY_SCOPE_WORKGROUP); }
                } }
            __syncthreads();
            if (tid < 32) baseE[tid] = (int)__hip_atomic_fetch_add(F.ctl + CW_CNT + 64 * tid, (unsigned)hist[tid], RLX_AGENT);
            __syncthreads();
            if (tid < 256) { const int e = selE[tid]; LIST[(size_t)e * LCAP + baseE[e] + selP[tid]] = (u32x2){(unsigned)((tb * 16 + (tid >> 2)) * 4 + (tid & 3)), __float_as_uint(selR[tid >> 2])}; }
            __syncthreads();
        }
        if (BOTH(4)) GRID_BAR();
    }

    LAS int* tstart = (LAS int*)(F.lds + XTRA_OFF + 14336);
    LAS int* ecnt = tstart + 64;
    LAS i32x4* ulist = (LAS i32x4*)(tstart + 128);
    if (IN(5) || IN(6)) {
        const int tid = F.wave * 64 + lane_id();
        __syncthreads();
        if (tid < 32) ecnt[tid] = (int)__hip_atomic_load(F.ctl + CW_CNT + 64 * tid, RLX_AGENT);
        __syncthreads();
        if (tid == 0) { int s = 0; for (int e = 0; e < NE; ++e) { tstart[e] = s; s += (ecnt[e] + 255) >> 8; } tstart[NE] = s; }
        __syncthreads();
        if (tid < 64) {
            const int which = tid >> 5, i = tid & 31, npn = which ? 4 : 8, nper = F.G / 8, xg = (int)(blockIdx.x % 8), j = (int)(blockIdx.x / 8);
            const int R = (nper / npn) * (i * 8 + xg) + j / npn, Rtot = tstart[NE];
            int e = 0; for (int q = 1; q < NE; ++q) e += (tstart[q] <= R) ? 1 : 0;
            i32x4 u = (i32x4){0, 0, 0, 0};
            if (R < Rtot) { const int pm = R - tstart[e], rem = ecnt[e] - pm * 256; u = (i32x4){e, pm, j % npn, rem < 256 ? rem : 256}; }
            ulist[which * 32 + i] = u; }
        __syncthreads();
    }

    if (IN(5)) {
        pg8::MoeOrder S{ulist, LIST, (const char*)Wgu8, 8, 2048, 2, args.in[13], args.in[15], 128};
        pg8::EpiGU E{HID8};
        pg8::gemm_phase<pg8::EpiGU, pg8::MoeOrder, true, 1>(F.lds, (const char*)T8, D, S, E);
        if (BOTH(5)) GRID_BAR();
    }

    if (IN(6)) {
        pg8::MoeOrder S{ulist + 32, LIST, (const char*)Wd8, 4, 1024, 0, args.in[17], args.in[17], 256};
        pg8::EpiDown E{OB};
        pg8::gemm_phase<pg8::EpiDown, pg8::MoeOrder, true, 1>(F.lds, (const char*)HID8, D, S, E);
        if (BOTH(6)) GRID_BAR();
    }

    if (IN(7)) {
        const int lane = lane_id();
        const GAS f32x4* gp = (const GAS f32x4*)args.in[18] + lane; f32x4 g[4];
#pragma unroll
        for (int j = 0; j < 4; ++j) g[j] = gp[64 * j];
        unsigned bad = __hip_atomic_load(F.ctl + CW_BAR + XB_TMO, RLX_AGENT);
        for (int m = gw; m < T; m += NGW) {
            const GAS u32x2* xr = (const GAS u32x2*)(X1 + (size_t)m * D) + lane; f32x4 v[4];
#pragma unroll
            for (int j = 0; j < 4; ++j) { const u32x2 w = __builtin_nontemporal_load(xr + 64 * j); v[j] = (f32x4){bf_lo(w.x), bf_hi(w.x), bf_lo(w.y), bf_hi(w.y)}; }
            const f32x4 tw = *(const GAS f32x4*)(TOPW + (size_t)m * 4);
#pragma unroll
            for (int k = 0; k < 4; ++k) { const GAS unsigned* orow = (const GAS unsigned*)(OB + ((size_t)m * 4 + k) * D) + lane; const float wk = tw[k] * (1.0f / SC_O);
#pragma unroll
                for (int j = 0; j < 4; ++j) { const unsigned w = __builtin_nontemporal_load(orow + 64 * j); const f32x2 lo = __builtin_amdgcn_cvt_pk_f32_fp8((int)w, false), hi = __builtin_amdgcn_cvt_pk_f32_fp8((int)w, true);
                    v[j].x += wk * lo.x; v[j].y += wk * lo.y; v[j].z += wk * hi.x; v[j].w += wk * hi.y; } }
            float s = 0.f;
#pragma unroll
            for (int j = 0; j < 4; ++j) s += (v[j].x * v[j].x + v[j].y * v[j].y) + (v[j].z * v[j].z + v[j].w * v[j].w);
            float r = 1.0f / sqrtf(wave_sum(s) * (1.f / D) + RMS_EPS);
            if (bad) r = __builtin_nanf("");
            GAS f32x4* o = (GAS f32x4*)(args.out + (size_t)m * D) + lane;
#pragma unroll
            for (int j = 0; j < 4; ++j) __builtin_nontemporal_store(v[j] * r * g[j], o + 64 * j);
        }
    }
#undef IN
#undef BOTH
#undef GRID_BAR
}

#ifndef MK_N_LAUNCHES
#define MK_N_LAUNCHES 1
#endif
extern "C" void kernel_launch(void* const* d_in, const int* in_sizes, int n_in, void* d_out, int out_size, void* d_ws, size_t ws_size, hipStream_t stream) {
    static int grid = 0;
    if (grid == 0) {
        if (n_in != 19 || in_sizes[0] != T * D || out_size != T * D || ws_size < WS_END) { fprintf(stderr, "kernel_launch: unexpected shapes (n_in %d, in0 %d, out %d, ws %zu); nothing launched\n", n_in, n_in > 0 ? in_sizes[0] : -1, out_size, ws_size); grid = -1; return; }
        int dev = 0, cus = 0, per_cu = 0;
        if (hipGetDevice(&dev) != hipSuccess || hipDeviceGetAttribute(&cus, hipDeviceAttributeMultiprocessorCount, dev) != hipSuccess) { fprintf(stderr, "kernel_launch: device query failed\n"); grid = -1; return; }
        if (hipFuncSetAttribute((const void*)hymba_fwd, hipFuncAttributeMaxDynamicSharedMemorySize, LDS_BYTES) != hipSuccess) { fprintf(stderr, "kernel_launch: hipFuncSetAttribute failed\n"); grid = -1; return; }
        if (hipOccupancyMaxActiveBlocksPerMultiprocessor(&per_cu, (const void*)hymba_fwd, NWAVES * 64, LDS_BYTES) != hipSuccess || per_cu < 1) fprintf(stderr, "kernel_launch: note: occupancy query reports %d workgroups per CU\n", per_cu);
        (void)hipGetLastError();
        grid = (cus / 64) * 64; if (grid > 256) grid = 256;
        if (grid < 64) { fprintf(stderr, "kernel_launch: %d CUs: unsupported\n", cus); grid = -1; return; }
    }
    if (grid < 0) return;
    if (hipMemsetAsync((char*)d_ws + WS_CTL, 0, CTL_ZERO_BYTES, stream) != hipSuccess) { fprintf(stderr, "kernel_launch: memset failed\n"); return; }
    Args a{};
    for (int i = 0; i < 19; ++i) a.in[i] = (const float*)d_in[i];
    a.out = (float*)d_out; a.ws = (unsigned char*)d_ws;
    constexpr int NPH = 8;
    if (MK_N_LAUNCHES == 1) { a.ph_lo = 0; a.ph_hi = NPH; hipLaunchKernelGGL(hymba_fwd, dim3(grid), dim3(NWAVES * 64), LDS_BYTES, stream, a); }
    else for (int p = 0; p < NPH; ++p) { a.ph_lo = p; a.ph_hi = p + 1; hipLaunchKernelGGL(hymba_fwd, dim3(grid), dim3(NWAVES * 64), LDS_BYTES, stream, a); }
    const hipError_t le = hipPeekAtLastError();
    if (le != hipSuccess) fprintf(stderr, "kernel_launch: launch failed: %s\n", hipGetErrorName(le));
}
```

```cpp
#include <hip/hip_runtime.h>
#include <cstdio>
#include <cstdint>

#define GAS __attribute__((address_space(1)))
#define LAS __attribute__((address_space(3)))
typedef unsigned short bf16_t;
typedef short bf16x8 __attribute__((ext_vector_type(8)));
typedef short s16x4 __attribute__((ext_vector_type(4)));
typedef float f32x2 __attribute__((ext_vector_type(2)));
typedef float f32x4 __attribute__((ext_vector_type(4)));
typedef float f32x16 __attribute__((ext_vector_type(16)));
typedef unsigned u32x2 __attribute__((ext_vector_type(2)));
typedef unsigned u32x4 __attribute__((ext_vector_type(4)));
typedef int i32x4 __attribute__((ext_vector_type(4)));
typedef int i32x8 __attribute__((ext_vector_type(8)));
typedef GAS unsigned gu32;
#define RLX_AGENT __ATOMIC_RELAXED, __HIP_MEMORY_SCOPE_AGENT
#define LDS_WAIT() asm volatile("s_waitcnt lgkmcnt(0)" ::: "memory")
#define VM_WAIT() asm volatile("s_waitcnt vmcnt(0)" ::: "memory")

constexpr int T = 16384, SEQ = 8192, D = 1024, NIN = 2560, DA = 512, NH = 8, HD = 64, DC = 512, CW = 31;
constexpr int NE = 32, TOPK = 4, NP = T * TOPK, LCAP = 16384, NREL = 192;
constexpr float RMS_EPS = 1e-5f, LN_EPS = 1e-5f, LOG2E = 1.4426950408889634f;
constexpr float QSCALE = 0.125f * LOG2E;
constexpr float SC_T = 16.0f, SC_W = 256.0f, SC_H = 4.0f, SC_O = 32.0f, SC_M = 16.0f;

constexpr size_t MiB = 1u << 20;
constexpr size_t WS_CTL = 0, CTL_ZERO_BYTES = 64 * 1024;
constexpr size_t WS_WIN = 1 * MiB, WS_WOUT = 6 * MiB, WS_WGU = 8 * MiB, WS_WD = 136 * MiB, WS_X1 = 200 * MiB, WS_XN = 264 * MiB;
constexpr size_t WS_Q = 296 * MiB, WS_K = 312 * MiB, WS_V = 328 * MiB, WS_A = 344 * MiB, WS_G = 360 * MiB, WS_MIX = 376 * MiB;
constexpr size_t WS_T8 = 232 * MiB;
constexpr size_t WS_HID = 296 * MiB;
constexpr size_t WS_O = 440 * MiB;
constexpr size_t WS_LIST = 424 * MiB, WS_TOPW = 428 * MiB, WS_RWT = 429 * MiB, WS_XCH = 430 * MiB, WS_END = 505 * MiB;
constexpr int CW_TMO = 0, CW_BAR = 4096, CW_CNT = 8192, GB_CNT = 12288, GB_GEN = 13312, GB_MAP = 14336, GB_MIXED = 14592, RT_DONE = 15360;

constexpr int RING_BYTES = 131072, XTRA_OFF = RING_BYTES, LDS_BYTES = 147456, LDSCTL_OFF = LDS_BYTES - 512;
constexpr int NWAVES = 8;

__device__ __forceinline__ unsigned f2bf(float f) { unsigned u = __builtin_bit_cast(unsigned, f); return (u + 0x7fffu + ((u >> 16) & 1u)) >> 16; }
__device__ __forceinline__ unsigned pk2(float lo, float hi) { return f2bf(lo) | (f2bf(hi) << 16); }
typedef __bf16 nbf16x2 __attribute__((ext_vector_type(2)));
__device__ __forceinline__ unsigned cvt_pk_bf16(float lo, float hi) { return __builtin_bit_cast(unsigned, __builtin_convertvector((f32x2){lo, hi}, nbf16x2)); }
__device__ __forceinline__ unsigned cvt_pk_bf16_tr(float lo, float hi) { return cvt_pk_bf16(lo, hi); }
__device__ __forceinline__ float clamp448(float v) { return __builtin_amdgcn_fmed3f(v, -448.0f, 448.0f); }
__device__ __forceinline__ unsigned pk4_fp8(float a, float b, float c, float d) {
    int r = __builtin_amdgcn_cvt_pk_fp8_f32(clamp448(a), clamp448(b), 0, false);
    r = __builtin_amdgcn_cvt_pk_fp8_f32(clamp448(c), clamp448(d), r, true);
    return (unsigned)r;
}
__device__ __forceinline__ unsigned pk4_fp8_nc(float a, float b, float c, float d) {
    int r = __builtin_amdgcn_cvt_pk_fp8_f32(a, b, 0, false);
    r = __builtin_amdgcn_cvt_pk_fp8_f32(c, d, r, true);
    return (unsigned)r;
}
__device__ __forceinline__ float bf_lo(unsigned w) { return __uint_as_float(w << 16); }
__device__ __forceinline__ float bf_hi(unsigned w) { return __uint_as_float(w & 0xffff0000u); }
__device__ __forceinline__ float fsigmoid(float z) { return __builtin_amdgcn_rcpf(1.0f + __builtin_amdgcn_exp2f(-z * LOG2E)); }
__device__ __forceinline__ int lane_id() { int l; asm volatile("v_mbcnt_lo_u32_b32 %0, -1, 0\n\tv_mbcnt_hi_u32_b32 %0, -1, %0" : "=v"(l)); return l; }
__device__ __forceinline__ float wave_sum(float v) {
#define WS_DPP(x, ctrl) __builtin_bit_cast(float, __builtin_amdgcn_update_dpp(0, __builtin_bit_cast(int, (x)), (ctrl), 0xf, 0xf, false))
    v += WS_DPP(v, 0xB1);
    v += WS_DPP(v, 0x4E);
    v += WS_DPP(v, 0x124);
    v += WS_DPP(v, 0x128);
#undef WS_DPP
    const float r0 = __builtin_bit_cast(float, __builtin_amdgcn_readlane(__builtin_bit_cast(int, v), 0)), r1 = __builtin_bit_cast(float, __builtin_amdgcn_readlane(__builtin_bit_cast(int, v), 16));
    const float r2 = __builtin_bit_cast(float, __builtin_amdgcn_readlane(__builtin_bit_cast(int, v), 32)), r3 = __builtin_bit_cast(float, __builtin_amdgcn_readlane(__builtin_bit_cast(int, v), 48));
    return (r0 + r1) + (r2 + r3);
}

__device__ __forceinline__ float row_sum16(float v) {
#define WS_DPP(x, ctrl) __builtin_bit_cast(float, __builtin_amdgcn_update_dpp(0, __builtin_bit_cast(int, (x)), (ctrl), 0xf, 0xf, false))
    v += WS_DPP(v, 0xB1); v += WS_DPP(v, 0x4E); v += WS_DPP(v, 0x124); v += WS_DPP(v, 0x128);
#undef WS_DPP
    return v;
}

namespace pg8 {
constexpr int BM = 256, BK = 64, HALF = 128, HTB = HALF * BK * 2, STAGE_BYTES = 8 * HTB;
__device__ __forceinline__ int lds_byte(int r, int c) { const int st = (r >> 4) * 2 + (c >> 5), rr = r & 15, cc = c & 31, ob = rr * 64 + cc * 2; return st * 1024 + (ob ^ (((ob >> 9) & 1) << 5)); }
__device__ __forceinline__ void stage_rc(int b, int& R, int& C) { const int st = b / 1024, sb = b % 1024, swz = sb ^ (((sb >> 9) & 1) << 5); R = (st >> 1) * 16 + swz / 64; C = (st & 1) * 32 + (swz % 64) / 2; }
__device__ __forceinline__ int perm32(int rho) { const int n = rho >> 4, i = rho & 15; return 8 * (i >> 2) + 4 * n + (i & 3); }

struct Unit { int pm, pn, e, nv, rt; };
template <int N> __device__ __forceinline__ void wait_vm() { asm volatile("s_waitcnt vmcnt(%0)" :: "n"(N) : "memory"); }
template <int NFRESH, int NSTEADY> __device__ __forceinline__ void wait_vm_sel(int fresh) {
    asm volatile("s_cmp_eq_u32 %0, 0\n\ts_cbranch_scc1 .Lwvs_a_%=\n\ts_waitcnt vmcnt(%1)\n\ts_branch .Lwvs_b_%=\n.Lwvs_a_%=:\n\ts_waitcnt vmcnt(%2)\n.Lwvs_b_%=:" :: "s"(__builtin_amdgcn_readfirstlane(fresh)), "n"(NFRESH), "n"(NSTEADY) : "scc", "memory"); }

template <class Epi, class Sched, bool ALIGN_EPI, int ESZ>
__device__ __forceinline__ void gemm_phase(LAS unsigned char* lds, const char* Abase, const int K, const Sched& S, const Epi& E) {
    const int wid = __builtin_amdgcn_readfirstlane(threadIdx.x >> 6), lane = lane_id(), tid = wid * 64 + lane, wr = wid >> 2, wc = wid & 3, fr = lane & 15, fq = lane >> 4;
    const int RB = K * ESZ, nt = RB / 128;
    unsigned voffB[2];
#pragma unroll
    for (int i = 0; i < 2; ++i) { int R, C; stage_rc(tid * 16 + i * 8192, R, C); const int Rb = Epi::PERM ? ((R & ~31) + perm32(R & 31)) : R; voffB[i] = (unsigned)(Rb * RB + 2 * C); }
    const size_t kstep = (size_t)(BK * 2);
    const size_t hstep = (size_t)HALF * RB;
    const unsigned ldsw = (unsigned)wid * 1024u;
    const int aoff = lds_byte(wr * 64 + fr, fq * 8), boff = lds_byte(wc * 32 + fr, fq * 8);
#define PG8_SA(b, h) (((b) * 2 + (h)) * HTB)
#define PG8_SB(b, h) ((4 + (b) * 2 + (h)) * HTB)
#define PG8_STAGE(bufoff, gbase, voff) do { _Pragma("unroll") for (int _i = 0; _i < 2; ++_i) \
        __builtin_amdgcn_global_load_lds((const unsigned*)((const char*)(gbase) + (voff)[_i]), (LAS unsigned*)(lds + (bufoff) + ldsw + _i * 8192), 16, 0, 0); } while (0)
#define PG8_LD16(off) (*(const LAS i32x4*)(lds + (off)))
#define PG8_LDA(dst, b, h) do { _Pragma("unroll") for (int m = 0; m < 4; ++m) { const i32x4 _x = PG8_LD16(PG8_SA(b, h) + aoff + m * 2048), _y = PG8_LD16(PG8_SA(b, h) + aoff + m * 2048 + 1024); dst[m] = __builtin_shufflevector(_x, _y, 0, 1, 2, 3, 4, 5, 6, 7); } } while (0)
#define PG8_LDB(dst, b, h) do { _Pragma("unroll") for (int n = 0; n < 2; ++n) { const i32x4 _x = PG8_LD16(PG8_SB(b, h) + boff + n * 2048), _y = PG8_LD16(PG8_SB(b, h) + boff + n * 2048 + 1024); dst[n] = __builtin_shufflevector(_x, _y, 0, 1, 2, 3, 4, 5, 6, 7); } } while (0)
#define PG8_MMA(ai, bj, At, Bt) do { __builtin_amdgcn_s_setprio(1); _Pragma("unroll") for (int m = 0; m < 4; ++m) _Pragma("unroll") for (int n = 0; n < 2; ++n) _Pragma("unroll") for (int k = 0; k < 2; ++k) \
        acc[ai][bj][m][n] = __builtin_amdgcn_mfma_f32_16x16x32_bf16(PG8_HALF(Bt[n], k), PG8_HALF(At[m], k), acc[ai][bj][m][n], 0, 0, 0); __builtin_amdgcn_s_setprio(0); } while (0)
#define PG8_HALF(v, k) __builtin_bit_cast(bf16x8, (k) == 0 ? __builtin_shufflevector((v), (v), 0, 1, 2, 3) : __builtin_shufflevector((v), (v), 4, 5, 6, 7))
#define PG8_MMA8(ai, bj, At, Bt) do { __builtin_amdgcn_s_setprio(1); _Pragma("unroll") for (int m = 0; m < 4; ++m) _Pragma("unroll") for (int n = 0; n < 2; ++n) \
        acc[ai][bj][m][n] = __builtin_amdgcn_mfma_scale_f32_16x16x128_f8f6f4(Bt[n], At[m], acc[ai][bj][m][n], 0, 0, 0, 0, 0, 0);     __builtin_amdgcn_s_setprio(0); } while (0)
#define PG8_MM(ai, bj, At, Bt) do { if constexpr (ESZ == 2) PG8_MMA(ai, bj, At, Bt); else PG8_MMA8(ai, bj, At, Bt); } while (0)
#define PG8_WAIT_V(n) asm volatile("s_waitcnt vmcnt(" #n ")" ::: "memory")
#define PG8_WAIT_L(n) asm volatile("s_waitcnt lgkmcnt(" #n ")" ::: "memory")
#define PG8_BAR __builtin_amdgcn_s_barrier()
#define PG8_SCHED __builtin_amdgcn_sched_barrier(0)
    Unit cur, nxt; int ui = 0;
    if (!S.next(0, cur)) return;
    f32x4 acc[2][2][4][2];
#pragma unroll
    for (int a = 0; a < 2; ++a)
#pragma unroll
        for (int b = 0; b < 2; ++b)
#pragma unroll
            for (int m = 0; m < 4; ++m)
#pragma unroll
                for (int n = 0; n < 2; ++n) acc[a][b][m][n] = (f32x4){0.f, 0.f, 0.f, 0.f};
    i32x8 At[4], B0[2], B1[2];
    unsigned vA0[2], vA1[2];
    LAS u32x4* const vslot = (LAS u32x4*)(lds + STAGE_BYTES) + tid;
    LAS u32x2* const rowtab = (LAS u32x2*)(lds + STAGE_BYTES + 8192);
    LAS f32x4* const biastab = (LAS f32x4*)(lds + STAGE_BYTES + 8192 + 4096);
    unsigned rdy = 0; int prev_rt = 0;
    if constexpr (Sched::DEP_MODE == 2) { if (wid == 0) rdy = (unsigned)__builtin_amdgcn_readfirstlane((int)S.poll_ready(0)); }
    if constexpr (Sched::GATHER) {
        if (tid < 256) rowtab[tid] = *S.entry_ptr(cur, tid);
        else if (tid < 320) biastab[tid - 256] = *(const f32x4*)S.bias_ptr(cur, tid - 256);
        __syncthreads();
        S.a_off_tab(rowtab, cur.nv, tid, RB, vA0, vA1);
    } else S.a_off(cur, tid, RB, vA0, vA1);
    const char* cB = S.b_ptr(cur, RB);
    const char* cA = Abase;
    PG8_STAGE(PG8_SB(0, 0), cB, voffB); PG8_STAGE(PG8_SB(0, 1), cB + hstep, voffB); PG8_STAGE(PG8_SA(0, 0), cA, vA0); PG8_STAGE(PG8_SA(0, 1), cA, vA1);
    if (wr == 1) PG8_BAR;
    PG8_WAIT_V(2); PG8_BAR;
    PG8_STAGE(PG8_SB(1, 0), cB + kstep, voffB); PG8_STAGE(PG8_SA(1, 0), cA + kstep, vA0); PG8_STAGE(PG8_SB(1, 1), cB + hstep + kstep, voffB);
    PG8_WAIT_V(6); PG8_BAR;
    for (;;) {
        const bool has_next = S.next(ui + 1, nxt);
        if constexpr (Sched::DEP_MODE == 2) {
            if (has_next && wid == 0 && !((rdy >> (ui + 1)) & 1u)) rdy = (unsigned)__builtin_amdgcn_readfirstlane((int)S.poll_ready(ui + 1)); }
        const char* nB = cB;
        const int par = ui & 1;
        if constexpr (Sched::GATHER) {
            if (has_next) nB = S.b_ptr(nxt, RB);
            else *vslot = (u32x4){vA0[0], vA0[1], vA1[0], vA1[1]};
        } else {
            unsigned n0[2] = {vA0[0], vA0[1]}, n1[2] = {vA1[0], vA1[1]};
            if (has_next) { S.a_off(nxt, tid, RB, n0, n1); nB = S.b_ptr(nxt, RB); }
            *vslot = (u32x4){n0[0], n0[1], n1[0], n1[1]};
        }
#pragma clang loop unroll(disable)
        for (int t = 0; t < nt; t += 2) {
            const bool last = (t == nt - 2);
            const int fresh = ((ui > 0) && (t == 0)) ? 1 : 0;
            if constexpr (Sched::GATHER) {
                if (has_next && t == 2) { const int l2 = lane_id();
                    if (wid < 2) __builtin_amdgcn_global_load_lds((const unsigned*)((const char*)S.entry_ptr(nxt, 0) + (wid * 64 + l2) * 16), (LAS unsigned*)((LAS char*)(rowtab + (par ^ 1) * 256) + wid * 1024), 16, 0, 0);
                    if (wid == 4) __builtin_amdgcn_global_load_lds((const unsigned*)S.bias_ptr(nxt, l2), (LAS unsigned*)(biastab + (par ^ 1) * 64), 16, 0, 0); }
                if (has_next && t == 4) { unsigned n0[2], n1[2]; const int t2 = wid * 64 + lane_id(); S.a_off_tab_nowait(rowtab + (par ^ 1) * 256, nxt.nv, t2, RB, n0, n1); ((LAS u32x4*)(lds + STAGE_BYTES))[t2] = (u32x4){n0[0], n0[1], n1[0], n1[1]}; }
            }
            const char* a1 = cA + (size_t)(t + 1) * kstep;
            const char* a2 = last ? cA : cA + (size_t)(t + 2) * kstep; const char* b2 = last ? nB : cB + (size_t)(t + 2) * kstep;
            const char* a3 = a2 + kstep; const char* b3 = b2 + kstep;
            PG8_LDB(B0, 0, 0); PG8_LDB(B1, 0, 1); PG8_SCHED; PG8_LDA(At, 0, 0); PG8_STAGE(PG8_SA(1, 1), a1, vA1);
            if (last) { const u32x4 nv = *vslot; vA0[0] = nv.x; vA0[1] = nv.y; vA1[0] = nv.z; vA1[1] = nv.w; }
            wait_vm_sel<8 + Epi::NSTORE, 8>(fresh); PG8_WAIT_L(0); PG8_BAR; PG8_MM(0, 0, At, B0); PG8_MM(0, 1, At, B1); PG8_BAR; PG8_SCHED;
            PG8_LDA(At, 0, 1); PG8_STAGE(PG8_SB(0, 0), b2, voffB); PG8_STAGE(PG8_SB(0, 1), b2 + hstep, voffB); PG8_STAGE(PG8_SA(0, 0), a2, vA0);
            wait_vm_sel<8 + Epi::NSTORE, 8>(fresh); PG8_WAIT_L(0); PG8_BAR; PG8_MM(1, 0, At, B0); PG8_MM(1, 1, At, B1); PG8_BAR; PG8_SCHED;
            PG8_LDB(B0, 1, 0); PG8_LDB(B1, 1, 1); PG8_SCHED; PG8_LDA(At, 1, 0); PG8_STAGE(PG8_SA(0, 1), a2, vA1);
            PG8_WAIT_V(8); PG8_WAIT_L(0); PG8_BAR; PG8_MM(0, 0, At, B0); PG8_MM(0, 1, At, B1); PG8_BAR; PG8_SCHED;
            PG8_LDA(At, 1, 1); PG8_STAGE(PG8_SB(1, 0), b3, voffB); PG8_STAGE(PG8_SB(1, 1), b3 + hstep, voffB); PG8_STAGE(PG8_SA(1, 0), a3, vA0);
            PG8_WAIT_V(8); PG8_WAIT_L(0); PG8_BAR; PG8_MM(1, 0, At, B0); PG8_MM(1, 1, At, B1); PG8_BAR; PG8_SCHED;
        }
        if constexpr (Sched::DEP_MODE == 1) { if (ui > 0 && wid == 0) S.signal(prev_rt); }
        if constexpr (ALIGN_EPI) { if (wr == 0) PG8_BAR; }
        if constexpr (Epi::AFTER_DRAIN) {   }
        else if constexpr (Sched::GATHER) { int zofs; asm volatile("s_mov_b32 %0, 0" : "=s"(zofs));
            E(acc, cur, wr, wc, fr, fq, rowtab + par * 256 + zofs, biastab + par * 64 + zofs); } else E(acc, cur, wr, wc, fr, fq);
        if (!has_next) break;
#pragma unroll
        for (int a = 0; a < 2; ++a)
#pragma unroll
            for (int b = 0; b < 2; ++b)
#pragma unroll
                for (int m = 0; m < 4; ++m)
#pragma unroll
                    for (int n = 0; n < 2; ++n) acc[a][b][m][n] = (f32x4){0.f, 0.f, 0.f, 0.f};
        prev_rt = 8 * cur.rt + cur.pn; cur = nxt; cB = nB; ++ui;
        if constexpr (ALIGN_EPI) { if (wr == 1) PG8_BAR; }
    }
    PG8_WAIT_V(0);
    if constexpr (!ALIGN_EPI) { if (wr == 0) PG8_BAR; }
    PG8_BAR;
    if constexpr (Sched::DEP_MODE == 1) { if (wid == 0) S.signal(8 * cur.rt + cur.pn); }
    if constexpr (Epi::AFTER_DRAIN) E.fused(acc, cur, wr, wc, fr, fq, lds, wid, lane);
#undef PG8_SA
#undef PG8_SB
#undef PG8_STAGE
#undef PG8_LDA
#undef PG8_LDB
#undef PG8_MMA
#undef PG8_MMA8
#undef PG8_MM
#undef PG8_HALF
#undef PG8_LD16
#undef PG8_WAIT_V
#undef PG8_WAIT_L
#undef PG8_BAR
#undef PG8_SCHED
}

struct DenseOrder {
    static constexpr bool GATHER = false; static constexpr int DEP_MODE = 0;
    int nM, nN, nwg, G, c; const char* Bt;
    __device__ __forceinline__ void init(int M, int N, int G_, int c_, const void* Bt_) { nM = M / BM; nN = N / BM; nwg = nM * nN; G = G_; c = c_; Bt = (const char*)Bt_; }
    __device__ __forceinline__ bool next(int i, Unit& u) const {
        const long L = (long)i * G + c; if (L >= nwg) return false;
        int wgid = (int)L; { const int q = nwg / 8, r = nwg % 8, xcd = wgid % 8, off = wgid / 8; wgid = (xcd < r ? xcd * (q + 1) : r * (q + 1) + (xcd - r) * q) + off; }
        const int nig = 8 * nN, gid = wgid / nig, fm = gid * 8, gsz = (nM - fm) < 8 ? (nM - fm) : 8;
        u.pm = fm + ((wgid % nig) % gsz); u.pn = (wgid % nig) / gsz; u.e = 0; u.nv = 256; u.rt = 0; return true;
    }
    __device__ __forceinline__ const char* b_ptr(const Unit& u, int RB) const { return Bt + (size_t)u.pn * (256 * (size_t)RB); }
    __device__ __forceinline__ void a_off(const Unit& u, int tid, int RB, unsigned (&v0)[2], unsigned (&v1)[2]) const {
#pragma unroll
        for (int i = 0; i < 2; ++i) { int R, C; stage_rc(tid * 16 + i * 8192, R, C); v0[i] = (unsigned)((u.pm * 256 + R) * RB + 2 * C); v1[i] = (unsigned)((u.pm * 256 + 128 + R) * RB + 2 * C); }
    }
};
template <int DEP> struct MoeOrder {
    static constexpr bool GATHER = true; static constexpr int DEP_MODE = DEP;
    const LAS i32x4* ul;
    const u32x2* list;
    const char* Bt; int npn, nrowsB, shiftA;
    const float* bias0; const float* bias1; int bcols; unsigned* rtd; unsigned* tmo;
    __device__ __forceinline__ bool next(int i, Unit& u) const {
        if (i >= 32) return false;
        const i32x4 v = ul[i];
        u.e = __builtin_amdgcn_readfirstlane(v.x); u.pm = __builtin_amdgcn_readfirstlane(v.y); { const int z = __builtin_amdgcn_readfirstlane(v.z); u.pn = z & 255; u.rt = z >> 8; } u.nv = __builtin_amdgcn_readfirstlane(v.w);
        return u.nv > 0;
    }
    __device__ __forceinline__ const char* b_ptr(const Unit& u, int RB) const { return Bt + ((size_t)u.e * nrowsB + (size_t)u.pn * 256) * (size_t)RB; }
    __device__ __forceinline__ void signal(int fi) const { if (lane_id() == 0) __hip_atomic_store((unsigned char*)rtd + fi, (unsigned char)1, __ATOMIC_RELAXED, __HIP_MEMORY_SCOPE_AGENT); }
    __device__ __forceinline__ unsigned poll_ready(int k) const {
        const int l = lane_id(); const i32x4 v = ul[l & 31]; const unsigned long long* c = (const unsigned long long*)rtd + ((unsigned)v.z >> 8); unsigned m, sp = 0;
        for (;;) {
            const bool ok = (v.w <= 0) || (__hip_atomic_load(c, __ATOMIC_RELAXED, __HIP_MEMORY_SCOPE_AGENT) == 0x0101010101010101ull);
            m = (unsigned)__builtin_amdgcn_ballot_w64(ok);
            if ((m >> k) & 1u) break;
            __builtin_amdgcn_s_sleep(1);
            if ((++sp & 255u) == 0u) { if (__hip_atomic_load(tmo, __ATOMIC_RELAXED, __HIP_MEMORY_SCOPE_AGENT)) break; if (sp > (1u << 18)) { if (l == 0) atomicAdd(tmo, 1u); break; } }
        }
        asm volatile("" ::: "memory");
        return m;
    }
    __device__ __forceinline__ const u32x2* entry_ptr(const Unit& u, int t) const { return list + (size_t)u.e * LCAP + u.pm * 256 + t; }
    __device__ __forceinline__ const float* bias_ptr(const Unit& u, int i) const {
        return (bcols == 128) ? ((i < 32 ? bias0 : bias1) + (size_t)u.e * D + u.pn * 128 + 4 * (i & 31)) : (bias0 + (size_t)u.e * D + u.pn * 256 + 4 * i); }
    __device__ __forceinline__ void a_off_tab(const LAS u32x2* rt, int nv, int tid, int RB, unsigned (&v0)[2], unsigned (&v1)[2]) const {
#pragma unroll
        for (int i = 0; i < 2; ++i) { int R, C; stage_rc(tid * 16 + i * 8192, R, C);
            const int p0 = (int)rt[R < nv ? R : 0].x >> shiftA, p1 = (int)rt[(128 + R) < nv ? (128 + R) : 0].x >> shiftA;
            v0[i] = (unsigned)(p0 * RB + 2 * C); v1[i] = (unsigned)(p1 * RB + 2 * C); }
    }
    __device__ __forceinline__ void a_off_tab_nowait(const LAS u32x2* rt, int nv, int tid, int RB, unsigned (&v0)[2], unsigned (&v1)[2]) const {
        unsigned pr[4]; int Cc[2];
#pragma unroll
        for (int i = 0; i < 2; ++i) { int R, C; stage_rc(tid * 16 + i * 8192, R, C); Cc[i] = C;
            const unsigned a0 = (unsigned)(uintptr_t)(rt + (R < nv ? R : 0)), a1 = (unsigned)(uintptr_t)(rt + ((128 + R) < nv ? (128 + R) : 0));
            asm volatile("ds_read_b32 %0, %1" : "=v"(pr[2 * i]) : "v"(a0) : "memory"); asm volatile("ds_read_b32 %0, %1" : "=v"(pr[2 * i + 1]) : "v"(a1) : "memory"); }
        asm volatile("s_waitcnt lgkmcnt(0)" : "+v"(pr[0]), "+v"(pr[1]), "+v"(pr[2]), "+v"(pr[3]) :: "memory");
#pragma unroll
        for (int i = 0; i < 2; ++i) { v0[i] = (unsigned)(((int)pr[2 * i] >> shiftA) * RB + 2 * Cc[i]); v1[i] = (unsigned)(((int)pr[2 * i + 1] >> shiftA) * RB + 2 * Cc[i]); }
    }
};

__device__ __forceinline__ void epi_tables_nowait(const LAS u32x2* rt, const LAS f32x4* bt, const int (&ri)[8], const int (&bi)[4], u32x2 (&en)[8], f32x4 (&bv)[4]) {
#pragma unroll
    for (int i = 0; i < 8; ++i) asm volatile("ds_read_b64 %0, %1" : "=v"(en[i]) : "v"((unsigned)(uintptr_t)(rt + ri[i])) : "memory");
#pragma unroll
    for (int i = 0; i < 4; ++i) asm volatile("ds_read_b128 %0, %1" : "=v"(bv[i]) : "v"((unsigned)(uintptr_t)(bt + bi[i])) : "memory");
    asm volatile("s_waitcnt lgkmcnt(0)" : "+v"(en[0]), "+v"(en[1]), "+v"(en[2]), "+v"(en[3]), "+v"(en[4]), "+v"(en[5]), "+v"(en[6]), "+v"(en[7]), "+v"(bv[0]), "+v"(bv[1]), "+v"(bv[2]), "+v"(bv[3]) :: "memory");
}
struct EpiSplit {
    static constexpr bool PERM = true, AFTER_DRAIN = false; static constexpr int NSTORE = 16;
    bf16_t* O; size_t split_stride; float scale0;
    __device__ __forceinline__ void operator()(const f32x4 (&acc)[2][2][4][2], const Unit& u, int wr, int wc, int fr, int fq) const {
        const int row0 = u.pm * BM + wr * 64 + fr;
        if (u.pn < 6) {
        int colt = u.pn * BM; const int t = colt / 512; bf16_t* base = O + (size_t)t * split_stride; colt -= t * 512;
        const float sc = (t == 0) ? scale0 : 1.f;
        const int col0 = colt + wc * 32 + 8 * fq;
#pragma unroll
        for (int ai = 0; ai < 2; ++ai)
#pragma unroll
            for (int m = 0; m < 4; ++m) { bf16_t* rowp = base + (size_t)(row0 + ai * HALF + m * 16) * 512 + col0;
#pragma unroll
                for (int bj = 0; bj < 2; ++bj) { const f32x4 v0 = acc[ai][bj][m][0] * sc, v1 = acc[ai][bj][m][1] * sc;
                    u32x4 w; w.x = cvt_pk_bf16(v0[0], v0[1]); w.y = cvt_pk_bf16(v0[2], v0[3]); w.z = cvt_pk_bf16(v1[0], v1[1]); w.w = cvt_pk_bf16(v1[2], v1[3]);
                    *(u32x4*)(rowp + bj * HALF) = w; } }
        } else {
        bf16_t* base = O + (size_t)3 * split_stride; const int col0 = (u.pn - 6) * HALF + wc * 32 + 8 * fq;
#pragma unroll
        for (int ai = 0; ai < 2; ++ai)
#pragma unroll
            for (int m = 0; m < 4; ++m) { bf16_t* rowp = base + (size_t)(row0 + ai * HALF + m * 16) * 512 + col0;
#pragma unroll
                for (int n = 0; n < 2; ++n) { const f32x4 a = acc[ai][0][m][n], g = acc[ai][1][m][n];
                    *(u32x2*)(rowp + 4 * n) = (u32x2){cvt_pk_bf16(a[0] * fsigmoid(g[0]), a[1] * fsigmoid(g[1])), cvt_pk_bf16(a[2] * fsigmoid(g[2]), a[3] * fsigmoid(g[3]))}; } }
        }
    }
};
struct EpiRes {
    static constexpr bool PERM = true, AFTER_DRAIN = false; static constexpr int NSTORE = 0;
    const float* base; bf16_t* out; unsigned char* t8; const float* gain;
    __device__ __forceinline__ void operator()(const f32x4 (&acc)[2][2][4][2], const Unit& u, int wr, int wc, int fr, int fq) const {
        const int row0 = u.pm * BM + wr * 64 + fr, col0 = u.pn * BM + wc * 32 + 8 * fq;
        f32x4 gv[2][2];
#pragma unroll
        for (int bj = 0; bj < 2; ++bj)
#pragma unroll
            for (int n = 0; n < 2; ++n) gv[bj][n] = *(const f32x4*)(gain + col0 + bj * HALF + 4 * n) * SC_T;
#pragma unroll
        for (int ai = 0; ai < 2; ++ai)
#pragma unroll
            for (int m = 0; m < 4; ++m) { const size_t off = (size_t)(row0 + ai * HALF + m * 16) * D + col0;
#pragma unroll
                for (int bj = 0; bj < 2; ++bj) { const f32x4 v0 = __builtin_nontemporal_load((const f32x4*)(base + off + bj * HALF)) + acc[ai][bj][m][0] * (1.0f / (SC_M * SC_W)), v1 = __builtin_nontemporal_load((const f32x4*)(base + off + bj * HALF + 4)) + acc[ai][bj][m][1] * (1.0f / (SC_M * SC_W));
                    *(u32x4*)(out + off + bj * HALF) = (u32x4){cvt_pk_bf16(v0[0], v0[1]), cvt_pk_bf16(v0[2], v0[3]), cvt_pk_bf16(v1[0], v1[1]), cvt_pk_bf16(v1[2], v1[3])};
                    const f32x4 s0 = v0 * gv[bj][0], s1 = v1 * gv[bj][1];
                    *(u32x2*)(t8 + off + bj * HALF) = (u32x2){pk4_fp8(s0[0], s0[1], s0[2], s0[3]), pk4_fp8(s1[0], s1[1], s1[2], s1[3])}; } }
    }
};
struct EpiResRouter {
    static constexpr bool PERM = true, AFTER_DRAIN = true; static constexpr int NSTORE = 0;
    const float* base; bf16_t* out; unsigned char* t8; const float* gain; const bf16_t* rwb; float* xch;
    __device__ __forceinline__ void operator()(const f32x4 (&)[2][2][4][2], const Unit&, int, int, int, int) const {}
    __device__ __forceinline__ void fused(f32x4 (&acc)[2][2][4][2], const Unit& u, int wr, int wc, int fr, int fq, LAS unsigned char* lds, int wid, int lane) const {
        const int row0 = u.pm * BM + wr * 64 + fr, col0 = u.pn * BM + wc * 32 + 8 * fq;
        LAS float* lp = (LAS float*)lds;
        LAS float* sp = (LAS float*)(lds + STAGE_BYTES);
        f32x4 xr[3][4];
#define ERR_ISSUE(g, buf) do { _Pragma("unroll") for (int bj = 0; bj < 2; ++bj) _Pragma("unroll") for (int n = 0; n < 2; ++n) \
            xr[buf][bj * 2 + n] = __builtin_nontemporal_load((const f32x4*)(base + (size_t)(row0 + ((g) >> 2) * HALF + ((g) & 3) * 16) * D + col0 + bj * HALF + 4 * n)); } while (0)
#define ERR_ADD(g, buf) do { _Pragma("unroll") for (int bj = 0; bj < 2; ++bj) _Pragma("unroll") for (int n = 0; n < 2; ++n) \
            acc[(g) >> 2][bj][(g) & 3][n] = acc[(g) >> 2][bj][(g) & 3][n] * (1.0f / (SC_M * SC_W)) + xr[buf][bj * 2 + n]; } while (0)
#define ERR_PIN(g) asm volatile("" : "+v"(acc[(g) >> 2][0][(g) & 3][0]), "+v"(acc[(g) >> 2][0][(g) & 3][1]), "+v"(acc[(g) >> 2][1][(g) & 3][0]), "+v"(acc[(g) >> 2][1][(g) & 3][1]) :: "memory")
        ERR_ISSUE(0, 0); ERR_ISSUE(1, 1); ERR_ISSUE(2, 2);
        ERR_ADD(0, 0); ERR_PIN(0); ERR_ISSUE(3, 0);
        ERR_ADD(1, 1); ERR_PIN(1); ERR_ISSUE(4, 1);
        ERR_ADD(2, 2); ERR_PIN(2); ERR_ISSUE(5, 2);
        ERR_ADD(3, 0); ERR_PIN(3); ERR_ISSUE(6, 0);
        ERR_ADD(4, 1); ERR_PIN(4); ERR_ISSUE(7, 1);
        ERR_ADD(5, 2); ERR_PIN(5);
        ERR_ADD(6, 0); ERR_PIN(6);
        f32x4 gv[2][2]; bf16x8 bfr[2][2][2];
#pragma unroll
        for (int bj = 0; bj < 2; ++bj) {
#pragma unroll
            for (int n = 0; n < 2; ++n) gv[bj][n] = *(const f32x4*)(gain + col0 + bj * HALF + 4 * n) * SC_T;
#pragma unroll
            for (int nt = 0; nt < 2; ++nt)
#pragma unroll
                for (int hl = 0; hl < 2; ++hl) bfr[bj][nt][hl] = *(const bf16x8*)(rwb + (size_t)hl * NE * D + (size_t)(16 * nt + fr) * D + col0 + bj * HALF); }
        ERR_ADD(7, 1); ERR_PIN(7);
#undef ERR_PIN
#undef ERR_ISSUE
#undef ERR_ADD
        float ssv[8];
#pragma unroll
        for (int ai = 0; ai < 2; ++ai)
#pragma unroll
            for (int m = 0; m < 4; ++m) { const size_t off = (size_t)(row0 + ai * HALF + m * 16) * D + col0; const int lrow = ai * HALF + wr * 64 + m * 16;
                f32x4 l0 = (f32x4){0.f, 0.f, 0.f, 0.f}, l1 = l0; float ss = 0.f; u32x2 t8w[2];
#pragma unroll
                for (int bj = 0; bj < 2; ++bj) { const f32x4 v0 = acc[ai][bj][m][0], v1 = acc[ai][bj][m][1];
                    const u32x4 hi = (u32x4){cvt_pk_bf16(v0[0], v0[1]), cvt_pk_bf16(v0[2], v0[3]), cvt_pk_bf16(v1[0], v1[1]), cvt_pk_bf16(v1[2], v1[3])};
                    __builtin_nontemporal_store(hi, (u32x4*)(out + off + bj * HALF));
                    const f32x4 s0 = v0 * gv[bj][0], s1 = v1 * gv[bj][1];
                    t8w[bj] = (u32x2){pk4_fp8(s0[0], s0[1], s0[2], s0[3]), pk4_fp8(s1[0], s1[1], s1[2], s1[3])};
                    ss += (v0[0] * v0[0] + v0[1] * v0[1]) + (v0[2] * v0[2] + v0[3] * v0[3]) + (v1[0] * v1[0] + v1[1] * v1[1]) + (v1[2] * v1[2] + v1[3] * v1[3]);
                    const bf16x8 ah = __builtin_bit_cast(bf16x8, hi);
                    l0 = __builtin_amdgcn_mfma_f32_16x16x32_bf16(ah, bfr[bj][0][0], l0, 0, 0, 0); l1 = __builtin_amdgcn_mfma_f32_16x16x32_bf16(ah, bfr[bj][1][0], l1, 0, 0, 0);
                    l0 = __builtin_amdgcn_mfma_f32_16x16x32_bf16(ah, bfr[bj][0][1], l0, 0, 0, 0); l1 = __builtin_amdgcn_mfma_f32_16x16x32_bf16(ah, bfr[bj][1][1], l1, 0, 0, 0); }
                { const auto sx = __builtin_amdgcn_permlane16_swap(t8w[0].x, t8w[1].x, false, false), sy = __builtin_amdgcn_permlane16_swap(t8w[0].y, t8w[1].y, false, false);
                  *(u32x4*)(t8 + off - ((fq & 1) ? 8 : 0) + ((fq & 1) ? HALF : 0)) = (u32x4){sx[0], sy[0], sx[1], sy[1]}; }
#pragma unroll
                for (int reg = 0; reg < 4; ++reg) { lp[(wc * 256 + lrow + 4 * fq + reg) * 32 + fr] = l0[reg]; lp[(wc * 256 + lrow + 4 * fq + reg) * 32 + 16 + fr] = l1[reg]; }
                ssv[ai * 4 + m] = ss; }
#pragma unroll
        for (int i = 0; i < 8; ++i) { float ss = ssv[i];
            { const auto sw = __builtin_amdgcn_permlane16_swap(__float_as_uint(ss), __float_as_uint(ss), false, false); ss = __uint_as_float(sw[0]) + __uint_as_float(sw[1]); }
            { const auto sw = __builtin_amdgcn_permlane32_swap(__float_as_uint(ss), __float_as_uint(ss), false, false); ss = __uint_as_float(sw[0]) + __uint_as_float(sw[1]); }
            if (fq == 0) sp[wc * 256 + (i >> 2) * HALF + wr * 64 + (i & 3) * 16 + fr] = ss; }
        __syncthreads();
        { const int tid = wid * 64 + lane, row = tid >> 1, h = tid & 1;
          float* dst = xch + ((size_t)(u.pm * 4 + u.pn) * 256 + row) * 36 + 16 * h;
#pragma unroll
          for (int e4 = 0; e4 < 4; ++e4) { f32x4 a = *(const LAS f32x4*)(lp + (0 * 256 + row) * 32 + 16 * h + 4 * e4);
#pragma unroll
              for (int w = 1; w < 4; ++w) a = a + *(const LAS f32x4*)(lp + (w * 256 + row) * 32 + 16 * h + 4 * e4);
              *(f32x4*)(dst + 4 * e4) = a; }
          if (h == 0) dst[32] = ((sp[row] + sp[256 + row]) + sp[512 + row]) + sp[768 + row]; }
    }
};
struct EpiGU {
    static constexpr bool PERM = true, AFTER_DRAIN = false; static constexpr int NSTORE = 4;
    unsigned char* hid;
    __device__ __forceinline__ void operator()(const f32x4 (&acc)[2][2][4][2], const Unit& u, int wr, int wc, int fr, int fq, const LAS u32x2* rt, const LAS f32x4* bt) const {
        const int hc = u.pn * 128 + wc * 32 + 8 * fq;
        u32x2 ent[8]; f32x4 btv[4];
        { int ri[8]; const int bi[4] = {8 * wc + 2 * fq, 8 * wc + 2 * fq + 1, 32 + 8 * wc + 2 * fq, 32 + 8 * wc + 2 * fq + 1};
#pragma unroll
          for (int i = 0; i < 8; ++i) ri[i] = (i >> 2) * HALF + wr * 64 + (i & 3) * 16 + fr;
          epi_tables_nowait(rt, bt, ri, bi, ent, btv); }
        const f32x4 g0 = btv[0], g1 = btv[1], u0 = btv[2], u1 = btv[3];
        constexpr float inv = 1.0f / (SC_T * SC_W);
        u32x2 wq[2]; unsigned pq[2];
#pragma unroll
        for (int ai = 0; ai < 2; ++ai)
#pragma unroll
            for (int m = 0; m < 4; ++m) { const int r = ai * HALF + wr * 64 + m * 16 + fr;
                const u32x2 en = ent[ai * 4 + m]; const float rs = __uint_as_float(en.y) * inv;
                f32x2 h[4];
#pragma unroll
                for (int n = 0; n < 2; ++n)
#pragma unroll
                    for (int x = 0; x < 2; ++x) { const f32x4 ga = acc[ai][0][m][n], ua = acc[ai][1][m][n], gb = n ? g1 : g0, ub = n ? u1 : u0;
                        f32x2 g = (f32x2){ga[2 * x], ga[2 * x + 1]} * rs + (f32x2){gb[2 * x], gb[2 * x + 1]}, up = (f32x2){ua[2 * x], ua[2 * x + 1]} * rs + (f32x2){ub[2 * x], ub[2 * x + 1]};
                        g.x = __builtin_amdgcn_fmed3f(g.x, -25.0f, 7.0f); g.y = __builtin_amdgcn_fmed3f(g.y, -25.0f, 7.0f);     up.x = __builtin_amdgcn_fmed3f(up.x, -7.0f, 7.0f); up.y = __builtin_amdgcn_fmed3f(up.y, -7.0f, 7.0f);
                        const f32x2 z = g * (-1.702f * LOG2E); f32x2 t; t.x = __builtin_amdgcn_exp2f(z.x); t.y = __builtin_amdgcn_exp2f(z.y); t = t + 1.0f;
                        const float rp = __builtin_amdgcn_rcpf(t.x * t.y); f32x2 sg; sg.x = rp * t.y; sg.y = rp * t.x;
                        h[n * 2 + x] = (up * SC_H + SC_H) * (g * sg); }
                u32x2 w; w.x = pk4_fp8_nc(h[0].x, h[0].y, h[1].x, h[1].y); w.y = pk4_fp8_nc(h[2].x, h[2].y, h[3].x, h[3].y);
                wq[m & 1] = w; pq[m & 1] = (r < u.nv) ? en.x : (unsigned)NP;
                if (m & 1) {
                    const auto sx = __builtin_amdgcn_permlane16_swap(wq[0].x, wq[1].x, false, false), sy = __builtin_amdgcn_permlane16_swap(wq[0].y, wq[1].y, false, false);
                    *(u32x4*)(hid + (size_t)((fq & 1) ? pq[1] : pq[0]) * D + (hc & ~8)) = (u32x4){sx[0], sy[0], sx[1], sy[1]}; } }
    }
};
struct EpiDown {
    static constexpr bool PERM = true, AFTER_DRAIN = false; static constexpr int NSTORE = 8;
    unsigned char* o;
    __device__ __forceinline__ void operator()(const f32x4 (&acc)[2][2][4][2], const Unit& u, int wr, int wc, int fr, int fq, const LAS u32x2* rt, const LAS f32x4* bt) const {
        constexpr float inv = SC_O / (SC_H * SC_W);
        const int c0 = u.pn * BM + wc * 32 + 8 * fq;
        u32x2 ent[8]; f32x4 btv[4];
        { int ri[8]; const int bi[4] = {wc * 8 + 2 * fq, wc * 8 + 2 * fq + 1, 32 + wc * 8 + 2 * fq, 32 + wc * 8 + 2 * fq + 1};
#pragma unroll
          for (int i = 0; i < 8; ++i) ri[i] = (i >> 2) * HALF + wr * 64 + (i & 3) * 16 + fr;
          epi_tables_nowait(rt, bt, ri, bi, ent, btv); }
        f32x4 bv[2][2];
#pragma unroll
        for (int bj = 0; bj < 2; ++bj)
#pragma unroll
            for (int n = 0; n < 2; ++n) bv[bj][n] = btv[bj * 2 + n] * SC_O;
#pragma unroll
        for (int ai = 0; ai < 2; ++ai)
#pragma unroll
            for (int m = 0; m < 4; ++m) { const int r = ai * HALF + wr * 64 + m * 16 + fr;
                const unsigned p = (r < u.nv) ? ent[ai * 4 + m].x : (unsigned)NP;
                u32x2 w[2];
#pragma unroll
                for (int bj = 0; bj < 2; ++bj) { const f32x4 v0 = acc[ai][bj][m][0] * inv + bv[bj][0], v1 = acc[ai][bj][m][1] * inv + bv[bj][1];
                    w[bj] = (u32x2){pk4_fp8(v0[0], v0[1], v0[2], v0[3]), pk4_fp8(v1[0], v1[1], v1[2], v1[3])}; }
                const auto sx = __builtin_amdgcn_permlane16_swap(w[0].x, w[1].x, false, false), sy = __builtin_amdgcn_permlane16_swap(w[0].y, w[1].y, false, false);
                unsigned char* rowp = o + (size_t)p * D + (c0 & ~8) + ((fq & 1) ? HALF : 0);
                *(u32x4*)rowp = (u32x4){sx[0], sy[0], sx[1], sy[1]}; }
    }
};
}

#define XB_TMO      128
#define XB_XCNT(j)  (256  + 64 * (j))
#define XB_XSUB(j)  (1280 + 64 * (j))
#define XB_XGEN(j)  (2304 + 64 * (j))
#define XB_TOP      3328
#define XB_TOPGEN   3392
#define XCD_BAR_WORDS 3456
#define XB_SPIN_CAP (1u << 18)
__device__ __forceinline__ unsigned xb_ld(unsigned* p)              { return __hip_atomic_load(p, __ATOMIC_RELAXED, __HIP_MEMORY_SCOPE_AGENT); }
__device__ __forceinline__ unsigned xb_add(unsigned* p, unsigned v) { return __hip_atomic_fetch_add(p, v, __ATOMIC_RELAXED, __HIP_MEMORY_SCOPE_AGENT); }
__device__ __forceinline__ unsigned xb_xcc_id() { return (unsigned)__builtin_amdgcn_s_getreg((3 << 11) | 20) & 0xFu; }
#define XB_SPIN(cond, bar) do { unsigned _sp = 0; while (cond) { __builtin_amdgcn_s_sleep(1); \
    if ((++_sp & 255u) == 0u) { if (xb_ld(&(bar)[XB_TMO])) break; if (_sp > XB_SPIN_CAP) { atomicAdd(&(bar)[XB_TMO], 1u); break; } } } } while (0)
struct XcdBarrier { unsigned* bar; unsigned x; volatile LAS unsigned* st; };
__device__ __forceinline__ XcdBarrier xcd_barrier_post(unsigned* bar, volatile LAS unsigned* st) {
    XcdBarrier b; b.bar = bar; b.x = xb_xcc_id(); b.st = st;
    if (threadIdx.x == 0) (void)xb_add(&bar[XB_XCNT(b.x)], 1u);
    return b;
}
__device__ __forceinline__ void xcd_barrier_complete(unsigned* bar, unsigned x, unsigned& nloc, unsigned& nx) {
    const unsigned G = gridDim.x * gridDim.y * gridDim.z;
    unsigned sum, cnt, mine, sp = 0u;
    for (;;) {
        sum = 0u; cnt = 0u; mine = 0u;
#pragma unroll
        for (unsigned j = 0; j < 16; ++j) { const unsigned c = xb_ld(&bar[XB_XCNT(j)]); sum += c; cnt += (c > 0u) ? 1u : 0u; mine = (j == x) ? c : mine; }
        if (sum == G) break;
        __builtin_amdgcn_s_sleep(1);
        if ((++sp & 255u) == 0u) { if (xb_ld(&bar[XB_TMO])) break; if (sp > XB_SPIN_CAP) { atomicAdd(&bar[XB_TMO], 1u); break; } }
    }
    nloc = mine > 0u ? mine : 1u; nx = cnt > 0u ? cnt : 1u;
}
__device__ __forceinline__ void early_acquire() { if (threadIdx.x == 64) { __builtin_amdgcn_fence(__ATOMIC_ACQUIRE, "agent"); asm volatile("s_waitcnt vmcnt(0)" ::: "memory"); } }
__device__ __forceinline__ void xcd_barrier(const XcdBarrier& b) {
    asm volatile("s_waitcnt vmcnt(0)" ::: "memory");
    __syncthreads();
    early_acquire();
    if (threadIdx.x == 0) {
        unsigned* bar = b.bar;
        __builtin_amdgcn_s_waitcnt(0);
        unsigned nloc = b.st[0], nx = b.st[1];
        if (nloc == 0u) { xcd_barrier_complete(bar, b.x, nloc, nx); b.st[0] = nloc; b.st[1] = nx; }
        const unsigned old = xb_add(&bar[XB_XSUB(b.x)], 1u);
        const unsigned gen = old / nloc;
        if (old + 1u == (gen + 1u) * nloc) {
            __builtin_amdgcn_fence(__ATOMIC_RELEASE, "agent");
            asm volatile("s_waitcnt vmcnt(0)" ::: "memory");
            const unsigned og = xb_add(&bar[XB_TOP], 1u);
            const unsigned tg = og / nx;
            if (og + 1u == (tg + 1u) * nx) xb_add(&bar[XB_TOPGEN], 1u);
            else XB_SPIN(xb_ld(&bar[XB_TOPGEN]) == tg, bar);
            asm volatile("" ::: "memory");
            xb_add(&bar[XB_XGEN(b.x)], 1u);
            asm volatile("s_waitcnt vmcnt(0)" ::: "memory");
        } else {
            XB_SPIN(xb_ld(&bar[XB_XGEN(b.x)]) == gen, bar);
            asm volatile("s_waitcnt vmcnt(0)" ::: "memory");
        }
    }
    __syncthreads();
}

__device__ __forceinline__ unsigned xcd_barrier_arrive(const XcdBarrier& b) {
    asm volatile("s_waitcnt vmcnt(0)" ::: "memory");
    __syncthreads();
    if (threadIdx.x == 0) {
        unsigned* bar = b.bar;
        __builtin_amdgcn_s_waitcnt(0);
        unsigned nloc = b.st[0], nx = b.st[1];
        if (nloc == 0u) { xcd_barrier_complete(bar, b.x, nloc, nx); b.st[0] = nloc; b.st[1] = nx; }
        const unsigned old = xb_add(&bar[XB_XSUB(b.x)], 1u);
        const unsigned gen = old / nloc;
        if (old + 1u == (gen + 1u) * nloc) {
            __builtin_amdgcn_fence(__ATOMIC_RELEASE, "agent");
            asm volatile("s_waitcnt vmcnt(0)" ::: "memory");
            const unsigned og = xb_add(&bar[XB_TOP], 1u);
            const unsigned tg = og / nx;
            if (og + 1u == (tg + 1u) * nx) xb_add(&bar[XB_TOPGEN], 1u);
            else XB_SPIN(xb_ld(&bar[XB_TOPGEN]) == tg, bar);
            __builtin_amdgcn_fence(__ATOMIC_ACQUIRE, "agent");
            xb_add(&bar[XB_XGEN(b.x)], 1u);
            asm volatile("s_waitcnt vmcnt(0)" ::: "memory");
        }
        b.st[2] = gen;
    }
    __syncthreads();
    return b.st[2];
}
__device__ __forceinline__ void xcd_barrier_finish(const XcdBarrier& b, unsigned gen) {
    if (threadIdx.x == 0) {
        XB_SPIN(xb_ld(&b.bar[XB_XGEN(b.x)]) == gen, b.bar);
        asm volatile("" ::: "memory");
    }
    __syncthreads();
}

struct Frame {
    LAS unsigned char* lds;
    gu32* ctl;
    int wave, G, vcu;
};

__device__ __forceinline__ void group_barrier(unsigned* ctl, unsigned* tmo_bar, int inst, int xg, unsigned nloc, int left = -1, bool publish = false) {
    asm volatile("s_waitcnt vmcnt(0)" ::: "memory");
    __syncthreads();
    early_acquire();
    if (threadIdx.x == 0) {
        __builtin_amdgcn_s_waitcnt(0);
        unsigned* cnt = ctl + GB_CNT + 32 * (inst * 8 + xg); unsigned* gen = ctl + GB_GEN + 32 * (inst * 8 + xg);
        const unsigned old = xb_add(cnt, 1u);
        if (old + 1u == nloc) { if (publish) { __builtin_amdgcn_fence(__ATOMIC_RELEASE, "agent"); asm volatile("s_waitcnt vmcnt(0)" ::: "memory"); } (void)xb_add(gen, 1u); }
        else XB_SPIN(xb_ld(gen) == 0u, tmo_bar);
        if (left >= 0) { unsigned* lgen = ctl + GB_GEN + 32 * (inst * 8 + left); XB_SPIN(xb_ld(lgen) == 0u, tmo_bar); }
        asm volatile("s_waitcnt vmcnt(0)" ::: "memory");
    }
    __syncthreads();
}

__device__ __forceinline__ void transpose_item(const float* W, int N, int k0, int n0, bf16_t* dst, int K, LAS float* scr, int lane) {
    f32x4 v[8];
#pragma unroll
    for (int it = 0; it < 8; ++it) v[it] = *(const GAS f32x4*)(W + (size_t)(k0 + it * 8 + (lane >> 3)) * N + n0 + 4 * (lane & 7));
#pragma unroll
    for (int it = 0; it < 8; ++it) { LAS float* s = scr + (it * 8 + (lane >> 3)) * 33 + 4 * (lane & 7); s[0] = v[it].x; s[1] = v[it].y; s[2] = v[it].z; s[3] = v[it].w; }
    LDS_WAIT(); asm volatile("" ::: "memory");
    const int c = lane & 7;
#pragma unroll
    for (int j = 0; j < 4; ++j) { const int n = (lane >> 3) + 8 * j; const LAS float* s = scr + (8 * c) * 33 + n;
        u32x4 o; o.x = pk2(s[0 * 33], s[1 * 33]); o.y = pk2(s[2 * 33], s[3 * 33]); o.z = pk2(s[4 * 33], s[5 * 33]); o.w = pk2(s[6 * 33], s[7 * 33]);
        *(GAS u32x4*)(dst + (size_t)n * K + k0 + 8 * c) = o; }
    LDS_WAIT(); asm volatile("" ::: "memory");
}

__device__ __forceinline__ void transpose_item_fp8(const float* W, int N, int k0, int n0, unsigned char* dst, int K, LAS float* scr, int lane) {
    f32x4 v[8];
#pragma unroll
    for (int it = 0; it < 8; ++it) v[it] = *(const GAS f32x4*)(W + (size_t)(k0 + it * 8 + (lane >> 3)) * N + n0 + 4 * (lane & 7));
#pragma unroll
    for (int it = 0; it < 8; ++it) { LAS float* s = scr + (it * 8 + (lane >> 3)) * 33 + 4 * (lane & 7); s[0] = v[it].x; s[1] = v[it].y; s[2] = v[it].z; s[3] = v[it].w; }
    LDS_WAIT(); asm volatile("" ::: "memory");
    const int c = lane & 7;
#pragma unroll
    for (int j = 0; j < 4; ++j) { const int n = (lane >> 3) + 8 * j; const LAS float* s = scr + (8 * c) * 33 + n;
        u32x2 o; o.x = pk4_fp8(s[0 * 33] * SC_W, s[1 * 33] * SC_W, s[2 * 33] * SC_W, s[3 * 33] * SC_W); o.y = pk4_fp8(s[4 * 33] * SC_W, s[5 * 33] * SC_W, s[6 * 33] * SC_W, s[7 * 33] * SC_W);
        *(GAS u32x2*)(dst + (size_t)n * K + k0 + 8 * c) = o; }
    LDS_WAIT(); asm volatile("" ::: "memory");
}

struct Args { const float* in[19]; float* out; unsigned char* ws; int ph_lo, ph_hi; };

namespace att {
constexpr int SLOT = 8192, NSL = 5;
constexpr int L_K = 0, L_V = NSL * SLOT, L_WS = 2 * NSL * SLOT, L_BIAS = L_WS + 8 * 256, L_OST = L_BIAS + 1024, L_END = L_OST + 8 * 4096;
__device__ __forceinline__ int crow(int r, int hi) { return (r & 3) + 8 * (r >> 2) + 4 * hi; }
__device__ __forceinline__ s16x4 vtr(const LAS char* p) { typedef short v4i16_t __attribute__((ext_vector_type(4))); return __builtin_bit_cast(s16x4, __builtin_amdgcn_ds_read_tr16_b64_v4i16((LAS v4i16_t*)p)); }

template <bool FIRST, int BIAS = -1>
__device__ __forceinline__ void tile_step(const LAS char* lds, int slot, int s, int lane, int r32, int hi, int qin, const bf16x8 (&qr)[4], const LAS float* tb, LAS float* wsf,
                                          float& m_run, f32x16& osum, f32x16 (&o)[2], f32x16& negm) {
    constexpr float THR = 8.0f;
    const LAS char* kp = lds + L_K + slot + hi * 1024 + r32 * 16;
    f32x16 p0, p1;
#pragma unroll
    for (int d0 = 0; d0 < 4; ++d0) {
        const bf16x8 b0 = *(const LAS bf16x8*)(kp + d0 * 2048), b1 = *(const LAS bf16x8*)(kp + d0 * 2048 + 512);
        p0 = __builtin_amdgcn_mfma_f32_32x32x16_bf16(b0, qr[d0], d0 == 0 ? negm : p0, 0, 0, 0); p1 = __builtin_amdgcn_mfma_f32_32x32x16_bf16(b1, qr[d0], d0 == 0 ? negm : p1, 0, 0, 0); }
    if (BIAS == 1 || (BIAS < 0 && s >= 6)) { const int ib = qin + 64 * (8 - s) + 63 - 4 * hi;
#pragma unroll
        for (int r = 0; r < 16; ++r) { const int off = (r & 3) + 8 * (r >> 2); p0[r] += tb[ib - off]; p1[r] += tb[ib - off - 32]; } }
    float mx = __builtin_fmaxf(__builtin_fmaxf(p0[0], p0[1]), p1[0]), my = __builtin_fmaxf(__builtin_fmaxf(p0[2], p0[3]), p1[1]);
    mx = __builtin_fmaxf(__builtin_fmaxf(mx, p1[2]), p1[3]);
#pragma unroll
    for (int r = 4; r < 16; r += 4) { mx = __builtin_fmaxf(__builtin_fmaxf(mx, p0[r]), p0[r + 1]); my = __builtin_fmaxf(__builtin_fmaxf(my, p0[r + 2]), p0[r + 3]);
                                      mx = __builtin_fmaxf(__builtin_fmaxf(mx, p1[r]), p1[r + 1]); my = __builtin_fmaxf(__builtin_fmaxf(my, p1[r + 2]), p1[r + 3]); }
    mx = fmaxf(mx, my); { const auto sw = __builtin_amdgcn_permlane32_swap(__float_as_uint(mx), __float_as_uint(mx), false, false); mx = fmaxf(__uint_as_float(sw[0]), __uint_as_float(sw[1])); }
    if constexpr (FIRST) {
        m_run = mx;
#pragma unroll
        for (int r = 0; r < 16; ++r) { p0[r] -= mx; p1[r] -= mx; negm[r] = -mx; }
    } else if (__any(mx > THR)) {
        const float d = mx > THR ? mx : 0.f, f = __builtin_amdgcn_exp2f(-d);
        m_run += d;
#pragma unroll
        for (int r = 0; r < 16; ++r) { p0[r] -= d; p1[r] -= d; negm[r] = -m_run; }
        if (hi == 0) wsf[r32] = f;
        LDS_WAIT();
#pragma unroll
        for (int r = 0; r < 16; ++r) { const float g = wsf[crow(r, hi)]; o[0][r] *= g; o[1][r] *= g; osum[r] *= g; }
    }
#pragma unroll
    for (int r = 0; r < 16; ++r) { p0[r] = __builtin_amdgcn_exp2f(p0[r]); p1[r] = __builtin_amdgcn_exp2f(p1[r]); }
    u32x4 pw[4];
#pragma unroll
    for (int q = 0; q < 4; ++q) { pw[0][q] = cvt_pk_bf16_tr(p0[2 * q], p0[2 * q + 1]); pw[1][q] = cvt_pk_bf16_tr(p0[8 + 2 * q], p0[8 + 2 * q + 1]);
                                  pw[2][q] = cvt_pk_bf16_tr(p1[2 * q], p1[2 * q + 1]); pw[3][q] = cvt_pk_bf16_tr(p1[8 + 2 * q], p1[8 + 2 * q + 1]); }
    { const bf16x8 ones = __builtin_bit_cast(bf16x8, (u32x4){0x3F803F80u, 0x3F803F80u, 0x3F803F80u, 0x3F803F80u});
#pragma unroll
      for (int ks = 0; ks < 4; ++ks) osum = __builtin_amdgcn_mfma_f32_32x32x16_bf16(__builtin_bit_cast(bf16x8, pw[ks]), ones, osum, 0, 0, 0); }
    const LAS char* vbp = lds + L_V + slot + ((lane >> 4) & 1) * 32 + (lane & 3) * 8 + (4 * hi + ((lane & 15) >> 2)) * 64;
    if constexpr (BIAS >= 0) {
#pragma unroll
        for (int d0 = 0; d0 < 2; ++d0) { s16x4 lo[4], hh[4];
#pragma unroll
            for (int ks = 0; ks < 4; ++ks) { lo[ks] = vtr(vbp + d0 * 4096 + ks * 1024); hh[ks] = vtr(vbp + d0 * 4096 + ks * 1024 + 512); }
#pragma unroll
            for (int ks = 0; ks < 4; ++ks) { const bf16x8 vf = (bf16x8){lo[ks][0], lo[ks][1], lo[ks][2], lo[ks][3], hh[ks][0], hh[ks][1], hh[ks][2], hh[ks][3]};
                o[d0] = __builtin_amdgcn_mfma_f32_32x32x16_bf16(__builtin_bit_cast(bf16x8, pw[ks]), vf, o[d0], 0, 0, 0); } }
    } else {
        const unsigned vb = (unsigned)(uintptr_t)vbp;
#pragma unroll
        for (int d0 = 0; d0 < 2; ++d0) { s16x4 lo[4], hh[4];
#pragma unroll
            for (int ks = 0; ks < 4; ++ks) {
                asm volatile("ds_read_b64_tr_b16 %0, %1 offset:%c2" : "=&v"(lo[ks]) : "v"(vb), "i"(d0 * 4096 + ks * 1024) : "memory");
                asm volatile("ds_read_b64_tr_b16 %0, %1 offset:%c2" : "=&v"(hh[ks]) : "v"(vb), "i"(d0 * 4096 + ks * 1024 + 512) : "memory"); }
            asm volatile("s_waitcnt lgkmcnt(0)" ::: "memory"); __builtin_amdgcn_sched_barrier(0);
#pragma unroll
            for (int ks = 0; ks < 4; ++ks) { const bf16x8 vf = (bf16x8){lo[ks][0], lo[ks][1], lo[ks][2], lo[ks][3], hh[ks][0], hh[ks][1], hh[ks][2], hh[ks][3]};
                o[d0] = __builtin_amdgcn_mfma_f32_32x32x16_bf16(__builtin_bit_cast(bf16x8, pw[ks]), vf, o[d0], 0, 0, 0); } }
    }
}

template <bool EDGE>
__device__ __forceinline__ void unit(const Frame& F, int b, int h, int cg, const bf16_t* Q, const bf16_t* Kb, const bf16_t* Vb, unsigned char* MIX, const float* relb) {
    LAS char* lds = (LAS char*)F.lds;
    const int wid = F.wave, lane = lane_id(), tid = wid * 64 + lane, r32 = lane & 31, hi = lane >> 5;
    const int wp = wid >> 1, half = wid & 1;
    const int c = 4 * cg + wp;
    const long rowbase = (long)b * SEQ;
    LAS float* wsf = (LAS float*)(lds + L_WS) + wid * 64;
    LAS float* tb = (LAS float*)(lds + L_BIAS);
    const float rbi = relb[h * NREL + ((tid & 255) < NREL ? (tid & 255) : NREL - 1)], rbf = relb[h * NREL + NREL - 1];
    const bf16_t* Qw = Q + (rowbase + c * 64 + half * 32 + r32) * DA + h * HD;
    bf16x8 qr[4];
#pragma unroll
    for (int d0 = 0; d0 < 4; ++d0) qr[d0] = *(const GAS bf16x8*)(Qw + d0 * 16 + hi * 8);
    const int kc0 = 4 * cg - 8;
    const int krow = tid & 63, kch = tid >> 6;
    const int vrow = tid >> 3, vch = tid & 7;
    const bf16_t* ksrc = Kb + (rowbase + krow) * DA + h * HD + kch * 8;
    const bf16_t* vsrc = Vb + (rowbase + vrow) * DA + h * HD + vch * 8;
    const int kdst = L_K + kch * 1024 + krow * 16, vdst = L_V + (vch >> 2) * 4096 + vrow * 64 + (vch & 3) * 16;
    if constexpr (!EDGE) { u32x4 kv[4], vv[4];
#pragma unroll
        for (int j = 0; j < 4; ++j) { kv[j] = *(const GAS u32x4*)(ksrc + (long)(kc0 + j) * 64 * DA); vv[j] = *(const GAS u32x4*)(vsrc + (long)(kc0 + j) * 64 * DA); }
        asm volatile("" ::: "memory");
        if (tid < 256) tb[tid] = (rbi - rbf) * LOG2E;
#pragma unroll
        for (int j = 0; j < 4; ++j) { *(LAS u32x4*)(lds + kdst + j * SLOT) = kv[j]; *(LAS u32x4*)(lds + vdst + j * SLOT) = vv[j]; }
    } else {
        if (tid < 256) tb[tid] = (rbi - rbf) * LOG2E;
#pragma unroll
        for (int j = 0; j < 4; ++j) { const int kc = kc0 + j;
            if (kc >= 0) { const u32x4 kv = *(const GAS u32x4*)(ksrc + (long)kc * 64 * DA); const u32x4 vv = *(const GAS u32x4*)(vsrc + (long)kc * 64 * DA);
                *(LAS u32x4*)(lds + kdst + j * SLOT) = kv; *(LAS u32x4*)(lds + vdst + j * SLOT) = vv; } } }
    float m_run = 0.f; f32x16 o[2]; o[0] = f32x16{}; o[1] = f32x16{}; f32x16 negm = f32x16{}, osum = f32x16{};
    const int qin = half * 32 + r32;
    if constexpr (!EDGE) {
        __syncthreads();
        { u32x4 kv = *(const GAS u32x4*)(ksrc + (long)(kc0 + 4) * 64 * DA), vv = *(const GAS u32x4*)(vsrc + (long)(kc0 + 4) * 64 * DA);
          tile_step<true, 0>(lds, (wp % NSL) * SLOT, 0, lane, r32, hi, qin, qr, tb, wsf, m_run, osum, o, negm);
          *(LAS u32x4*)(lds + kdst + 4 * SLOT) = kv; *(LAS u32x4*)(lds + vdst + 4 * SLOT) = vv; }
#pragma unroll 1
        for (int s = 1; s < 6; ++s) {
            __syncthreads();
            const int jn = s + 4;
            const u32x4 kv = *(const GAS u32x4*)(ksrc + (long)(kc0 + jn) * 64 * DA), vv = *(const GAS u32x4*)(vsrc + (long)(kc0 + jn) * 64 * DA);
            tile_step<false, 0>(lds, ((wp + s) % NSL) * SLOT, s, lane, r32, hi, qin, qr, tb, wsf, m_run, osum, o, negm);
            { const int sl = (jn % NSL) * SLOT; *(LAS u32x4*)(lds + kdst + sl) = kv; *(LAS u32x4*)(lds + vdst + sl) = vv; }
        }
#pragma unroll 1
        for (int s = 6; s < 8; ++s) {
            __syncthreads();
            const int jn = s + 4;
            const u32x4 kv = *(const GAS u32x4*)(ksrc + (long)(kc0 + jn) * 64 * DA), vv = *(const GAS u32x4*)(vsrc + (long)(kc0 + jn) * 64 * DA);
            tile_step<false, 1>(lds, ((wp + s) % NSL) * SLOT, s, lane, r32, hi, qin, qr, tb, wsf, m_run, osum, o, negm);
            { const int sl = (jn % NSL) * SLOT; *(LAS u32x4*)(lds + kdst + sl) = kv; *(LAS u32x4*)(lds + vdst + sl) = vv; }
        }
        __syncthreads();
        tile_step<false, 1>(lds, ((wp + 8) % NSL) * SLOT, 8, lane, r32, hi, qin, qr, tb, wsf, m_run, osum, o, negm);
    } else {
        bool first = true;
#pragma unroll 1
        for (int s = 0; s < 9; ++s) {
            __syncthreads();
            const int jn = s + 4, kcn = kc0 + jn; const bool ldn = (jn < 12) && (kcn >= 0);
            u32x4 kv = (u32x4){0u, 0u, 0u, 0u}, vv = (u32x4){0u, 0u, 0u, 0u};
            if (ldn) { kv = *(const GAS u32x4*)(ksrc + (long)kcn * 64 * DA); vv = *(const GAS u32x4*)(vsrc + (long)kcn * 64 * DA); }
            const int j = wp + s, kc = kc0 + j;
            if (kc >= 0) { if (first) { tile_step<true>(lds, (j % NSL) * SLOT, s, lane, r32, hi, qin, qr, tb, wsf, m_run, osum, o, negm); first = false; }
                           else tile_step<false>(lds, (j % NSL) * SLOT, s, lane, r32, hi, qin, qr, tb, wsf, m_run, osum, o, negm); }
            if (ldn) { const int sl = (jn % NSL) * SLOT; *(LAS u32x4*)(lds + kdst + sl) = kv; *(LAS u32x4*)(lds + vdst + sl) = vv; }
        }
    }
    LAS unsigned char* stg = (LAS unsigned char*)(lds + L_OST) + wid * 2048;
#pragma unroll
    for (int r = 0; r < 16; ++r) { const int orow = crow(r, hi); const float rl = __builtin_amdgcn_rcpf(osum[r]) * SC_M;
        const int pk = __builtin_amdgcn_cvt_pk_fp8_f32(clamp448(o[0][r] * rl), clamp448(o[1][r] * rl), 0, false);
        stg[orow * 64 + r32] = (unsigned char)(pk & 0xff); stg[orow * 64 + 32 + r32] = (unsigned char)((pk >> 8) & 0xff); }
    LDS_WAIT();
    unsigned char* Ow = MIX + (rowbase + c * 64 + half * 32) * D + h * HD;
    { const int row = lane >> 1, hb = (lane & 1) * 32; const u32x4 v0 = *(const LAS u32x4*)(stg + row * 64 + hb), v1 = *(const LAS u32x4*)(stg + row * 64 + hb + 16);
      *(GAS u32x4*)(Ow + (long)row * D + hb) = v0; *(GAS u32x4*)(Ow + (long)row * D + hb + 16) = v1; }
    __syncthreads();
}
}

namespace cv {
constexpr int TT = 32, UR = TT + CW - 1;
constexpr int L_U = 0, L_Y = UR * DC * 2  , L_END = L_Y + TT * DC * 4;
struct Par { f32x2 w[CW]; f32x2 bias; f32x4 lg[8], lb[8]; };
__device__ __forceinline__ void load_par(Par& P, const float* dw_w, const float* dw_b, const float* ln_g, const float* ln_b, int cp, int lane) {
#pragma unroll
    for (int jj = 0; jj < 8; ++jj) { P.lg[jj] = *(const GAS f32x4*)(ln_g + 4 * (lane & 15) + 64 * jj); P.lb[jj] = *(const GAS f32x4*)(ln_b + 4 * (lane & 15) + 64 * jj); }
#pragma unroll
    for (int j = 0; j < CW; ++j) P.w[j] = *(const GAS f32x2*)(dw_w + j * DC + 2 * cp);
    P.bias = *(const GAS f32x2*)(dw_b + 2 * cp);
}
__device__ __forceinline__ void load_rows(u32x4 (&uv)[8], const bf16_t* Ub, int b, int tt, int wid, int lane) {
    const int t0 = tt * TT; const long rowbase = (long)b * SEQ;
#pragma unroll
    for (int it = 0; it < 8; ++it) { const int r = min(wid + 8 * it, UR - 1); const int tok = max(t0 - (CW - 1) + r, 0);
        uv[it] = *(const GAS u32x4*)(Ub + (rowbase + tok) * DC + lane * 8); }
}
__device__ __forceinline__ void unit(const Frame& F, int b, int tt, u32x4 (&uv)[8], bool has_next, int bn, int ttn, const bf16_t* Ub, unsigned char* MIX, const Par& P) {
    LAS char* lds = (LAS char*)F.lds;
    const int wid = F.wave, lane = lane_id(), tid = wid * 64 + lane;
    const int t0 = tt * TT; const long rowbase = (long)b * SEQ;
    const int cp = tid & 255, th = tid >> 8;
#pragma unroll
    for (int it = 0; it < 8; ++it) { const int r = wid + 8 * it;
        *(LAS u32x4*)(lds + L_U + r * (DC * 2) + lane * 16) = (t0 - (CW - 1) + r >= 0) ? uv[it] : (u32x4){0u, 0u, 0u, 0u}; }
    __syncthreads();
    { const int tbk = th * 16;
      unsigned uw[16 + CW - 1];
      { const LAS char* up = lds + L_U + tbk * (DC * 2) + cp * 4;
#pragma unroll
        for (int i = 0; i < 16 + CW - 1; ++i) uw[i] = *(const LAS unsigned*)(up + i * (DC * 2)); }
      __builtin_amdgcn_sched_barrier(0);
      f32x2 acc[16];
#pragma unroll
      for (int k = 0; k < 16; ++k) acc[k] = P.bias;
#pragma unroll
      for (int i = 0; i < 16 + CW - 1; ++i) { const f32x2 u2 = (f32x2){bf_lo(uw[i]), bf_hi(uw[i])};
#pragma unroll
          for (int k = 0; k < 16; ++k) { const int j = i - k; if (j >= 0 && j < CW) acc[k] += u2 * P.w[j]; } }
#pragma unroll
      for (int k = 0; k < 16; ++k) *(LAS f32x2*)(lds + L_Y + (tbk + k) * (DC * 4) + cp * 8) = acc[k]; }
    __syncthreads();
    if (has_next) load_rows(uv, Ub, bn, ttn, wid, lane);
    __builtin_amdgcn_sched_barrier(0);
    { const int t = wid * 4 + (lane >> 4), l16 = lane & 15;
      f32x4 y[8]; float sm = 0.f;
#pragma unroll
      for (int jj = 0; jj < 8; ++jj) { y[jj] = *(const LAS f32x4*)(lds + L_Y + t * (DC * 4) + l16 * 16 + jj * 256); sm += (y[jj].x + y[jj].y) + (y[jj].z + y[jj].w); }
      const float mean = row_sum16(sm) * (1.f / DC); float sq = 0.f;
#pragma unroll
      for (int jj = 0; jj < 8; ++jj) { y[jj] = y[jj] - mean; sq += (y[jj].x * y[jj].x + y[jj].y * y[jj].y) + (y[jj].z * y[jj].z + y[jj].w * y[jj].w); }
      const float rstd = __builtin_amdgcn_rsqf(row_sum16(sq) * (1.f / DC) + LN_EPS);
      unsigned char* orow = MIX + (rowbase + t0 + t) * D + DA + 4 * l16;
#pragma unroll
      for (int jj = 0; jj < 8; ++jj) { const f32x4 z = y[jj] * rstd * P.lg[jj] + P.lb[jj];
          *(GAS unsigned*)(orow + 64 * jj) = pk4_fp8(z.x * fsigmoid(z.x) * SC_M, z.y * fsigmoid(z.y) * SC_M, z.z * fsigmoid(z.z) * SC_M, z.w * fsigmoid(z.w) * SC_M); } }
    __syncthreads();
}
}

__global__ void __launch_bounds__(NWAVES * 64, 2) hymba_fwd(Args args) {
    extern __shared__ __attribute__((aligned(16))) unsigned char lds_raw[];
    Frame F;
    F.lds = (LAS unsigned char*)lds_raw;
    F.wave = __builtin_amdgcn_readfirstlane(threadIdx.x >> 6);
    F.G = gridDim.x; { const int bx = blockIdx.x; F.vcu = (F.G % 8 == 0) ? (bx % 8) * (F.G / 8) + bx / 8 : bx; }
    unsigned char* ws = args.ws;
    F.ctl = (gu32*)(ws + WS_CTL);
    volatile LAS unsigned* MISC = (volatile LAS unsigned*)(F.lds + LDSCTL_OFF);
    for (int u = threadIdx.x; u < (LDS_BYTES - LDSCTL_OFF) / 4; u += NWAVES * 64) ((LAS unsigned*)(F.lds + LDSCTL_OFF))[u] = 0u;
    __syncthreads();
    const int lo = args.ph_lo, hi = args.ph_hi;
    const bool multi = (hi - lo) > 1;
    XcdBarrier bar; bar.bar = (unsigned*)(F.ctl + CW_BAR); bar.x = 0; bar.st = nullptr;
    if (multi) bar = xcd_barrier_post((unsigned*)(F.ctl + CW_BAR), MISC + 8);
#define IN(k) (lo <= (k) && (k) < hi)
#define BOTH(k) (IN(k) && IN((k) + 1))
#define GRID_BAR() xcd_barrier(bar)
    const int xgrp = (int)(blockIdx.x % 8);
    unsigned b0_gen = 0u; bool b0_pending = false;
    unsigned gmixed = 1u;
    if (multi && F.G == 256 && threadIdx.x == 0) { const unsigned me = xb_xcc_id() + 1u;
        const unsigned was = atomicCAS((unsigned*)(F.ctl + GB_MAP + 32 * xgrp), 0u, me);
        if (was != 0u && was != me) atomicOr((unsigned*)(F.ctl + GB_MIXED), 1u); }
#define GROUP_BAR(inst) do { if (F.G == 256 && gmixed == 0u) group_barrier((unsigned*)F.ctl, bar.bar, (inst), xgrp, 32u); else GRID_BAR(); } while (0)

    const float* x = args.in[0];
    bf16_t* Win_t = (bf16_t*)(ws + WS_WIN); unsigned char* Wout8 = ws + WS_WOUT;     unsigned char* Wgu8 = ws + WS_WGU; unsigned char* Wd8 = ws + WS_WD;
    bf16_t* X1 = (bf16_t*)(ws + WS_X1); bf16_t* XN = (bf16_t*)(ws + WS_XN);
    bf16_t* Qb = (bf16_t*)(ws + WS_Q); bf16_t* Kb = (bf16_t*)(ws + WS_K); bf16_t* Vb = (bf16_t*)(ws + WS_V); bf16_t* Ub = (bf16_t*)(ws + WS_A);
    unsigned char* MIX = ws + WS_MIX;        unsigned char* HID8 = ws + WS_HID; unsigned char* T8 = ws + WS_T8; unsigned char* OB = ws + WS_O;
    u32x2* LIST = (u32x2*)(ws + WS_LIST); float* XCH = (float*)(ws + WS_XCH);   float* TOPW = (float*)(ws + WS_TOPW); bf16_t* RWB = (bf16_t*)(ws + WS_RWT);
    const int gw = F.vcu * NWAVES + F.wave, NGW = F.G * NWAVES;

    if (IN(0)) {
        const int lane = lane_id(), tid = F.wave * 64 + lane;
        LAS float* scr = (LAS float*)(F.lds + F.wave * 16896);
        constexpr int I_IN = (D / 64) * (NIN / 32), I_OUT = (D / 64) * (D / 32), I_EXP = (D / 64) * (D / 32);
        for (int it = gw; it < I_IN + I_OUT; it += NGW) {
            int r = it;
            if (r < I_IN) { const int kb = r / (NIN / 32), nb = r % (NIN / 32); int nd = nb * 32;
                if (nd >= 3 * DC) { const int gt = (nd >= 4 * DC), ch = nd - (3 + gt) * DC; nd = 3 * DC + 256 * (ch >> 7) + 128 * gt + (ch & 127); }
                transpose_item(args.in[2], NIN, kb * 64, nb * 32, Win_t + (size_t)nd * D, D, scr, lane); continue; } r -= I_IN;
            const int kb = r / (D / 32), nb = r % (D / 32); transpose_item_fp8(args.in[8], D, kb * 64, nb * 32, Wout8 + (size_t)(nb * 32) * D, D, scr, lane);
        }
        { const GAS f32x4* gp = (const GAS f32x4*)args.in[1] + lane; f32x4 g[4];
#pragma unroll
          for (int j = 0; j < 4; ++j) g[j] = gp[64 * j];
          const bool own = (F.G == 256); const int mstep = own ? 256 : NGW, mbase = own ? 2048 * (int)(blockIdx.x % 8) + (int)(blockIdx.x / 8) * NWAVES + F.wave : gw, mend = own ? 2048 * (int)(blockIdx.x % 8) + 2048 : T;
          for (int m = mbase; m < mend; m += 2 * mstep) { const int m2 = m + mstep;
              const GAS f32x4* xr = (const GAS f32x4*)(x + (size_t)m * D) + lane; const GAS f32x4* xr2 = (const GAS f32x4*)(x + (size_t)(m2 < mend ? m2 : m) * D) + lane; f32x4 v[4], v2[4]; float s = 0.f, s2 = 0.f;
#pragma unroll
              for (int j = 0; j < 4; ++j) { v[j] = __builtin_nontemporal_load(xr + 64 * j); v2[j] = __builtin_nontemporal_load(xr2 + 64 * j); }
#pragma unroll
              for (int j = 0; j < 4; ++j) { s += (v[j].x * v[j].x + v[j].y * v[j].y) + (v[j].z * v[j].z + v[j].w * v[j].w); s2 += (v2[j].x * v2[j].x + v2[j].y * v2[j].y) + (v2[j].z * v2[j].z + v2[j].w * v2[j].w); }
              const float r = 1.0f / sqrtf(wave_sum(s) * (1.f / D) + RMS_EPS), r2 = 1.0f / sqrtf(wave_sum(s2) * (1.f / D) + RMS_EPS);
              GAS u32x2* o8 = (GAS u32x2*)(XN + (size_t)m * D) + lane;
#pragma unroll
              for (int j = 0; j < 4; ++j) { const f32x4 y = v[j] * r * g[j]; o8[64 * j] = (u32x2){pk2(y.x, y.y), pk2(y.z, y.w)}; }
              if (m2 < mend) { GAS u32x2* o82 = (GAS u32x2*)(XN + (size_t)m2 * D) + lane;
#pragma unroll
                  for (int j = 0; j < 4; ++j) { const f32x4 y = v2[j] * r2 * g[j]; o82[64 * j] = (u32x2){pk2(y.x, y.y), pk2(y.z, y.w)}; } } } }
        for (int i = blockIdx.x * 512 + tid; i < NE * D; i += F.G * 512) { const int e = i / D, k = i % D; const float v = args.in[10][k * NE + e] * args.in[9][k];
            const unsigned h = f2bf(v); RWB[i] = (bf16_t)h; RWB[NE * D + i] = (bf16_t)f2bf(v - __uint_as_float(h << 16)); }
        if (BOTH(0)) { if ((int)(blockIdx.x / 8) >= F.G / 16) { b0_gen = xcd_barrier_arrive(bar); b0_pending = true; } else { GRID_BAR(); gmixed = (unsigned)__builtin_amdgcn_readfirstlane((int)xb_ld((unsigned*)(F.ctl + GB_MIXED))); } }
    }

    if (IN(1)) {
        const int xg = (int)(blockIdx.x % 8), jb = (int)(blockIdx.x / 8), half = F.G / 16;
        if (jb < half) {
            pg8::DenseOrder S; S.init(T, NIN, F.G / 2, xg + 8 * jb, Win_t);
            pg8::EpiSplit E{Qb, (size_t)(WS_K - WS_Q) / 2, QSCALE};
            pg8::gemm_phase<pg8::EpiSplit, pg8::DenseOrder, true, 2>(F.lds, (const char*)XN, D, S, E);
        } else {
            const int cgw = (xg * half + (jb - half)) * NWAVES + F.wave, CNGW = (F.G / 2) * NWAVES;
        { constexpr int NIT = NE * 3 * 8 * 32;
          LAS unsigned* tile = (LAS unsigned*)(F.lds + F.wave * 4352); const int lane = lane_id();
          f32x4 v[16], w[16];
          auto src_of = [&](int r) -> const float* { const int em = r >> 8, ri = r & 255, e = em / 3, mat = em % 3, kb = ri >> 5, nb = ri & 31;
              const float* base = (mat == 0 ? args.in[12] : mat == 1 ? args.in[14] : args.in[16]) + (size_t)e * D * D;
              return base + (size_t)(kb * 128 + (lane >> 3)) * D + nb * 32 + 4 * (lane & 7); };
          int it = cgw;
          if (it < NIT) { const float* sp = src_of(it);
#pragma unroll
              for (int q = 0; q < 16; ++q) v[q] = __builtin_nontemporal_load((const GAS f32x4*)(sp + (size_t)q * 8 * D)); }
#pragma unroll 1
          for (; it < NIT; it += CNGW) {
              const int nx = it + CNGW;
              if (nx < NIT) { const float* sp = src_of(nx);
#pragma unroll
                  for (int q = 0; q < 16; ++q) w[q] = __builtin_nontemporal_load((const GAS f32x4*)(sp + (size_t)q * 8 * D)); }
              const int em = it >> 8, ri = it & 255, e = em / 3, mat = em % 3, kb = ri >> 5, nb = ri & 31, n0 = nb * 32, k0 = kb * 128;
              unsigned char* dst = (mat == 2) ? Wd8 + ((size_t)e * D + n0) * D : Wgu8 + ((size_t)e * 2048 + (size_t)(n0 >> 7) * 256 + (n0 & 127) + (mat == 1 ? 128 : 0)) * D;
#pragma unroll
              for (int q = 0; q < 16; ++q) tile[(lane & 7) * 132 + q * 8 + (lane >> 3)] = pk4_fp8(v[q].x * SC_W, v[q].y * SC_W, v[q].z * SC_W, v[q].w * SC_W);
              LDS_WAIT(); asm volatile("" ::: "memory");
              const int nq = lane >> 3, c = lane & 7;
              u32x4 r[4];
#pragma unroll
              for (int i = 0; i < 4; ++i) r[i] = *(const LAS u32x4*)(tile + nq * 132 + 16 * c + 4 * i);
              LDS_WAIT(); asm volatile("" ::: "memory");
              u32x4 o[4];
#pragma unroll
              for (int i = 0; i < 4; ++i) {
                  const unsigned x01 = __builtin_amdgcn_perm(r[i].y, r[i].x, 0x05010400u), y01 = __builtin_amdgcn_perm(r[i].y, r[i].x, 0x07030602u);
                  const unsigned x23 = __builtin_amdgcn_perm(r[i].w, r[i].z, 0x05010400u), y23 = __builtin_amdgcn_perm(r[i].w, r[i].z, 0x07030602u);
                  o[0][i] = __builtin_amdgcn_perm(x23, x01, 0x05040100u); o[1][i] = __builtin_amdgcn_perm(x23, x01, 0x07060302u);
                  o[2][i] = __builtin_amdgcn_perm(y23, y01, 0x05040100u); o[3][i] = __builtin_amdgcn_perm(y23, y01, 0x07060302u); }
#pragma unroll
              for (int j = 0; j < 4; ++j) *(GAS u32x4*)(dst + (size_t)(4 * nq + j) * D + k0 + 16 * c) = o[j];
#pragma unroll
              for (int q = 0; q < 16; ++q) v[q] = w[q];
          } }
        }
        if (b0_pending) { xcd_barrier_finish(bar, b0_gen); b0_pending = false; gmixed = (unsigned)__builtin_amdgcn_readfirstlane((int)xb_ld((unsigned*)(F.ctl + GB_MIXED))); }
        if (BOTH(1)) {
            if (IN(0) && F.G == 256 && gmixed == 0u) group_barrier((unsigned*)F.ctl, bar.bar, 3, xgrp, 32u, (xgrp & 3) ? xgrp - 1 : -1, true);
            else GRID_BAR(); }
    }

    if (IN(2)) {
        if (F.G == 256) {
            const int xg = (int)(blockIdx.x % 8), j = (int)(blockIdx.x / 8);
            for (int i = 0; i < 2; ++i) { const int h = 4 * i + (j >> 3), pm = 8 * xg + (j & 7), b = pm >> 5, cg = pm & 31;
                if (cg < 2) att::unit<true>(F, b, h, cg, Qb, Kb, Vb, MIX, args.in[7]); else att::unit<false>(F, b, h, cg, Qb, Kb, Vb, MIX, args.in[7]); }
            { const int lane = lane_id(); cv::Par P; cv::load_par(P, args.in[3], args.in[4], args.in[5], args.in[6], (F.wave * 64 + lane) & 255, lane);
              int cb[2], ct[2];
#pragma unroll
              for (int i = 0; i < 2; ++i) { const int loc = j + 32 * i, tg = (8 * xg + (loc >> 3)) * 8 + (loc & 7); cb[i] = tg / (SEQ / cv::TT); ct[i] = tg % (SEQ / cv::TT); }
              u32x4 uv[8]; cv::load_rows(uv, Ub, cb[0], ct[0], F.wave, lane);
#pragma unroll
              for (int i = 0; i < 2; ++i) cv::unit(F, cb[i], ct[i], uv, i == 0, cb[1], ct[1], Ub, MIX, P); }
        } else {
        for (int u = F.vcu; u < 2 * NH * 32; u += F.G) { const int cg = u & 31, h = (u >> 5) & 7, b = u >> 8;
            if (cg < 2) att::unit<true>(F, b, h, cg, Qb, Kb, Vb, MIX, args.in[7]); else att::unit<false>(F, b, h, cg, Qb, Kb, Vb, MIX, args.in[7]); }
        if (F.vcu < T / cv::TT) { const int lane = lane_id(); cv::Par P; cv::load_par(P, args.in[3], args.in[4], args.in[5], args.in[6], (F.wave * 64 + lane) & 255, lane);
            u32x4 uv[8]; cv::load_rows(uv, Ub, F.vcu / (SEQ / cv::TT), F.vcu % (SEQ / cv::TT), F.wave, lane);
            for (int u = F.vcu; u < T / cv::TT; u += F.G) { const int un = u + F.G; const bool hn = un < T / cv::TT; const int uc = hn ? un : u;
                cv::unit(F, u / (SEQ / cv::TT), u % (SEQ / cv::TT), uv, hn, uc / (SEQ / cv::TT), uc % (SEQ / cv::TT), Ub, MIX, P); } }
        }
        if (BOTH(2)) { if (IN(0)) GROUP_BAR(0); else GRID_BAR(); }
    }

    if (IN(3)) {
        pg8::DenseOrder S; S.init(T, D, F.G, (int)blockIdx.x, Wout8);
        if (F.G == 256) {
            pg8::EpiResRouter E{x, X1, T8, args.in[9], RWB, XCH};
            pg8::gemm_phase<pg8::EpiResRouter, pg8::DenseOrder, false, 1>(F.lds, (const char*)MIX, D, S, E);
            if (BOTH(3)) { if (IN(0)) GROUP_BAR(1); else GRID_BAR(); }
        } else {
        pg8::EpiRes E{x, X1, T8, args.in[9]};
        pg8::gemm_phase<pg8::EpiRes, pg8::DenseOrder, false, 1>(F.lds, (const char*)MIX, D, S, E);
        if (BOTH(3)) {
            const int tid = F.wave * 64 + lane_id();
            for (int i = tid; i < 8192; i += 512) { const int row = i >> 7, ch = i & 127; const u32x4 v = ((const GAS u32x4*)RWB)[i];
                *(LAS u32x4*)(F.lds + row * 2048 + (((ch & ~15) | ((ch ^ row) & 15)) * 16)) = v; }
            GRID_BAR(); }
        }
    }

    if (IN(4)) {
        const int lane = lane_id(), tid = F.wave * 64 + lane, fr = lane & 15, fq = lane >> 4;
        LAS unsigned char* rwl = F.lds;
        LAS int* hist = (LAS int*)(F.lds + XTRA_OFF);
        LAS int* baseE = hist + 32;
        LAS int* selE = baseE + 32;
        LAS int* selP = selE + 256;
        LAS float* selR = (LAS float*)(selP + 256);
        LAS float* part = selR + 64;
        const int w4 = F.wave & 3, kh = F.wave >> 2;
        const float rb0 = args.in[11][fr], rb1 = args.in[11][16 + fr];
        bool filled = false; const bool fusedr = (F.G == 256);
#pragma unroll 1
        for (int tb = F.vcu * 4; tb < T / 16; tb += F.G * 4) {
            const int task = tb + w4;
            f32x4 acc0 = (f32x4){0.f, 0.f, 0.f, 0.f}, acc1 = acc0; float ss = 0.f;
            if (fusedr) {
                if (tid < 32) hist[tid] = 0;
                if (kh == 0) { const int pm = task >> 4, rb = (task & 15) * 16;
#pragma unroll
                    for (int pn = 0; pn < 4; ++pn) { const float* xp = XCH + ((size_t)(pm * 4 + pn) * 256 + rb) * 36;
#pragma unroll
                        for (int q = 0; q < 4; ++q) { acc0[q] += xp[(4 * fq + q) * 36 + fr]; acc1[q] += xp[(4 * fq + q) * 36 + 16 + fr]; }
                        ss += xp[fr * 36 + 32]; } }
                __syncthreads();
            } else {
            const bf16_t* xrow = X1 + (size_t)(task * 16 + fr) * D + kh * 512 + 8 * fq;
            u32x4 xv[16];
#pragma unroll
            for (int ks = 0; ks < 16; ++ks) xv[ks] = *(const GAS u32x4*)(xrow + 32 * ks);
            if (!filled && !BOTH(3)) {
                for (int i = tid; i < 8192; i += 512) { const int row = i >> 7, ch = i & 127; const u32x4 v = ((const GAS u32x4*)RWB)[i];
                    *(LAS u32x4*)(rwl + row * 2048 + (((ch & ~15) | ((ch ^ row) & 15)) * 16)) = v; } }
            filled = true;
            if (tid < 32) hist[tid] = 0;
            __syncthreads();
#pragma unroll
            for (int ks = 0; ks < 16; ++ks) {
                const u32x4 hi = xv[ks];
                { const float a0 = bf_lo(hi.x), a1 = bf_hi(hi.x), a2 = bf_lo(hi.y), a3 = bf_hi(hi.y), a4 = bf_lo(hi.z), a5 = bf_hi(hi.z), a6 = bf_lo(hi.w), a7 = bf_hi(hi.w);
                  ss += (a0 * a0 + a1 * a1) + (a2 * a2 + a3 * a3) + (a4 * a4 + a5 * a5) + (a6 * a6 + a7 * a7); }
                const bf16x8 ah = __builtin_bit_cast(bf16x8, hi);
                const int ch = kh * 64 + 4 * ks + fq;
                const int o0 = fr * 2048 + (((ch & ~15) | ((ch ^ fr) & 15)) * 16), o1 = o0 + 16 * 2048;
                const bf16x8 bh0 = *(const LAS bf16x8*)(rwl + o0), bl0 = *(const LAS bf16x8*)(rwl + 65536 + o0), bh1 = *(const LAS bf16x8*)(rwl + o1), bl1 = *(const LAS bf16x8*)(rwl + 65536 + o1);
                acc0 = __builtin_amdgcn_mfma_f32_16x16x32_bf16(ah, bh0, acc0, 0, 0, 0); acc1 = __builtin_amdgcn_mfma_f32_16x16x32_bf16(ah, bh1, acc1, 0, 0, 0);
                acc0 = __builtin_amdgcn_mfma_f32_16x16x32_bf16(ah, bl0, acc0, 0, 0, 0); acc1 = __builtin_amdgcn_mfma_f32_16x16x32_bf16(ah, bl1, acc1, 0, 0, 0);
            }
            ss += __shfl_xor(ss, 16); ss += __shfl_xor(ss, 32);
            if (kh == 1) { LAS float* pp = part + w4 * 576 + lane;
#pragma unroll
                for (int q = 0; q < 4; ++q) { pp[64 * q] = acc0[q]; pp[64 * (4 + q)] = acc1[q]; }
                pp[64 * 8] = ss; }
            __syncthreads();
            if (kh == 0) { const LAS float* pp = part + w4 * 576 + lane;
#pragma unroll
                for (int q = 0; q < 4; ++q) { acc0[q] += pp[64 * q]; acc1[q] += pp[64 * (4 + q)]; }
                ss += pp[64 * 8]; }
            }
            if (kh == 0) {
                const float rrow = 1.0f / sqrtf(ss * (1.f / D) + RMS_EPS);
                float c0[4], c1[4], rt[4], tv[4][4]; int te[4][4];
#pragma unroll
                for (int q = 0; q < 4; ++q) { rt[q] = __shfl(rrow, 4 * fq + q); c0[q] = acc0[q] * rt[q] + rb0; c1[q] = acc1[q] * rt[q] + rb1; }
#pragma unroll
                for (int k = 0; k < 4; ++k) { float v[4]; int e[4];
#pragma unroll
                    for (int q = 0; q < 4; ++q) { const bool hi1 = c1[q] > c0[q]; v[q] = hi1 ? c1[q] : c0[q]; e[q] = hi1 ? 16 + fr : fr; }
#define RT_STEP(CTRL) _Pragma("unroll") for (int q = 0; q < 4; ++q) { const float v2 = __builtin_bit_cast(float, __builtin_amdgcn_update_dpp(0, __builtin_bit_cast(int, v[q]), CTRL, 0xf, 0xf, false)); \
                        const int e2 = __builtin_amdgcn_update_dpp(0, e[q], CTRL, 0xf, 0xf, false); const bool take = (v2 > v[q]) | ((v2 == v[q]) & (e2 < e[q])); v[q] = take ? v2 : v[q]; e[q] = take ? e2 : e[q]; }
                    RT_STEP(0x128) RT_STEP(0x124) RT_STEP(0x122) RT_STEP(0x121)
#undef RT_STEP
#pragma unroll
                    for (int q = 0; q < 4; ++q) { tv[q][k] = v[q]; te[q][k] = e[q]; c0[q] = (e[q] == fr) ? -INFINITY : c0[q]; c1[q] = (e[q] == 16 + fr) ? -INFINITY : c1[q]; } }
#pragma unroll
                for (int q = 0; q < 4; ++q) {
                    const float e1 = __expf(tv[q][1] - tv[q][0]), e2 = __expf(tv[q][2] - tv[q][0]), e3 = __expf(tv[q][3] - tv[q][0]); const float inv = 1.0f / (1.0f + e1 + e2 + e3);
                    const int tl = w4 * 16 + 4 * fq + q, tok = task * 16 + 4 * fq + q;
                    if (fr == 0) { *(GAS f32x4*)(TOPW + (size_t)tok * 4) = (f32x4){inv, e1 * inv, e2 * inv, e3 * inv}; selR[tl] = rt[q]; }
                    if (fr < 4) { const int em = fr == 0 ? te[q][0] : fr == 1 ? te[q][1] : fr == 2 ? te[q][2] : te[q][3];
                        selE[tl * 4 + fr] = em; selP[tl * 4 + fr] = __hip_atomic_fetch_add(&hist[em], 1, __ATOMIC_RELAXED, __HIP_MEMORY_SCOPE_WORKGROUP); }
                } }
            __syncthreads();
            if (tid < 32) baseE[tid] = (int)__hip_atomic_fetch_add(F.ctl + CW_CNT + 64 * tid, (unsigned)hist[tid], RLX_AGENT);
            __syncthreads();
            if (tid < 256) { const int e = selE[tid]; LIST[(size_t)e * LCAP + baseE[e] + selP[tid]] = (u32x2){(unsigned)((tb * 16 + (tid >> 2)) * 4 + (tid & 3)), __float_as_uint(selR[tid >> 2])}; }
            __syncthreads();
        }
        if (BOTH(4)) GRID_BAR();
    }

    LAS int* tstart = (LAS int*)(F.lds + XTRA_OFF + 14336);
    LAS int* ecnt = tstart + 64;
    LAS i32x4* ulist = (LAS i32x4*)(tstart + 128);
    if (IN(5) || IN(6)) {
        const int tid = F.wave * 64 + lane_id();
        __syncthreads();
        if (tid < 64) {
            const int l = tid & 31, c = (int)__hip_atomic_load(F.ctl + CW_CNT + 64 * l, RLX_AGENT), nt = (c + 255) >> 8;
            int inc = nt;
#pragma unroll
            for (int d = 1; d < 32; d <<= 1) { const int v = __shfl_up(inc, d, 32); inc += (l >= d) ? v : 0; }
            const int ts = inc - nt;
            if (tid < 32) { ecnt[l] = c; tstart[l] = ts; if (l == 31) tstart[NE] = inc; }
            const int which = tid >> 5, i = tid & 31, npn = which ? 4 : 8, nper = F.G / 8, xg = (int)(blockIdx.x % 8), j = (int)(blockIdx.x / 8);
            const int Rtot = __shfl(inc, 31); int R, col;
            if (F.G == 256) {
                const int cyc = Rtot >> 5, rem = Rtot & 31, c4 = 4 * cyc, tail = (rem > xg) ? ((rem - xg + 7) >> 3) : 0, jr = which ? ((j - 8 * tail) & 31) : j;
                const int kq = which ? (8 * i + jr / 4) : (4 * i + j / 8);
                R = (kq < c4) ? 4 * (8 * (kq >> 2) + xg) + (kq & 3) : ((kq - c4) < tail ? 32 * cyc + 8 * (kq - c4) + xg : Rtot);
                col = which ? (jr & 3) : (j & 7);
            } else { R = (nper / npn) * (i * 8 + xg) + j / npn; col = j % npn; }
            int e = 0;
#pragma unroll
            for (int q = 1; q < NE; ++q) e += (__builtin_amdgcn_readlane(ts, q) <= R) ? 1 : 0;
            const int ts_e = __shfl(ts, e), c_e = __shfl(c, e);
            i32x4 u = (i32x4){0, 0, 0, 0};
            if (R < Rtot) { const int pm = R - ts_e, rem2 = c_e - pm * 256; u = (i32x4){e, pm, col | (R << 8), rem2 < 256 ? rem2 : 256}; }
            ulist[which * 32 + i] = u; }
        __syncthreads();
    }

    if (IN(5)) {
        pg8::MoeOrder<1> S{ulist, LIST, (const char*)Wgu8, 8, 2048, 2, args.in[13], args.in[15], 128, (unsigned*)F.ctl + RT_DONE, bar.bar + XB_TMO};
        pg8::EpiGU E{HID8};
        pg8::gemm_phase<pg8::EpiGU, pg8::MoeOrder<1>, true, 1>(F.lds, (const char*)T8, D, S, E);
        if (BOTH(5)) { if (!(IN(0) && F.G == 256 && gmixed == 0u)) GRID_BAR(); }
    }

    if (IN(6)) {
        pg8::MoeOrder<2> S{ulist + 32, LIST, (const char*)Wd8, 4, 1024, 0, args.in[17], args.in[17], 256, (unsigned*)F.ctl + RT_DONE, bar.bar + XB_TMO};
        pg8::EpiDown E{OB};
        pg8::gemm_phase<pg8::EpiDown, pg8::MoeOrder<2>, true, 1>(F.lds, (const char*)HID8, D, S, E);
        if (BOTH(6)) GRID_BAR();
    }

    if (IN(7)) {
        const int lane = lane_id();
        const GAS f32x4* gp = (const GAS f32x4*)args.in[18] + lane; f32x4 g[4];
#pragma unroll
        for (int j = 0; j < 4; ++j) g[j] = gp[64 * j];
        unsigned bad = __hip_atomic_load(F.ctl + CW_BAR + XB_TMO, RLX_AGENT);
        for (int m = gw; m < T; m += NGW) {
            const GAS u32x2* xr = (const GAS u32x2*)(X1 + (size_t)m * D) + lane; f32x4 v[4];
#pragma unroll
            for (int j = 0; j < 4; ++j) { const u32x2 w = __builtin_nontemporal_load(xr + 64 * j); v[j] = (f32x4){bf_lo(w.x), bf_hi(w.x), bf_lo(w.y), bf_hi(w.y)}; }
            const f32x4 tw = *(const GAS f32x4*)(TOPW + (size_t)m * 4);
#pragma unroll
            for (int k = 0; k < 4; ++k) { const GAS unsigned* orow = (const GAS unsigned*)(OB + ((size_t)m * 4 + k) * D) + lane; const float wk = tw[k] * (1.0f / SC_O);
#pragma unroll
                for (int j = 0; j < 4; ++j) { const unsigned w = __builtin_nontemporal_load(orow + 64 * j); const f32x2 lo = __builtin_amdgcn_cvt_pk_f32_fp8((int)w, false), hi = __builtin_amdgcn_cvt_pk_f32_fp8((int)w, true);
                    v[j].x += wk * lo.x; v[j].y += wk * lo.y; v[j].z += wk * hi.x; v[j].w += wk * hi.y; } }
            float s = 0.f;
#pragma unroll
            for (int j = 0; j < 4; ++j) s += (v[j].x * v[j].x + v[j].y * v[j].y) + (v[j].z * v[j].z + v[j].w * v[j].w);
            float r = 1.0f / sqrtf(wave_sum(s) * (1.f / D) + RMS_EPS);
            if (bad) r = __builtin_nanf("");
            GAS f32x4* o = (GAS f32x4*)(args.out + (size_t)m * D) + lane;
#pragma unroll
            for (int j = 0; j < 4; ++j) __builtin_nontemporal_store(v[j] * r * g[j], o + 64 * j);
        }
    }
#undef IN
#undef BOTH
#undef GRID_BAR
#undef GROUP_BAR
}

#ifndef MK_N_LAUNCHES
#define MK_N_LAUNCHES 1
#endif
extern "C" void kernel_launch(void* const* d_in, const int* in_sizes, int n_in, void* d_out, int out_size, void* d_ws, size_t ws_size, hipStream_t stream) {
    static int grid = 0;
    if (grid == 0) {
        if (n_in != 19 || in_sizes[0] != T * D || out_size != T * D || ws_size < WS_END) { fprintf(stderr, "kernel_launch: unexpected shapes (n_in %d, in0 %d, out %d, ws %zu); nothing launched\n", n_in, n_in > 0 ? in_sizes[0] : -1, out_size, ws_size); grid = -1; return; }
        int dev = 0, cus = 0, per_cu = 0;
        if (hipGetDevice(&dev) != hipSuccess || hipDeviceGetAttribute(&cus, hipDeviceAttributeMultiprocessorCount, dev) != hipSuccess) { fprintf(stderr, "kernel_launch: device query failed\n"); grid = -1; return; }
        if (hipFuncSetAttribute((const void*)hymba_fwd, hipFuncAttributeMaxDynamicSharedMemorySize, LDS_BYTES) != hipSuccess) { fprintf(stderr, "kernel_launch: hipFuncSetAttribute failed\n"); grid = -1; return; }
        if (hipOccupancyMaxActiveBlocksPerMultiprocessor(&per_cu, (const void*)hymba_fwd, NWAVES * 64, LDS_BYTES) != hipSuccess || per_cu < 1) fprintf(stderr, "kernel_launch: note: occupancy query reports %d workgroups per CU\n", per_cu);
        (void)hipGetLastError();
        grid = (cus / 64) * 64; if (grid > 256) grid = 256;
        if (grid < 64) { fprintf(stderr, "kernel_launch: %d CUs: unsupported\n", cus); grid = -1; return; }
    }
    if (grid < 0) return;
    if (hipMemsetAsync((char*)d_ws + WS_CTL, 0, CTL_ZERO_BYTES, stream) != hipSuccess) { fprintf(stderr, "kernel_launch: memset failed\n"); return; }
    Args a{};
    for (int i = 0; i < 19; ++i) a.in[i] = (const float*)d_in[i];
    a.out = (float*)d_out; a.ws = (unsigned char*)d_ws;
    constexpr int NPH = 8;
    if (MK_N_LAUNCHES == 1) { a.ph_lo = 0; a.ph_hi = NPH; hipLaunchKernelGGL(hymba_fwd, dim3(grid), dim3(NWAVES * 64), LDS_BYTES, stream, a); }
    else for (int p = 0; p < NPH; ++p) { a.ph_lo = p; a.ph_hi = p + 1; hipLaunchKernelGGL(hymba_fwd, dim3(grid), dim3(NWAVES * 64), LDS_BYTES, stream, a); }
    const hipError_t le = hipPeekAtLastError();
    if (le != hipSuccess) fprintf(stderr, "kernel_launch: launch failed: %s\n", hipGetErrorName(le));
}
```
